# Optimizing an MI355X kernel written in HIP

```python
import jax
import jax.numpy as jnp
from jax import lax
import numpy as np

D_MODEL = 1024
BATCH = 8
SEQ = 4096
DEPTH = 2

GRID_W = 64
CTX_LEN = 256
F32 = jnp.float32
EPS = 1e-6
NEG_INF = -1e30
HEAD_DIM = 64
ROPE_THETA = 10000.0

RET_HEADS = 4
RET_DK = 64
RET_DV = 128
RET_CHUNK = 128
WIN_HEADS = 8
WIN_KV_HEADS = 2
WINDOW = 128
WIN_BLOCK = 128
NA_HEADS = 8
NA_KH = 8
NA_KW = 16
NA_QCOLS = 16
NA_BAND = NA_QCOLS + NA_KW
GDN_HEADS = 4
GDN_DK = 128
GDN_DV = 128
GDN_CHUNK = 64
SHORT_CONV = 3
N_BRANCH = 4
BRANCH_W = 512
N_EXPERTS = 32
N_GROUPS = 8
EXPERTS_PER_GROUP = N_EXPERTS // N_GROUPS
TOP_K = 2
D_EXPERT = 512
MOE_BLOCK = 128

IN_LAYOUT = (
    ('ret_q', RET_HEADS * RET_DK), ('ret_k', RET_HEADS * RET_DK),
    ('ret_v', RET_HEADS * RET_DV), ('ret_g', RET_HEADS * RET_DV),
    ('win_q', WIN_HEADS * HEAD_DIM), ('win_k', WIN_KV_HEADS * HEAD_DIM), ('win_v', WIN_KV_HEADS * HEAD_DIM),
    ('na_q', NA_HEADS * HEAD_DIM), ('na_k', NA_HEADS * HEAD_DIM), ('na_v', NA_HEADS * HEAD_DIM),
    ('gdn_q', GDN_HEADS * GDN_DK), ('gdn_k', GDN_HEADS * GDN_DK), ('gdn_v', GDN_HEADS * GDN_DV),
    ('gdn_g', GDN_HEADS * GDN_DV), ('gdn_a', 2 * GDN_HEADS), ('gdn_b', 2 * GDN_HEADS),
)
IN_NAMES = tuple(n for n, _ in IN_LAYOUT)
IN_OFFSETS = tuple(sum(w for _, w in IN_LAYOUT[:i + 1]) for i in range(len(IN_LAYOUT) - 1))
D_IN = sum(w for _, w in IN_LAYOUT)
GDN_QKV = 2 * GDN_HEADS * GDN_DK + GDN_HEADS * GDN_DV

kernel_name = 'hybrid_prefix_dit_retention_window_natten_gdn_moe'


def rmsnorm(x, gain):
    xf = x.astype(F32)
    y = xf * lax.rsqrt(jnp.mean(xf * xf, axis=-1, keepdims=True) + EPS)
    return (y * gain.astype(F32)).astype(x.dtype)


def l2norm(x):
    return x * lax.rsqrt(jnp.sum(x * x, axis=-1, keepdims=True) + EPS)


def modulate(x, gain, shift, scale):
    return rmsnorm(x, gain) * (1.0 + scale) + shift


def to_heads(z, n_heads):
    b, l, _ = z.shape
    return z.reshape(b, l, n_heads, -1).transpose(0, 2, 1, 3)


def from_heads(z):
    b, h, l, d = z.shape
    return z.transpose(0, 2, 1, 3).reshape(b, l, h * d)


def flip_seq(a):
    return jnp.flip(a, axis=2)


def split_projection(z):
    return dict(zip(IN_NAMES, jnp.split(z, IN_OFFSETS, axis=-1)))


def axial_rope_tables(n_tokens, dim):
    t = jnp.arange(n_tokens)
    row = (t // GRID_W).astype(F32)
    col = (t % GRID_W).astype(F32)
    n_freq = dim // 4
    inv = ROPE_THETA ** (-jnp.arange(n_freq, dtype=F32) / n_freq)
    ang = jnp.concatenate([row[:, None] * inv, col[:, None] * inv], axis=-1)
    return jnp.cos(ang), jnp.sin(ang)


def apply_rope(x, cos, sin):
    xf = x.astype(F32)
    x1, x2 = jnp.split(xf, 2, axis=-1)
    return jnp.concatenate([x1 * cos - x2 * sin, x1 * sin + x2 * cos], axis=-1).astype(x.dtype)


def sink_softmax(s, sink):
    m = jnp.maximum(jnp.max(s, axis=-1, keepdims=True), sink)
    p = jnp.exp(s - m)
    return p / (jnp.sum(p, axis=-1, keepdims=True) + jnp.exp(sink - m))


def context_attention(q, k, v, sink):
    b, hq, lc, d = q.shape
    g = k.shape[1]
    qg = q.reshape(b, g, hq // g, lc, d)
    s = jnp.einsum('bgrqd,bgkd->bgrqk', qg, k).astype(F32) * d ** -0.5
    if sink is None:
        p = jax.nn.softmax(s, axis=-1)
    else:
        p = sink_softmax(s, sink.astype(F32).reshape(g, -1)[None, :, :, None, None])
    o = jnp.einsum('bgrqk,bgkd->bgrqd', p.astype(v.dtype), v)
    return o.reshape(b, hq, lc, d)


def retention_chunked(q, k, v, log_gamma, s0):
    b, h, l, dk = q.shape
    dv = v.shape[-1]
    c = RET_CHUNK
    n = l // c
    qc = q.reshape(b, h, n, c, dk)
    kc = k.reshape(b, h, n, c, dk)
    vc = v.reshape(b, h, n, c, dv)
    pos = jnp.arange(c, dtype=F32)
    diff = pos[:, None] - pos[None, :]
    dmask = jnp.where(diff >= 0, jnp.exp(log_gamma[:, None, None] * jnp.maximum(diff, 0.0)), 0.0)
    q_decay = jnp.exp(log_gamma[:, None] * (pos + 1.0))
    k_decay = jnp.exp(log_gamma[:, None] * (c - 1.0 - pos))
    chunk_decay = jnp.exp(log_gamma * c)
    scores = jnp.einsum('bhncd,bhnsd->bhncs', qc, kc) * dmask[None, :, None]
    o_intra = jnp.einsum('bhncs,bhnse->bhnce', scores, vc)
    kv = jnp.einsum('bhncd,bhnce->bhnde', kc * k_decay[None, :, None, :, None], vc)

    def step(s, kv_n):
        return chunk_decay[None, :, None, None] * s + kv_n, s

    s_fin, s_prev = lax.scan(step, s0, jnp.moveaxis(kv, 2, 0))
    s_prev = jnp.moveaxis(s_prev, 0, 2)
    o_inter = jnp.einsum('bhncd,bhnde->bhnce', qc * q_decay[None, :, None, :, None], s_prev)
    return (o_intra + o_inter).reshape(b, h, l, dv), s_fin


def retention_state(k, v, log_gamma):
    l = k.shape[2]
    w = jnp.exp(log_gamma[:, None] * (l - 1.0 - jnp.arange(l, dtype=F32)))
    return jnp.einsum('bhld,bhle->bhde', k * w[None, :, :, None], v)


def retention_output(o, gate, gain):
    mu = jnp.mean(o, axis=-1, keepdims=True)
    var = jnp.mean(jnp.square(o - mu), axis=-1, keepdims=True)
    y = from_heads((o - mu) * lax.rsqrt(var + EPS)) * gain.astype(F32)
    return (y * jax.nn.silu(gate.astype(F32))).astype(gate.dtype)


def retention_branch(zl, zc, decay_logit, gn_gain, cos, sin, ctx_out):
    log_gamma = jax.nn.log_sigmoid(decay_logit.astype(F32))

    def qkv(z):
        q = to_heads(z['ret_q'], RET_HEADS).astype(F32)
        k = to_heads(z['ret_k'], RET_HEADS).astype(F32) * RET_DK ** -0.5
        v = to_heads(z['ret_v'], RET_HEADS).astype(F32)
        return q, k, v

    qc, kc, vc = qkv(zc)
    ql, kl, vl = qkv(zl)
    ql = apply_rope(ql, cos, sin)
    kl = apply_rope(kl, cos, sin)
    s0 = jnp.zeros((ql.shape[0], RET_HEADS, RET_DK, RET_DV), F32)
    yc = None
    if ctx_out:
        oc_f, sc_f = retention_chunked(qc, kc, vc, log_gamma[0], s0)
        oc_b, sc_b = retention_chunked(flip_seq(qc), flip_seq(kc), flip_seq(vc), log_gamma[1], s0)
        yc = retention_output(oc_f + flip_seq(oc_b), zc['ret_g'], gn_gain)
    else:
        sc_f = retention_state(kc, vc, log_gamma[0])
        sc_b = retention_state(flip_seq(kc), flip_seq(vc), log_gamma[1])
    ol_f, _ = retention_chunked(ql, kl, vl, log_gamma[0], sc_f)
    ol_b, _ = retention_chunked(flip_seq(ql), flip_seq(kl), flip_seq(vl), log_gamma[1], sc_b)
    yl = retention_output(ol_f + flip_seq(ol_b), zl['ret_g'], gn_gain)
    return yc, yl


def window_attention(q, k, v, kc, vc, sink):
    b, hq, l, d = q.shape
    g = k.shape[1]
    r = hq // g
    nb = l // WIN_BLOCK
    span = WIN_BLOCK + 2 * WINDOW
    qg = (q * d ** -0.5).reshape(b, g, r, l, d)
    kp = jnp.pad(k, ((0, 0), (0, 0), (WINDOW, WINDOW), (0, 0)))
    vp = jnp.pad(v, ((0, 0), (0, 0), (WINDOW, WINDOW), (0, 0)))
    sink_b = sink.astype(F32).reshape(g, r)[None, :, :, None, None]

    def block(n):
        s0 = n * WIN_BLOCK
        qb = lax.dynamic_slice_in_dim(qg, s0, WIN_BLOCK, axis=3)
        kb = lax.dynamic_slice_in_dim(kp, s0, span, axis=2)
        vb = lax.dynamic_slice_in_dim(vp, s0, span, axis=2)
        qpos = s0 + jnp.arange(WIN_BLOCK)
        kpos = s0 - WINDOW + jnp.arange(span)
        ok = (kpos[None, :] >= 0) & (kpos[None, :] < l) & (jnp.abs(qpos[:, None] - kpos[None, :]) <= WINDOW)
        s_loc = jnp.where(ok, jnp.einsum('bgrqd,bgkd->bgrqk', qb, kb).astype(F32), NEG_INF)
        s_ctx = jnp.einsum('bgrqd,bgkd->bgrqk', qb, kc).astype(F32)
        p = sink_softmax(jnp.concatenate([s_loc, s_ctx], axis=-1), sink_b).astype(v.dtype)
        return (jnp.einsum('bgrqk,bgkd->bgrqd', p[..., :span], vb)
                + jnp.einsum('bgrqk,bgkd->bgrqd', p[..., span:], vc))

    out = lax.map(block, jnp.arange(nb))
    return jnp.moveaxis(out, 0, 3).reshape(b, hq, l, d)


def window_branch(zl, zc, q_gain, k_gain, sink, cos, sin, ctx_out):
    def qkv(z):
        q = rmsnorm(to_heads(z['win_q'], WIN_HEADS), q_gain)
        k = rmsnorm(to_heads(z['win_k'], WIN_KV_HEADS), k_gain)
        v = to_heads(z['win_v'], WIN_KV_HEADS)
        return q, k, v

    qc, kc, vc = qkv(zc)
    ql, kl, vl = qkv(zl)
    ql = apply_rope(ql, cos, sin)
    kl = apply_rope(kl, cos, sin)
    yl = from_heads(window_attention(ql, kl, vl, kc, vc, sink))
    yc = from_heads(context_attention(qc, kc, vc, sink)) if ctx_out else None
    return yc, yl


def neighborhood_attention(q, k, v, kc, vc, rpb):
    b, h, l, d = q.shape
    rows = l // GRID_W
    kh = min(NA_KH, rows)
    n_cb = GRID_W // NA_QCOLS
    qcol = np.arange(GRID_W).reshape(n_cb, NA_QCOLS)
    band0 = np.clip(qcol[:, 0] - NA_KW // 2, 0, GRID_W - NA_BAND)
    kcol = band0[:, None] + np.arange(NA_BAND)
    cstart = np.clip(qcol - NA_KW // 2, 0, GRID_W - NA_KW)
    col_ok = (kcol[:, None, :] >= cstart[:, :, None]) & (kcol[:, None, :] < cstart[:, :, None] + NA_KW)
    col_off = np.clip(kcol[:, None, :] - qcol[:, :, None] + NA_KW - 1, 0, 2 * NA_KW - 2)
    rstart = np.clip(np.arange(rows) - kh // 2, 0, rows - kh)
    row_off = rstart[:, None] + np.arange(kh)[None, :] - np.arange(rows)[:, None] + NA_KH - 1
    bias = rpb.astype(F32)[:, row_off[:, None, None, :, None], col_off[None, :, :, None, :]]
    bias = jnp.where(col_ok[None, None, :, :, None, :], bias, NEG_INF)
    bias = jnp.moveaxis(bias, 1, 0).reshape(rows, h, n_cb, NA_QCOLS, kh * NA_BAND)
    qg = (q * d ** -0.5).reshape(b, h, rows, n_cb, NA_QCOLS, d)
    kg = k.reshape(b, h, rows, GRID_W, d)
    vg = v.reshape(b, h, rows, GRID_W, d)

    def row_step(args):
        r, rs, bias_r = args
        qr = lax.dynamic_index_in_dim(qg, r, axis=2, keepdims=False)
        kr = lax.dynamic_slice_in_dim(kg, rs, kh, axis=2)[:, :, :, kcol]
        vr = lax.dynamic_slice_in_dim(vg, rs, kh, axis=2)[:, :, :, kcol]
        s_loc = jnp.einsum('bhcqd,bhicjd->bhcqij', qr, kr).astype(F32)
        s_loc = s_loc.reshape(b, h, n_cb, NA_QCOLS, kh * NA_BAND) + bias_r
        s_ctx = jnp.einsum('bhcqd,bhkd->bhcqk', qr, kc).astype(F32)
        p = jax.nn.softmax(jnp.concatenate([s_loc, s_ctx], axis=-1), axis=-1).astype(v.dtype)
        p_loc = p[..., :kh * NA_BAND].reshape(b, h, n_cb, NA_QCOLS, kh, NA_BAND)
        o = (jnp.einsum('bhcqij,bhicjd->bhcqd', p_loc, vr)
             + jnp.einsum('bhcqk,bhkd->bhcqd', p[..., kh * NA_BAND:], vc))
        return o.reshape(b, h, GRID_W, d)

    out = lax.map(row_step, (jnp.arange(rows, dtype=jnp.int32), jnp.asarray(rstart, jnp.int32), bias))
    return jnp.moveaxis(out, 0, 2).reshape(b, h, l, d)


def neighborhood_branch(zl, zc, q_gain, k_gain, rpb, ctx_out):
    def qkv(z):
        q = rmsnorm(to_heads(z['na_q'], NA_HEADS), q_gain)
        k = rmsnorm(to_heads(z['na_k'], NA_HEADS), k_gain)
        v = to_heads(z['na_v'], NA_HEADS)
        return q, k, v

    qc, kc, vc = qkv(zc)
    ql, kl, vl = qkv(zl)
    yl = from_heads(neighborhood_attention(ql, kl, vl, kc, vc, rpb))
    yc = from_heads(context_attention(qc, kc, vc, None)) if ctx_out else None
    return yc, yl


def short_conv(z, w):
    taps, l = w.shape[0], z.shape[1]
    pad = taps // 2
    zp = jnp.pad(z, ((0, 0), (pad, pad), (0, 0)))
    return sum(zp[:, j:j + l] * w[j] for j in range(taps))


def gated_delta_chunked(q, k, v, g, beta, s0, with_out):
    b, h, l, dk = k.shape
    dv = v.shape[-1]
    c = GDN_CHUNK
    n = l // c
    kc = k.reshape(b, h, n, c, dk)
    vc = v.reshape(b, h, n, c, dv)
    gcum = jnp.cumsum(g.reshape(b, h, n, c), axis=-1)
    bc = beta.reshape(b, h, n, c)
    incl = jnp.asarray(np.tril(np.ones((c, c), bool)))
    strict = jnp.asarray(np.tril(np.ones((c, c), bool), -1))
    gdiff = gcum[..., :, None] - gcum[..., None, :]
    decay = jnp.where(incl, jnp.exp(jnp.where(incl, gdiff, 0.0)), 0.0)
    kb = kc * bc[..., None]
    a_low = jnp.where(strict, jnp.einsum('bhnid,bhnjd->bhnij', kb, kc) * decay, 0.0)
    rhs = jnp.concatenate([vc * bc[..., None], kb * jnp.exp(gcum)[..., None]], axis=-1)
    sol = lax.linalg.triangular_solve(a_low + jnp.eye(c, dtype=F32), rhs, left_side=True, lower=True)
    u, w = sol[..., :dv], sol[..., dv:]
    k_end = kc * jnp.exp(gcum[..., -1:] - gcum)[..., None]
    c_decay = jnp.exp(gcum[..., -1])

    def mv(a):
        return jnp.moveaxis(a, 2, 0)

    if with_out:
        qc = q.reshape(b, h, n, c, dk)
        q_dec = qc * jnp.exp(gcum)[..., None]
        a_qk = jnp.where(incl, jnp.einsum('bhnid,bhnjd->bhnij', qc, kc) * decay, 0.0)

        def step(s, xs):
            qd, ke, u_n, w_n, aq, cd = xs
            v_new = u_n - jnp.einsum('bhcd,bhde->bhce', w_n, s)
            o = jnp.einsum('bhcd,bhde->bhce', qd, s) + jnp.einsum('bhcs,bhse->bhce', aq, v_new)
            s = s * cd[..., None, None] + jnp.einsum('bhcd,bhce->bhde', ke, v_new)
            return s, o

        s_fin, o = lax.scan(step, s0, (mv(q_dec), mv(k_end), mv(u), mv(w), mv(a_qk), mv(c_decay)))
        return jnp.moveaxis(o, 0, 2).reshape(b, h, l, dv), s_fin

    def step_state(s, xs):
        ke, u_n, w_n, cd = xs
        v_new = u_n - jnp.einsum('bhcd,bhde->bhce', w_n, s)
        return s * cd[..., None, None] + jnp.einsum('bhcd,bhce->bhde', ke, v_new), None

    s_fin, _ = lax.scan(step_state, s0, (mv(k_end), mv(u), mv(w), mv(c_decay)))
    return None, s_fin


def gdn_output(o, gate, gain):
    y = o * lax.rsqrt(jnp.mean(o * o, axis=-1, keepdims=True) + EPS) * gain.astype(F32)
    return (from_heads(y) * jax.nn.silu(gate.astype(F32))).astype(gate.dtype)


def gdn_branch(zl, zc, conv_w, a_log, dt_bias, norm_gain, ctx_out):
    def prep(z):
        b, l, _ = z['gdn_q'].shape
        qkv = jnp.concatenate([z['gdn_q'], z['gdn_k'], z['gdn_v']], axis=-1)
        qkv = jax.nn.silu(short_conv(qkv, conv_w)).astype(F32)
        q, k, v = jnp.split(qkv, [GDN_HEADS * GDN_DK, 2 * GDN_HEADS * GDN_DK], axis=-1)
        q = l2norm(to_heads(q, GDN_HEADS)) * GDN_DK ** -0.5
        k = l2norm(to_heads(k, GDN_HEADS))
        v = to_heads(v, GDN_HEADS)
        a = z['gdn_a'].astype(F32).reshape(b, l, 2, GDN_HEADS)
        bb = z['gdn_b'].astype(F32).reshape(b, l, 2, GDN_HEADS)
        g = -jnp.exp(a_log.astype(F32)) * jax.nn.softplus(a + dt_bias.astype(F32))
        beta = jax.nn.sigmoid(bb)
        return q, k, v, jnp.transpose(g, (2, 0, 3, 1)), jnp.transpose(beta, (2, 0, 3, 1))

    qc, kc, vc, gc, bc = prep(zc)
    ql, kl, vl, gl, bl = prep(zl)
    s0 = jnp.zeros((ql.shape[0], GDN_HEADS, GDN_DK, GDN_DV), F32)
    oc_f, sc_f = gated_delta_chunked(qc, kc, vc, gc[0], bc[0], s0, ctx_out)
    oc_b, sc_b = gated_delta_chunked(flip_seq(qc), flip_seq(kc), flip_seq(vc),
                                     flip_seq(gc[1]), flip_seq(bc[1]), s0, ctx_out)
    ol_f, _ = gated_delta_chunked(ql, kl, vl, gl[0], bl[0], sc_f, True)
    ol_b, _ = gated_delta_chunked(flip_seq(ql), flip_seq(kl), flip_seq(vl),
                                  flip_seq(gl[1]), flip_seq(bl[1]), sc_b, True)
    yl = gdn_output(ol_f + flip_seq(ol_b), zl['gdn_g'], norm_gain)
    yc = gdn_output(oc_f + flip_seq(oc_b), zc['gdn_g'], norm_gain) if ctx_out else None
    return yc, yl


def merge_branches(h, ys, w_merge, w_branch, w_out):
    acc = 0.0
    for i, y in enumerate(ys):
        gate = jax.nn.sigmoid(h @ w_merge[:, i * D_MODEL:(i + 1) * D_MODEL])
        acc = acc + gate * (y @ w_branch[i])
    return acc @ w_out


def moe(h, w_router, router_bias, w_gate, w_up, w_down):
    t, d = h.shape
    scores = jax.nn.sigmoid((h @ w_router).astype(F32))
    sel = (scores + router_bias.astype(F32)).reshape(t, N_GROUPS, EXPERTS_PER_GROUP)
    grp_score = jnp.sum(lax.top_k(sel, 2)[0], axis=-1)
    g_idx = jnp.argmax(grp_score, axis=-1)
    in_grp = jnp.take_along_axis(sel, g_idx[:, None, None], axis=1)[:, 0]
    _, local = lax.top_k(in_grp, TOP_K)
    e_idx = g_idx[:, None] * EXPERTS_PER_GROUP + local
    wts = jnp.take_along_axis(scores, e_idx, axis=1)
    wts = wts / jnp.sum(wts, axis=-1, keepdims=True)
    a = t * TOP_K
    flat_e = e_idx.reshape(-1)
    flat_tok = jnp.repeat(jnp.arange(t, dtype=jnp.int32), TOP_K)
    flat_w = wts.reshape(-1).astype(h.dtype)
    order = jnp.argsort(flat_e)
    se, stok, sw = flat_e[order], flat_tok[order], flat_w[order]
    counts = jnp.bincount(flat_e, length=N_EXPERTS)
    starts = jnp.cumsum(counts) - counts
    padded = (counts + MOE_BLOCK - 1) // MOE_BLOCK * MOE_BLOCK
    ends = jnp.cumsum(padded)
    pstarts = ends - padded
    dest = pstarts[se] + jnp.arange(a) - starts[se]
    n_blocks = -(-a // MOE_BLOCK) + N_EXPERTS
    size = n_blocks * MOE_BLOCK
    tok_buf = jnp.full((size,), t, jnp.int32).at[dest].set(stok)
    w_buf = jnp.zeros((size,), h.dtype).at[dest].set(sw)
    block_e = jnp.minimum(jnp.searchsorted(ends, jnp.arange(n_blocks) * MOE_BLOCK, side='right'), N_EXPERTS - 1)
    h_pad = jnp.concatenate([h, jnp.zeros((1, d), h.dtype)], axis=0)
    xb = h_pad[tok_buf].reshape(n_blocks, MOE_BLOCK, d)

    def run(args):
        xe, e = args
        return (jax.nn.silu(xe @ w_gate[e]) * (xe @ w_up[e])) @ w_down[e]

    yb = lax.map(run, (xb, block_e)).reshape(size, d)
    out = jnp.zeros((t + 1, d), h.dtype).at[tok_buf].add(yb * w_buf[:, None])
    return out[:t]


def trunk_layer(xl, xc, c, c_ctx, p, w_router, router_bias, cos, sin, ctx_out):
    mod_l = (jax.nn.silu(c) @ p['w_mod'] + p['b_mod'])[:, None, :]
    mod_c = (jax.nn.silu(c_ctx) @ p['w_mod'] + p['b_mod'])[None, None, :]
    sh1l, sc1l, g1l, sh2l, sc2l, g2l = jnp.split(mod_l, 6, axis=-1)
    sh1c, sc1c, g1c, sh2c, sc2c, g2c = jnp.split(mod_c, 6, axis=-1)
    hl = modulate(xl, p['norm1'], sh1l, sc1l)
    hc = modulate(xc, p['norm1'], sh1c, sc1c)
    zl = split_projection(hl @ p['w_in'])
    zc = split_projection(hc @ p['w_in'])
    ret_c, ret_l = retention_branch(zl, zc, p['ret_decay'], p['ret_gn'], cos, sin, ctx_out)
    win_c, win_l = window_branch(zl, zc, p['win_qnorm'], p['win_knorm'], p['win_sink'], cos, sin, ctx_out)
    na_c, na_l = neighborhood_branch(zl, zc, p['na_qnorm'], p['na_knorm'], p['na_rpb'], ctx_out)
    gdn_c, gdn_l = gdn_branch(zl, zc, p['gdn_conv'], p['gdn_a_log'], p['gdn_dt_bias'], p['gdn_norm'], ctx_out)
    xl = xl + g1l * merge_branches(hl, (ret_l, win_l, na_l, gdn_l), p['w_merge'], p['w_branch'], p['w_out'])
    hl2 = modulate(xl, p['norm2'], sh2l, sc2l)
    b, l, d = xl.shape
    if not ctx_out:
        y = moe(hl2.reshape(b * l, d), w_router, router_bias, p['w_e_gate'], p['w_e_up'], p['w_e_down'])
        return xl + g2l * y.reshape(b, l, d), xc
    xc = xc + g1c * merge_branches(hc, (ret_c, win_c, na_c, gdn_c), p['w_merge'], p['w_branch'], p['w_out'])
    hc2 = modulate(xc, p['norm2'], sh2c, sc2c)
    lc = xc.shape[1]
    tokens = jnp.concatenate([hc2.reshape(b * lc, d), hl2.reshape(b * l, d)], axis=0)
    y = moe(tokens, w_router, router_bias, p['w_e_gate'], p['w_e_up'], p['w_e_down'])
    xc = xc + g2c * y[:b * lc].reshape(b, lc, d)
    xl = xl + g2l * y[b * lc:].reshape(b, l, d)
    return xl, xc


def setup_inputs(seed: int = 0) -> dict:
    key = jax.random.key(seed)
    ks = iter(jax.random.split(key, 40))
    D = D_MODEL

    def nrm(shape, scale):
        return scale * jax.random.normal(next(ks), shape, F32)

    def unif(shape, lo, hi):
        return jax.random.uniform(next(ks), shape, F32, lo, hi)

    gamma0 = 1.0 - 2.0 ** (-5.0 - jnp.arange(RET_HEADS, dtype=F32))
    dt = jnp.exp(unif((DEPTH, 2, GDN_HEADS), float(np.log(1e-3)), float(np.log(1e-1))))
    return {
        'x': nrm((BATCH, SEQ, D), 1.0),
        'c': nrm((BATCH, D), 1.0),
        'ctx': nrm((BATCH, CTX_LEN, D), 1.0),
        'c_ctx': nrm((D,), 1.0),
        'w_mod': nrm((DEPTH, D, 6 * D), 0.5 * D ** -0.5),
        'b_mod': nrm((DEPTH, 6 * D), 0.01),
        'norm1': 1.0 + nrm((DEPTH, D), 0.02),
        'norm2': 1.0 + nrm((DEPTH, D), 0.02),
        'w_in': nrm((DEPTH, D, D_IN), D ** -0.5),
        'ret_decay': jnp.log(gamma0 / (1.0 - gamma0))[None, None, :] + nrm((DEPTH, 2, RET_HEADS), 0.1),
        'ret_gn': 1.0 + nrm((DEPTH, RET_HEADS * RET_DV), 0.02),
        'win_qnorm': 1.0 + nrm((DEPTH, HEAD_DIM), 0.02),
        'win_knorm': 1.0 + nrm((DEPTH, HEAD_DIM), 0.02),
        'win_sink': nrm((DEPTH, WIN_HEADS), 0.5),
        'na_qnorm': 1.0 + nrm((DEPTH, HEAD_DIM), 0.02),
        'na_knorm': 1.0 + nrm((DEPTH, HEAD_DIM), 0.02),
        'na_rpb': nrm((DEPTH, NA_HEADS, 2 * NA_KH - 1, 2 * NA_KW - 1), 0.02),
        'gdn_conv': nrm((DEPTH, SHORT_CONV, GDN_QKV), SHORT_CONV ** -0.5),
        'gdn_a_log': jnp.log(unif((DEPTH, 2, GDN_HEADS), 1.0, 16.0)),
        'gdn_dt_bias': dt + jnp.log(-jnp.expm1(-dt)),
        'gdn_norm': 1.0 + nrm((DEPTH, GDN_DV), 0.02),
        'w_branch': nrm((DEPTH, N_BRANCH, BRANCH_W, D), BRANCH_W ** -0.5),
        'w_merge': nrm((DEPTH, D, N_BRANCH * D), D ** -0.5),
        'w_out': nrm((DEPTH, D, D), D ** -0.5),
        'w_router': nrm((D, N_EXPERTS), D ** -0.5),
        'router_bias': nrm((N_EXPERTS,), 0.01),
        'w_e_gate': nrm((DEPTH, N_EXPERTS, D, D_EXPERT), D ** -0.5),
        'w_e_up': nrm((DEPTH, N_EXPERTS, D, D_EXPERT), D ** -0.5),
        'w_e_down': nrm((DEPTH, N_EXPERTS, D_EXPERT, D), D_EXPERT ** -0.5),
    }


def reference(x, c, ctx, c_ctx, w_mod, b_mod, norm1, norm2, w_in, ret_decay, ret_gn, win_qnorm, win_knorm,
              win_sink, na_qnorm, na_knorm, na_rpb, gdn_conv, gdn_a_log, gdn_dt_bias, gdn_norm, w_branch,
              w_merge, w_out, w_router, router_bias, w_e_gate, w_e_up, w_e_down):
    cos, sin = axial_rope_tables(x.shape[1], HEAD_DIM)
    xl, xc = x, ctx
    for layer in range(DEPTH):
        p = {
            'w_mod': w_mod[layer], 'b_mod': b_mod[layer], 'norm1': norm1[layer], 'norm2': norm2[layer],
            'w_in': w_in[layer], 'ret_decay': ret_decay[layer], 'ret_gn': ret_gn[layer],
            'win_qnorm': win_qnorm[layer], 'win_knorm': win_knorm[layer], 'win_sink': win_sink[layer],
            'na_qnorm': na_qnorm[layer], 'na_knorm': na_knorm[layer], 'na_rpb': na_rpb[layer],
            'gdn_conv': gdn_conv[layer], 'gdn_a_log': gdn_a_log[layer], 'gdn_dt_bias': gdn_dt_bias[layer],
            'gdn_norm': gdn_norm[layer], 'w_branch': w_branch[layer], 'w_merge': w_merge[layer],
            'w_out': w_out[layer], 'w_e_gate': w_e_gate[layer], 'w_e_up': w_e_up[layer],
            'w_e_down': w_e_down[layer],
        }
        xl, xc = trunk_layer(xl, xc, c, c_ctx, p, w_router, router_bias, cos, sin, layer < DEPTH - 1)
    return xl
```

```cpp
#include <hip/hip_runtime.h>
#include <cstdio>
#include <cstdint>

#define LAS __attribute__((address_space(3)))
#define GAS __attribute__((address_space(1)))
typedef unsigned short bf16_t;
typedef short bf16x8 __attribute__((ext_vector_type(8)));
typedef short s16x4 __attribute__((ext_vector_type(4)));
typedef float f32x4 __attribute__((ext_vector_type(4)));
typedef float f32x2 __attribute__((ext_vector_type(2)));
typedef unsigned u32x4 __attribute__((ext_vector_type(4)));
typedef unsigned u32x2 __attribute__((ext_vector_type(2)));

__device__ __forceinline__ unsigned f2bf(float f) { unsigned u = __builtin_bit_cast(unsigned, f); return (u + 0x7fffu + ((u >> 16) & 1u)) >> 16; }
__device__ __forceinline__ unsigned pk2(float lo, float hi) { return f2bf(lo) | (f2bf(hi) << 16); }
__device__ __forceinline__ float bflo(unsigned u) { return __builtin_bit_cast(float, u << 16); }
__device__ __forceinline__ float bfhi(unsigned u) { return __builtin_bit_cast(float, u & 0xffff0000u); }
__device__ __forceinline__ float bf2f(bf16_t h) { return __builtin_bit_cast(float, (unsigned)h << 16); }
__device__ __forceinline__ float sigmoidf_(float x) { return 1.0f / (1.0f + __expf(-x)); }
__device__ __forceinline__ float siluf_(float x) { return x / (1.0f + __expf(-x)); }

__device__ __forceinline__ int OTID() { int t = threadIdx.x; asm volatile("" : "+v"(t)); return t; }
__device__ __forceinline__ int OBLK() { int t = blockIdx.x; asm volatile("" : "+s"(t)); return t; }
__device__ __forceinline__ int OGRID() { int t = gridDim.x; asm volatile("" : "+s"(t)); return t; }

namespace pg8 {
constexpr int BM = 256, BK = 64, HALF = 128, HTB = HALF * BK * 2, STAGE_BYTES = 8 * HTB, NXCD = 8, WGM = 8;
__host__ __device__ __forceinline__ int lds_byte(int r, int c) { const int st = (r >> 4) * 2 + (c >> 5), rr = r & 15, cc = c & 31, ob = rr * 64 + cc * 2; return st * 1024 + (ob ^ (((ob >> 9) & 1) << 5)); }
__host__ __device__ __forceinline__ void stage_rc(int b, int& R, int& C) { const int st = b / 1024, sb = b % 1024, swz = sb ^ (((sb >> 9) & 1) << 5); R = (st >> 1) * 16 + swz / 64; C = (st & 1) * 32 + (swz % 64) / 2; }
__host__ __device__ __forceinline__ int perm32(int rho) { const int n = rho >> 4, i = rho & 15; return 8 * (i >> 2) + 4 * n + (i & 3); }

struct Unit { int pm, pn, aux; };

template <class Epi, class Sched, bool ALIGN_EPI>
__device__ __forceinline__ void gemm_phase(LAS unsigned char* lds, const int K, const int lda, const int ldb, const Sched& S, const Epi& E) {
    const int tid = OTID(), wid = __builtin_amdgcn_readfirstlane(tid >> 6), lane = tid & 63, wr = wid >> 2, wc = wid & 3, fr = lane & 15, fq = lane >> 4;
    const int nt = K / BK;
    unsigned voffA[2], voffB[2];
#pragma unroll
    for (int i = 0; i < 2; ++i) { int R, C; stage_rc(tid * 16 + i * 8192, R, C); const int Rb = (R & ~31) + perm32(R & 31);
        voffA[i] = (unsigned)(R * lda + C) * 2u; voffB[i] = (unsigned)(Rb * ldb + C) * 2u; }
    const size_t kstep = (size_t)(BK * 2);
    const size_t hstepA = (size_t)HALF * lda * 2, hstepB = (size_t)HALF * ldb * 2;
    const unsigned ldsw = (unsigned)wid * 1024u;
    const int aoff = lds_byte(wr * 64 + fr, fq * 8), boff = lds_byte(wc * 32 + fr, fq * 8);
#define PG8_SA(b, h) (((b) * 2 + (h)) * HTB)
#define PG8_SB(b, h) ((4 + (b) * 2 + (h)) * HTB)
#define PG8_STAGE(bufoff, gbase, voff) do { _Pragma("unroll") for (int _i = 0; _i < 2; ++_i) \
        __builtin_amdgcn_global_load_lds((const unsigned*)((const char*)(gbase) + (voff)[_i]), (LAS unsigned*)(lds + (bufoff) + ldsw + _i * 8192), 16, 0, 0); } while (0)
#define PG8_LDA(dst, b, h) do { _Pragma("unroll") for (int m = 0; m < 4; ++m) _Pragma("unroll") for (int k = 0; k < 2; ++k) dst[m][k] = *(const LAS bf16x8*)(lds + PG8_SA(b, h) + aoff + m * 2048 + k * 1024); } while (0)
#define PG8_LDB(dst, b, h) do { _Pragma("unroll") for (int n = 0; n < 2; ++n) _Pragma("unroll") for (int k = 0; k < 2; ++k) dst[n][k] = *(const LAS bf16x8*)(lds + PG8_SB(b, h) + boff + n * 2048 + k * 1024); } while (0)
#define PG8_MMA(ai, bj, At, Bt) do { __builtin_amdgcn_s_setprio(1); _Pragma("unroll") for (int m = 0; m < 4; ++m) _Pragma("unroll") for (int n = 0; n < 2; ++n) _Pragma("unroll") for (int k = 0; k < 2; ++k) \
        acc[ai][bj][m][n] = __builtin_amdgcn_mfma_f32_16x16x32_bf16(Bt[n][k], At[m][k], acc[ai][bj][m][n], 0, 0, 0); __builtin_amdgcn_s_setprio(0); } while (0)
#define PG8_WAIT_V(n) asm volatile("s_waitcnt vmcnt(" #n ")" ::: "memory")
#define PG8_WAIT_L(n) asm volatile("s_waitcnt lgkmcnt(" #n ")" ::: "memory")
#define PG8_BAR __builtin_amdgcn_s_barrier()
#define PG8_SCHED __builtin_amdgcn_sched_barrier(0)
    Unit cur, nxt; int ui = 0;
    if (!S.next(0, cur)) return;
    f32x4 acc[2][2][4][2];
#pragma unroll
    for (int a = 0; a < 2; ++a)
#pragma unroll
        for (int b = 0; b < 2; ++b)
#pragma unroll
            for (int m = 0; m < 4; ++m)
#pragma unroll
                for (int n = 0; n < 2; ++n) acc[a][b][m][n] = (f32x4){0.f, 0.f, 0.f, 0.f};
    bf16x8 At[4][2], B0[2][2], B1[2][2];
    const char* cA = S.A(cur); const char* cB = S.B(cur);
    PG8_STAGE(PG8_SB(0, 0), cB, voffB); PG8_STAGE(PG8_SB(0, 1), cB + hstepB, voffB); PG8_STAGE(PG8_SA(0, 0), cA, voffA); PG8_STAGE(PG8_SA(0, 1), cA + hstepA, voffA);
    if (wr == 1) PG8_BAR;
    PG8_WAIT_V(2); PG8_BAR;
    PG8_STAGE(PG8_SB(1, 0), cB + kstep, voffB); PG8_STAGE(PG8_SA(1, 0), cA + kstep, voffA); PG8_STAGE(PG8_SB(1, 1), cB + hstepB + kstep, voffB);
    PG8_WAIT_V(6); PG8_BAR;
    for (;;) {
        const bool has_next = S.next(ui + 1, nxt);
        const char* nA = has_next ? S.A(nxt) : cA; const char* nB = has_next ? S.B(nxt) : cB;
        for (int t = 0; t < nt; t += 2) {
            const bool last = (t == nt - 2);
            const char* a1 = cA + (size_t)(t + 1) * kstep;
            const char* a2 = last ? nA : cA + (size_t)(t + 2) * kstep; const char* b2 = last ? nB : cB + (size_t)(t + 2) * kstep;
            const char* a3 = a2 + kstep; const char* b3 = b2 + kstep;
            PG8_LDB(B0, 0, 0); PG8_LDB(B1, 0, 1); PG8_SCHED; PG8_LDA(At, 0, 0); PG8_STAGE(PG8_SA(1, 1), a1 + hstepA, voffA);
            PG8_WAIT_V(8); PG8_WAIT_L(0); PG8_BAR; PG8_MMA(0, 0, At, B0); PG8_MMA(0, 1, At, B1); PG8_BAR; PG8_SCHED;
            PG8_LDA(At, 0, 1); PG8_STAGE(PG8_SB(0, 0), b2, voffB); PG8_STAGE(PG8_SB(0, 1), b2 + hstepB, voffB); PG8_STAGE(PG8_SA(0, 0), a2, voffA);
            PG8_WAIT_V(8); PG8_WAIT_L(0); PG8_BAR; PG8_MMA(1, 0, At, B0); PG8_MMA(1, 1, At, B1); PG8_BAR; PG8_SCHED;
            PG8_LDB(B0, 1, 0); PG8_LDB(B1, 1, 1); PG8_SCHED; PG8_LDA(At, 1, 0); PG8_STAGE(PG8_SA(0, 1), a2 + hstepA, voffA);
            PG8_WAIT_V(8); PG8_WAIT_L(0); PG8_BAR; PG8_MMA(0, 0, At, B0); PG8_MMA(0, 1, At, B1); PG8_BAR; PG8_SCHED;
            PG8_LDA(At, 1, 1); PG8_STAGE(PG8_SB(1, 0), b3, voffB); PG8_STAGE(PG8_SB(1, 1), b3 + hstepB, voffB); PG8_STAGE(PG8_SA(1, 0), a3, voffA);
            PG8_WAIT_V(8); PG8_WAIT_L(0); PG8_BAR; PG8_MMA(1, 0, At, B0); PG8_MMA(1, 1, At, B1); PG8_BAR; PG8_SCHED;
        }
        if constexpr (ALIGN_EPI) { if (wr == 0) PG8_BAR; }
        E(acc, cur, wr, wc, fr, fq);
        if (!has_next) break;
#pragma unroll
        for (int a = 0; a < 2; ++a)
#pragma unroll
            for (int b = 0; b < 2; ++b)
#pragma unroll
                for (int m = 0; m < 4; ++m)
#pragma unroll
                    for (int n = 0; n < 2; ++n) acc[a][b][m][n] = (f32x4){0.f, 0.f, 0.f, 0.f};
        cur = nxt; cA = nA; cB = nB; ++ui;
        if constexpr (ALIGN_EPI) { if (wr == 1) PG8_BAR; }
    }
    PG8_WAIT_V(0);
    if constexpr (!ALIGN_EPI) { if (wr == 0) PG8_BAR; }
    PG8_BAR;
#undef PG8_SA
#undef PG8_SB
#undef PG8_STAGE
#undef PG8_LDA
#undef PG8_LDB
#undef PG8_MMA
#undef PG8_WAIT_V
#undef PG8_WAIT_L
#undef PG8_BAR
#undef PG8_SCHED
}
}
#define XB_TMO      128
#define XB_XCNT(j)  (256  + 64 * (j))
#define XB_XSUB(j)  (1280 + 64 * (j))
#define XB_XGEN(j)  (2304 + 64 * (j))
#define XB_TOP      3328
#define XB_TOPGEN   3392
#define XCD_BAR_WORDS 3456
#define XB_SPIN_CAP (1u << 22)
__device__ __forceinline__ unsigned xb_ld(unsigned* p)              { return __hip_atomic_load(p, __ATOMIC_RELAXED, __HIP_MEMORY_SCOPE_AGENT); }
__device__ __forceinline__ unsigned xb_add(unsigned* p, unsigned v) { return __hip_atomic_fetch_add(p, v, __ATOMIC_RELAXED, __HIP_MEMORY_SCOPE_AGENT); }
__device__ __forceinline__ unsigned xb_xcc_id() { return (unsigned)__builtin_amdgcn_s_getreg((3 << 11) | 20) & 0xFu; }
#define XB_SPIN(cond, bar) do { unsigned _sp = 0; while (cond) { __builtin_amdgcn_s_sleep(1); \
    if ((++_sp & 255u) == 0u) { if (xb_ld(&(bar)[XB_TMO])) break; if (_sp > XB_SPIN_CAP) { atomicAdd(&(bar)[XB_TMO], 1u); break; } } } } while (0)
struct XcdBarrier { unsigned* bar; unsigned x; volatile LAS unsigned* st; };
__device__ __forceinline__ XcdBarrier xcd_barrier_post(unsigned* bar, volatile LAS unsigned* st) {
    XcdBarrier b; b.bar = bar; b.x = xb_xcc_id(); b.st = st;
    if (threadIdx.x == 0) (void)xb_add(&bar[XB_XCNT(b.x)], 1u);
    return b;
}
__device__ __forceinline__ void xcd_barrier_complete(unsigned* bar, unsigned x, unsigned& nloc, unsigned& nx) {
    const unsigned G = gridDim.x * gridDim.y * gridDim.z;
    unsigned sum, cnt, mine, sp = 0u;
    for (;;) {
        sum = 0u; cnt = 0u; mine = 0u;
#pragma unroll 1
        for (unsigned j = 0; j < 16; ++j) { const unsigned c = xb_ld(&bar[XB_XCNT(j)]); sum += c; cnt += (c > 0u) ? 1u : 0u; mine = (j == x) ? c : mine; }
        if (sum == G) break;
        __builtin_amdgcn_s_sleep(1);
        if ((++sp & 255u) == 0u) { if (xb_ld(&bar[XB_TMO])) break; if (sp > XB_SPIN_CAP) { atomicAdd(&bar[XB_TMO], 1u); break; } }
    }
    nloc = mine > 0u ? mine : 1u; nx = cnt > 0u ? cnt : 1u;
}
__device__ __attribute__((noinline)) void xcd_barrier_impl(unsigned* bbar, unsigned bx, volatile LAS unsigned* bst) {
    XcdBarrier b; b.bar = bbar; b.x = bx; b.st = bst;
    asm volatile("s_waitcnt vmcnt(0)" ::: "memory");
    __syncthreads();
    if (threadIdx.x == 0) {
        unsigned* bar = b.bar;
        __builtin_amdgcn_s_waitcnt(0);
        unsigned nloc = b.st[0], nx = b.st[1];
        if (nloc == 0u) { xcd_barrier_complete(bar, b.x, nloc, nx); b.st[0] = nloc; b.st[1] = nx; }
        const unsigned old = xb_add(&bar[XB_XSUB(b.x)], 1u);
        const unsigned gen = old / nloc;
        if (old + 1u == (gen + 1u) * nloc) {
            __builtin_amdgcn_fence(__ATOMIC_RELEASE, "agent");
            asm volatile("s_waitcnt vmcnt(0)" ::: "memory");
            const unsigned og = xb_add(&bar[XB_TOP], 1u);
            const unsigned tg = og / nx;
            if (og + 1u == (tg + 1u) * nx) xb_add(&bar[XB_TOPGEN], 1u);
            else XB_SPIN(xb_ld(&bar[XB_TOPGEN]) == tg, bar);
            __builtin_amdgcn_fence(__ATOMIC_ACQUIRE, "agent");
            xb_add(&bar[XB_XGEN(b.x)], 1u);
            asm volatile("s_waitcnt vmcnt(0)" ::: "memory");
        } else {
            XB_SPIN(xb_ld(&bar[XB_XGEN(b.x)]) == gen, bar);
            __builtin_amdgcn_fence(__ATOMIC_ACQUIRE, "agent");
            asm volatile("s_waitcnt vmcnt(0)" ::: "memory");
        }
    }
    __syncthreads();
}
__device__ __forceinline__ void xcd_barrier(const XcdBarrier& b) { xcd_barrier_impl(b.bar, b.x, b.st); }

constexpr int D = 1024, NBATCH = 8, SEQ = 4096, CTXL = 256, ML = NBATCH * SEQ, MC = NBATCH * CTXL, MA = ML + MC;
constexpr int ZP = 6144, PP = 1536;
constexpr int C_RQ = 0, C_RK = 256, C_RV = 512, C_RG = 1024, C_WQ = 1536, C_WK = 2048, C_WV = 2176, C_NQ = 2304, C_NK = 2816, C_NV = 3328,
              C_GQ = 3840, C_GK = 4352, C_GV = 4864, C_GG = 5376, C_GA = 5888, C_GB = 5896;
constexpr int C_GTMP = 3840, C_RTMP = 4352, C_GSUM = 4864, C_RSUM = 512;
constexpr int Y_RET = C_RG, Y_WIN = C_WQ, Y_NA = C_NQ, Y_GDN = C_GG;
__host__ __device__ __forceinline__ int dead_tile(int gt) { return gt < 4 ? gt : (gt == 4 ? 8 : (gt < 15 ? gt + 6 : 23)); }
constexpr float EPS = 1e-6f;
constexpr int NEXP = 32, DEXP = 512, MAXT = 304;
constexpr int NWAVES = 8, NTHR = 512;

constexpr size_t MiB = 1u << 20;
constexpr size_t WS_CTL = 0, CTL_ZERO_BYTES = 1 * MiB;
constexpr size_t WS_ROPE = 1 * MiB;
constexpr size_t WS_MOD = 2 * MiB;
constexpr size_t WS_XC = 3 * MiB;
constexpr size_t WS_GB = 11 * MiB;
constexpr size_t WS_TOK = 14 * MiB;
constexpr size_t WS_WSM = 16 * MiB;
constexpr size_t WSM_LAYER = 26 * MiB, WSM_IN = 0, WSM_MERGE = 12 * MiB, WSM_BR = 20 * MiB, WSM_OUT = 24 * MiB;
constexpr size_t WS_HL = 68 * MiB;
constexpr size_t WS_Z = 136 * MiB;
constexpr size_t WS_P = 544 * MiB;
constexpr size_t WS_END = 646 * MiB;
constexpr size_t WS_WGU = WS_Z, WS_WDN = WS_Z + 64 * MiB, WS_XB = WS_Z + 96 * MiB, WS_ACT = WS_Z + 248 * MiB, WS_YB = WS_Z + 324 * MiB;
static_assert(WS_YB + (size_t)MAXT * 256 * 1024 * 2 <= WS_END, "moe overlay");
static_assert(WS_HL + (size_t)MA * 1024 * 2 <= WS_Z && WS_Z + (size_t)MA * ZP * 2 <= WS_P && WS_P + (size_t)MA * PP * 2 <= WS_END, "ws map");
constexpr size_t TOK_E = 0, TOK_SLOT = 256 * 1024, TOK_W = 512 * 1024, TOK_POS = 1024 * 1024, TOK_BCNT = 1536 * 1024, TOK_TILE = 1600 * 1024;
constexpr int CW_BAR = 1024;

constexpr int LDS_BYTES = 163840 - 1024;
constexpr int LDS_CTL = LDS_BYTES - 256;
struct KArgs { const float* in[29]; float* out; unsigned char* ws; int ph_lo, ph_hi; };
enum { I_X = 0, I_C, I_CTX, I_CCTX, I_WMOD, I_BMOD, I_NORM1, I_NORM2, I_WIN, I_RDECAY, I_RGN, I_WQN, I_WKN, I_WSINK, I_NQN, I_NKN, I_RPB, I_GCONV, I_GALOG, I_GDT, I_GNORM,
       I_WBR, I_WMERGE, I_WOUT, I_WROUTER, I_RBIAS, I_WEG, I_WEU, I_WED };

__device__ __forceinline__ float wave_sum(float v) {
#pragma unroll
    for (int o = 1; o < 64; o <<= 1) v += __shfl_xor(v, o);
    return v;
}
__device__ __forceinline__ float sum16(float v) { v += __shfl_xor(v, 1); v += __shfl_xor(v, 2); v += __shfl_xor(v, 4); v += __shfl_xor(v, 8); return v; }
#define LDS_WAIT() asm volatile("s_waitcnt lgkmcnt(0)" ::: "memory")

__device__ __forceinline__ void transpose_item(const float* W, int ldw, int ncols, int k0, int n0, bf16_t* WT, int ldt, int dst_row0, LAS float* scr, int lane) {
    const int nn = n0 + (lane & 31);
#pragma unroll 8
    for (int i = 0; i < 32; ++i) { const int kk = 2 * i + (lane >> 5); scr[kk * 33 + (lane & 31)] = (nn < ncols) ? W[(size_t)(k0 + kk) * ldw + nn] : 0.f; }
    LDS_WAIT(); asm volatile("" ::: "memory");
    const int c = lane & 7;
#pragma unroll
    for (int j = 0; j < 4; ++j) { const int n = (lane >> 3) + 8 * j; const LAS float* s = scr + (8 * c) * 33 + n;
        u32x4 o; o.x = pk2(s[0 * 33], s[1 * 33]); o.y = pk2(s[2 * 33], s[3 * 33]); o.z = pk2(s[4 * 33], s[5 * 33]); o.w = pk2(s[6 * 33], s[7 * 33]);
        *(u32x4*)(WT + (size_t)(dst_row0 + n) * ldt + k0 + 8 * c) = o; }
    LDS_WAIT(); asm volatile("" ::: "memory");
}

__device__ __forceinline__ void phase_prologue(const KArgs& a, LAS unsigned char* lds) {
    const int tid = OTID(), lane = tid & 63, wave = tid >> 6, G = OGRID(), blk = OBLK();
    unsigned char* ws = a.ws;
    { float* cs = (float*)(ws + WS_ROPE); float* sn = cs + 4096 * 32;
      for (int idx = blk * NTHR + tid; idx < 4096 * 32; idx += G * NTHR) { const int t = idx >> 5, i = idx & 31; const float pos = (float)((i < 16) ? (t >> 6) : (t & 63));
          const float inv = exp2f(-(float)(i & 15) * (13.287712379549449f / 16.0f)); const float ang = pos * inv; cs[idx] = cosf(ang); sn[idx] = sinf(ang); } }
    if (blk < 192) {
        const int l = blk / 96, cg = blk % 96;
        LAS float* sc = (LAS float*)lds; LAS float* red = (LAS float*)(lds + 40960);
        for (int idx = tid; idx < 9 * 1024; idx += NTHR) { const int v = idx >> 10, k = idx & 1023; const float cv = (v < 8) ? a.in[I_C][v * 1024 + k] : a.in[I_CCTX][k]; sc[idx] = siluf_(cv); }
        __syncthreads();
        const float* wm = a.in[I_WMOD] + (size_t)l * 1024 * 6144 + cg * 64 + lane;
        float acc[9];
#pragma unroll
        for (int v = 0; v < 9; ++v) acc[v] = 0.f;
#pragma unroll 8
        for (int kk = 0; kk < 128; ++kk) { const int k = wave * 128 + kk; const float w = wm[(size_t)k * 6144];
#pragma unroll
            for (int v = 0; v < 9; ++v) acc[v] += sc[v * 1024 + k] * w; }
#pragma unroll
        for (int v = 0; v < 9; ++v) red[(wave * 9 + v) * 64 + lane] = acc[v];
        __syncthreads();
        for (int idx = tid; idx < 576; idx += NTHR) { const int v = idx >> 6, ln = idx & 63; float s = a.in[I_BMOD][l * 6144 + cg * 64 + ln];
#pragma unroll
            for (int w = 0; w < 8; ++w) s += red[(w * 9 + v) * 64 + ln];
            ((float*)(ws + WS_MOD))[(size_t)(l * 9 + v) * 6144 + cg * 64 + ln] = s; }
        __syncthreads();
    }
    LAS float* scr = (LAS float*)(lds + 65536 + wave * 8448);
    const int gw = blk * NWAVES + wave, NGW = G * NWAVES;
    constexpr int I_IN = 16 * 192, I_MG = 16 * 128, I_BR = 4 * 8 * 32, I_OUT = 16 * 32, I_LAYER = I_IN + I_MG + I_BR + I_OUT;
    for (int it = gw; it < 2 * I_LAYER; it += NGW) {
        const int l = it / I_LAYER; int r = it % I_LAYER;
        bf16_t* wsm = (bf16_t*)(ws + WS_WSM + (size_t)l * WSM_LAYER);
        if (r < I_IN) { const int kb = r / 192, nb = r % 192; transpose_item(a.in[I_WIN] + (size_t)l * 1024 * 5904, 5904, 5904, kb * 64, nb * 32, wsm + WSM_IN / 2, 1024, nb * 32, scr, lane); continue; } r -= I_IN;
        if (r < I_MG) { const int kb = r / 128, nb = r % 128; transpose_item(a.in[I_WMERGE] + (size_t)l * 1024 * 4096, 4096, 4096, kb * 64, nb * 32, wsm + WSM_MERGE / 2, 1024, nb * 32, scr, lane); continue; } r -= I_MG;
        if (r < I_BR) { const int br = r / 256, q = r % 256, kb = q / 32, nb = q % 32;
            transpose_item(a.in[I_WBR] + (size_t)(l * 4 + br) * 512 * 1024, 1024, 1024, kb * 64, nb * 32, wsm + WSM_BR / 2 + (size_t)br * 1024 * 512, 512, nb * 32, scr, lane); continue; } r -= I_BR;
        { const int kb = r / 32, nb = r % 32; transpose_item(a.in[I_WOUT] + (size_t)l * 1024 * 1024, 1024, 1024, kb * 64, nb * 32, wsm + WSM_OUT / 2, 1024, nb * 32, scr, lane); }
    }
}

__device__ __forceinline__ void phase_expert_convert(const KArgs& a, LAS unsigned char* lds, int l) {
    const int tid = OTID(), lane = tid & 63, wave = tid >> 6, G = OGRID(), blk = OBLK();
    LAS float* scr = (LAS float*)(lds + 65536 + wave * 8448);
    const int gw = blk * NWAVES + wave, NGW = G * NWAVES;
    bf16_t* wgu = (bf16_t*)(a.ws + WS_WGU); bf16_t* wdn = (bf16_t*)(a.ws + WS_WDN);
    for (int it = gw; it < 3 * 8192; it += NGW) {
        const int which = it / 8192, r = it % 8192, e = r / 256, q = r % 256;
        if (which < 2) { const int kb = q / 16, nb = q % 16, n0 = nb * 32;
            transpose_item(a.in[which == 0 ? I_WEG : I_WEU] + (size_t)(l * 32 + e) * 1024 * 512, 512, 512, kb * 64, n0, wgu + (size_t)e * 1024 * 1024, 1024, 256 * (n0 >> 7) + (n0 & 127) + which * 128, scr, lane); }
        else { const int kb = q / 32, nb = q % 32; transpose_item(a.in[I_WED] + (size_t)(l * 32 + e) * 512 * 1024, 1024, 1024, kb * 64, nb * 32, wdn + (size_t)e * 1024 * 512, 512, nb * 32, scr, lane); }
    }
}

__device__ __forceinline__ void modulate_store(const f32x4 (&v)[4], const float* gain, const float* sh, const float* sc, bf16_t* orow, int lane) {
    float ss = 0.f;
#pragma unroll
    for (int j = 0; j < 4; ++j) ss += (v[j].x * v[j].x + v[j].y * v[j].y) + (v[j].z * v[j].z + v[j].w * v[j].w);
    const float rstd = rsqrtf(wave_sum(ss) * (1.f / 1024.f) + EPS);
#pragma unroll
    for (int j = 0; j < 4; ++j) {
        const f32x4 g = ((const f32x4*)gain)[lane + 64 * j], s1 = ((const f32x4*)sc)[lane + 64 * j], s0 = ((const f32x4*)sh)[lane + 64 * j];
        const f32x4 y = (v[j] * rstd * g) * (s1 + 1.0f) + s0;
        u32x2 o; o.x = pk2(y.x, y.y); o.y = pk2(y.z, y.w);
        ((u32x2*)orow)[lane + 64 * j] = o;
    }
}
__device__ __forceinline__ int row_modidx(int row) { return row < ML ? (row >> 12) : 8; }

__device__ __forceinline__ void phase_modulate1(const KArgs& a, int l) {
    const int tid = OTID(), lane = tid & 63, wave = tid >> 6;
    const int gw = OBLK() * NWAVES + wave, NGW = OGRID() * NWAVES;
    const float* xl = (l == 0) ? a.in[I_X] : a.out; const float* xc = (l == 0) ? a.in[I_CTX] : (const float*)(a.ws + WS_XC);
    bf16_t* hl = (bf16_t*)(a.ws + WS_HL);
    for (int row = gw; row < MA; row += NGW) {
        const float* xr = row < ML ? xl + (size_t)row * D : xc + (size_t)(row - ML) * D;
        f32x4 v[4];
#pragma unroll
        for (int j = 0; j < 4; ++j) v[j] = ((const f32x4*)xr)[lane + 64 * j];
        const float* mod = (const float*)(a.ws + WS_MOD) + (size_t)(l * 9 + row_modidx(row)) * 6144;
        modulate_store(v, a.in[I_NORM1] + l * D, mod, mod + 1024, hl + (size_t)row * D, lane);
    }
}
__device__ __forceinline__ void head64_pass(bf16_t* zr, int col0, int nh, const float* gain, bool rope, float scale, const float* cs, const float* sn, int lane) {
    const int hs = lane >> 4, ii = (lane & 15) * 2; const bool act = hs < nh;
    bf16_t* p = zr + col0 + hs * 64 + ii;
    unsigned u1 = 0u, u2 = 0u;
    if (act) { u1 = *(const unsigned*)p; u2 = *(const unsigned*)(p + 32); }
    float x1a = bflo(u1), x1b = bfhi(u1), x2a = bflo(u2), x2b = bfhi(u2);
    if (gain) {
        const float ss = sum16((x1a * x1a + x1b * x1b) + (x2a * x2a + x2b * x2b));
        const float r = rsqrtf(ss * (1.f / 64.f) + EPS);
        x1a *= r * gain[ii]; x1b *= r * gain[ii + 1]; x2a *= r * gain[32 + ii]; x2b *= r * gain[33 + ii];
    }
    if (rope) {
        const float ca = cs[ii], cb = cs[ii + 1], sa = sn[ii], sb = sn[ii + 1];
        const float y1a = x1a * ca - x2a * sa, y2a = x1a * sa + x2a * ca, y1b = x1b * cb - x2b * sb, y2b = x1b * sb + x2b * cb;
        x1a = y1a; x2a = y2a; x1b = y1b; x2b = y2b;
    }
    if (act) { *(unsigned*)p = pk2(x1a * scale, x1b * scale); *(unsigned*)(p + 32) = pk2(x2a * scale, x2b * scale); }
}
__device__ __forceinline__ void phase_prep(const KArgs& a, int l) {
    const int tid = OTID(), lane = tid & 63, wave = tid >> 6;
    const int gw = OBLK() * NWAVES + wave, NGW = OGRID() * NWAVES;
    bf16_t* Z = (bf16_t*)(a.ws + WS_Z); bf16_t* P = (bf16_t*)(a.ws + WS_P);
    const float* cs0 = (const float*)(a.ws + WS_ROPE); const float* sn0 = cs0 + 4096 * 32;
    float* GBa = (float*)(a.ws + WS_GB); float* GBb = GBa + (size_t)MA * 8;
    const float* wqn = a.in[I_WQN] + l * 64; const float* wkn = a.in[I_WKN] + l * 64; const float* nqn = a.in[I_NQN] + l * 64; const float* nkn = a.in[I_NKN] + l * 64;
    const float* cw = a.in[I_GCONV] + (size_t)l * 3 * 1536;
    for (int row = gw; row < MA; row += NGW) {
        const bool lat = row < ML; const int t = lat ? (row & 4095) : ((row - ML) & 255); const int slen = lat ? 4096 : 256;
        bf16_t* zr = Z + (size_t)row * ZP;
        const float* cs = cs0 + t * 32; const float* sn = sn0 + t * 32;
#pragma unroll 1
        for (int hh = 0; hh < 12; ++hh) {
            const int c = hh * 128 + lane * 2; const bf16_t* zc = zr + C_GQ + c;
            const unsigned uc = *(const unsigned*)zc; const unsigned up = (t > 0) ? *(const unsigned*)(zc - ZP) : 0u; const unsigned un = (t < slen - 1) ? *(const unsigned*)(zc + ZP) : 0u;
            const f32x2 w0 = *(const f32x2*)(cw + c), w1 = *(const f32x2*)(cw + 1536 + c), w2 = *(const f32x2*)(cw + 3072 + c);
            float xa = w0.x * bflo(up) + w1.x * bflo(uc) + w2.x * bflo(un), xb = w0.y * bfhi(up) + w1.y * bfhi(uc) + w2.y * bfhi(un);
            xa = siluf_(xa); xb = siluf_(xb);
            if (hh < 8) { const float r = rsqrtf(wave_sum(xa * xa + xb * xb) + EPS) * (hh < 4 ? 0.08838834764831845f : 1.0f); xa *= r; xb *= r; }
            *(unsigned*)(P + (size_t)row * PP + c) = pk2(xa, xb);
        }
        if (lane < 8) {
            const float av = bf2f(zr[C_GA + lane]) + a.in[I_GDT][l * 8 + lane], bv = bf2f(zr[C_GB + lane]);
            const float sp = fmaxf(av, 0.f) + log1pf(__expf(-fabsf(av)));
            const float g = -__expf(a.in[I_GALOG][l * 8 + lane]) * sp;
            GBa[(size_t)row * 8 + lane] = __expf(g); GBb[(size_t)row * 8 + lane] = sigmoidf_(bv);
        }
        head64_pass(zr, C_RQ, 4, nullptr, lat, 1.0f, cs, sn, lane);
        head64_pass(zr, C_RK, 4, nullptr, lat, 0.125f, cs, sn, lane);
        head64_pass(zr, C_WQ, 4, wqn, lat, 0.125f, cs, sn, lane);
        head64_pass(zr, C_WQ + 256, 4, wqn, lat, 0.125f, cs, sn, lane);
        head64_pass(zr, C_WK, 2, wkn, lat, 1.0f, cs, sn, lane);
        head64_pass(zr, C_NQ, 4, nqn, false, 0.125f, cs, sn, lane);
        head64_pass(zr, C_NQ + 256, 4, nqn, false, 0.125f, cs, sn, lane);
        head64_pass(zr, C_NK, 4, nkn, false, 1.0f, cs, sn, lane);
        head64_pass(zr, C_NK + 256, 4, nkn, false, 1.0f, cs, sn, lane);
    }
}

__device__ __forceinline__ void phase_post(const KArgs& a, int l, int nrows) {
    const int tid = OTID(), lane = tid & 63, wave = tid >> 6;
    const int gw = OBLK() * NWAVES + wave, NGW = OGRID() * NWAVES;
    bf16_t* Z = (bf16_t*)(a.ws + WS_Z);
    const float* rgn = a.in[I_RGN] + l * 512; const float* gnm = a.in[I_GNORM] + l * 128;
    for (int row = gw; row < nrows; row += NGW) {
        bf16_t* zr = Z + (size_t)row * ZP;
#pragma unroll
        for (int h = 0; h < 4; ++h) {
            const int c = h * 128 + lane * 2;
            { const unsigned uo = *(const unsigned*)(zr + C_RSUM + c), ug = *(const unsigned*)(zr + C_RG + c);
              const float oa = bflo(uo), ob = bfhi(uo); const float mean = wave_sum(oa + ob) * (1.f / 128.f); const float da = oa - mean, db = ob - mean;
              const float r = rsqrtf(wave_sum(da * da + db * db) * (1.f / 128.f) + EPS);
              *(unsigned*)(zr + Y_RET + c) = pk2(da * r * rgn[c] * siluf_(bflo(ug)), db * r * rgn[c + 1] * siluf_(bfhi(ug))); }
            { const unsigned uo = *(const unsigned*)(zr + C_GSUM + c), ug = *(const unsigned*)(zr + C_GG + c);
              const float oa = bflo(uo), ob = bfhi(uo); const float r = rsqrtf(wave_sum(oa * oa + ob * ob) * (1.f / 128.f) + EPS);
              *(unsigned*)(zr + Y_GDN + c) = pk2(oa * r * gnm[lane * 2] * siluf_(bflo(ug)), ob * r * gnm[lane * 2 + 1] * siluf_(bfhi(ug))); }
        }
    }
}
constexpr int AT_TILE = 4096;
constexpr int AT_BUF = 2 * AT_TILE;
constexpr int AT_WAVE_BYTES = 2 * AT_BUF + 2048;
template <int NQ> struct AttnSt { f32x4 O[NQ][4]; float m[NQ], l[NQ]; bf16x8 Q[NQ][2]; };
__device__ __forceinline__ void stage_issue(const char* const (&rp)[4], int kcolb, int vcolb, LAS unsigned char* buf) {
    asm volatile("s_waitcnt lgkmcnt(0)" ::: "memory");
#pragma unroll
    for (int c = 0; c < 4; ++c) {
        __builtin_amdgcn_global_load_lds((const unsigned*)(rp[c] + kcolb), (LAS unsigned*)(buf + c * 1024), 16, 0, 0);
        __builtin_amdgcn_global_load_lds((const unsigned*)(rp[c] + vcolb), (LAS unsigned*)(buf + AT_TILE + c * 1024), 16, 0, 0);
    }
}
__device__ __forceinline__ int at_piece_off(int lane) { const int row = lane >> 3; return (((lane & 7) ^ (row & 7)) * 16); }
__device__ __forceinline__ s16x4 lds_tr16(const LAS unsigned char* p) { return __builtin_bit_cast(s16x4, __builtin_amdgcn_ds_read_tr16_b64_v4i16((LAS s16x4*)p)); }

template <int NQ, class BiasF>
__device__ __forceinline__ void attn_step(AttnSt<NQ>& st, const LAS unsigned char* kl, const BiasF& bias, int lane) {
    const int g = lane >> 4, r16 = lane & 15;
    const LAS unsigned char* vl = kl + AT_TILE;
    bf16x8 kf[2][2];
#pragma unroll
    for (int kt = 0; kt < 2; ++kt)
#pragma unroll
        for (int ks = 0; ks < 2; ++ks) { const int row = kt * 16 + r16; kf[kt][ks] = *(const LAS bf16x8*)(kl + row * 128 + (((ks * 4 + g) ^ (row & 7)) * 16)); }
    bf16x8 vf[4];
    { const int qq = r16 >> 2, pp = r16 & 3;
#pragma unroll
      for (int dt = 0; dt < 4; ++dt) {
          const int row = 4 * g + qq, sw = (((dt * 2 + (pp >> 1)) ^ (row & 7)) * 16) + (pp & 1) * 8;
          const s16x4 lo = lds_tr16(vl + row * 128 + sw);
          const s16x4 hi = lds_tr16(vl + (16 + row) * 128 + sw);
          vf[dt] = (bf16x8){lo[0], lo[1], lo[2], lo[3], hi[0], hi[1], hi[2], hi[3]};
      } }
#pragma unroll
    for (int qi = 0; qi < NQ; ++qi) {
        f32x4 s0 = (f32x4){0.f, 0.f, 0.f, 0.f}, s1 = (f32x4){0.f, 0.f, 0.f, 0.f};
        s0 = __builtin_amdgcn_mfma_f32_16x16x32_bf16(kf[0][0], st.Q[qi][0], s0, 0, 0, 0);
        s0 = __builtin_amdgcn_mfma_f32_16x16x32_bf16(kf[0][1], st.Q[qi][1], s0, 0, 0, 0);
        s1 = __builtin_amdgcn_mfma_f32_16x16x32_bf16(kf[1][0], st.Q[qi][0], s1, 0, 0, 0);
        s1 = __builtin_amdgcn_mfma_f32_16x16x32_bf16(kf[1][1], st.Q[qi][1], s1, 0, 0, 0);
#pragma unroll
        for (int j = 0; j < 4; ++j) { s0[j] += bias(qi, r16, 4 * g + j); s1[j] += bias(qi, r16, 16 + 4 * g + j); }
        float mx = fmaxf(fmaxf(fmaxf(s0[0], s0[1]), fmaxf(s0[2], s0[3])), fmaxf(fmaxf(s1[0], s1[1]), fmaxf(s1[2], s1[3])));
        mx = fmaxf(mx, __shfl_xor(mx, 16)); mx = fmaxf(mx, __shfl_xor(mx, 32));
        const float mnew = fmaxf(st.m[qi], mx), alpha = __expf(st.m[qi] - mnew);
        float p0[4], p1[4], ps = 0.f;
#pragma unroll
        for (int j = 0; j < 4; ++j) { p0[j] = __expf(s0[j] - mnew); p1[j] = __expf(s1[j] - mnew); ps += p0[j] + p1[j]; }
        st.l[qi] = st.l[qi] * alpha + ps; st.m[qi] = mnew;
        u32x4 pw; pw.x = pk2(p0[0], p0[1]); pw.y = pk2(p0[2], p0[3]); pw.z = pk2(p1[0], p1[1]); pw.w = pk2(p1[2], p1[3]);
        const bf16x8 pf = __builtin_bit_cast(bf16x8, pw);
#pragma unroll
        for (int dt = 0; dt < 4; ++dt) { st.O[qi][dt] = st.O[qi][dt] * alpha; st.O[qi][dt] = __builtin_amdgcn_mfma_f32_16x16x32_bf16(vf[dt], pf, st.O[qi][dt], 0, 0, 0); }
    }
}
template <int NQ> __device__ __forceinline__ void attn_init(AttnSt<NQ>& st) {
#pragma unroll
    for (int qi = 0; qi < NQ; ++qi) { st.m[qi] = -1e4f; st.l[qi] = 0.f;
#pragma unroll
        for (int dt = 0; dt < 4; ++dt) st.O[qi][dt] = (f32x4){0.f, 0.f, 0.f, 0.f}; }
}
template <int NQ> __device__ __forceinline__ void attn_store(AttnSt<NQ>& st, int qi, bf16_t* orow, int lane) {
    const int g = lane >> 4;
    float lt = st.l[qi]; lt += __shfl_xor(lt, 16); lt += __shfl_xor(lt, 32);
    const float inv = 1.0f / lt;
#pragma unroll
    for (int dt = 0; dt < 4; ++dt) { const f32x4 o = st.O[qi][dt] * inv; u32x2 w; w.x = pk2(o[0], o[1]); w.y = pk2(o[2], o[3]); *(u32x2*)(orow + dt * 16 + 4 * g) = w; }
}
struct BiasZero { __device__ __forceinline__ float operator()(int, int, int) const { return 0.f; } };
struct BiasWin { int d0;
    int kstart;
    __device__ __forceinline__ float operator()(int, int q, int kk) const { const int kp = kstart + kk, dd = d0 + kk - q; return (kp >= 0 && kp < SEQ && dd <= 128 && dd >= -128) ? 0.f : -1e30f; } };
struct BiasNA { const LAS float* tab; int rowoff31; int c0;
    __device__ __forceinline__ float operator()(int qi, int q, int kk) const { const int qc = qi * 16 + q, kc = c0 + kk; int cst = qc - 8; cst = cst < 0 ? 0 : (cst > 48 ? 48 : cst);
        const bool ok = (kc >= cst) && (kc < cst + 16); const int idx = ok ? (rowoff31 + kc - qc + 15) : 0; const float b = tab[idx]; return ok ? b : -1e30f; } };

template <int NQ>
__device__ __forceinline__ void attn_ctx_steps(AttnSt<NQ>& st, const bf16_t* Z, int row0, int kcol, int vcol, int nsteps, LAS unsigned char* kl, int lane) {
    const char* base = (const char*)(Z + (size_t)(row0 + (lane >> 3)) * ZP) + at_piece_off(lane);
    const char* rp[4];
#pragma unroll
    for (int c = 0; c < 4; ++c) rp[c] = base + (size_t)(c * 8) * ZP * 2;
    stage_issue(rp, kcol * 2, vcol * 2, kl);
    for (int s = 0; s < nsteps; ++s) {
        if (s + 1 < nsteps) {
#pragma unroll
            for (int c = 0; c < 4; ++c) rp[c] += (size_t)32 * ZP * 2;
            stage_issue(rp, kcol * 2, vcol * 2, kl + ((s + 1) & 1) * AT_BUF);
            asm volatile("s_waitcnt vmcnt(8)" ::: "memory");
        } else asm volatile("s_waitcnt vmcnt(0)" ::: "memory");
        attn_step<NQ>(st, kl + (s & 1) * AT_BUF, BiasZero(), lane);
    }
}

__device__ __forceinline__ void win_item(const KArgs& a, int l, int item, bool ctxq, LAS unsigned char* kl, int lane) {
    bf16_t* Z = (bf16_t*)(a.ws + WS_Z);
    int b, gi, qt;
    if (!ctxq) { b = item >> 9; gi = (item >> 8) & 1; qt = item & 255; } else { b = item >> 5; gi = (item >> 4) & 1; qt = item & 15; }
    const int t0 = qt * 16, r16 = lane & 15, g = lane >> 4;
    const int qrow = (ctxq ? ML + b * CTXL : b * SEQ) + t0 + r16;
    AttnSt<4> st; attn_init<4>(st);
#pragma unroll
    for (int qi = 0; qi < 4; ++qi) { const bf16_t* qp = Z + (size_t)qrow * ZP + C_WQ + (gi * 4 + qi) * 64 + g * 8;
        st.Q[qi][0] = *(const bf16x8*)qp; st.Q[qi][1] = *(const bf16x8*)(qp + 32); st.m[qi] = a.in[I_WSINK][l * 8 + gi * 4 + qi]; st.l[qi] = 1.0f; }
    const int kcol = C_WK + gi * 64, vcol = C_WV + gi * 64;
    if (!ctxq) {
        int s0 = 0, s1 = 9;
        { const int ks = t0 - 128; while (s0 < s1 && ks + 32 * s0 + 31 < 0) ++s0; while (s1 > s0 && ks + 32 * (s1 - 1) >= SEQ) --s1; }
        const char* zb = (const char*)(Z + (size_t)b * SEQ * ZP) + at_piece_off(lane);
        const char* rp[4];
#define WIN_RP(s_) do { _Pragma("unroll") for (int c = 0; c < 4; ++c) { int kp = t0 - 128 + 32 * (s_) + c * 8 + (lane >> 3); kp = kp < 0 ? 0 : (kp > SEQ - 1 ? SEQ - 1 : kp); rp[c] = zb + (size_t)kp * ZP * 2; } } while (0)
        WIN_RP(s0); stage_issue(rp, kcol * 2, vcol * 2, kl + (s0 & 1) * AT_BUF);
        for (int s = s0; s < s1; ++s) {
            if (s + 1 < s1) { WIN_RP(s + 1); stage_issue(rp, kcol * 2, vcol * 2, kl + ((s + 1) & 1) * AT_BUF); asm volatile("s_waitcnt vmcnt(8)" ::: "memory"); }
            else asm volatile("s_waitcnt vmcnt(0)" ::: "memory");
            BiasWin bw; bw.kstart = t0 - 128 + 32 * s; bw.d0 = bw.kstart - t0;
            attn_step<4>(st, kl + (s & 1) * AT_BUF, bw, lane);
        }
#undef WIN_RP
    }
    attn_ctx_steps<4>(st, Z, ML + b * CTXL, kcol, vcol, 8, kl, lane);
#pragma unroll
    for (int qi = 0; qi < 4; ++qi) attn_store<4>(st, qi, Z + (size_t)qrow * ZP + Y_WIN + (gi * 4 + qi) * 64, lane);
}

__device__ __forceinline__ void na_item(const KArgs& a, int l, int item, bool ctxq, LAS unsigned char* kl, int lane) {
    bf16_t* Z = (bf16_t*)(a.ws + WS_Z);
    int b, h, r;
    if (!ctxq) { b = item >> 9; h = (item >> 6) & 7; r = item & 63; } else { b = item >> 5; h = (item >> 2) & 7; r = item & 3; }
    const int r16 = lane & 15, g = lane >> 4;
    const int qrow0 = (ctxq ? ML + b * CTXL : b * SEQ) + r * 64 + r16;
    AttnSt<4> st; attn_init<4>(st);
#pragma unroll
    for (int qi = 0; qi < 4; ++qi) { const bf16_t* qp = Z + (size_t)(qrow0 + qi * 16) * ZP + C_NQ + h * 64 + g * 8; st.Q[qi][0] = *(const bf16x8*)qp; st.Q[qi][1] = *(const bf16x8*)(qp + 32); }
    const int kcol = C_NK + h * 64, vcol = C_NV + h * 64;
    if (!ctxq) {
        LAS float* tab = (LAS float*)(kl + 2 * AT_BUF);
        const float* rpbp = a.in[I_RPB] + (size_t)(l * 8 + h) * 465;
        for (int i = lane; i < 465; i += 64) tab[i] = rpbp[i];
        int rs = r - 4; rs = rs < 0 ? 0 : (rs > 56 ? 56 : rs);
        const char* base = (const char*)(Z + (size_t)(b * SEQ + rs * 64 + (lane >> 3)) * ZP) + at_piece_off(lane);
        const char* rp[4];
#pragma unroll
        for (int c = 0; c < 4; ++c) rp[c] = base + (size_t)(c * 8) * ZP * 2;
        stage_issue(rp, kcol * 2, vcol * 2, kl);
        for (int s = 0; s < 16; ++s) {
            if (s + 1 < 16) {
#pragma unroll
                for (int c = 0; c < 4; ++c) rp[c] += (size_t)32 * ZP * 2;
                stage_issue(rp, kcol * 2, vcol * 2, kl + ((s + 1) & 1) * AT_BUF);
                asm volatile("s_waitcnt vmcnt(8)" ::: "memory");
            } else asm volatile("s_waitcnt vmcnt(0)" ::: "memory");
            BiasNA bn; bn.tab = tab; bn.rowoff31 = (rs + (s >> 1) - r + 7) * 31; bn.c0 = (s & 1) * 32;
            attn_step<4>(st, kl + (s & 1) * AT_BUF, bn, lane);
        }
    }
    attn_ctx_steps<4>(st, Z, ML + b * CTXL, kcol, vcol, 8, kl, lane);
#pragma unroll
    for (int qi = 0; qi < 4; ++qi) attn_store<4>(st, qi, Z + (size_t)(qrow0 + qi * 16) * ZP + Y_NA + h * 64, lane);
}
#define DPP_ADD(x, ctrl) ((x) + __builtin_bit_cast(float, __builtin_amdgcn_update_dpp(0, __builtin_bit_cast(int, (x)), (ctrl), 0xf, 0xf, false)))
__device__ __forceinline__ float allsum16(float x) { x = DPP_ADD(x, 0xB1); x = DPP_ADD(x, 0x4E); x = DPP_ADD(x, 0x141); x = DPP_ADD(x, 0x140); return x; }
constexpr int RC_CH = 32, RC_NCH = (CTXL + SEQ) / RC_CH;
constexpr int RC_KOFF = 0, RC_QOFF = 8192, RC_VOFF = 16384, RC_AOFF = 17408, RC_BOFF = 17536, RC_SET = 17920;

template <bool GDN>
__device__ __forceinline__ void recur_unit(const KArgs& a, LAS unsigned char* lds, int l, int unit, bool ctx_out) {
    constexpr int DK = GDN ? 128 : 64, EPT = DK / 16, ROWB = DK * 2, PCS = ROWB / 16, NPC = (32 * PCS) / 256;
    const int tid = OTID(), dir = tid >> 8, t = tid & 255, sl = t & 15, col = t >> 4;
    const int b = unit >> 5, h = (unit >> 3) & 3, cs = unit & 7;
    bf16_t* Z = (bf16_t*)(a.ws + WS_Z);
    const bf16_t* SRC = GDN ? (const bf16_t*)(a.ws + WS_P) : (const bf16_t*)Z;
    const int SP = GDN ? PP : ZP;
    const int qcol = GDN ? h * 128 : C_RQ + h * 64, kcol = GDN ? 512 + h * 128 : C_RK + h * 64, vcol = (GDN ? 1024 : C_RV) + h * 128 + cs * 16;
    const float* GBa = (const float*)(a.ws + WS_GB); const float* GBb = GBa + (size_t)MA * 8;
    const int tmpcol = (GDN ? C_GTMP : C_RTMP) + h * 128 + cs * 16 + col, sumcol = (GDN ? C_GSUM : C_RSUM) + h * 128 + cs * 16 + col;
    float gamma = 1.f;
    if (!GDN) { const float dl = a.in[I_RDECAY][l * 8 + dir * 4 + h]; gamma = 1.0f / (1.0f + __expf(-dl)); }
    float s[EPT];
#pragma unroll
    for (int j = 0; j < EPT; ++j) s[j] = 0.f;
    u32x4 rk[NPC], rq[NPC], rv; float ra = 0.f;
    rv = (u32x4){0u, 0u, 0u, 0u};
#define RC_ROW(c, ii) ((c) < 8 ? (ML + b * CTXL + (dir == 0 ? (c) * 32 + (ii) : CTXL - 1 - ((c) * 32 + (ii)))) : (b * SEQ + (dir == 0 ? ((c) - 8) * 32 + (ii) : SEQ - 1 - (((c) - 8) * 32 + (ii)))))
#define RC_LOAD(c) do { \
        _Pragma("unroll") for (int pi = 0; pi < NPC; ++pi) { const int p = t + pi * 256, ii = p / PCS, part = p % PCS; const size_t ro = (size_t)RC_ROW(c, ii) * SP; \
            rk[pi] = *(const u32x4*)(SRC + ro + kcol + part * 8); rq[pi] = *(const u32x4*)(SRC + ro + qcol + part * 8); } \
        if (t < 64) { const int ii = t >> 1, part = t & 1; rv = *(const u32x4*)(SRC + (size_t)RC_ROW(c, ii) * SP + vcol + part * 8); } \
        else if (GDN && t < 128) { const int ii = t & 31; const size_t ro = (size_t)RC_ROW(c, ii) * 8 + dir * 4 + h; ra = (t < 96) ? GBa[ro] : GBb[ro]; } \
    } while (0)
#define RC_STORE(bufi) do { LAS unsigned char* sb = lds + ((bufi) * 2 + dir) * RC_SET; \
        _Pragma("unroll") for (int pi = 0; pi < NPC; ++pi) { const int p = t + pi * 256, ii = p / PCS, part = p % PCS; \
            *(LAS u32x4*)(sb + RC_KOFF + ii * ROWB + part * 16) = rk[pi]; *(LAS u32x4*)(sb + RC_QOFF + ii * ROWB + part * 16) = rq[pi]; } \
        if (t < 64) { *(LAS u32x4*)(sb + RC_VOFF + (t >> 1) * 32 + (t & 1) * 16) = rv; } \
        else if (GDN && t < 128) { *(LAS float*)(sb + (t < 96 ? RC_AOFF : RC_BOFF) + (t & 31) * 4) = ra; } \
    } while (0)
    RC_LOAD(0); RC_STORE(0);
    __syncthreads();
    for (int c = 0; c < RC_NCH; ++c) {
        if (c + 1 < RC_NCH) RC_LOAD(c + 1);
        const LAS unsigned char* sb = lds + ((c & 1) * 2 + dir) * RC_SET;
        const bool isctx = c < 8; const bool wout = !isctx || ctx_out;
        const int jb = (isctx ? c : c - 8) * 32, half = isctx ? CTXL / 2 : SEQ / 2;
#pragma unroll 4
        for (int ii = 0; ii < RC_CH; ++ii) {
            float kk[EPT], qq[EPT];
            if constexpr (GDN) { const u32x4 ku = *(const LAS u32x4*)(sb + RC_KOFF + ii * ROWB + sl * 16), qu = *(const LAS u32x4*)(sb + RC_QOFF + ii * ROWB + sl * 16);
                kk[0] = bflo(ku.x); kk[1] = bfhi(ku.x); kk[2] = bflo(ku.y); kk[3] = bfhi(ku.y); kk[4] = bflo(ku.z); kk[5] = bfhi(ku.z); kk[6] = bflo(ku.w); kk[7] = bfhi(ku.w);
                qq[0] = bflo(qu.x); qq[1] = bfhi(qu.x); qq[2] = bflo(qu.y); qq[3] = bfhi(qu.y); qq[4] = bflo(qu.z); qq[5] = bfhi(qu.z); qq[6] = bflo(qu.w); qq[7] = bfhi(qu.w);
            } else { const u32x2 ku = *(const LAS u32x2*)(sb + RC_KOFF + ii * ROWB + sl * 8), qu = *(const LAS u32x2*)(sb + RC_QOFF + ii * ROWB + sl * 8);
                kk[0] = bflo(ku.x); kk[1] = bfhi(ku.x); kk[2] = bflo(ku.y); kk[3] = bfhi(ku.y); qq[0] = bflo(qu.x); qq[1] = bfhi(qu.x); qq[2] = bflo(qu.y); qq[3] = bfhi(qu.y); }
            const float v = bf2f(*(const LAS bf16_t*)(sb + RC_VOFF + ii * 32 + col * 2));
            float od = 0.f;
            if constexpr (GDN) {
                const float at = *(const LAS float*)(sb + RC_AOFF + ii * 4), bt = *(const LAS float*)(sb + RC_BOFF + ii * 4);
                float kd = 0.f;
#pragma unroll
                for (int j = 0; j < EPT; ++j) { s[j] *= at; kd += kk[j] * s[j]; }
                kd = allsum16(kd);
                const float r = bt * (v - kd);
#pragma unroll
                for (int j = 0; j < EPT; ++j) { s[j] += kk[j] * r; od += qq[j] * s[j]; }
            } else {
#pragma unroll
                for (int j = 0; j < EPT; ++j) { s[j] = gamma * s[j] + kk[j] * v; od += qq[j] * s[j]; }
            }
            od = allsum16(od);
            if (wout && sl == 0) {
                const int j = jb + ii; const size_t ro = (size_t)RC_ROW(c, ii) * ZP;
                if (j < half) { Z[ro + tmpcol] = (bf16_t)f2bf(od); }
                else { const unsigned w = __hip_atomic_load((const unsigned*)(Z + ro + (tmpcol & ~1)), __ATOMIC_RELAXED, __HIP_MEMORY_SCOPE_AGENT);
                       const float prev = (tmpcol & 1) ? bfhi(w) : bflo(w); Z[ro + sumcol] = (bf16_t)f2bf(od + prev); }
            }
        }
        if (c + 1 < RC_NCH) RC_STORE((c + 1) & 1);
        asm volatile("s_waitcnt vmcnt(0)" ::: "memory");
        __syncthreads();
    }
#undef RC_ROW
#undef RC_LOAD
#undef RC_STORE
}

typedef const __attribute__((address_space(4))) KArgs* KAP;
#define NOINL __forceinline__
__device__ __forceinline__ KArgs load_kargs(KAP kp) { unsigned long long kv = (unsigned long long)kp; asm volatile("" : "+s"(kv)); KAP ka = (KAP)kv; KArgs a;
#pragma unroll
    for (int i = 0; i < 29; ++i) a.in[i] = ka->in[i];
    a.out = ka->out; a.ws = ka->ws; a.ph_lo = ka->ph_lo; a.ph_hi = ka->ph_hi; return a; }
__device__ NOINL void call_gdn(KAP ka, LAS unsigned char* lds, int l, int unit, bool ctx_out) { const KArgs a = load_kargs(ka); recur_unit<true>(a, lds, l, unit, ctx_out); }
__device__ NOINL void call_ret(KAP ka, LAS unsigned char* lds, int l, int unit, bool ctx_out) { const KArgs a = load_kargs(ka); recur_unit<false>(a, lds, l, unit, ctx_out); }
__device__ NOINL void call_na(KAP ka, int l, int item, bool ctxq, LAS unsigned char* kl, int lane) { const KArgs a = load_kargs(ka); na_item(a, l, item, ctxq, kl, lane); }
__device__ NOINL void call_win(KAP ka, int l, int item, bool ctxq, LAS unsigned char* kl, int lane) { const KArgs a = load_kargs(ka); win_item(a, l, item, ctxq, kl, lane); }
__device__ __forceinline__ void phase_mixers(KAP ka, LAS unsigned char* lds, int l, bool ctx_out) {
    const int tid = OTID(), lane = tid & 63, wave = tid >> 6, blk = OBLK(), G = OGRID();
    for (int u = blk; u < 256; u += G) { call_gdn(ka, lds, l, u, ctx_out); __syncthreads(); }
    for (int u = blk; u < 256; u += G) { call_ret(ka, lds, l, u, ctx_out); __syncthreads(); }
    LAS unsigned char* kl = lds + wave * AT_WAVE_BYTES;
    const int gw = blk * NWAVES + wave, NGW = G * NWAVES;
    const int nitems = ctx_out ? 4096 + 4096 + 256 + 256 : 8192;
    for (int it = gw; it < nitems; it += NGW) {
        const bool cq = it >= 8192; const int j = cq ? it - 8192 : it;
        const bool isna = cq ? (j < 256) : (j < 4096);
        const int item = cq ? (j & 255) : (j & 4095);
        if (isna) call_na(ka, l, item, cq, kl, lane);
        else call_win(ka, l, item, cq, kl, lane);
    }
}
using pg8::Unit;
struct SchedPlain {
    const char* A0; const char* B0; size_t tA, tB;
    int nM, nN, nwg, G, c;
    __device__ __forceinline__ void init(const void* A, int lda, const void* Bt, int ldb, int M, int N, int G_, int c_) {
        A0 = (const char*)A; B0 = (const char*)Bt; tA = (size_t)256 * lda * 2; tB = (size_t)256 * ldb * 2; nM = M / 256; nN = N / 256; nwg = nM * nN; G = G_; c = c_; }
    __device__ __forceinline__ bool next(int i, Unit& u) const {
        const long L = (long)i * G + c; if (L >= nwg) return false;
        int wgid = (int)L; { const int q = nwg / 8, r = nwg % 8, xcd = wgid % 8, off = wgid / 8; wgid = (xcd < r ? xcd * (q + 1) : r * (q + 1) + (xcd - r) * q) + off; }
        const int nig = 8 * nN, gid = wgid / nig, fm = gid * 8, gsz = (nM - fm) < 8 ? (nM - fm) : 8;
        u.pm = fm + ((wgid % nig) % gsz); u.pn = (wgid % nig) / gsz; u.aux = 0; return true; }
    __device__ __forceinline__ const char* A(const Unit& u) const { return A0 + (size_t)u.pm * tA; }
    __device__ __forceinline__ const char* B(const Unit& u) const { return B0 + (size_t)u.pn * tB; }
};
struct SchedBranch {
    const char* Z0; const char* W0; int ntiles, G, c;
    __device__ __forceinline__ bool next(int i, Unit& u) const { const int tile = (i >> 2) * G + c; if (tile >= ntiles) return false; u.pm = tile >> 2; u.pn = tile & 3; u.aux = i & 3; return true; }
    __device__ __forceinline__ const char* A(const Unit& u) const { const int yc = u.aux == 0 ? Y_RET : (u.aux == 1 ? Y_WIN : (u.aux == 2 ? Y_NA : Y_GDN)); return Z0 + ((size_t)u.pm * 256 * ZP + yc) * 2; }
    __device__ __forceinline__ const char* B(const Unit& u) const { return W0 + ((size_t)u.aux * 1024 * 512 + (size_t)u.pn * 256 * 512) * 2; }
};
struct SchedMoe {
    const char* A0; const char* W0; const int* tile_e; size_t tA, eB, tB; int ntiles, G, c;
    __device__ __forceinline__ bool next(int i, Unit& u) const { const int L = i * G + c; if (L >= ntiles * 4) return false; u.pm = L >> 2; u.pn = L & 3; u.aux = tile_e[u.pm]; return true; }
    __device__ __forceinline__ const char* A(const Unit& u) const { return A0 + (size_t)u.pm * tA; }
    __device__ __forceinline__ const char* B(const Unit& u) const { return W0 + (size_t)u.aux * eB + (size_t)u.pn * tB; }
};

template <int MODE  > struct EpiStore {
    bf16_t* O; int ldc;
    __device__ __forceinline__ void operator()(const f32x4 (&acc)[2][2][4][2], const Unit& u, int wr, int wc, int fr, int fq) const {
        const int row0 = u.pm * 256 + wr * 64 + fr; const int colt = (MODE == 1 ? dead_tile(u.pn) : u.pn) * 256; const int col0 = colt + wc * 32 + 8 * fq;
#pragma unroll
        for (int ai = 0; ai < 2; ++ai)
#pragma unroll
            for (int m = 0; m < 4; ++m) { bf16_t* rowp = O + (size_t)(row0 + ai * 128 + m * 16) * ldc + col0;
#pragma unroll
                for (int bj = 0; bj < 2; ++bj) { f32x4 v0 = acc[ai][bj][m][0], v1 = acc[ai][bj][m][1];
                    if (MODE == 1) {
#pragma unroll
                        for (int e = 0; e < 4; ++e) { v0[e] = sigmoidf_(v0[e]); v1[e] = sigmoidf_(v1[e]); } }
                    u32x4 w; w.x = pk2(v0[0], v0[1]); w.y = pk2(v0[2], v0[3]); w.z = pk2(v1[0], v1[1]); w.w = pk2(v1[2], v1[3]);
                    *(u32x4*)(rowp + bj * 128) = w; } }
    }
};
struct EpiBranch {
    bf16_t* ACC; const bf16_t* Z;
    __device__ __forceinline__ void operator()(const f32x4 (&acc)[2][2][4][2], const Unit& u, int wr, int wc, int fr, int fq) const {
        const int row0 = u.pm * 256 + wr * 64 + fr; const int gcol0 = dead_tile(u.aux * 4 + u.pn) * 256 + wc * 32 + 8 * fq, col0 = u.pn * 256 + wc * 32 + 8 * fq;
#pragma unroll
        for (int ai = 0; ai < 2; ++ai)
#pragma unroll
            for (int m = 0; m < 4; ++m) { const size_t row = (size_t)(row0 + ai * 128 + m * 16);
#pragma unroll
                for (int bj = 0; bj < 2; ++bj) {
                    const u32x4 gw = *(const u32x4*)(Z + row * ZP + gcol0 + bj * 128);
                    bf16_t* ap = ACC + row * D + col0 + bj * 128;
                    u32x4 pw = (u32x4){0u, 0u, 0u, 0u}; if (u.aux != 0) pw = *(const u32x4*)ap;
                    const f32x4 v0 = acc[ai][bj][m][0], v1 = acc[ai][bj][m][1];
                    u32x4 w;
                    w.x = pk2(bflo(pw.x) + bflo(gw.x) * v0[0], bfhi(pw.x) + bfhi(gw.x) * v0[1]); w.y = pk2(bflo(pw.y) + bflo(gw.y) * v0[2], bfhi(pw.y) + bfhi(gw.y) * v0[3]);
                    w.z = pk2(bflo(pw.z) + bflo(gw.z) * v1[0], bfhi(pw.z) + bfhi(gw.z) * v1[1]); w.w = pk2(bflo(pw.w) + bflo(gw.w) * v1[2], bfhi(pw.w) + bfhi(gw.w) * v1[3]);
                    *(u32x4*)ap = w; } }
    }
};
struct EpiResid {
    const float* xl_src; const float* xc_src; float* xl_dst; float* xc_dst; const float* mod_g;
    __device__ __forceinline__ void operator()(const f32x4 (&acc)[2][2][4][2], const Unit& u, int wr, int wc, int fr, int fq) const {
        const int row0 = u.pm * 256 + wr * 64 + fr; const int col0 = u.pn * 256 + wc * 32 + 8 * fq;
        const bool lat = u.pm < ML / 256; const float* src = lat ? xl_src : xc_src - (size_t)ML * D; float* dst = lat ? xl_dst : xc_dst - (size_t)ML * D;
        const float* gv = mod_g + (size_t)(lat ? (u.pm >> 4) : 8) * 6144;
#pragma unroll
        for (int bj = 0; bj < 2; ++bj) {
            const f32x4 g0 = *(const f32x4*)(gv + col0 + bj * 128), g1 = *(const f32x4*)(gv + col0 + bj * 128 + 4);
#pragma unroll
            for (int ai = 0; ai < 2; ++ai)
#pragma unroll
                for (int m = 0; m < 4; ++m) { const size_t o = (size_t)(row0 + ai * 128 + m * 16) * D + col0 + bj * 128;
                    const f32x4 x0 = *(const f32x4*)(src + o), x1 = *(const f32x4*)(src + o + 4);
                    *(f32x4*)(dst + o) = x0 + g0 * acc[ai][bj][m][0]; *(f32x4*)(dst + o + 4) = x1 + g1 * acc[ai][bj][m][1]; } }
    }
};
struct EpiAct {
    bf16_t* ACT;
    __device__ __forceinline__ void operator()(const f32x4 (&acc)[2][2][4][2], const Unit& u, int wr, int wc, int fr, int fq) const {
        const int row0 = u.pm * 256 + wr * 64 + fr; const int col0 = u.pn * 128 + wc * 32 + 8 * fq;
#pragma unroll
        for (int ai = 0; ai < 2; ++ai)
#pragma unroll
            for (int m = 0; m < 4; ++m) { const f32x4 g0 = acc[ai][0][m][0], g1 = acc[ai][0][m][1], u0 = acc[ai][1][m][0], u1 = acc[ai][1][m][1];
                u32x4 w; w.x = pk2(siluf_(g0[0]) * u0[0], siluf_(g0[1]) * u0[1]); w.y = pk2(siluf_(g0[2]) * u0[2], siluf_(g0[3]) * u0[3]);
                w.z = pk2(siluf_(g1[0]) * u1[0], siluf_(g1[1]) * u1[1]); w.w = pk2(siluf_(g1[2]) * u1[2], siluf_(g1[3]) * u1[3]);
                *(u32x4*)(ACT + (size_t)(row0 + ai * 128 + m * 16) * DEXP + col0) = w; }
    }
};
__device__ __forceinline__ void phase_route(const KArgs& a, LAS unsigned char* lds, int l, int nrows) {
    const int tid = OTID(), lane = tid & 63, wave = tid >> 6, blk = OBLK(), G = OGRID();
    LAS float* wr = (LAS float*)lds;
    LAS float* lg = (LAS float*)(lds + 131072) + wave * (17 * 32);
    LAS unsigned* lcnt = (LAS unsigned*)(lds + 131072 + 8 * 17 * 32 * 4);
    for (int idx = tid; idx < 32 * 1024; idx += NTHR) { const int k = idx >> 5, e = idx & 31; wr[e * 1024 + k] = a.in[I_WROUTER][idx]; }
    if (tid < 32) lcnt[tid] = 0u;
    __syncthreads();
    const float* xl = a.out; const float* xc = (const float*)(a.ws + WS_XC);
    bf16_t* hl = (bf16_t*)(a.ws + WS_HL);
    const int gw = blk * NWAVES + wave, NGW = G * NWAVES;
    int nr = 0;
    for (int row = gw; row < nrows; row += NGW, ++nr) {
        const float* xr = row < ML ? xl + (size_t)row * D : xc + (size_t)(row - ML) * D;
        f32x4 v[4];
#pragma unroll
        for (int j = 0; j < 4; ++j) v[j] = ((const f32x4*)xr)[lane + 64 * j];
        const float* mod = (const float*)(a.ws + WS_MOD) + (size_t)(l * 9 + row_modidx(row)) * 6144;
        const float* gain = a.in[I_NORM2] + l * D; const float* sh = mod + 3 * 1024; const float* sc = mod + 4 * 1024;
        float ss = 0.f;
#pragma unroll
        for (int j = 0; j < 4; ++j) ss += (v[j].x * v[j].x + v[j].y * v[j].y) + (v[j].z * v[j].z + v[j].w * v[j].w);
        const float rstd = rsqrtf(wave_sum(ss) * (1.f / 1024.f) + EPS);
        f32x4 y[4];
#pragma unroll
        for (int j = 0; j < 4; ++j) { const f32x4 g = ((const f32x4*)gain)[lane + 64 * j], s1 = ((const f32x4*)sc)[lane + 64 * j], s0 = ((const f32x4*)sh)[lane + 64 * j];
            y[j] = (v[j] * rstd * g) * (s1 + 1.0f) + s0; u32x2 o; o.x = pk2(y[j].x, y[j].y); o.y = pk2(y[j].z, y[j].w); ((u32x2*)(hl + (size_t)row * D))[lane + 64 * j] = o; }
        float acc[32];
#pragma unroll
        for (int e = 0; e < 32; ++e) { float s = 0.f;
#pragma unroll
            for (int j = 0; j < 4; ++j) { const f32x4 w = *(const LAS f32x4*)(wr + e * 1024 + 4 * lane + 256 * j); s += (y[j].x * w.x + y[j].y * w.y) + (y[j].z * w.z + y[j].w * w.w); }
            acc[e] = s; }
#pragma unroll
        for (int e = 0; e < 16; ++e) { const bool hi = (lane & 32) != 0; const float keep = hi ? acc[e + 16] : acc[e], send = hi ? acc[e] : acc[e + 16]; acc[e] = keep + __shfl_xor(send, 32); }
#pragma unroll
        for (int e = 0; e < 8; ++e) { const bool hi = (lane & 16) != 0; const float keep = hi ? acc[e + 8] : acc[e], send = hi ? acc[e] : acc[e + 8]; acc[e] = keep + __shfl_xor(send, 16); }
#pragma unroll
        for (int e = 0; e < 4; ++e) { const bool hi = (lane & 8) != 0; const float keep = hi ? acc[e + 4] : acc[e], send = hi ? acc[e] : acc[e + 4]; acc[e] = keep + __shfl_xor(send, 8); }
#pragma unroll
        for (int e = 0; e < 2; ++e) { const bool hi = (lane & 4) != 0; const float keep = hi ? acc[e + 2] : acc[e], send = hi ? acc[e] : acc[e + 2]; acc[e] = keep + __shfl_xor(send, 4); }
        { const bool hi = (lane & 2) != 0; const float keep = hi ? acc[1] : acc[0], send = hi ? acc[0] : acc[1]; acc[0] = keep + __shfl_xor(send, 2); }
        acc[0] += __shfl_xor(acc[0], 1);
        const int eidx = ((lane >> 5) & 1) * 16 + ((lane >> 4) & 1) * 8 + ((lane >> 3) & 1) * 4 + ((lane >> 2) & 1) * 2 + ((lane >> 1) & 1);
        if ((lane & 1) == 0) lg[nr * 32 + eidx] = acc[0];
    }
    LDS_WAIT(); asm volatile("" ::: "memory");
    unsigned* tokE = (unsigned*)(a.ws + WS_TOK + TOK_E); unsigned* tokS = (unsigned*)(a.ws + WS_TOK + TOK_SLOT); f32x2* tokW = (f32x2*)(a.ws + WS_TOK + TOK_W);
    if (lane < nr) {
        const int row = gw + lane * NGW;
        float sc[32], bestg = -1e30f; int gi = 0;
#pragma unroll
        for (int e = 0; e < 32; ++e) sc[e] = sigmoidf_(lg[lane * 32 + e]);
#pragma unroll
        for (int g = 0; g < 8; ++g) {
            float s4[4];
#pragma unroll
            for (int j = 0; j < 4; ++j) s4[j] = sc[g * 4 + j] + a.in[I_RBIAS][g * 4 + j];
            const float m01 = fmaxf(s4[0], s4[1]), n01 = fminf(s4[0], s4[1]), m23 = fmaxf(s4[2], s4[3]), n23 = fminf(s4[2], s4[3]);
            const float top = fmaxf(m01, m23), second = fmaxf(fminf(m01, m23), (m01 >= m23) ? n01 : n23);
            const float gs = top + second;
            if (gs > bestg) { bestg = gs; gi = g; }
        }
        float s4[4], w4[4];
#pragma unroll
        for (int j = 0; j < 4; ++j) { float sv = 0.f, wv = 0.f;
#pragma unroll
            for (int g = 0; g < 8; ++g) { if (g == gi) { sv = sc[g * 4 + j] + a.in[I_RBIAS][g * 4 + j]; wv = sc[g * 4 + j]; } }
            s4[j] = sv; w4[j] = wv; }
        int i0 = 0;
#pragma unroll
        for (int j = 1; j < 4; ++j) if (s4[j] > s4[i0]) i0 = j;
        int i1 = (i0 == 0) ? 1 : 0;
#pragma unroll
        for (int j = 0; j < 4; ++j) if (j != i0 && j != i1 && s4[j] > s4[i1]) i1 = j;
        float w0 = 0.f, w1 = 0.f;
#pragma unroll
        for (int j = 0; j < 4; ++j) { if (j == i0) w0 = w4[j]; if (j == i1) w1 = w4[j]; }
        const float inv = 1.0f / (w0 + w1);
        const int e0 = gi * 4 + i0, e1 = gi * 4 + i1;
        const unsigned s0 = atomicAdd((unsigned*)&lcnt[e0], 1u), s1 = atomicAdd((unsigned*)&lcnt[e1], 1u);
        tokE[row] = (unsigned)e0 | ((unsigned)e1 << 8); tokS[row] = s0 | (s1 << 16); tokW[row] = (f32x2){w0 * inv, w1 * inv};
    }
    __syncthreads();
    if (tid < 32) ((unsigned*)(a.ws + WS_TOK + TOK_BCNT))[blk * 32 + tid] = lcnt[tid];
}

__device__ __forceinline__ void phase_gather(const KArgs& a, LAS unsigned char* lds, int nrows) {
    const int tid = OTID(), lane = tid & 63, wave = tid >> 6, blk = OBLK(), G = OGRID();
    LAS unsigned* tot = (LAS unsigned*)lds;
    LAS unsigned* bef = tot + 32;
    LAS unsigned* base = tot + 64;
    const unsigned* bc = (const unsigned*)(a.ws + WS_TOK + TOK_BCNT);
    if (tid < 32) { unsigned t = 0u, bf = 0u; for (int g = 0; g < G; ++g) { const unsigned c = bc[g * 32 + tid]; t += c; if (g < blk) bf += c; } tot[tid] = t; bef[tid] = bf; }
    __syncthreads();
    if (tid == 0) {
        unsigned pos = 0u; int* tile_e = (int*)(a.ws + WS_TOK + TOK_TILE);
#pragma unroll 1
        for (int e = 0; e < 32; ++e) { base[e] = pos + bef[e]; const unsigned nt = (tot[e] + 255u) >> 8;
            if (blk == 0) for (unsigned i = 0; i < nt; ++i) tile_e[(pos >> 8) + i] = e;
            pos += nt << 8; }
        if (blk == 0) tile_e[MAXT] = (int)(pos >> 8);
    }
    __syncthreads();
    const unsigned* tokE = (const unsigned*)(a.ws + WS_TOK + TOK_E); const unsigned* tokS = (const unsigned*)(a.ws + WS_TOK + TOK_SLOT); u32x2* tokP = (u32x2*)(a.ws + WS_TOK + TOK_POS);
    const bf16_t* hl = (const bf16_t*)(a.ws + WS_HL); bf16_t* xb = (bf16_t*)(a.ws + WS_XB);
    const int gw = blk * NWAVES + wave, NGW = G * NWAVES;
    for (int row = gw; row < nrows; row += NGW) {
        const unsigned e = tokE[row], s = tokS[row];
        const unsigned p0 = base[e & 255u] + (s & 0xffffu), p1 = base[(e >> 8) & 255u] + (s >> 16);
        const u32x4* src = (const u32x4*)(hl + (size_t)row * D);
        const u32x4 v0 = src[lane], v1 = src[lane + 64];
        u32x4* d0 = (u32x4*)(xb + (size_t)p0 * D); u32x4* d1 = (u32x4*)(xb + (size_t)p1 * D);
        d0[lane] = v0; d0[lane + 64] = v1; d1[lane] = v0; d1[lane + 64] = v1;
        if (lane == 0) tokP[row] = (u32x2){p0, p1};
    }
}

__device__ __forceinline__ void phase_combine(const KArgs& a, int l, int nrows) {
    const int tid = OTID(), lane = tid & 63, wave = tid >> 6;
    const int gw = OBLK() * NWAVES + wave, NGW = OGRID() * NWAVES;
    const u32x2* tokP = (const u32x2*)(a.ws + WS_TOK + TOK_POS); const f32x2* tokW = (const f32x2*)(a.ws + WS_TOK + TOK_W);
    const bf16_t* yb = (const bf16_t*)(a.ws + WS_YB); bf16_t* hl = (bf16_t*)(a.ws + WS_HL);
    for (int row = gw; row < nrows; row += NGW) {
        float* xr = row < ML ? a.out + (size_t)row * D : (float*)(a.ws + WS_XC) + (size_t)(row - ML) * D;
        const u32x2 p = tokP[row]; const f32x2 w = tokW[row];
        const float* mod = (const float*)(a.ws + WS_MOD) + (size_t)(l * 9 + row_modidx(row)) * 6144;
        f32x4 v[4];
#pragma unroll
        for (int j = 0; j < 4; ++j) {
            const f32x4 x = ((const f32x4*)xr)[lane + 64 * j], g2 = ((const f32x4*)(mod + 5 * 1024))[lane + 64 * j];
            const u32x2 y0 = ((const u32x2*)(yb + (size_t)p.x * D))[lane + 64 * j], y1 = ((const u32x2*)(yb + (size_t)p.y * D))[lane + 64 * j];
            f32x4 m; m.x = w.x * bflo(y0.x) + w.y * bflo(y1.x); m.y = w.x * bfhi(y0.x) + w.y * bfhi(y1.x); m.z = w.x * bflo(y0.y) + w.y * bflo(y1.y); m.w = w.x * bfhi(y0.y) + w.y * bfhi(y1.y);
            v[j] = x + g2 * m; ((f32x4*)xr)[lane + 64 * j] = v[j];
        }
        if (l == 0) { const float* mod1 = (const float*)(a.ws + WS_MOD) + (size_t)(9 + row_modidx(row)) * 6144;
            modulate_store(v, a.in[I_NORM1] + D, mod1, mod1 + 1024, hl + (size_t)row * D, lane); }
    }
}
#ifndef MK_PER_PHASE
#define MK_PER_PHASE 1
#endif
constexpr int NPH_LAYER = 13, NPHASES = 1 + 2 * NPH_LAYER;

__device__ NOINL void ph_prologue(KAP ka, LAS unsigned char* lds) { const KArgs a = load_kargs(ka); phase_prologue(a, lds); }
__device__ NOINL void ph_modulate1(KAP ka, int l) { const KArgs a = load_kargs(ka); phase_modulate1(a, l); }
__device__ NOINL void ph_prep(KAP ka, int l) { const KArgs a = load_kargs(ka); phase_prep(a, l); }
__device__ NOINL void ph_mixers(KAP ka, LAS unsigned char* lds, int l, bool ctx_out) { phase_mixers(ka, lds, l, ctx_out); }
__device__ NOINL void ph_post(KAP ka, int l, int mrows) { const KArgs a = load_kargs(ka); phase_post(a, l, mrows); }
__device__ NOINL void ph_gemm_in(KAP ka, LAS unsigned char* lds, int l) { const KArgs a = load_kargs(ka);
    const bf16_t* wsm = (const bf16_t*)(a.ws + WS_WSM + (size_t)l * WSM_LAYER);
    SchedPlain S; S.init(a.ws + WS_HL, 1024, wsm + WSM_IN / 2, 1024, MA, ZP, OGRID(), OBLK());
    EpiStore<0> E{(bf16_t*)(a.ws + WS_Z), ZP};
    pg8::gemm_phase<EpiStore<0>, SchedPlain, true>(lds, 1024, 1024, 1024, S, E); }
__device__ NOINL void ph_gemm_gate(KAP ka, LAS unsigned char* lds, int l, int mrows) { const KArgs a = load_kargs(ka);
    const bf16_t* wsm = (const bf16_t*)(a.ws + WS_WSM + (size_t)l * WSM_LAYER);
    SchedPlain S; S.init(a.ws + WS_HL, 1024, wsm + WSM_MERGE / 2, 1024, mrows, 4096, OGRID(), OBLK());
    EpiStore<1> E{(bf16_t*)(a.ws + WS_Z), ZP};
    pg8::gemm_phase<EpiStore<1>, SchedPlain, true>(lds, 1024, 1024, 1024, S, E); }
__device__ NOINL void ph_gemm_branch(KAP ka, LAS unsigned char* lds, int l, int mrows) { const KArgs a = load_kargs(ka);
    const bf16_t* wsm = (const bf16_t*)(a.ws + WS_WSM + (size_t)l * WSM_LAYER);
    SchedBranch S{(const char*)(a.ws + WS_Z), (const char*)(wsm + WSM_BR / 2), (mrows / 256) * 4, OGRID(), OBLK()};
    EpiBranch E{(bf16_t*)(a.ws + WS_HL), (const bf16_t*)(a.ws + WS_Z)};
    pg8::gemm_phase<EpiBranch, SchedBranch, true>(lds, 512, ZP, 512, S, E); }
__device__ NOINL void ph_gemm_out(KAP ka, LAS unsigned char* lds, int l, int mrows) { const KArgs a = load_kargs(ka);
    const bf16_t* wsm = (const bf16_t*)(a.ws + WS_WSM + (size_t)l * WSM_LAYER);
    SchedPlain S; S.init(a.ws + WS_HL, 1024, wsm + WSM_OUT / 2, 1024, mrows, 1024, OGRID(), OBLK());
    EpiResid E{l == 0 ? a.in[I_X] : a.out, l == 0 ? a.in[I_CTX] : (const float*)(a.ws + WS_XC), a.out, (float*)(a.ws + WS_XC), (const float*)(a.ws + WS_MOD) + (size_t)l * 9 * 6144 + 2 * 1024};
    pg8::gemm_phase<EpiResid, SchedPlain, true>(lds, 1024, 1024, 1024, S, E); }
__device__ NOINL void ph_expconv(KAP ka, LAS unsigned char* lds, int l) { const KArgs a = load_kargs(ka); phase_expert_convert(a, lds, l); }
__device__ NOINL void ph_route(KAP ka, LAS unsigned char* lds, int l, int mrows) { const KArgs a = load_kargs(ka); phase_route(a, lds, l, mrows); }
__device__ NOINL void ph_gather(KAP ka, LAS unsigned char* lds, int mrows) { const KArgs a = load_kargs(ka); phase_gather(a, lds, mrows); }
__device__ NOINL void ph_gemm_gu(KAP ka, LAS unsigned char* lds) { const KArgs a = load_kargs(ka);
    const int* tile_e = (const int*)(a.ws + WS_TOK + TOK_TILE);
    SchedMoe S{(const char*)(a.ws + WS_XB), (const char*)(a.ws + WS_WGU), tile_e, (size_t)256 * 1024 * 2, (size_t)1024 * 1024 * 2, (size_t)256 * 1024 * 2, tile_e[MAXT], OGRID(), OBLK()};
    EpiAct E{(bf16_t*)(a.ws + WS_ACT)};
    pg8::gemm_phase<EpiAct, SchedMoe, true>(lds, 1024, 1024, 1024, S, E); }
__device__ NOINL void ph_gemm_dn(KAP ka, LAS unsigned char* lds) { const KArgs a = load_kargs(ka);
    const int* tile_e = (const int*)(a.ws + WS_TOK + TOK_TILE);
    SchedMoe S{(const char*)(a.ws + WS_ACT), (const char*)(a.ws + WS_WDN), tile_e, (size_t)256 * 512 * 2, (size_t)1024 * 512 * 2, (size_t)256 * 512 * 2, tile_e[MAXT], OGRID(), OBLK()};
    EpiStore<0> E{(bf16_t*)(a.ws + WS_YB), 1024};
    pg8::gemm_phase<EpiStore<0>, SchedMoe, true>(lds, 512, 512, 512, S, E); }
__device__ NOINL void ph_combine(KAP ka, int l, int mrows) { const KArgs a = load_kargs(ka); phase_combine(a, l, mrows); }

__global__ void __launch_bounds__(NTHR, 2) fwd_kernel(KArgs a) {
    extern __shared__ __attribute__((aligned(16))) unsigned char lds_raw[];
    LAS unsigned char* lds = (LAS unsigned char*)lds_raw;
    KAP ka = (KAP)__builtin_amdgcn_kernarg_segment_ptr();
    const int tid = OTID();
    volatile LAS unsigned* ctlw = (volatile LAS unsigned*)(lds + LDS_CTL);
    if (tid < 64) ctlw[tid] = 0u;
    __syncthreads();
    const int lo = a.ph_lo, hi = a.ph_hi;
    const bool use_bar = (hi - lo) > 1;
    XcdBarrier bar; bar.bar = (unsigned*)(a.ws + WS_CTL) + CW_BAR; bar.x = 0u; bar.st = ctlw + 8;
    if (use_bar) bar = xcd_barrier_post((unsigned*)(a.ws + WS_CTL) + CW_BAR, ctlw + 8);
#define IN(k) (lo <= (k) && (k) < hi)
#define SEAM(k) do { if (use_bar && (k) + 1 < hi) xcd_barrier(bar); } while (0)
    if (IN(0)) { ph_prologue(ka, lds); SEAM(0); }
#define LAYER_BODY(l) do { \
        constexpr int pb = 1 + (l) * NPH_LAYER; constexpr bool ctx_out = ((l) == 0); constexpr int mrows = ctx_out ? MA : ML; \
        if (IN(pb + 0)) { if ((l) == 0) ph_modulate1(ka, (l)); SEAM(pb + 0); } \
        if (IN(pb + 1)) { ph_gemm_in(ka, lds, (l)); SEAM(pb + 1); } \
        if (IN(pb + 2)) { ph_prep(ka, (l)); SEAM(pb + 2); } \
        if (IN(pb + 3)) { ph_mixers(ka, lds, (l), ctx_out); SEAM(pb + 3); } \
        if (IN(pb + 4)) { ph_post(ka, (l), mrows); SEAM(pb + 4); } \
        if (IN(pb + 5)) { ph_gemm_gate(ka, lds, (l), mrows); SEAM(pb + 5); } \
        if (IN(pb + 6)) { ph_gemm_branch(ka, lds, (l), mrows); SEAM(pb + 6); } \
        if (IN(pb + 7)) { ph_gemm_out(ka, lds, (l), mrows); ph_expconv(ka, lds, (l)); SEAM(pb + 7); } \
        if (IN(pb + 8)) { ph_route(ka, lds, (l), mrows); SEAM(pb + 8); } \
        if (IN(pb + 9)) { ph_gather(ka, lds, mrows); SEAM(pb + 9); } \
        if (IN(pb + 10)) { ph_gemm_gu(ka, lds); SEAM(pb + 10); } \
        if (IN(pb + 11)) { ph_gemm_dn(ka, lds); SEAM(pb + 11); } \
        if (IN(pb + 12)) { ph_combine(ka, (l), mrows); SEAM(pb + 12); } \
    } while (0)
    LAYER_BODY(0);
    LAYER_BODY(1);
#undef LAYER_BODY
#undef IN
#undef SEAM
}

extern "C" void kernel_launch(void* const* d_in, const int* in_sizes, int n_in, void* d_out, int out_size, void* d_ws, size_t ws_size, hipStream_t stream) {
    static int grid = 0;
    if (grid == 0) {
        if (n_in != 29 || in_sizes[0] != ML * D || out_size != ML * D || ws_size < WS_END) {
            fprintf(stderr, "kernel_launch: unexpected problem (n_in %d, in0 %d, out %d, ws %zu < %zu); nothing launched\n", n_in, n_in > 0 ? in_sizes[0] : -1, out_size, ws_size, (size_t)WS_END); grid = -1; return; }
        int dev = 0, cus = 0, per_cu = 0;
        if (hipGetDevice(&dev) != hipSuccess || hipDeviceGetAttribute(&cus, hipDeviceAttributeMultiprocessorCount, dev) != hipSuccess) { grid = -1; return; }
        if (hipFuncSetAttribute((const void*)fwd_kernel, hipFuncAttributeMaxDynamicSharedMemorySize, LDS_BYTES) != hipSuccess) { fprintf(stderr, "kernel_launch: hipFuncSetAttribute failed\n"); grid = -1; return; }
        if (hipOccupancyMaxActiveBlocksPerMultiprocessor(&per_cu, (const void*)fwd_kernel, NTHR, LDS_BYTES) != hipSuccess || per_cu < 1) {
            fprintf(stderr, "kernel_launch: occupancy query says %d workgroups per CU\n", per_cu); }
        (void)hipGetLastError();
        grid = cus;
        if (grid > 256) grid = 256;
    }
    if (grid < 0) return;
    if (hipMemsetAsync((char*)d_ws + WS_CTL, 0, CTL_ZERO_BYTES, stream) != hipSuccess) return;
    KArgs a{};
    for (int i = 0; i < 29; ++i) a.in[i] = (const float*)d_in[i];
    a.out = (float*)d_out; a.ws = (unsigned char*)d_ws;
#if MK_PER_PHASE
    for (int k = 0; k < NPHASES; ++k) { if (k == 1 + NPH_LAYER) continue; a.ph_lo = k; a.ph_hi = k + 1; hipLaunchKernelGGL(fwd_kernel, dim3(grid), dim3(NTHR), LDS_BYTES, stream, a); }
#else
    a.ph_lo = 0; a.ph_hi = NPHASES;
    hipLaunchKernelGGL(fwd_kernel, dim3(grid), dim3(NTHR), LDS_BYTES, stream, a);
#endif
}
```

```cpp
#include <hip/hip_runtime.h>
#include <cstdio>
#include <cstdint>

#define LAS __attribute__((address_space(3)))
#define GAS __attribute__((address_space(1)))
typedef unsigned short bf16_t;
typedef short bf16x8 __attribute__((ext_vector_type(8)));
typedef short s16x4 __attribute__((ext_vector_type(4)));
typedef float f32x4 __attribute__((ext_vector_type(4)));
typedef float f32x2 __attribute__((ext_vector_type(2)));
typedef unsigned u32x4 __attribute__((ext_vector_type(4)));
typedef unsigned u32x2 __attribute__((ext_vector_type(2)));

typedef __bf16 bf16x2_t __attribute__((ext_vector_type(2)));
__device__ __forceinline__ unsigned pk2(float lo, float hi) { const f32x2 v = {lo, hi}; const bf16x2_t b = __builtin_convertvector(v, bf16x2_t); return __builtin_bit_cast(unsigned, b); }
__device__ __forceinline__ unsigned f2bf(float f) { return pk2(f, f) & 0xffffu; }
__device__ __forceinline__ float bflo(unsigned u) { return __builtin_bit_cast(float, u << 16); }
__device__ __forceinline__ float bfhi(unsigned u) { return __builtin_bit_cast(float, u & 0xffff0000u); }
__device__ __forceinline__ float bf2f(bf16_t h) { return __builtin_bit_cast(float, (unsigned)h << 16); }
__device__ __forceinline__ float sigmoidf_(float x) { return 1.0f / (1.0f + __expf(-x)); }
__device__ __forceinline__ float siluf_(float x) { return x / (1.0f + __expf(-x)); }

__device__ __forceinline__ bf16x8 cat8(u32x2 lo, u32x2 hi) { u32x4 w; w.x = lo.x; w.y = lo.y; w.z = hi.x; w.w = hi.y; return __builtin_bit_cast(bf16x8, w); }
__device__ __forceinline__ int OTID() { int t = threadIdx.x; asm volatile("" : "+v"(t)); return t; }
__device__ __forceinline__ int OBLK() { int t = blockIdx.x; asm volatile("" : "+s"(t)); return t; }
__device__ __forceinline__ int OGRID() { int t = gridDim.x; asm volatile("" : "+s"(t)); return t; }

namespace pg8 {
constexpr int BM = 256, BK = 64, HALF = 128, HTB = HALF * BK * 2, STAGE_BYTES = 8 * HTB, NXCD = 8, WGM = 8;
__host__ __device__ __forceinline__ int lds_byte(int r, int c) { const int st = (r >> 4) * 2 + (c >> 5), rr = r & 15, cc = c & 31, ob = rr * 64 + cc * 2; return st * 1024 + (ob ^ (((ob >> 9) & 1) << 5)); }
__host__ __device__ __forceinline__ void stage_rc(int b, int& R, int& C) { const int st = b / 1024, sb = b % 1024, swz = sb ^ (((sb >> 9) & 1) << 5); R = (st >> 1) * 16 + swz / 64; C = (st & 1) * 32 + (swz % 64) / 2; }
__host__ __device__ __forceinline__ int perm32(int rho) { const int n = rho >> 4, i = rho & 15; return 8 * (i >> 2) + 4 * n + (i & 3); }

struct Unit { int pm, pn, aux; };

template <class Epi, class Sched, bool ALIGN_EPI>
__device__ __forceinline__ void gemm_phase(LAS unsigned char* lds, const int K, const int lda, const int ldb, const Sched& S, const Epi& E) {
    const int tid = OTID(), wid = __builtin_amdgcn_readfirstlane(tid >> 6), lane = tid & 63, wr = wid >> 2, wc = wid & 3, fr = lane & 15, fq = lane >> 4;
    const int nt = K / BK;
    unsigned voffA[2], voffB[2];
#pragma unroll
    for (int i = 0; i < 2; ++i) { int R, C; stage_rc(tid * 16 + i * 8192, R, C); const int Rb = (R & ~31) + perm32(R & 31);
        voffA[i] = (unsigned)(R * lda + C) * 2u; voffB[i] = (unsigned)(Rb * ldb + C) * 2u; }
    const size_t kstep = (size_t)(BK * 2);
    const size_t hstepA = (size_t)HALF * lda * 2, hstepB = (size_t)HALF * ldb * 2;
    const unsigned ldsw = (unsigned)wid * 1024u;
    const int aoff = lds_byte(wr * 64 + fr, fq * 8), boff = lds_byte(wc * 32 + fr, fq * 8);
#define PG8_SA(b, h) (((b) * 2 + (h)) * HTB)
#define PG8_SB(b, h) ((4 + (b) * 2 + (h)) * HTB)
#define PG8_STAGE(bufoff, gbase, voff) do { _Pragma("unroll") for (int _i = 0; _i < 2; ++_i) \
        __builtin_amdgcn_global_load_lds((const unsigned*)((const char*)(gbase) + (voff)[_i]), (LAS unsigned*)(lds + (bufoff) + ldsw + _i * 8192), 16, 0, 0); } while (0)
#define PG8_LDA(dst, b, h) do { _Pragma("unroll") for (int m = 0; m < 4; ++m) _Pragma("unroll") for (int k = 0; k < 2; ++k) dst[m][k] = *(const LAS bf16x8*)(lds + PG8_SA(b, h) + aoff + m * 2048 + k * 1024); } while (0)
#define PG8_LDB(dst, b, h) do { _Pragma("unroll") for (int n = 0; n < 2; ++n) _Pragma("unroll") for (int k = 0; k < 2; ++k) dst[n][k] = *(const LAS bf16x8*)(lds + PG8_SB(b, h) + boff + n * 2048 + k * 1024); } while (0)
#define PG8_MMA(ai, bj, At, Bt) do { __builtin_amdgcn_s_setprio(1); _Pragma("unroll") for (int m = 0; m < 4; ++m) _Pragma("unroll") for (int n = 0; n < 2; ++n) _Pragma("unroll") for (int k = 0; k < 2; ++k) \
        acc[ai][bj][m][n] = __builtin_amdgcn_mfma_f32_16x16x32_bf16(Bt[n][k], At[m][k], acc[ai][bj][m][n], 0, 0, 0); __builtin_amdgcn_s_setprio(0); } while (0)
#define PG8_WAIT_V(n) asm volatile("s_waitcnt vmcnt(" #n ")" ::: "memory")
#define PG8_WAIT_L(n) asm volatile("s_waitcnt lgkmcnt(" #n ")" ::: "memory")
#define PG8_BAR __builtin_amdgcn_s_barrier()
#define PG8_SCHED __builtin_amdgcn_sched_barrier(0)
    Unit cur, nxt; int ui = 0;
    if (!S.next(0, cur)) return;
    f32x4 acc[2][2][4][2];
#pragma unroll
    for (int a = 0; a < 2; ++a)
#pragma unroll
        for (int b = 0; b < 2; ++b)
#pragma unroll
            for (int m = 0; m < 4; ++m)
#pragma unroll
                for (int n = 0; n < 2; ++n) acc[a][b][m][n] = (f32x4){0.f, 0.f, 0.f, 0.f};
    bf16x8 At[4][2], B0[2][2], B1[2][2];
    const char* cA = S.A(cur); const char* cB = S.B(cur);
    PG8_STAGE(PG8_SB(0, 0), cB, voffB); PG8_STAGE(PG8_SB(0, 1), cB + hstepB, voffB); PG8_STAGE(PG8_SA(0, 0), cA, voffA); PG8_STAGE(PG8_SA(0, 1), cA + hstepA, voffA);
    if (wr == 1) PG8_BAR;
    PG8_WAIT_V(2); PG8_BAR;
    PG8_STAGE(PG8_SB(1, 0), cB + kstep, voffB); PG8_STAGE(PG8_SA(1, 0), cA + kstep, voffA); PG8_STAGE(PG8_SB(1, 1), cB + hstepB + kstep, voffB);
    PG8_WAIT_V(6); PG8_BAR;
    for (;;) {
        const bool has_next = S.next(ui + 1, nxt);
        const char* nA = has_next ? S.A(nxt) : cA; const char* nB = has_next ? S.B(nxt) : cB;
        for (int t = 0; t < nt; t += 2) {
            const bool last = (t == nt - 2);
            const char* a1 = cA + (size_t)(t + 1) * kstep;
            const char* a2 = last ? nA : cA + (size_t)(t + 2) * kstep; const char* b2 = last ? nB : cB + (size_t)(t + 2) * kstep;
            const char* a3 = a2 + kstep; const char* b3 = b2 + kstep;
            PG8_LDB(B0, 0, 0); PG8_LDB(B1, 0, 1); PG8_SCHED; PG8_LDA(At, 0, 0); PG8_STAGE(PG8_SA(1, 1), a1 + hstepA, voffA);
            PG8_WAIT_V(8); PG8_WAIT_L(0); PG8_BAR; PG8_MMA(0, 0, At, B0); PG8_MMA(0, 1, At, B1); PG8_BAR; PG8_SCHED;
            PG8_LDA(At, 0, 1); PG8_STAGE(PG8_SB(0, 0), b2, voffB); PG8_STAGE(PG8_SB(0, 1), b2 + hstepB, voffB); PG8_STAGE(PG8_SA(0, 0), a2, voffA);
            PG8_WAIT_V(8); PG8_WAIT_L(0); PG8_BAR; PG8_MMA(1, 0, At, B0); PG8_MMA(1, 1, At, B1); PG8_BAR; PG8_SCHED;
            PG8_LDB(B0, 1, 0); PG8_LDB(B1, 1, 1); PG8_SCHED; PG8_LDA(At, 1, 0); PG8_STAGE(PG8_SA(0, 1), a2 + hstepA, voffA);
            PG8_WAIT_V(8); PG8_WAIT_L(0); PG8_BAR; PG8_MMA(0, 0, At, B0); PG8_MMA(0, 1, At, B1); PG8_BAR; PG8_SCHED;
            PG8_LDA(At, 1, 1); PG8_STAGE(PG8_SB(1, 0), b3, voffB); PG8_STAGE(PG8_SB(1, 1), b3 + hstepB, voffB); PG8_STAGE(PG8_SA(1, 0), a3, voffA);
            PG8_WAIT_V(8); PG8_WAIT_L(0); PG8_BAR; PG8_MMA(1, 0, At, B0); PG8_MMA(1, 1, At, B1); PG8_BAR; PG8_SCHED;
        }
        if constexpr (ALIGN_EPI) { if (wr == 0) PG8_BAR; }
        E(acc, cur, wr, wc, fr, fq);
        if (!has_next) break;
#pragma unroll
        for (int a = 0; a < 2; ++a)
#pragma unroll
            for (int b = 0; b < 2; ++b)
#pragma unroll
                for (int m = 0; m < 4; ++m)
#pragma unroll
                    for (int n = 0; n < 2; ++n) acc[a][b][m][n] = (f32x4){0.f, 0.f, 0.f, 0.f};
        cur = nxt; cA = nA; cB = nB; ++ui;
        if constexpr (ALIGN_EPI) { if (wr == 1) PG8_BAR; }
    }
    PG8_WAIT_V(0);
    if constexpr (!ALIGN_EPI) { if (wr == 0) PG8_BAR; }
    PG8_BAR;
#undef PG8_SA
#undef PG8_SB
#undef PG8_STAGE
#undef PG8_LDA
#undef PG8_LDB
#undef PG8_MMA
#undef PG8_WAIT_V
#undef PG8_WAIT_L
#undef PG8_BAR
#undef PG8_SCHED
}
}
#define XB_TMO      128
#define XB_XCNT(j)  (256  + 64 * (j))
#define XB_XSUB(j)  (1280 + 64 * (j))
#define XB_XGEN(j)  (2304 + 64 * (j))
#define XB_TOP      3328
#define XB_TOPGEN   3392
#define XCD_BAR_WORDS 3456
#define XB_SPIN_CAP (1u << 22)
__device__ __forceinline__ unsigned xb_ld(unsigned* p)              { return __hip_atomic_load(p, __ATOMIC_RELAXED, __HIP_MEMORY_SCOPE_AGENT); }
__device__ __forceinline__ unsigned xb_add(unsigned* p, unsigned v) { return __hip_atomic_fetch_add(p, v, __ATOMIC_RELAXED, __HIP_MEMORY_SCOPE_AGENT); }
__device__ __forceinline__ unsigned xb_xcc_id() { return (unsigned)__builtin_amdgcn_s_getreg((3 << 11) | 20) & 0xFu; }
#define XB_SPIN(cond, bar) do { unsigned _sp = 0; while (cond) { __builtin_amdgcn_s_sleep(1); \
    if ((++_sp & 255u) == 0u) { if (xb_ld(&(bar)[XB_TMO])) break; if (_sp > XB_SPIN_CAP) { atomicAdd(&(bar)[XB_TMO], 1u); break; } } } } while (0)
struct XcdBarrier { unsigned* bar; unsigned x; volatile LAS unsigned* st; };
__device__ __forceinline__ XcdBarrier xcd_barrier_post(unsigned* bar, volatile LAS unsigned* st) {
    XcdBarrier b; b.bar = bar; b.x = xb_xcc_id(); b.st = st;
    if (threadIdx.x == 0) (void)xb_add(&bar[XB_XCNT(b.x)], 1u);
    return b;
}
__device__ __forceinline__ void xcd_barrier_complete(unsigned* bar, unsigned x, unsigned& nloc, unsigned& nx) {
    const unsigned G = gridDim.x * gridDim.y * gridDim.z;
    unsigned sum, cnt, mine, sp = 0u;
    for (;;) {
        sum = 0u; cnt = 0u; mine = 0u;
#pragma unroll 1
        for (unsigned j = 0; j < 16; ++j) { const unsigned c = xb_ld(&bar[XB_XCNT(j)]); sum += c; cnt += (c > 0u) ? 1u : 0u; mine = (j == x) ? c : mine; }
        if (sum == G) break;
        __builtin_amdgcn_s_sleep(1);
        if ((++sp & 255u) == 0u) { if (xb_ld(&bar[XB_TMO])) break; if (sp > XB_SPIN_CAP) { atomicAdd(&bar[XB_TMO], 1u); break; } }
    }
    nloc = mine > 0u ? mine : 1u; nx = cnt > 0u ? cnt : 1u;
}
__device__ __forceinline__ void xcd_barrier_impl(unsigned* bbar, unsigned bx, volatile LAS unsigned* bst) {
    XcdBarrier b; b.bar = bbar; b.x = bx; b.st = bst;
    asm volatile("s_waitcnt vmcnt(0)" ::: "memory");
    __syncthreads();
    if (threadIdx.x == 0) {
        unsigned* bar = b.bar;
        __builtin_amdgcn_s_waitcnt(0);
        unsigned nloc = b.st[0], nx = b.st[1];
        if (nloc == 0u) { xcd_barrier_complete(bar, b.x, nloc, nx); b.st[0] = nloc; b.st[1] = nx; }
        const unsigned old = xb_add(&bar[XB_XSUB(b.x)], 1u);
        const unsigned gen = old / nloc;
        if (old + 1u == (gen + 1u) * nloc) {
            __builtin_amdgcn_fence(__ATOMIC_RELEASE, "agent");
            asm volatile("s_waitcnt vmcnt(0)" ::: "memory");
            const unsigned og = xb_add(&bar[XB_TOP], 1u);
            const unsigned tg = og / nx;
            if (og + 1u == (tg + 1u) * nx) xb_add(&bar[XB_TOPGEN], 1u);
            else XB_SPIN(xb_ld(&bar[XB_TOPGEN]) == tg, bar);
            __builtin_amdgcn_fence(__ATOMIC_ACQUIRE, "agent");
            xb_add(&bar[XB_XGEN(b.x)], 1u);
            asm volatile("s_waitcnt vmcnt(0)" ::: "memory");
        } else {
            XB_SPIN(xb_ld(&bar[XB_XGEN(b.x)]) == gen, bar);
            __builtin_amdgcn_fence(__ATOMIC_ACQUIRE, "agent");
            asm volatile("s_waitcnt vmcnt(0)" ::: "memory");
        }
    }
    __syncthreads();
}
__device__ __forceinline__ void xcd_barrier(const XcdBarrier& b) { xcd_barrier_impl(b.bar, b.x, b.st); }

constexpr int D = 1024, NBATCH = 8, SEQ = 4096, CTXL = 256, ML = NBATCH * SEQ, MC = NBATCH * CTXL, MA = ML + MC;
constexpr int ZP = 6144, PP = 1536;
constexpr int C_RQ = 0, C_RK = 256, C_RV = 512, C_RG = 1024, C_WQ = 1536, C_WK = 2048, C_WV = 2176, C_NQ = 2304, C_NK = 2816, C_NV = 3328,
              C_GQ = 3840, C_GK = 4352, C_GV = 4864, C_GG = 5376, C_GA = 5888, C_GB = 5896;
constexpr int C_GSUM = 3840;
constexpr int Y_RET = C_RG, Y_WIN = C_WQ, Y_NA = C_NQ, Y_GDN = C_GG;
__host__ __device__ __forceinline__ int dead_tile(int gt) { return gt < 4 ? gt : (gt == 4 ? 8 : (gt < 15 ? gt + 6 : 23)); }
__device__ __forceinline__ int utile_off(int i, int col) { const int a_ = i >> 5, g_ = (i >> 3) & 3, p_ = (i >> 2) & 1, j_ = i & 3; const int rt_ = 2 * a_ + p_, lane_ = 16 * g_ + (col & 15), ch_ = col >> 6, c_ = (col >> 4) & 3;
    return ((((rt_ * 2 + ch_) * 64 + lane_) * 4 + c_) * 4 + j_); }
constexpr float EPS = 1e-6f;
constexpr int NEXP = 32, DEXP = 512, MAXT = 304;
constexpr int NWAVES = 8, NTHR = 512;

constexpr size_t MiB = 1u << 20;
constexpr size_t WS_CTL = 0, CTL_ZERO_BYTES = 1 * MiB;
constexpr size_t WS_ROPE = 1 * MiB;
constexpr size_t WS_MOD = 2 * MiB;
constexpr size_t WS_XC = 3 * MiB;
constexpr size_t WS_GB = 11 * MiB;
constexpr size_t WS_TOK = 14 * MiB;
constexpr size_t WS_WSM = 16 * MiB;
constexpr size_t WSM_IN = 0, WSM_MERGE = 12 * MiB, WSM_BR = 20 * MiB, WSM_OUT = 24 * MiB;
constexpr size_t WS_KVT = 42 * MiB;
constexpr size_t WS_HL = 76 * MiB;
constexpr size_t WS_Z = 144 * MiB;
constexpr size_t WS_P = 552 * MiB;
constexpr size_t WS_GC2 = 654 * MiB;
constexpr size_t WS_END = 656 * MiB;
constexpr size_t WS_WGU = WS_P, WS_WDN = WS_P + 64 * MiB;
constexpr size_t WS_XB = WS_Z, WS_ACT = WS_Z + 152 * MiB, WS_YB = WS_Z + 228 * MiB;
static_assert(WS_YB + (size_t)MAXT * 256 * 1024 * 2 <= WS_P && WS_WDN + (size_t)32 * 1024 * 512 * 2 <= WS_P + (size_t)MA * PP * 2, "moe overlay");
static_assert(WS_HL + (size_t)MA * 1024 * 2 <= WS_Z && WS_Z + (size_t)MA * ZP * 2 <= WS_P && WS_P + (size_t)MA * PP * 2 <= WS_END, "ws map");
constexpr size_t TOK_E = 0, TOK_SLOT = 256 * 1024, TOK_W = 512 * 1024, TOK_POS = 1024 * 1024, TOK_BCNT = 1536 * 1024, TOK_TILE = 1600 * 1024, TOK_RSTD = 1664 * 1024;
constexpr int CW_BAR = 1024;

constexpr int LDS_BYTES = 163840 - 1024;
constexpr int LDS_CTL = LDS_BYTES - 256;
struct KArgs { const float* in[29]; float* out; unsigned char* ws; int ph_lo, ph_hi; };
enum { I_X = 0, I_C, I_CTX, I_CCTX, I_WMOD, I_BMOD, I_NORM1, I_NORM2, I_WIN, I_RDECAY, I_RGN, I_WQN, I_WKN, I_WSINK, I_NQN, I_NKN, I_RPB, I_GCONV, I_GALOG, I_GDT, I_GNORM,
       I_WBR, I_WMERGE, I_WOUT, I_WROUTER, I_RBIAS, I_WEG, I_WEU, I_WED };

__device__ __forceinline__ float wave_sum(float v) {
#pragma unroll
    for (int o = 1; o < 64; o <<= 1) v += __shfl_xor(v, o);
    return v;
}
__device__ __forceinline__ float sum16(float v) { v += __shfl_xor(v, 1); v += __shfl_xor(v, 2); v += __shfl_xor(v, 4); v += __shfl_xor(v, 8); return v; }
#define LDS_WAIT() asm volatile("s_waitcnt lgkmcnt(0)" ::: "memory")

__device__ __forceinline__ void transpose_item(const float* W, int ldw, int ncols, int k0, int n0, bf16_t* WT, int ldt, int dst_row0, LAS float* scr, int lane) {
    const int nn = n0 + (lane & 31);
#pragma unroll 8
    for (int i = 0; i < 32; ++i) { const int kk = 2 * i + (lane >> 5); scr[kk * 33 + (lane & 31)] = (nn < ncols) ? W[(size_t)(k0 + kk) * ldw + nn] : 0.f; }
    LDS_WAIT(); asm volatile("" ::: "memory");
    const int c = lane & 7;
#pragma unroll
    for (int j = 0; j < 4; ++j) { const int n = (lane >> 3) + 8 * j; const LAS float* s = scr + (8 * c) * 33 + n;
        u32x4 o; o.x = pk2(s[0 * 33], s[1 * 33]); o.y = pk2(s[2 * 33], s[3 * 33]); o.z = pk2(s[4 * 33], s[5 * 33]); o.w = pk2(s[6 * 33], s[7 * 33]);
        *(u32x4*)(WT + (size_t)(dst_row0 + n) * ldt + k0 + 8 * c) = o; }
    LDS_WAIT(); asm volatile("" ::: "memory");
}

__device__ __forceinline__ void small_weight_convert(const KArgs& a, LAS unsigned char* lds, int l) {
    const int tid = OTID(), lane = tid & 63, wave = tid >> 6, G = OGRID(), blk = OBLK();
    unsigned char* ws = a.ws;
    LAS float* scr = (LAS float*)(lds + 65536 + wave * 8448);
    const int gw = blk * NWAVES + wave, NGW = G * NWAVES;
    constexpr int I_IN = 16 * 192, I_MG = 16 * 128, I_BR = 4 * 8 * 32, I_OUT = 16 * 32, I_LAYER = I_IN + I_MG + I_BR + I_OUT;
    bf16_t* wsm = (bf16_t*)(ws + WS_WSM);
    for (int it = gw; it < I_LAYER; it += NGW) {
        int r = it;
        if (r < I_IN) { const int kb = r / 192, nb = r % 192; transpose_item(a.in[I_WIN] + (size_t)l * 1024 * 5904, 5904, 5904, kb * 64, nb * 32, wsm + WSM_IN / 2, 1024, nb * 32, scr, lane); continue; } r -= I_IN;
        if (r < I_MG) { const int kb = r / 128, nb = r % 128; transpose_item(a.in[I_WMERGE] + (size_t)l * 1024 * 4096, 4096, 4096, kb * 64, nb * 32, wsm + WSM_MERGE / 2, 1024, nb * 32, scr, lane); continue; } r -= I_MG;
        if (r < I_BR) { const int br = r / 256, q = r % 256, kb = q / 32, nb = q % 32;
            transpose_item(a.in[I_WBR] + (size_t)(l * 4 + br) * 512 * 1024, 1024, 1024, kb * 64, nb * 32, wsm + WSM_BR / 2 + (size_t)br * 1024 * 512, 512, nb * 32, scr, lane); continue; } r -= I_BR;
        { const int kb = r / 32, nb = r % 32; transpose_item(a.in[I_WOUT] + (size_t)l * 1024 * 1024, 1024, 1024, kb * 64, nb * 32, wsm + WSM_OUT / 2, 1024, nb * 32, scr, lane); }
    }
}

__device__ __forceinline__ void phase_prologue(const KArgs& a, LAS unsigned char* lds) {
    const int tid = OTID(), lane = tid & 63, wave = tid >> 6, G = OGRID(), blk = OBLK();
    unsigned char* ws = a.ws;
    { float* cs = (float*)(ws + WS_ROPE); float* sn = cs + 4096 * 32;
      for (int idx = blk * NTHR + tid; idx < 4096 * 32; idx += G * NTHR) { const int t = idx >> 5, i = idx & 31; const float pos = (float)((i < 16) ? (t >> 6) : (t & 63));
          const float inv = exp2f(-(float)(i & 15) * (13.287712379549449f / 16.0f)); const float ang = pos * inv; cs[idx] = cosf(ang); sn[idx] = sinf(ang); } }
    if (blk < 192) {
        const int l = blk / 96, cg = blk % 96;
        LAS float* sc = (LAS float*)lds; LAS float* red = (LAS float*)(lds + 40960);
        for (int idx = tid; idx < 9 * 1024; idx += NTHR) { const int v = idx >> 10, k = idx & 1023; const float cv = (v < 8) ? a.in[I_C][v * 1024 + k] : a.in[I_CCTX][k]; sc[idx] = siluf_(cv); }
        __syncthreads();
        const float* wm = a.in[I_WMOD] + (size_t)l * 1024 * 6144 + cg * 64 + lane;
        float acc[9];
#pragma unroll
        for (int v = 0; v < 9; ++v) acc[v] = 0.f;
#pragma unroll 8
        for (int kk = 0; kk < 128; ++kk) { const int k = wave * 128 + kk; const float w = wm[(size_t)k * 6144];
#pragma unroll
            for (int v = 0; v < 9; ++v) acc[v] += sc[v * 1024 + k] * w; }
#pragma unroll
        for (int v = 0; v < 9; ++v) red[(wave * 9 + v) * 64 + lane] = acc[v];
        __syncthreads();
        for (int idx = tid; idx < 576; idx += NTHR) { const int v = idx >> 6, ln = idx & 63; float s = a.in[I_BMOD][l * 6144 + cg * 64 + ln];
#pragma unroll
            for (int w = 0; w < 8; ++w) s += red[(w * 9 + v) * 64 + ln];
            ((float*)(ws + WS_MOD))[(size_t)(l * 9 + v) * 6144 + cg * 64 + ln] = s; }
        __syncthreads();
    }
    small_weight_convert(a, lds, 0);
}

constexpr int EXPC_ITEMS = 3 * 8192;
__device__ __forceinline__ void expert_convert_range(const KArgs& a, LAS unsigned char* lds, int l, int lo, int hi, int blk0) {
    const int tid = OTID(), lane = tid & 63, wave = tid >> 6, blk = OBLK(), G = OGRID();
    if (G <= blk0) blk0 = 0;
    if (blk < blk0) return;
    LAS float* scr = (LAS float*)(lds + 65536 + wave * 8448);
    bf16_t* wgu = (bf16_t*)(a.ws + WS_WGU); bf16_t* wdn = (bf16_t*)(a.ws + WS_WDN);
    const int gw = (blk - blk0) * NWAVES + wave, NGW = (G - blk0) * NWAVES;
    for (int it = lo + gw; it < hi; it += NGW) {
        const int which = it / 8192, r = it % 8192, e = r / 256, q = r % 256;
        if (which < 2) { const int kb = q / 16, nb = q % 16, n0 = nb * 32;
            transpose_item(a.in[which == 0 ? I_WEG : I_WEU] + (size_t)(l * 32 + e) * 1024 * 512, 512, 512, kb * 64, n0, wgu + (size_t)e * 1024 * 1024, 1024, 256 * (n0 >> 7) + (n0 & 127) + which * 128, scr, lane); }
        else { const int kb = q / 32, nb = q % 32; transpose_item(a.in[I_WED] + (size_t)(l * 32 + e) * 512 * 1024, 1024, 1024, kb * 64, nb * 32, wdn + (size_t)e * 1024 * 512, 512, nb * 32, scr, lane); }
    }
}

__device__ __forceinline__ void modulate_store(const f32x4 (&v)[4], const float* gain, const float* sh, const float* sc, bf16_t* orow, int lane) {
    float ss = 0.f;
#pragma unroll
    for (int j = 0; j < 4; ++j) ss += (v[j].x * v[j].x + v[j].y * v[j].y) + (v[j].z * v[j].z + v[j].w * v[j].w);
    const float rstd = rsqrtf(wave_sum(ss) * (1.f / 1024.f) + EPS);
#pragma unroll
    for (int j = 0; j < 4; ++j) {
        const f32x4 g = ((const f32x4*)gain)[lane + 64 * j], s1 = ((const f32x4*)sc)[lane + 64 * j], s0 = ((const f32x4*)sh)[lane + 64 * j];
        const f32x4 y = (v[j] * rstd * g) * (s1 + 1.0f) + s0;
        u32x2 o; o.x = pk2(y.x, y.y); o.y = pk2(y.z, y.w);
        ((u32x2*)orow)[lane + 64 * j] = o;
    }
}
__device__ __forceinline__ int row_modidx(int row) { return row < ML ? (row >> 12) : 8; }

__device__ __forceinline__ void phase_modulate1(const KArgs& a, int l, int nrows) {
    const int tid = OTID(), lane = tid & 63, wave = tid >> 6;
    const int gw = OBLK() * NWAVES + wave, NGW = OGRID() * NWAVES;
    const float* xl = (l == 0) ? a.in[I_X] : a.out; const float* xc = (l == 0) ? a.in[I_CTX] : (const float*)(a.ws + WS_XC);
    bf16_t* hl = (bf16_t*)(a.ws + WS_HL);
    for (int row = gw; row < nrows; row += NGW) {
        const float* xr = row < ML ? xl + (size_t)row * D : xc + (size_t)(row - ML) * D;
        f32x4 v[4];
#pragma unroll
        for (int j = 0; j < 4; ++j) v[j] = ((const f32x4*)xr)[lane + 64 * j];
        const float* mod = (const float*)(a.ws + WS_MOD) + (size_t)(l * 9 + row_modidx(row)) * 6144;
        modulate_store(v, a.in[I_NORM1] + l * D, mod, mod + 1024, hl + (size_t)row * D, lane);
    }
}
__device__ __forceinline__ void unpack8(const u32x4 u, float (&x)[8]) { x[0] = bflo(u.x); x[1] = bfhi(u.x); x[2] = bflo(u.y); x[3] = bfhi(u.y); x[4] = bflo(u.z); x[5] = bfhi(u.z); x[6] = bflo(u.w); x[7] = bfhi(u.w); }
__device__ __forceinline__ u32x4 pack8(const float (&x)[8]) { u32x4 u; u.x = pk2(x[0], x[1]); u.y = pk2(x[2], x[3]); u.z = pk2(x[4], x[5]); u.w = pk2(x[6], x[7]); return u; }
__device__ __forceinline__ void head64_pass16(bf16_t* zr, int hbase, const float* wqn, const float* wkn, const float* nqn, const float* nkn, bool lat, const float* cs, const float* sn, int lane) {
    const int hidx = hbase + (lane >> 2), p = lane & 3; const bool act = hidx < 34;
    const int col = (hidx < 8 ? hidx * 64 : (hidx < 18 ? C_WQ + (hidx - 8) * 64 : C_NQ + (hidx - 18) * 64)) + 8 * p;
    const float* gain = hidx < 8 ? nullptr : (hidx < 16 ? wqn : (hidx < 18 ? wkn : (hidx < 26 ? nqn : nkn)));
    const bool rope = lat && hidx < 18;
    const float scale = (hidx >= 4 && hidx < 8) ? 0.125f : (((hidx >= 8 && hidx < 16) || (hidx >= 18 && hidx < 26)) ? 0.125f * 1.4426950408889634f : 1.0f);
    float x1[8], x2[8];
    { u32x4 u1 = (u32x4){0u, 0u, 0u, 0u}, u2 = u1; if (act) { u1 = *(const u32x4*)(zr + col); u2 = *(const u32x4*)(zr + col + 32); } unpack8(u1, x1); unpack8(u2, x2); }
    float ss = 0.f;
#pragma unroll
    for (int e = 0; e < 8; ++e) ss += x1[e] * x1[e] + x2[e] * x2[e];
    ss += __shfl_xor(ss, 1); ss += __shfl_xor(ss, 2);
    if (gain) { const float r = rsqrtf(ss * (1.f / 64.f) + EPS);
        const f32x4 g0 = *(const f32x4*)(gain + 8 * p), g1 = *(const f32x4*)(gain + 8 * p + 4), g2 = *(const f32x4*)(gain + 32 + 8 * p), g3 = *(const f32x4*)(gain + 36 + 8 * p);
#pragma unroll
        for (int e = 0; e < 4; ++e) { x1[e] *= r * g0[e]; x1[e + 4] *= r * g1[e]; x2[e] *= r * g2[e]; x2[e + 4] *= r * g3[e]; } }
    if (rope) { const f32x4 c0 = *(const f32x4*)(cs + 8 * p), c1 = *(const f32x4*)(cs + 8 * p + 4), s0 = *(const f32x4*)(sn + 8 * p), s1 = *(const f32x4*)(sn + 8 * p + 4);
#pragma unroll
        for (int e = 0; e < 8; ++e) { const float c = e < 4 ? c0[e & 3] : c1[e & 3], sv = e < 4 ? s0[e & 3] : s1[e & 3]; const float y1 = x1[e] * c - x2[e] * sv, y2 = x1[e] * sv + x2[e] * c; x1[e] = y1; x2[e] = y2; } }
#pragma unroll
    for (int e = 0; e < 8; ++e) { x1[e] *= scale; x2[e] *= scale; }
    if (act) { *(u32x4*)(zr + col) = pack8(x1); *(u32x4*)(zr + col + 32) = pack8(x2); }
}
__device__ __forceinline__ void phase_prep(const KArgs& a, int l) {
    const int tid = OTID(), lane = tid & 63, wave = tid >> 6;
    const int gw = OBLK() * NWAVES + wave, NGW = OGRID() * NWAVES;
    bf16_t* Z = (bf16_t*)(a.ws + WS_Z); bf16_t* P = (bf16_t*)(a.ws + WS_P);
    const float* cs0 = (const float*)(a.ws + WS_ROPE); const float* sn0 = cs0 + 4096 * 32;
    float* GBa = (float*)(a.ws + WS_GB); float* GBb = GBa + (size_t)MA * 8;
    const float* wqn = a.in[I_WQN] + l * 64; const float* wkn = a.in[I_WKN] + l * 64; const float* nqn = a.in[I_NQN] + l * 64; const float* nkn = a.in[I_NKN] + l * 64;
    const float* cw = a.in[I_GCONV] + (size_t)l * 3 * 1536;
    for (int row = gw; row < MA; row += NGW) {
        const bool lat = row < ML; const int t = lat ? (row & 4095) : ((row - ML) & 255); const int slen = lat ? 4096 : 256;
        bf16_t* zr = Z + (size_t)row * ZP;
        const float* cs = cs0 + t * 32; const float* sn = sn0 + t * 32;
#pragma unroll
        for (int ps = 0; ps < 3; ++ps) {
            const int c = (ps * 4 + (lane >> 4)) * 128 + (lane & 15) * 8; const bf16_t* zc = zr + C_GQ + c;
            const u32x4 zero = (u32x4){0u, 0u, 0u, 0u};
            const u32x4 uc = *(const u32x4*)zc, up = (t > 0) ? *(const u32x4*)(zc - ZP) : zero, un = (t < slen - 1) ? *(const u32x4*)(zc + ZP) : zero;
            float xp[8], xc[8], xn[8], y[8]; unpack8(up, xp); unpack8(uc, xc); unpack8(un, xn);
            const f32x4 w00 = *(const f32x4*)(cw + c), w01 = *(const f32x4*)(cw + c + 4), w10 = *(const f32x4*)(cw + 1536 + c), w11 = *(const f32x4*)(cw + 1536 + c + 4), w20 = *(const f32x4*)(cw + 3072 + c), w21 = *(const f32x4*)(cw + 3072 + c + 4);
            float ss = 0.f;
#pragma unroll
            for (int e = 0; e < 8; ++e) { const float w0 = e < 4 ? w00[e & 3] : w01[e & 3], w1 = e < 4 ? w10[e & 3] : w11[e & 3], w2 = e < 4 ? w20[e & 3] : w21[e & 3];
                y[e] = siluf_(w0 * xp[e] + w1 * xc[e] + w2 * xn[e]); ss += y[e] * y[e]; }
            if (ps < 2) { ss += __shfl_xor(ss, 1); ss += __shfl_xor(ss, 2); ss += __shfl_xor(ss, 4); ss += __shfl_xor(ss, 8);
                const float r = rsqrtf(ss + EPS) * (ps == 0 ? 0.08838834764831845f : 1.0f);
#pragma unroll
                for (int e = 0; e < 8; ++e) y[e] *= r; }
            *(u32x4*)(P + (size_t)row * PP + c) = pack8(y);
        }
        if (lane < 8) {
            const float av = bf2f(zr[C_GA + lane]) + a.in[I_GDT][l * 8 + lane], bv = bf2f(zr[C_GB + lane]);
            const float sp = fmaxf(av, 0.f) + log1pf(__expf(-fabsf(av)));
            const float g = -__expf(a.in[I_GALOG][l * 8 + lane]) * sp;
            GBa[(size_t)row * 8 + lane] = g; GBb[(size_t)row * 8 + lane] = sigmoidf_(bv);
        }
        head64_pass16(zr, 0, wqn, wkn, nqn, nkn, lat, cs, sn, lane);
        head64_pass16(zr, 16, wqn, wkn, nqn, nkn, lat, cs, sn, lane);
        head64_pass16(zr, 32, wqn, wkn, nqn, nkn, lat, cs, sn, lane);
    }
}

__device__ __forceinline__ void phase_post(const KArgs& a, int l, int nrows) {
    const int tid = OTID(), lane = tid & 63, wave = tid >> 6;
    const int gw = OBLK() * NWAVES + wave, NGW = OGRID() * NWAVES;
    bf16_t* Z = (bf16_t*)(a.ws + WS_Z);
    const float* gnm = a.in[I_GNORM] + l * 128;
    for (int row = gw; row < nrows; row += NGW) {
        bf16_t* zr = Z + (size_t)row * ZP;
#pragma unroll
        for (int h = 0; h < 4; ++h) {
            const int c = h * 128 + lane * 2;
            { const unsigned ug = *(const unsigned*)(zr + C_GG + c);
              const int ci = (row < ML ? row : row - ML) & 63; const bf16_t* zblk = zr - (size_t)ci * ZP;
              const int e0 = utile_off(ci, lane * 2), e1 = utile_off(ci, lane * 2 + 1);
              const bf16_t* p0 = zblk + (size_t)(e0 >> 7) * ZP + h * 128 + (e0 & 127); const bf16_t* p1 = zblk + (size_t)(e1 >> 7) * ZP + h * 128 + (e1 & 127);
              const float oa = bf2f(p0[C_GQ]) + bf2f(p0[C_GK]), ob = bf2f(p1[C_GQ]) + bf2f(p1[C_GK]); const float r = rsqrtf(wave_sum(oa * oa + ob * ob) * (1.f / 128.f) + EPS);
              *(unsigned*)(zr + Y_GDN + c) = pk2(oa * r * gnm[lane * 2] * siluf_(bflo(ug)), ob * r * gnm[lane * 2 + 1] * siluf_(bfhi(ug))); }
        }
    }
}
constexpr int AT_TILE = 4096;
constexpr int AT_BUF = 2 * AT_TILE;
constexpr int AT_TABOFF = 2 * AT_BUF;
constexpr int AT_WAVE_BYTES = 2 * AT_BUF + 2048;
template <int NQ> struct AttnSt { f32x4 O[NQ][4]; float m[NQ], l[NQ]; bf16x8 Q[NQ][2]; };
__device__ __forceinline__ void stage_issue(const char* zb, const unsigned (&rp)[4], int kcolb, int vcolb, LAS unsigned char* buf) {
    asm volatile("s_waitcnt lgkmcnt(0)" ::: "memory");
#pragma unroll
    for (int c = 0; c < 4; ++c) {
        __builtin_amdgcn_global_load_lds((const unsigned*)(zb + rp[c] + kcolb), (LAS unsigned*)(buf + c * 1024), 16, 0, 0);
        __builtin_amdgcn_global_load_lds((const unsigned*)(zb + rp[c] + vcolb), (LAS unsigned*)(buf + AT_TILE + c * 1024), 16, 0, 0);
    }
}
__device__ __forceinline__ int at_piece_off(int lane) { const int row = lane >> 3; return (((lane & 7) ^ (row & 7)) * 16); }
__device__ __forceinline__ s16x4 lds_tr16(const LAS unsigned char* p) { return __builtin_bit_cast(s16x4, __builtin_amdgcn_ds_read_tr16_b64_v4i16((LAS s16x4*)p)); }

struct AttnAddr { unsigned k0, k1, v[4]; };
__device__ __forceinline__ unsigned lds_u32(const LAS unsigned char* p) { return (unsigned)(unsigned long long)p; }
__device__ __forceinline__ AttnAddr attn_addr(int lane) {
    const int g = lane >> 4, r16 = lane & 15, qq = r16 >> 2, pp = r16 & 3, row = 4 * g + qq; AttnAddr A;
    A.k0 = r16 * 128 + ((g ^ (r16 & 7)) * 16); A.k1 = r16 * 128 + (((4 + g) ^ (r16 & 7)) * 16);
#pragma unroll
    for (int dt = 0; dt < 4; ++dt) A.v[dt] = row * 128 + (((dt * 2 + (pp >> 1)) ^ (row & 7)) * 16) + (pp & 1) * 8;
    return A;
}
struct AttnFrag { bf16x8 kf[2][2]; bf16x8 vf[4]; };
__device__ __forceinline__ void attn_read(AttnFrag& F, const LAS unsigned char* kl, int lane) {
    const AttnAddr AD = attn_addr(lane);
    const unsigned base = lds_u32(kl);
    u32x4 k00, k01, k10, k11; u32x2 vl0, vh0, vl1, vh1, vl2, vh2, vl3, vh3;
    asm volatile(
        "ds_read_b128 %0, %12\n\t" "ds_read_b128 %1, %13\n\t" "ds_read_b128 %2, %12 offset:2048\n\t" "ds_read_b128 %3, %13 offset:2048\n\t"
        "ds_read_b64_tr_b16 %4, %14 offset:4096\n\t" "ds_read_b64_tr_b16 %5, %14 offset:6144\n\t"
        "ds_read_b64_tr_b16 %6, %15 offset:4096\n\t" "ds_read_b64_tr_b16 %7, %15 offset:6144\n\t"
        "ds_read_b64_tr_b16 %8, %16 offset:4096\n\t" "ds_read_b64_tr_b16 %9, %16 offset:6144\n\t"
        "ds_read_b64_tr_b16 %10, %17 offset:4096\n\t" "ds_read_b64_tr_b16 %11, %17 offset:6144\n\t"
        "s_waitcnt lgkmcnt(0)"
        : "=&v"(k00), "=&v"(k01), "=&v"(k10), "=&v"(k11), "=&v"(vl0), "=&v"(vh0), "=&v"(vl1), "=&v"(vh1), "=&v"(vl2), "=&v"(vh2), "=&v"(vl3), "=&v"(vh3)
        : "v"(base + AD.k0), "v"(base + AD.k1), "v"(base + AD.v[0]), "v"(base + AD.v[1]), "v"(base + AD.v[2]), "v"(base + AD.v[3])
        : "memory");
    F.kf[0][0] = __builtin_bit_cast(bf16x8, k00); F.kf[0][1] = __builtin_bit_cast(bf16x8, k01); F.kf[1][0] = __builtin_bit_cast(bf16x8, k10); F.kf[1][1] = __builtin_bit_cast(bf16x8, k11);
    F.vf[0] = cat8(vl0, vh0); F.vf[1] = cat8(vl1, vh1); F.vf[2] = cat8(vl2, vh2); F.vf[3] = cat8(vl3, vh3);
}
template <int NQ, class BiasF>
__device__ __forceinline__ void attn_compute(AttnSt<NQ>& st, const AttnFrag& F, const BiasF& bias, int lane) {
    const int g = lane >> 4, r16 = lane & 15;
#pragma unroll
    for (int qi = 0; qi < NQ; ++qi) {
        if (bias.skip(qi)) continue;
        const bf16x8 Q0 = st.Q[qi][0], Q1 = st.Q[qi][1];
        f32x4 s0 = (f32x4){0.f, 0.f, 0.f, 0.f}, s1 = (f32x4){0.f, 0.f, 0.f, 0.f};
        s0 = __builtin_amdgcn_mfma_f32_16x16x32_bf16(F.kf[0][0], Q0, s0, 0, 0, 0);
        s0 = __builtin_amdgcn_mfma_f32_16x16x32_bf16(F.kf[0][1], Q1, s0, 0, 0, 0);
        s1 = __builtin_amdgcn_mfma_f32_16x16x32_bf16(F.kf[1][0], Q0, s1, 0, 0, 0);
        s1 = __builtin_amdgcn_mfma_f32_16x16x32_bf16(F.kf[1][1], Q1, s1, 0, 0, 0);
        if (BiasF::HAS_BIAS && !bias.nobias()) { f32x4 b0, b1; bias.get(qi, r16, g, b0, b1); s0 = s0 + b0; s1 = s1 + b1; }
        float mx = fmaxf(fmaxf(fmaxf(s0[0], s0[1]), fmaxf(s0[2], s0[3])), fmaxf(fmaxf(s1[0], s1[1]), fmaxf(s1[2], s1[3])));
        mx = fmaxf(mx, __shfl_xor(mx, 16)); mx = fmaxf(mx, __shfl_xor(mx, 32));
        const float mnew = fmaxf(st.m[qi], mx), alpha = __builtin_amdgcn_exp2f(st.m[qi] - mnew);
        float p0[4], p1[4], ps = 0.f;
#pragma unroll
        for (int j = 0; j < 4; ++j) { p0[j] = __builtin_amdgcn_exp2f(s0[j] - mnew); p1[j] = __builtin_amdgcn_exp2f(s1[j] - mnew); ps += p0[j] + p1[j]; }
        st.l[qi] = st.l[qi] * alpha + ps; st.m[qi] = mnew;
        u32x4 pw; pw.x = pk2(p0[0], p0[1]); pw.y = pk2(p0[2], p0[3]); pw.z = pk2(p1[0], p1[1]); pw.w = pk2(p1[2], p1[3]);
        const bf16x8 pf = __builtin_bit_cast(bf16x8, pw);
        if (__builtin_amdgcn_ballot_w64(alpha != 1.0f) != 0ull) {
#pragma unroll
            for (int dt = 0; dt < 4; ++dt) st.O[qi][dt] = st.O[qi][dt] * alpha; }
#pragma unroll
        for (int dt = 0; dt < 4; ++dt) st.O[qi][dt] = __builtin_amdgcn_mfma_f32_16x16x32_bf16(F.vf[dt], pf, st.O[qi][dt], 0, 0, 0);
    }
}
template <int NQ> __device__ __forceinline__ void attn_init(AttnSt<NQ>& st) {
#pragma unroll
    for (int qi = 0; qi < NQ; ++qi) { st.m[qi] = -1e4f; st.l[qi] = 0.f;
#pragma unroll
        for (int dt = 0; dt < 4; ++dt) st.O[qi][dt] = (f32x4){0.f, 0.f, 0.f, 0.f}; }
}
template <int NQ> __device__ __forceinline__ void attn_store(AttnSt<NQ>& st, int qi, bf16_t* orow, int lane) {
    const int g = lane >> 4;
    float lt = st.l[qi]; lt += __shfl_xor(lt, 16); lt += __shfl_xor(lt, 32);
    const float inv = 1.0f / lt;
#pragma unroll
    for (int dt = 0; dt < 4; ++dt) { const f32x4 o = st.O[qi][dt] * inv; u32x2 w; w.x = pk2(o[0], o[1]); w.y = pk2(o[2], o[3]); *(u32x2*)(orow + dt * 16 + 4 * g) = w; }
}
constexpr float LOG2E = 1.4426950408889634f;
struct BiasZero { static constexpr bool HAS_BIAS = false; __device__ __forceinline__ bool skip(int) const { return false; } __device__ __forceinline__ bool nobias() const { return true; }
    __device__ __forceinline__ void get(int, int, int, f32x4& b0, f32x4& b1) const { b0 = (f32x4){0.f, 0.f, 0.f, 0.f}; b1 = b0; } };
struct BiasWin { static constexpr bool HAS_BIAS = true; int d0; int kstart; bool interior;
    __device__ __forceinline__ bool skip(int) const { return false; } __device__ __forceinline__ bool nobias() const { return interior; }
    __device__ __forceinline__ float one(int q, int kk) const { const int kp = kstart + kk, dd = d0 + kk - q; return (kp >= 0 && kp < SEQ && dd <= 128 && dd >= -128) ? 0.f : -1e30f; }
    __device__ __forceinline__ void get(int, int q, int g, f32x4& b0, f32x4& b1) const {
#pragma unroll
        for (int j = 0; j < 4; ++j) { b0[j] = one(q, 4 * g + j); b1[j] = one(q, 16 + 4 * g + j); } } };
struct BiasNA { static constexpr bool HAS_BIAS = true; unsigned tabaddr; int rowoff31; int c0;
    __device__ __forceinline__ bool skip(int qi) const { return (qi == 0 && c0 != 0) || (qi == 3 && c0 == 0); } __device__ __forceinline__ bool nobias() const { return false; }
    __device__ __forceinline__ void get(int qi, int q, int g, f32x4& b0, f32x4& b1) const {
        const int qc = qi * 16 + q; int cst = qc - 8; cst = cst < 0 ? 0 : (cst > 48 ? 48 : cst);
        const int kc0 = c0 + 4 * g;
        const unsigned ad = tabaddr + (unsigned)((rowoff31 + kc0 - qc + 15) * 4);
        u32x2 t0, t1, t2, t3;
        asm volatile("ds_read2_b32 %0, %4 offset1:1\n\t" "ds_read2_b32 %1, %4 offset0:2 offset1:3\n\t" "ds_read2_b32 %2, %4 offset0:16 offset1:17\n\t" "ds_read2_b32 %3, %4 offset0:18 offset1:19\n\t" "s_waitcnt lgkmcnt(0)"
                     : "=&v"(t0), "=&v"(t1), "=&v"(t2), "=&v"(t3) : "v"(ad) : "memory");
        const float v0[4] = {__builtin_bit_cast(float, t0.x), __builtin_bit_cast(float, t0.y), __builtin_bit_cast(float, t1.x), __builtin_bit_cast(float, t1.y)};
        const float v1[4] = {__builtin_bit_cast(float, t2.x), __builtin_bit_cast(float, t2.y), __builtin_bit_cast(float, t3.x), __builtin_bit_cast(float, t3.y)};
#pragma unroll
        for (int j = 0; j < 4; ++j) { const int ka = kc0 + j, kb = kc0 + 16 + j;
            b0[j] = (ka >= cst && ka < cst + 16) ? v0[j] : -1e30f; b1[j] = (kb >= cst && kb < cst + 16) ? v1[j] : -1e30f; } } };

template <int NQ>
__device__ __forceinline__ void attn_ctx_steps(AttnSt<NQ>& st, const bf16_t* Z, int row0, int kcol, int vcol, int nsteps, LAS unsigned char* kl, int lane) {
    const char* zb = (const char*)Z;
    unsigned rp[4];
#pragma unroll
    for (int c = 0; c < 4; ++c) rp[c] = (unsigned)(row0 + (lane >> 3) + c * 8) * (unsigned)(ZP * 2) + (unsigned)at_piece_off(lane);
    stage_issue(zb, rp, kcol * 2, vcol * 2, kl);
    for (int s = 0; s < nsteps; ++s) {
        if (s + 1 < nsteps) {
#pragma unroll
            for (int c = 0; c < 4; ++c) rp[c] += 32u * (unsigned)(ZP * 2);
            stage_issue(zb, rp, kcol * 2, vcol * 2, kl + ((s + 1) & 1) * AT_BUF);
            asm volatile("s_waitcnt vmcnt(8)" ::: "memory");
        } else asm volatile("s_waitcnt vmcnt(0)" ::: "memory");
        AttnFrag F; attn_read(F, kl + (s & 1) * AT_BUF, lane);
        attn_compute<NQ>(st, F, BiasZero(), lane);
    }
}

__device__ __forceinline__ void win_item(const KArgs& a, int l, int item, bool ctxq, LAS unsigned char* kl, int lane) {
    asm volatile("" : "+v"(lane));
    bf16_t* Z = (bf16_t*)(a.ws + WS_Z);
    int b, gi, qt;
    if (!ctxq) { b = item >> 9; gi = (item >> 8) & 1; qt = item & 255; } else { b = item >> 5; gi = (item >> 4) & 1; qt = item & 15; }
    const int t0 = qt * 16, r16 = lane & 15;
    const int qrow0 = (ctxq ? ML + b * CTXL : b * SEQ) + t0, qrow = qrow0 + r16;
    const char* zb = (const char*)Z; const int g = lane >> 4;
    AttnSt<4> st; attn_init<4>(st);
#pragma unroll
    for (int qi = 0; qi < 4; ++qi) { const bf16_t* qp = Z + (size_t)qrow * ZP + C_WQ + (gi * 4 + qi) * 64 + g * 8;
        st.Q[qi][0] = *(const bf16x8*)qp; st.Q[qi][1] = *(const bf16x8*)(qp + 32); st.m[qi] = a.in[I_WSINK][l * 8 + gi * 4 + qi] * LOG2E; st.l[qi] = 1.0f; }
    const int kcol = C_WK + gi * 64, vcol = C_WV + gi * 64;
    if (!ctxq) {
        int s0 = 0, s1 = 9;
        { const int ks = t0 - 128; while (s0 < s1 && ks + 32 * s0 + 31 < 0) ++s0; while (s1 > s0 && ks + 32 * (s1 - 1) >= SEQ) --s1; }
        unsigned rp[4];
#define WIN_RP(s_) do { _Pragma("unroll") for (int c = 0; c < 4; ++c) { int kp = t0 - 128 + 32 * (s_) + c * 8 + (lane >> 3); kp = kp < 0 ? 0 : (kp > SEQ - 1 ? SEQ - 1 : kp); rp[c] = (unsigned)(b * SEQ + kp) * (unsigned)(ZP * 2) + (unsigned)at_piece_off(lane); } } while (0)
        WIN_RP(s0); stage_issue(zb, rp, kcol * 2, vcol * 2, kl + (s0 & 1) * AT_BUF);
        for (int s = s0; s < s1; ++s) {
            if (s + 1 < s1) { WIN_RP(s + 1); stage_issue(zb, rp, kcol * 2, vcol * 2, kl + ((s + 1) & 1) * AT_BUF); asm volatile("s_waitcnt vmcnt(8)" ::: "memory"); }
            else asm volatile("s_waitcnt vmcnt(0)" ::: "memory");
            AttnFrag F; attn_read(F, kl + (s & 1) * AT_BUF, lane);
            const int kstart = t0 - 128 + 32 * s;
            BiasWin bw; bw.kstart = kstart; bw.d0 = kstart - t0; bw.interior = (kstart >= 0 && kstart + 31 < SEQ && kstart >= t0 + 15 - 128 && kstart + 31 <= t0 + 128);
            attn_compute<4>(st, F, bw, lane);
        }
#undef WIN_RP
    }
    attn_ctx_steps<4>(st, Z, ML + b * CTXL, kcol, vcol, 8, kl, lane);
#pragma unroll
    for (int qi = 0; qi < 4; ++qi) attn_store<4>(st, qi, Z + (size_t)qrow * ZP + Y_WIN + (gi * 4 + qi) * 64, lane);
}

__device__ __forceinline__ void na_item(const KArgs& a, int l, int item, bool ctxq, LAS unsigned char* kl, int lane) {
    asm volatile("" : "+v"(lane));
    bf16_t* Z = (bf16_t*)(a.ws + WS_Z);
    int b, h, r;
    if (!ctxq) { b = item >> 9; h = (item >> 6) & 7; r = item & 63; } else { b = item >> 5; h = (item >> 2) & 7; r = item & 3; }
    const int r16 = lane & 15;
    const int qbase = (ctxq ? ML + b * CTXL : b * SEQ) + r * 64, qrow0 = qbase + r16;
    const char* zb = (const char*)Z; const int g = lane >> 4;
    AttnSt<4> st; attn_init<4>(st);
#pragma unroll
    for (int qi = 0; qi < 4; ++qi) { const bf16_t* qp = Z + (size_t)(qrow0 + qi * 16) * ZP + C_NQ + h * 64 + g * 8; st.Q[qi][0] = *(const bf16x8*)qp; st.Q[qi][1] = *(const bf16x8*)(qp + 32); }
    const int kcol = C_NK + h * 64, vcol = C_NV + h * 64;
    if (!ctxq) {
        LAS float* tab = (LAS float*)(kl + AT_TABOFF);
        const float* rpbp = a.in[I_RPB] + (size_t)(l * 8 + h) * 465;
        for (int i = lane; i < 465; i += 64) tab[i] = rpbp[i] * LOG2E;
        int rs = r - 4; rs = rs < 0 ? 0 : (rs > 56 ? 56 : rs);
        unsigned rp[4];
#pragma unroll
        for (int c = 0; c < 4; ++c) rp[c] = (unsigned)(b * SEQ + rs * 64 + (lane >> 3) + c * 8) * (unsigned)(ZP * 2) + (unsigned)at_piece_off(lane);
        stage_issue(zb, rp, kcol * 2, vcol * 2, kl);
        for (int s = 0; s < 16; ++s) {
            if (s + 1 < 16) {
#pragma unroll
                for (int c = 0; c < 4; ++c) rp[c] += 32u * (unsigned)(ZP * 2);
                stage_issue(zb, rp, kcol * 2, vcol * 2, kl + ((s + 1) & 1) * AT_BUF);
                asm volatile("s_waitcnt vmcnt(8)" ::: "memory");
            } else asm volatile("s_waitcnt vmcnt(0)" ::: "memory");
            AttnFrag F; attn_read(F, kl + (s & 1) * AT_BUF, lane);
            BiasNA bn; bn.tabaddr = lds_u32((const LAS unsigned char*)tab); bn.rowoff31 = (rs + (s >> 1) - r + 7) * 31; bn.c0 = (s & 1) * 32;
            attn_compute<4>(st, F, bn, lane);
        }
    }
    attn_ctx_steps<4>(st, Z, ML + b * CTXL, kcol, vcol, 8, kl, lane);
#pragma unroll
    for (int qi = 0; qi < 4; ++qi) attn_store<4>(st, qi, Z + (size_t)(qrow0 + qi * 16) * ZP + Y_NA + h * 64, lane);
}
constexpr int RT_VS = 288, RT_KS = 160, RT_SS = 144;
__device__ __forceinline__ size_t kvt_off(int bh, int dir, int ch) { return (((size_t)bh * 2 + dir) * 34 + ch) * 8192; }
__device__ __forceinline__ float log_sigmoidf_(float x) { return -(fmaxf(-x, 0.f) + log1pf(__expf(-fabsf(x)))); }
__device__ __forceinline__ int ret_row0(int b, int ch) { return ch < 2 ? ML + b * CTXL + ch * 128 : b * SEQ + (ch - 2) * 128; }

__device__ __forceinline__ void ret_kv_unit(const KArgs& a, LAS unsigned char* lds, int l, int unit) {
    const int tid = OTID(), lane = tid & 63, wave = tid >> 6, g = lane >> 4, r16 = lane & 15;
    const int bh = unit / 34, ch = unit % 34, b = bh >> 2, h = bh & 3;
    const bf16_t* Z = (const bf16_t*)(a.ws + WS_Z);
    const int row0 = ret_row0(b, ch);
    const float lgf = log_sigmoidf_(a.in[I_RDECAY][l * 8 + h]), lgb = log_sigmoidf_(a.in[I_RDECAY][l * 8 + 4 + h]);
    LAS unsigned char* Vl = lds; LAS unsigned char* Kf = lds + 128 * RT_VS; LAS unsigned char* Kb = Kf + 128 * RT_KS;
#pragma unroll
    for (int i = 0; i < 4; ++i) { const int p = tid + i * 512, r = p >> 4, c = p & 15;
        *(LAS u32x4*)(Vl + r * RT_VS + c * 16) = *(const u32x4*)(Z + (size_t)(row0 + r) * ZP + C_RV + h * 128 + c * 8); }
#pragma unroll
    for (int i = 0; i < 2; ++i) { const int p = tid + i * 512, r = p >> 3, c = p & 7;
        const u32x4 kv = *(const u32x4*)(Z + (size_t)(row0 + r) * ZP + C_RK + h * 64 + c * 8);
        const float df = __expf(lgf * (float)(127 - r)), db = __expf(lgb * (float)r);
        u32x4 of, ob;
        of.x = pk2(bflo(kv.x) * df, bfhi(kv.x) * df); of.y = pk2(bflo(kv.y) * df, bfhi(kv.y) * df); of.z = pk2(bflo(kv.z) * df, bfhi(kv.z) * df); of.w = pk2(bflo(kv.w) * df, bfhi(kv.w) * df);
        ob.x = pk2(bflo(kv.x) * db, bfhi(kv.x) * db); ob.y = pk2(bflo(kv.y) * db, bfhi(kv.y) * db); ob.z = pk2(bflo(kv.z) * db, bfhi(kv.z) * db); ob.w = pk2(bflo(kv.w) * db, bfhi(kv.w) * db);
        *(LAS u32x4*)(Kf + r * RT_KS + c * 16) = of; *(LAS u32x4*)(Kb + r * RT_KS + c * 16) = ob; }
    __syncthreads();
    f32x4 acc[2][4];
#pragma unroll
    for (int d = 0; d < 2; ++d)
#pragma unroll
        for (int t = 0; t < 4; ++t) acc[d][t] = (f32x4){0.f, 0.f, 0.f, 0.f};
    const int qq = r16 >> 2, pp = r16 & 3;
#pragma unroll
    for (int ks = 0; ks < 4; ++ks) {
        const int tr0 = ks * 32 + 4 * g + qq;
        const s16x4 alo = lds_tr16(Vl + tr0 * RT_VS + (wave * 16 + 4 * pp) * 2), ahi = lds_tr16(Vl + (tr0 + 16) * RT_VS + (wave * 16 + 4 * pp) * 2);
        const bf16x8 A = (bf16x8){alo[0], alo[1], alo[2], alo[3], ahi[0], ahi[1], ahi[2], ahi[3]};
#pragma unroll
        for (int t = 0; t < 4; ++t) {
            const s16x4 flo = lds_tr16(Kf + tr0 * RT_KS + (t * 16 + 4 * pp) * 2), fhi = lds_tr16(Kf + (tr0 + 16) * RT_KS + (t * 16 + 4 * pp) * 2);
            const s16x4 blo = lds_tr16(Kb + tr0 * RT_KS + (t * 16 + 4 * pp) * 2), bhi = lds_tr16(Kb + (tr0 + 16) * RT_KS + (t * 16 + 4 * pp) * 2);
            acc[0][t] = __builtin_amdgcn_mfma_f32_16x16x32_bf16(A, (bf16x8){flo[0], flo[1], flo[2], flo[3], fhi[0], fhi[1], fhi[2], fhi[3]}, acc[0][t], 0, 0, 0);
            acc[1][t] = __builtin_amdgcn_mfma_f32_16x16x32_bf16(A, (bf16x8){blo[0], blo[1], blo[2], blo[3], bhi[0], bhi[1], bhi[2], bhi[3]}, acc[1][t], 0, 0, 0);
        }
    }
    bf16_t* kvt = (bf16_t*)(a.ws + WS_KVT);
#pragma unroll
    for (int d = 0; d < 2; ++d) { bf16_t* o = kvt + kvt_off(bh, d, ch);
#pragma unroll
        for (int t = 0; t < 4; ++t)
#pragma unroll
            for (int j = 0; j < 4; ++j) o[(wave * 16 + 4 * g + j) * 64 + t * 16 + r16] = (bf16_t)f2bf(acc[d][t][j]); }
    __syncthreads();
}

__device__ __forceinline__ void ret_out_unit(const KArgs& a, LAS unsigned char* lds, int l, int unit) {
    const int tid = OTID(), lane = tid & 63, wave = tid >> 6, g = lane >> 4, r16 = lane & 15;
    const int bh = unit / 34, ch = unit % 34, b = bh >> 2, h = bh & 3;
    bf16_t* Z = (bf16_t*)(a.ws + WS_Z);
    const bf16_t* kvt = (const bf16_t*)(a.ws + WS_KVT);
    const int row0 = ret_row0(b, ch);
    const float lgf = log_sigmoidf_(a.in[I_RDECAY][l * 8 + h]), lgb = log_sigmoidf_(a.in[I_RDECAY][l * 8 + 4 + h]);
    LAS unsigned char* Vl = lds; LAS unsigned char* Sf = lds + 128 * RT_VS; LAS unsigned char* Sb = Sf + 128 * RT_SS;
#pragma unroll
    for (int i = 0; i < 4; ++i) { const int p = tid + i * 512, r = p >> 4, c = p & 15;
        *(LAS u32x4*)(Vl + r * RT_VS + c * 16) = *(const u32x4*)(Z + (size_t)(row0 + r) * ZP + C_RV + h * 128 + c * 8); }
    { const int dv = tid >> 2, dk0 = (tid & 3) * 16;
#pragma unroll
      for (int d = 0; d < 2; ++d) {
          float s[16];
#pragma unroll
          for (int e = 0; e < 16; ++e) s[e] = 0.f;
          const float gC = __expf((d == 0 ? lgf : lgb) * 128.0f);
          const int ord = (d == 0) ? ch : (ch < 2 ? 1 - ch : 35 - ch);
          for (int o = 0; o < ord; o += 8) {
              u32x4 x0[8], x1[8];
#pragma unroll
              for (int k = 0; k < 8; ++k) { const int oo = (o + k < ord) ? o + k : ord - 1; const int ci = (d == 0) ? oo : (oo < 2 ? 1 - oo : 35 - oo);
                  const u32x4* src = (const u32x4*)(kvt + kvt_off(bh, d, ci) + dv * 64 + dk0); x0[k] = src[0]; x1[k] = src[1]; }
#pragma unroll
              for (int k = 0; k < 8; ++k) if (o + k < ord) {
                  s[0] = s[0] * gC + bflo(x0[k].x); s[1] = s[1] * gC + bfhi(x0[k].x); s[2] = s[2] * gC + bflo(x0[k].y); s[3] = s[3] * gC + bfhi(x0[k].y);
                  s[4] = s[4] * gC + bflo(x0[k].z); s[5] = s[5] * gC + bfhi(x0[k].z); s[6] = s[6] * gC + bflo(x0[k].w); s[7] = s[7] * gC + bfhi(x0[k].w);
                  s[8] = s[8] * gC + bflo(x1[k].x); s[9] = s[9] * gC + bfhi(x1[k].x); s[10] = s[10] * gC + bflo(x1[k].y); s[11] = s[11] * gC + bfhi(x1[k].y);
                  s[12] = s[12] * gC + bflo(x1[k].z); s[13] = s[13] * gC + bfhi(x1[k].z); s[14] = s[14] * gC + bflo(x1[k].w); s[15] = s[15] * gC + bfhi(x1[k].w);
              }
          }
          u32x4 w0, w1; w0.x = pk2(s[0], s[1]); w0.y = pk2(s[2], s[3]); w0.z = pk2(s[4], s[5]); w0.w = pk2(s[6], s[7]);
          w1.x = pk2(s[8], s[9]); w1.y = pk2(s[10], s[11]); w1.z = pk2(s[12], s[13]); w1.w = pk2(s[14], s[15]);
          LAS unsigned char* S = (d == 0) ? Sf : Sb;
          *(LAS u32x4*)(S + dv * RT_SS + dk0 * 2) = w0; *(LAS u32x4*)(S + dv * RT_SS + dk0 * 2 + 16) = w1;
      } }
    __syncthreads();
    const int qi = wave * 16 + r16;
    const bf16_t* qp = Z + (size_t)(row0 + qi) * ZP + C_RQ + h * 64 + g * 8;
    const bf16x8 Q0 = *(const bf16x8*)qp, Q1 = *(const bf16x8*)(qp + 32);
    bf16x8 Kf[8][2];
#pragma unroll
    for (int kt = 0; kt < 8; ++kt) { const bf16_t* kp = Z + (size_t)(row0 + kt * 16 + r16) * ZP + C_RK + h * 64 + g * 8; Kf[kt][0] = *(const bf16x8*)kp; Kf[kt][1] = *(const bf16x8*)(kp + 32); }
    f32x4 O[8];
#pragma unroll
    for (int dt = 0; dt < 8; ++dt) O[dt] = (f32x4){0.f, 0.f, 0.f, 0.f};
    const int qq = r16 >> 2, pp = r16 & 3;
#pragma unroll
    for (int ks = 0; ks < 4; ++ks) {
        u32x4 pw;
#pragma unroll
        for (int half = 0; half < 2; ++half) {
            const int kt = 2 * ks + half;
            f32x4 s = (f32x4){0.f, 0.f, 0.f, 0.f};
            s = __builtin_amdgcn_mfma_f32_16x16x32_bf16(Kf[kt][0], Q0, s, 0, 0, 0);
            s = __builtin_amdgcn_mfma_f32_16x16x32_bf16(Kf[kt][1], Q1, s, 0, 0, 0);
            float p[4];
#pragma unroll
            for (int j = 0; j < 4; ++j) { const int diff = qi - (kt * 16 + 4 * g + j);
                const float df = (diff >= 0) ? __expf(lgf * (float)diff) : 0.f, db = (diff <= 0) ? __expf(lgb * (float)(-diff)) : 0.f; p[j] = s[j] * (df + db); }
            if (half == 0) { pw.x = pk2(p[0], p[1]); pw.y = pk2(p[2], p[3]); } else { pw.z = pk2(p[0], p[1]); pw.w = pk2(p[2], p[3]); }
        }
        const bf16x8 pf = __builtin_bit_cast(bf16x8, pw);
        const int tr0 = ks * 32 + 4 * g + qq;
#pragma unroll
        for (int dt = 0; dt < 8; ++dt) {
            const s16x4 lo = lds_tr16(Vl + tr0 * RT_VS + (dt * 16 + 4 * pp) * 2), hi = lds_tr16(Vl + (tr0 + 16) * RT_VS + (dt * 16 + 4 * pp) * 2);
            O[dt] = __builtin_amdgcn_mfma_f32_16x16x32_bf16((bf16x8){lo[0], lo[1], lo[2], lo[3], hi[0], hi[1], hi[2], hi[3]}, pf, O[dt], 0, 0, 0);
        }
    }
    { const float dqf = __expf(lgf * (float)(qi + 1)), dqb = __expf(lgb * (float)(128 - qi));
#pragma unroll
      for (int dt = 0; dt < 8; ++dt) {
          f32x4 tf = (f32x4){0.f, 0.f, 0.f, 0.f}, tb = (f32x4){0.f, 0.f, 0.f, 0.f};
          const LAS unsigned char* sf = Sf + (dt * 16 + r16) * RT_SS + g * 16; const LAS unsigned char* sb = Sb + (dt * 16 + r16) * RT_SS + g * 16;
          tf = __builtin_amdgcn_mfma_f32_16x16x32_bf16(*(const LAS bf16x8*)sf, Q0, tf, 0, 0, 0); tf = __builtin_amdgcn_mfma_f32_16x16x32_bf16(*(const LAS bf16x8*)(sf + 64), Q1, tf, 0, 0, 0);
          tb = __builtin_amdgcn_mfma_f32_16x16x32_bf16(*(const LAS bf16x8*)sb, Q0, tb, 0, 0, 0); tb = __builtin_amdgcn_mfma_f32_16x16x32_bf16(*(const LAS bf16x8*)(sb + 64), Q1, tb, 0, 0, 0);
          O[dt] = O[dt] + tf * dqf + tb * dqb;
      } }
    float sm = 0.f;
#pragma unroll
    for (int dt = 0; dt < 8; ++dt) sm += (O[dt][0] + O[dt][1]) + (O[dt][2] + O[dt][3]);
    sm += __shfl_xor(sm, 16); sm += __shfl_xor(sm, 32);
    const float mean = sm * (1.f / 128.f);
    float sq = 0.f;
#pragma unroll
    for (int dt = 0; dt < 8; ++dt) { const f32x4 dd = O[dt] - mean; sq += (dd[0] * dd[0] + dd[1] * dd[1]) + (dd[2] * dd[2] + dd[3] * dd[3]); }
    sq += __shfl_xor(sq, 16); sq += __shfl_xor(sq, 32);
    const float rstd = rsqrtf(sq * (1.f / 128.f) + EPS);
    const float* gn = a.in[I_RGN] + l * 512 + h * 128;
    bf16_t* yrow = Z + (size_t)(row0 + qi) * ZP + Y_RET + h * 128;
#pragma unroll
    for (int dt = 0; dt < 8; ++dt) { const int c = dt * 16 + 4 * g;
        const u32x2 gt = *(const u32x2*)(yrow + c); const f32x4 gv = *(const f32x4*)(gn + c);
        u32x2 w; w.x = pk2((O[dt][0] - mean) * rstd * gv[0] * siluf_(bflo(gt.x)), (O[dt][1] - mean) * rstd * gv[1] * siluf_(bfhi(gt.x)));
        w.y = pk2((O[dt][2] - mean) * rstd * gv[2] * siluf_(bflo(gt.y)), (O[dt][3] - mean) * rstd * gv[3] * siluf_(bfhi(gt.y)));
        *(u32x2*)(yrow + c) = w; }
    __syncthreads();
}
constexpr int C_UF = C_GQ, C_UB = C_GK, C_WF = C_GV, C_AQ = 5888;
__device__ __forceinline__ int gdn_row0(int b, int c) { return c < 4 ? ML + b * CTXL + c * 64 : b * SEQ + (c - 4) * 64; }

__device__ __forceinline__ void gdn_prep_unit(const KArgs& a, LAS unsigned char* lds, int unit) {
    const int tid = OTID(), lane = tid & 63, wave = tid >> 6, g = lane >> 4, r16 = lane & 15;
    const int bh = unit / 68, c = unit % 68, b = bh >> 2, h = bh & 3;
    const int row0 = gdn_row0(b, c);
    bf16_t* Z = (bf16_t*)(a.ws + WS_Z); bf16_t* P = (bf16_t*)(a.ws + WS_P);
    float* GBa = (float*)(a.ws + WS_GB); const float* GBb = GBa + (size_t)MA * 8;
    LAS float* KK = (LAS float*)lds; LAS float* QK = KK + 4096; LAS float* AF = QK + 4096; LAS float* AB = AF + 4096;
    LAS float* gcs = AB + 4096;
    LAS float* bes = gcs + 128;
    if (tid < 128) { const int d = tid >> 6, i = tid & 63; const size_t o = (size_t)(row0 + i) * 8 + d * 4 + h; gcs[tid] = GBa[o]; bes[tid] = GBb[o]; }
    __syncthreads();
    if (wave < 2) { float v = gcs[tid];
#pragma unroll
        for (int off = 1; off < 64; off <<= 1) { const float t = (wave == 0) ? __shfl_up(v, off) : __shfl_down(v, off); if ((wave == 0) ? (lane >= off) : (lane + off < 64)) v += t; }
        gcs[tid] = v; }
    { const int rt = wave & 3; const bf16_t* ap = P + (size_t)(row0 + rt * 16 + r16) * PP + (wave < 4 ? 512 : 0) + h * 128 + g * 8;
      bf16x8 A[4];
#pragma unroll
      for (int ks = 0; ks < 4; ++ks) A[ks] = *(const bf16x8*)(ap + ks * 32);
      LAS float* M = (wave < 4) ? KK : QK;
#pragma unroll
      for (int ct = 0; ct < 4; ++ct) { const bf16_t* bp = P + (size_t)(row0 + ct * 16 + r16) * PP + 512 + h * 128 + g * 8;
          f32x4 acc = (f32x4){0.f, 0.f, 0.f, 0.f};
#pragma unroll
          for (int ks = 0; ks < 4; ++ks) acc = __builtin_amdgcn_mfma_f32_16x16x32_bf16(A[ks], *(const bf16x8*)(bp + ks * 32), acc, 0, 0, 0);
#pragma unroll
          for (int j = 0; j < 4; ++j) M[(rt * 16 + 4 * g + j) * 64 + ct * 16 + r16] = acc[j]; } }
    __syncthreads();
    if (tid < 128) { const int d = tid >> 6, i = tid & 63; ((float*)(a.ws + WS_GC2))[(size_t)(d * 4 + h) * MA + row0 + i] = gcs[tid]; }
#pragma unroll
    for (int e = 0; e < 8; ++e) { const int idx = tid + 512 * e, i = idx >> 6, j = idx & 63;
        const float kk = KK[idx], qk = QK[idx];
        const float ef = __expf(fminf(gcs[i] - gcs[j], 0.f)), eb = __expf(fminf(gcs[64 + i] - gcs[64 + j], 0.f));
        const float af = (j < i) ? bes[i] * kk * ef : 0.f, ab = (j > i) ? bes[64 + i] * kk * eb : 0.f;
        AF[idx] = af; AB[(63 - i) * 64 + (63 - j)] = ab;
        ((LAS bf16_t*)(lds + 66560))[idx] = (bf16_t)f2bf(-af); ((LAS bf16_t*)(lds + 66560))[4096 + (63 - i) * 64 + (63 - j)] = (bf16_t)f2bf(-ab);
        Z[(size_t)(row0 + i) * ZP + C_AQ + h * 64 + j] = (bf16_t)f2bf(qk * (j < i ? ef : (j > i ? eb : 1.0f))); }
    LAS bf16_t* NAm = (LAS bf16_t*)(lds + 66560);
    LAS bf16_t* TL = (LAS bf16_t*)(lds + 82944);
    __syncthreads();
    { const int dd = wave >> 2, bb = wave & 3; const LAS float* Am = (dd ? AB : AF) + (bb * 16) * 64 + bb * 16;
      if (lane < 16) { float t[16];
#pragma unroll
          for (int i = 0; i < 16; ++i) { float acc = (i == lane) ? 1.f : 0.f;
#pragma unroll
              for (int j = 0; j < i; ++j) acc -= Am[i * 64 + j] * t[j];
              t[i] = acc; }
#pragma unroll
          for (int i = 0; i < 16; ++i) TL[((dd * 4 + bb) * 16 + i) * 16 + lane] = (bf16_t)f2bf(t[i]); } }
    const int d = wave >> 2, part = wave & 3; const bool isw = part >= 2;
    f32x4 R[4][4];
#pragma unroll
    for (int bk = 0; bk < 4; ++bk)
#pragma unroll
        for (int j = 0; j < 4; ++j) { const int ip = bk * 16 + 4 * g + j, tok = d ? 63 - ip : ip;
            const float f = isw ? bes[d * 64 + tok] * __expf(gcs[d * 64 + tok]) : bes[d * 64 + tok];
            const bf16_t* src = P + (size_t)(row0 + tok) * PP + (isw ? 512 : 1024) + h * 128 + (part & 1) * 64 + r16;
#pragma unroll
            for (int ct = 0; ct < 4; ++ct) R[bk][ct][j] = f * bf2f(src[ct * 16]); }
    asm volatile("s_waitcnt vmcnt(0)" ::: "memory");
    __syncthreads();
    { const LAS bf16_t* Nd = NAm + d * 4096; const LAS bf16_t* Td = TL + d * 1024;
      const u32x2 zero2 = (u32x2){0u, 0u};
#pragma unroll
      for (int bk = 0; bk < 4; ++bk) {
#pragma unroll
          for (int c0 = 0; c0 < 4; c0 += 2) if (c0 < bk) {
              const u32x2 alo = *(const LAS u32x2*)(Nd + (bk * 16 + r16) * 64 + c0 * 16 + 4 * g);
              const u32x2 ahi = (c0 + 1 < bk) ? *(const LAS u32x2*)(Nd + (bk * 16 + r16) * 64 + (c0 + 1) * 16 + 4 * g) : zero2;
              const bf16x8 Af = cat8(alo, ahi);
#pragma unroll
              for (int ct = 0; ct < 4; ++ct) { u32x2 blo, bhi = zero2; blo.x = pk2(R[c0][ct][0], R[c0][ct][1]); blo.y = pk2(R[c0][ct][2], R[c0][ct][3]);
                  if (c0 + 1 < bk) { bhi.x = pk2(R[c0 + 1][ct][0], R[c0 + 1][ct][1]); bhi.y = pk2(R[c0 + 1][ct][2], R[c0 + 1][ct][3]); }
                  R[bk][ct] = __builtin_amdgcn_mfma_f32_16x16x32_bf16(Af, cat8(blo, bhi), R[bk][ct], 0, 0, 0); } }
          const bf16x8 Tf = cat8(*(const LAS u32x2*)(Td + (bk * 16 + r16) * 16 + 4 * g), zero2);
#pragma unroll
          for (int ct = 0; ct < 4; ++ct) { u32x2 blo; blo.x = pk2(R[bk][ct][0], R[bk][ct][1]); blo.y = pk2(R[bk][ct][2], R[bk][ct][3]);
              R[bk][ct] = __builtin_amdgcn_mfma_f32_16x16x32_bf16(Tf, cat8(blo, zero2), (f32x4){0.f, 0.f, 0.f, 0.f}, 0, 0, 0); }
      } }
#pragma unroll
    for (int bk = 0; bk < 4; ++bk)
#pragma unroll
        for (int j = 0; j < 4; ++j) { const int ip = bk * 16 + 4 * g + j, tok = d ? 63 - ip : ip;
            if (isw) { bf16_t* dst = (d == 0 ? Z + (size_t)(row0 + tok) * ZP + C_WF : P + (size_t)(row0 + tok) * PP + 1024) + h * 128 + (part & 1) * 64 + r16;
#pragma unroll
                for (int ct = 0; ct < 4; ++ct) dst[ct * 16] = (bf16_t)f2bf(R[bk][ct][j]); }
            else {
#pragma unroll
                for (int ct = 0; ct < 4; ++ct) { const int e = utile_off(tok, (part & 1) * 64 + ct * 16 + r16);
                    Z[(size_t)(row0 + (e >> 7)) * ZP + (d == 0 ? C_UF : C_UB) + h * 128 + (e & 127)] = (bf16_t)f2bf(R[bk][ct][j]); } } }
    __syncthreads();
}

constexpr int GS_SF = 0, GS_VF = 32768, GS_VE = 49152, GS_KB = 65536;
struct GsRegs { bf16x8 W[4], Q[4], AQ[2]; u32x4 K[2]; float u[4][4], gc[4], gl; };
__device__ __forceinline__ void gdn_scan_unit(const KArgs& a, LAS unsigned char* lds, int unit, bool ctx_out) {
    const int tid = OTID(), lane = tid & 63, wave = tid >> 6, g = lane >> 4, r16 = lane & 15, rt = wave & 3, ch = wave >> 2;
    const int bh = unit >> 1, d = unit & 1, b = bh >> 2, h = bh & 3;
    bf16_t* Z = (bf16_t*)(a.ws + WS_Z); const bf16_t* P = (const bf16_t*)(a.ws + WS_P);
    const float* GBa = (const float*)(a.ws + WS_GB);
    const bf16_t* Wb = d == 0 ? (const bf16_t*)Z + C_WF : P + 1024; const int Wp = d == 0 ? ZP : PP;
    const int ubase = (d == 0 ? C_UF : C_UB) + h * 128, ue0 = ((rt * 2 + ch) * 64 + lane) * 16;
    const float* GC2 = (const float*)(a.ws + WS_GC2) + (size_t)(d * 4 + h) * MA;
    const int rhoA = 32 * (rt >> 1) + 8 * (r16 >> 2) + 4 * (rt & 1) + (r16 & 3);
    const int rhoC = 32 * (rt >> 1) + 8 * g + 4 * (rt & 1);
    f32x4 Sa[4], Sb[4];
#pragma unroll
    for (int c = 0; c < 4; ++c) { Sa[c] = (f32x4){0.f, 0.f, 0.f, 0.f}; Sb[c] = Sa[c]; }
#define GS_ROW0(s_) gdn_row0(b, d == 0 ? (s_) : ((s_) < 4 ? 3 - (s_) : 71 - (s_)))
#define GS_LOAD_WQ(R, s_) do { const int r0_ = GS_ROW0(s_); const size_t ra_ = (size_t)(r0_ + rhoA); \
        _Pragma("unroll") for (int ks = 0; ks < 4; ++ks) { R.W[ks] = *(const bf16x8*)(Wb + ra_ * Wp + h * 128 + ks * 32 + 8 * g); R.Q[ks] = *(const bf16x8*)(P + ra_ * PP + h * 128 + ks * 32 + 8 * g); } \
        { const f32x4 gv_ = *(const f32x4*)(GC2 + r0_ + rhoC); R.gc[0] = gv_[0]; R.gc[1] = gv_[1]; R.gc[2] = gv_[2]; R.gc[3] = gv_[3]; } \
        { const bf16_t* up_ = Z + (size_t)(r0_ + (ue0 >> 7)) * ZP + ubase + (ue0 & 127); const u32x4 ua_ = *(const u32x4*)up_, ub_ = *(const u32x4*)(up_ + 8); \
          R.u[0][0] = bflo(ua_.x); R.u[0][1] = bfhi(ua_.x); R.u[0][2] = bflo(ua_.y); R.u[0][3] = bfhi(ua_.y); R.u[1][0] = bflo(ua_.z); R.u[1][1] = bfhi(ua_.z); R.u[1][2] = bflo(ua_.w); R.u[1][3] = bfhi(ua_.w); \
          R.u[2][0] = bflo(ub_.x); R.u[2][1] = bfhi(ub_.x); R.u[2][2] = bflo(ub_.y); R.u[2][3] = bfhi(ub_.y); R.u[3][0] = bflo(ub_.z); R.u[3][1] = bfhi(ub_.z); R.u[3][2] = bflo(ub_.w); R.u[3][3] = bfhi(ub_.w); } \
        R.gl = GC2[r0_ + (d == 0 ? 63 : 0)]; } while (0)
#define GS_LOAD_AQ(R, s_) do { const int r0_ = GS_ROW0(s_); const size_t ra_ = (size_t)(r0_ + rhoA); \
        _Pragma("unroll") for (int k2 = 0; k2 < 2; ++k2) { u32x4 w_ = *(const u32x4*)(Z + ra_ * ZP + C_AQ + h * 64 + k2 * 32 + 8 * g); const int j0_ = k2 * 32 + 8 * g; \
              \
            w_.x &= ((d == 0 ? (j0_ + 0 <= rhoA) : (j0_ + 0 >= rhoA)) ? 0x0000ffffu : 0u) | ((d == 0 ? (j0_ + 1 <= rhoA) : (j0_ + 1 >= rhoA)) ? 0xffff0000u : 0u); \
            w_.y &= ((d == 0 ? (j0_ + 2 <= rhoA) : (j0_ + 2 >= rhoA)) ? 0x0000ffffu : 0u) | ((d == 0 ? (j0_ + 3 <= rhoA) : (j0_ + 3 >= rhoA)) ? 0xffff0000u : 0u); \
            w_.z &= ((d == 0 ? (j0_ + 4 <= rhoA) : (j0_ + 4 >= rhoA)) ? 0x0000ffffu : 0u) | ((d == 0 ? (j0_ + 5 <= rhoA) : (j0_ + 5 >= rhoA)) ? 0xffff0000u : 0u); \
            w_.w &= ((d == 0 ? (j0_ + 6 <= rhoA) : (j0_ + 6 >= rhoA)) ? 0x0000ffffu : 0u) | ((d == 0 ? (j0_ + 7 <= rhoA) : (j0_ + 7 >= rhoA)) ? 0xffff0000u : 0u); \
            R.AQ[k2] = __builtin_bit_cast(bf16x8, w_); } } while (0)
#define GS_LOAD_K(R, s_) do { const int r0_ = GS_ROW0(s_); \
        _Pragma("unroll") for (int cc = 0; cc < 2; ++cc) { const int row_ = wave * 8 + cc * 4 + (lane >> 4); \
            R.K[cc] = *(const u32x4*)(P + (size_t)(r0_ + row_) * PP + 512 + h * 128 + (lane & 15) * 8); } } while (0)
#define GS_LOAD(R, s_) do { GS_LOAD_WQ(R, s_); GS_LOAD_AQ(R, s_); GS_LOAD_K(R, s_); } while (0)
#define GS_BAR() do { asm volatile("s_waitcnt lgkmcnt(0)" ::: "memory"); __builtin_amdgcn_s_barrier(); asm volatile("" ::: "memory"); } while (0)
    const int qq = r16 >> 2, pp = r16 & 3;
#define GS_STEP(s_, PRE) do { const int s = (s_); \
        _Pragma("unroll") for (int c = 0; c < 4; ++c) { u32x4 w; w.x = pk2(Sa[c][0], Sa[c][1]); w.y = pk2(Sa[c][2], Sa[c][3]); w.z = pk2(Sb[c][0], Sb[c][1]); w.w = pk2(Sb[c][2], Sb[c][3]); \
            *(LAS u32x4*)(lds + GS_SF + ((rt * 8 + ch * 4 + c) * 64 + lane) * 16) = w; } \
        _Pragma("unroll") for (int cc = 0; cc < 2; ++cc) { const int row_ = wave * 8 + cc * 4 + (lane >> 4); \
            *(LAS u32x4*)(lds + GS_KB + (s & 1) * 16384 + row_ * 256 + (((lane & 15) ^ ((row_ & 3) << 2)) * 16)) = PRE.K[cc]; } \
        if (s + 1 < 68) GS_LOAD_K(PRE, s + 1); \
        GS_BAR(); \
        const int r0 = GS_ROW0(s); \
        f32x4 vacc[4], oacc[4]; \
        _Pragma("unroll") for (int c = 0; c < 4; ++c) { vacc[c] = (f32x4){0.f, 0.f, 0.f, 0.f}; oacc[c] = vacc[c]; } \
        { bf16x8 Bs[2][4]; \
          _Pragma("unroll") for (int c = 0; c < 4; ++c) Bs[0][c] = *(const LAS bf16x8*)(lds + GS_SF + ((0 * 8 + ch * 4 + c) * 64 + lane) * 16); \
          _Pragma("unroll") for (int ks = 0; ks < 4; ++ks) { \
              if (ks < 3) { _Pragma("unroll") for (int c = 0; c < 4; ++c) Bs[(ks + 1) & 1][c] = *(const LAS bf16x8*)(lds + GS_SF + (((ks + 1) * 8 + ch * 4 + c) * 64 + lane) * 16); } \
              __builtin_amdgcn_sched_barrier(0); \
              _Pragma("unroll") for (int c = 0; c < 4; ++c) { vacc[c] = __builtin_amdgcn_mfma_f32_16x16x32_bf16(PRE.W[ks], Bs[ks & 1][c], vacc[c], 0, 0, 0); oacc[c] = __builtin_amdgcn_mfma_f32_16x16x32_bf16(PRE.Q[ks], Bs[ks & 1][c], oacc[c], 0, 0, 0); } \
              __builtin_amdgcn_sched_barrier(0); } } \
        const float cd = __expf(PRE.gl); \
        float eg[4], ee[4]; \
        _Pragma("unroll") for (int j = 0; j < 4; ++j) { eg[j] = __expf(PRE.gc[j]); ee[j] = __expf(fminf(PRE.gl - PRE.gc[j], 0.f)); } \
        _Pragma("unroll") for (int c = 0; c < 4; ++c) { float vn[4], ve[4]; \
            _Pragma("unroll") for (int j = 0; j < 4; ++j) { vn[j] = PRE.u[c][j] - vacc[c][j]; oacc[c][j] *= eg[j]; ve[j] = vn[j] * ee[j]; } \
            u32x2 w; w.x = pk2(vn[0], vn[1]); w.y = pk2(vn[2], vn[3]); u32x2 e; e.x = pk2(ve[0], ve[1]); e.y = pk2(ve[2], ve[3]); \
            *(LAS u32x2*)(lds + GS_VF + (((rt >> 1) * 8 + ch * 4 + c) * 64 + lane) * 16 + (rt & 1) * 8) = w; \
            *(LAS u32x2*)(lds + GS_VE + (((rt >> 1) * 8 + ch * 4 + c) * 64 + lane) * 16 + (rt & 1) * 8) = e; } \
        if (s + 1 < 68) GS_LOAD_WQ(PRE, s + 1); \
        GS_BAR(); \
        const LAS unsigned char* kb = lds + GS_KB + (s & 1) * 16384; \
        _Pragma("unroll") for (int c = 0; c < 4; ++c) { Sa[c] = Sa[c] * cd; Sb[c] = Sb[c] * cd; } \
        _Pragma("unroll") for (int k2 = 0; k2 < 2; ++k2) { \
            const int rr = k2 * 32 + 8 * g + qq; const int pc = 4 * rt + pp; \
            bf16x8 Bv[4], Be[4]; \
            _Pragma("unroll") for (int c = 0; c < 4; ++c) { Bv[c] = *(const LAS bf16x8*)(lds + GS_VF + ((k2 * 8 + ch * 4 + c) * 64 + lane) * 16); Be[c] = *(const LAS bf16x8*)(lds + GS_VE + ((k2 * 8 + ch * 4 + c) * 64 + lane) * 16); } \
            const s16x4 alo = lds_tr16(kb + rr * 256 + ((pc ^ ((rr & 3) << 2)) * 16)), ahi = lds_tr16(kb + (rr + 4) * 256 + ((pc ^ (((rr + 4) & 3) << 2)) * 16)); \
            const s16x4 blo = lds_tr16(kb + rr * 256 + ((pc ^ ((rr & 3) << 2)) * 16) + 8), bhi = lds_tr16(kb + (rr + 4) * 256 + ((pc ^ (((rr + 4) & 3) << 2)) * 16) + 8); \
            const bf16x8 KTa = (bf16x8){alo[0], alo[1], alo[2], alo[3], ahi[0], ahi[1], ahi[2], ahi[3]}, KTb = (bf16x8){blo[0], blo[1], blo[2], blo[3], bhi[0], bhi[1], bhi[2], bhi[3]}; \
            __builtin_amdgcn_sched_barrier(0); \
            _Pragma("unroll") for (int c = 0; c < 4; ++c) { \
                oacc[c] = __builtin_amdgcn_mfma_f32_16x16x32_bf16(PRE.AQ[k2], Bv[c], oacc[c], 0, 0, 0); \
                Sa[c] = __builtin_amdgcn_mfma_f32_16x16x32_bf16(KTa, Be[c], Sa[c], 0, 0, 0); Sb[c] = __builtin_amdgcn_mfma_f32_16x16x32_bf16(KTb, Be[c], Sb[c], 0, 0, 0); } \
            __builtin_amdgcn_sched_barrier(0); \
        } \
        if (s + 1 < 68) GS_LOAD_AQ(PRE, s + 1); \
        if (s >= 4 || ctx_out) { \
            u32x4 oa_, ob_; oa_.x = pk2(oacc[0][0], oacc[0][1]); oa_.y = pk2(oacc[0][2], oacc[0][3]); oa_.z = pk2(oacc[1][0], oacc[1][1]); oa_.w = pk2(oacc[1][2], oacc[1][3]); \
            ob_.x = pk2(oacc[2][0], oacc[2][1]); ob_.y = pk2(oacc[2][2], oacc[2][3]); ob_.z = pk2(oacc[3][0], oacc[3][1]); ob_.w = pk2(oacc[3][2], oacc[3][3]); \
            bf16_t* op_ = Z + (size_t)(r0 + (ue0 >> 7)) * ZP + ubase + (ue0 & 127); *(u32x4*)op_ = oa_; *(u32x4*)(op_ + 8) = ob_; \
        } \
    } while (0)
    GsRegs RA;
    GS_LOAD(RA, 0);
    for (int s2 = 0; s2 < 68; s2 += 2) { GS_STEP(s2, RA); GS_STEP(s2 + 1, RA); }
#undef GS_STEP
#undef GS_BAR
#undef GS_ROW0
#undef GS_LOAD
#undef GS_LOAD_WQ
#undef GS_LOAD_AQ
#undef GS_LOAD_K
    __syncthreads();
}
typedef const __attribute__((address_space(4))) KArgs* KAP;
#define NOINL __forceinline__
__device__ __forceinline__ KArgs load_kargs(KAP kp) { unsigned long long kv = (unsigned long long)kp; asm volatile("" : "+s"(kv)); KAP ka = (KAP)kv; KArgs a;
#pragma unroll
    for (int i = 0; i < 29; ++i) a.in[i] = ka->in[i];
    a.out = ka->out; a.ws = ka->ws; a.ph_lo = ka->ph_lo; a.ph_hi = ka->ph_hi; return a; }
__device__ NOINL void call_gdnprep(KAP ka, LAS unsigned char* lds, int unit) { const KArgs a = load_kargs(ka); gdn_prep_unit(a, lds, unit); }
__device__ NOINL void call_gdnscan(KAP ka, LAS unsigned char* lds, int unit, bool ctx_out) { const KArgs a = load_kargs(ka); gdn_scan_unit(a, lds, unit, ctx_out); }
__device__ NOINL void call_retkv(KAP ka, LAS unsigned char* lds, int l, int unit) { const KArgs a = load_kargs(ka); ret_kv_unit(a, lds, l, unit); }
__device__ NOINL void call_retout(KAP ka, LAS unsigned char* lds, int l, int unit) { const KArgs a = load_kargs(ka); ret_out_unit(a, lds, l, unit); }
__device__ NOINL void call_na(KAP ka, int l, int item, bool ctxq, LAS unsigned char* kl, int lane) { const KArgs a = load_kargs(ka); na_item(a, l, item, ctxq, kl, lane); }
__device__ NOINL void call_win(KAP ka, int l, int item, bool ctxq, LAS unsigned char* kl, int lane) { const KArgs a = load_kargs(ka); win_item(a, l, item, ctxq, kl, lane); }
#ifndef SCAN_ONLY_M2
#define SCAN_ONLY_M2 0
#endif
constexpr int CW_WQ = 8192;
__device__ __forceinline__ void phase_mixers(KAP ka, LAS unsigned char* lds, int l, bool ctx_out) {
    const int blk = OBLK(), G = OGRID();
    for (int u = blk; u < 32 * 68; u += G) call_gdnprep(ka, lds, u);
    for (int u = blk; u < 32 * 34; u += G) call_retkv(ka, lds, l, u);
#if SCAN_ONLY_M2
    { const int tid = OTID(), lane = tid & 63, wave = tid >> 6; LAS unsigned char* kl = lds + wave * AT_WAVE_BYTES; const int gw = blk * NWAVES + wave, NGW = G * NWAVES;
      const int nitems = ctx_out ? 4096 + 4096 + 256 + 256 : 8192;
      for (int it = gw; it < nitems; it += NGW) { const bool cq = it >= 8192; const int j = cq ? it - 8192 : it; const bool isna = cq ? (j < 256) : (j < 4096); const int item = cq ? (j & 255) : (j & 4095);
          if (isna) call_na(ka, l, item, cq, kl, lane); else call_win(ka, l, item, cq, kl, lane); } }
#endif
}
__device__ __forceinline__ void phase_scan_attn(KAP ka, LAS unsigned char* lds, int l, bool ctx_out, int qslot) {
    const int tid = OTID(), lane = tid & 63, wave = tid >> 6, blk = OBLK(), G = OGRID();
    for (int u = blk; u < 64; u += G) call_gdnscan(ka, lds, (((u & 7) * 4 + ((u >> 3) >> 1)) << 1) | ((u >> 3) & 1), ctx_out);
#if SCAN_ONLY_M2
    return;
#endif
    LAS unsigned char* kl = lds + wave * AT_WAVE_BYTES;
    unsigned* ctr; { const KArgs a = load_kargs(ka); ctr = (unsigned*)(a.ws + WS_CTL) + CW_WQ + qslot * 1024 + (blk & 7) * 64; }
    const int xb = blk & 7;
    const int nper = ctx_out ? 512 + 512 + 32 + 32 : 1024;
    for (;;) {
        int k = 0; if (lane == 0) k = (int)__hip_atomic_fetch_add(ctr, 1u, __ATOMIC_RELAXED, __HIP_MEMORY_SCOPE_AGENT);
        k = __builtin_amdgcn_readfirstlane(k);
        if (k >= nper) break;
        const bool cq = k >= 1024; const int j = cq ? k - 1024 : k;
        const bool isna = cq ? (j < 32) : (j < 512);
        const int item = cq ? xb * 32 + (j & 31) : xb * 512 + (j & 511);
        if (isna) call_na(ka, l, item, cq, kl, lane);
        else call_win(ka, l, item, cq, kl, lane);
    }
}
using pg8::Unit;
struct SchedPlain {
    const char* A0; const char* B0; size_t tA, tB;
    int nM, nN, nwg, G, c;
    __device__ __forceinline__ void init(const void* A, int lda, const void* Bt, int ldb, int M, int N, int G_, int c_) {
        A0 = (const char*)A; B0 = (const char*)Bt; tA = (size_t)256 * lda * 2; tB = (size_t)256 * ldb * 2; nM = M / 256; nN = N / 256; nwg = nM * nN; G = G_; c = c_; }
    __device__ __forceinline__ bool next(int i, Unit& u) const {
        const long L = (long)i * G + c; if (L >= nwg) return false;
        int wgid = (int)L; { const int q = nwg / 8, r = nwg % 8, xcd = wgid % 8, off = wgid / 8; wgid = (xcd < r ? xcd * (q + 1) : r * (q + 1) + (xcd - r) * q) + off; }
        const int nig = 8 * nN, gid = wgid / nig, fm = gid * 8, gsz = (nM - fm) < 8 ? (nM - fm) : 8;
        u.pm = fm + ((wgid % nig) % gsz); u.pn = (wgid % nig) / gsz; u.aux = 0; return true; }
    __device__ __forceinline__ const char* A(const Unit& u) const { return A0 + (size_t)u.pm * tA; }
    __device__ __forceinline__ const char* B(const Unit& u) const { return B0 + (size_t)u.pn * tB; }
};
struct SchedBranch {
    const char* Z0; const char* W0; int ntiles, G, c;
    __device__ __forceinline__ bool next(int i, Unit& u) const { const int x = c & 7, j = c >> 3, tl = (i >> 2) * (G >> 3) + j; const int pm = x + 8 * (tl >> 2);
        if (pm * 4 >= ntiles) return false; u.pm = pm; u.pn = tl & 3; u.aux = i & 3; return true; }
    __device__ __forceinline__ const char* A(const Unit& u) const { const int yc = u.aux == 0 ? Y_RET : (u.aux == 1 ? Y_WIN : (u.aux == 2 ? Y_NA : Y_GDN)); return Z0 + ((size_t)u.pm * 256 * ZP + yc) * 2; }
    __device__ __forceinline__ const char* B(const Unit& u) const { return W0 + ((size_t)u.aux * 1024 * 512 + (size_t)u.pn * 256 * 512) * 2; }
};
struct SchedMoe {
    const char* A0; const char* W0; const int* tile_start; size_t tA, eB, tB; int G, c;
    int e_[4], t0_[4], cum_[5], rank_, nrank_;
    __device__ __forceinline__ void init() {
        const int x = c & 7; rank_ = c >> 3; nrank_ = G >> 3; cum_[0] = 0;
#pragma unroll
        for (int k = 0; k < 4; ++k) { e_[k] = x + 8 * k; t0_[k] = tile_start[e_[k]]; cum_[k + 1] = cum_[k] + (tile_start[e_[k] + 1] - t0_[k]); }
    }
    __device__ __forceinline__ bool next(int i, Unit& u) const {
        const int L = i * nrank_ + rank_; const int tt = L >> 2; if (tt >= cum_[4]) return false;
        const int k = (tt >= cum_[1]) + (tt >= cum_[2]) + (tt >= cum_[3]);
        int e = e_[0], t0 = t0_[0], cm = cum_[0];
        if (k == 1) { e = e_[1]; t0 = t0_[1]; cm = cum_[1]; } else if (k == 2) { e = e_[2]; t0 = t0_[2]; cm = cum_[2]; } else if (k == 3) { e = e_[3]; t0 = t0_[3]; cm = cum_[3]; }
        u.pm = t0 + (tt - cm); u.pn = L & 3; u.aux = e; return true; }
    __device__ __forceinline__ const char* A(const Unit& u) const { return A0 + (size_t)u.pm * tA; }
    __device__ __forceinline__ const char* B(const Unit& u) const { return W0 + (size_t)u.aux * eB + (size_t)u.pn * tB; }
};

template <int MODE  > struct EpiStore {
    bf16_t* O; int ldc;
    __device__ __forceinline__ void operator()(const f32x4 (&acc)[2][2][4][2], const Unit& u, int wr, int wc, int fr, int fq) const {
        const int row0 = u.pm * 256 + wr * 64 + fr; const int colt = (MODE == 1 ? dead_tile(u.pn) : u.pn) * 256; const int col0 = colt + wc * 32 + 8 * fq;
#pragma unroll
        for (int ai = 0; ai < 2; ++ai)
#pragma unroll
            for (int m = 0; m < 4; ++m) { bf16_t* rowp = O + (size_t)(row0 + ai * 128 + m * 16) * ldc + col0;
#pragma unroll
                for (int bj = 0; bj < 2; ++bj) { f32x4 v0 = acc[ai][bj][m][0], v1 = acc[ai][bj][m][1];
                    if (MODE == 1) {
#pragma unroll
                        for (int e = 0; e < 4; ++e) { v0[e] = sigmoidf_(v0[e]); v1[e] = sigmoidf_(v1[e]); } }
                    u32x4 w; w.x = pk2(v0[0], v0[1]); w.y = pk2(v0[2], v0[3]); w.z = pk2(v1[0], v1[1]); w.w = pk2(v1[2], v1[3]);
                    *(u32x4*)(rowp + bj * 128) = w; } }
    }
};
struct EpiBranch {
    bf16_t* ACC; const bf16_t* Z;
    __device__ __forceinline__ void operator()(const f32x4 (&acc)[2][2][4][2], const Unit& u, int wr, int wc, int fr, int fq) const {
        const int row0 = u.pm * 256 + wr * 64 + fr; const int gcol0 = dead_tile(u.aux * 4 + u.pn) * 256 + wc * 32 + 8 * fq, col0 = u.pn * 256 + wc * 32 + 8 * fq;
        const bool first = (u.aux == 0);
#pragma unroll
        for (int ai = 0; ai < 2; ++ai) {
            u32x4 gw[4][2], pw[4][2];
#pragma unroll
            for (int m = 0; m < 4; ++m)
#pragma unroll
                for (int bj = 0; bj < 2; ++bj) { const size_t row = (size_t)(row0 + ai * 128 + m * 16);
                    gw[m][bj] = *(const u32x4*)(Z + row * ZP + gcol0 + bj * 128);
                    pw[m][bj] = (u32x4){0u, 0u, 0u, 0u}; if (!first) pw[m][bj] = *(const u32x4*)(ACC + row * D + col0 + bj * 128); }
#pragma unroll
            for (int m = 0; m < 4; ++m)
#pragma unroll
                for (int bj = 0; bj < 2; ++bj) { const size_t row = (size_t)(row0 + ai * 128 + m * 16);
                    const f32x4 v0 = acc[ai][bj][m][0], v1 = acc[ai][bj][m][1]; const u32x4 g = gw[m][bj], p = pw[m][bj];
                    u32x4 w;
                    w.x = pk2(bflo(p.x) + bflo(g.x) * v0[0], bfhi(p.x) + bfhi(g.x) * v0[1]); w.y = pk2(bflo(p.y) + bflo(g.y) * v0[2], bfhi(p.y) + bfhi(g.y) * v0[3]);
                    w.z = pk2(bflo(p.z) + bflo(g.z) * v1[0], bfhi(p.z) + bfhi(g.z) * v1[1]); w.w = pk2(bflo(p.w) + bflo(g.w) * v1[2], bfhi(p.w) + bfhi(g.w) * v1[3]);
                    *(u32x4*)(ACC + row * D + col0 + bj * 128) = w; }
        }
    }
};
struct EpiResid {
    const float* xl_src; const float* xc_src; float* xl_dst; float* xc_dst; const float* mod_g;
    __device__ __forceinline__ void operator()(const f32x4 (&acc)[2][2][4][2], const Unit& u, int wr, int wc, int fr, int fq) const {
        const int row0 = u.pm * 256 + wr * 64 + fr; const int col0 = u.pn * 256 + wc * 32 + 8 * fq;
        const bool lat = u.pm < ML / 256; const float* src = lat ? xl_src : xc_src - (size_t)ML * D; float* dst = lat ? xl_dst : xc_dst - (size_t)ML * D;
        const float* gv = mod_g + (size_t)(lat ? (u.pm >> 4) : 8) * 6144;
        f32x4 gg[2][2];
#pragma unroll
        for (int bj = 0; bj < 2; ++bj) { gg[bj][0] = *(const f32x4*)(gv + col0 + bj * 128); gg[bj][1] = *(const f32x4*)(gv + col0 + bj * 128 + 4); }
#pragma unroll
        for (int ai = 0; ai < 2; ++ai) {
            f32x4 xv[4][2][2];
#pragma unroll
            for (int m = 0; m < 4; ++m)
#pragma unroll
                for (int bj = 0; bj < 2; ++bj) { const size_t o = (size_t)(row0 + ai * 128 + m * 16) * D + col0 + bj * 128; xv[m][bj][0] = *(const f32x4*)(src + o); xv[m][bj][1] = *(const f32x4*)(src + o + 4); }
#pragma unroll
            for (int m = 0; m < 4; ++m)
#pragma unroll
                for (int bj = 0; bj < 2; ++bj) { const size_t o = (size_t)(row0 + ai * 128 + m * 16) * D + col0 + bj * 128;
                    *(f32x4*)(dst + o) = xv[m][bj][0] + gg[bj][0] * acc[ai][bj][m][0]; *(f32x4*)(dst + o + 4) = xv[m][bj][1] + gg[bj][1] * acc[ai][bj][m][1]; }
        }
    }
};
struct EpiAct {
    bf16_t* ACT;
    __device__ __forceinline__ void operator()(const f32x4 (&acc)[2][2][4][2], const Unit& u, int wr, int wc, int fr, int fq) const {
        const int row0 = u.pm * 256 + wr * 64 + fr; const int col0 = u.pn * 128 + wc * 32 + 8 * fq;
#pragma unroll
        for (int ai = 0; ai < 2; ++ai)
#pragma unroll
            for (int m = 0; m < 4; ++m) { const f32x4 g0 = acc[ai][0][m][0], g1 = acc[ai][0][m][1], u0 = acc[ai][1][m][0], u1 = acc[ai][1][m][1];
                u32x4 w; w.x = pk2(siluf_(g0[0]) * u0[0], siluf_(g0[1]) * u0[1]); w.y = pk2(siluf_(g0[2]) * u0[2], siluf_(g0[3]) * u0[3]);
                w.z = pk2(siluf_(g1[0]) * u1[0], siluf_(g1[1]) * u1[1]); w.w = pk2(siluf_(g1[2]) * u1[2], siluf_(g1[3]) * u1[3]);
                *(u32x4*)(ACT + (size_t)(row0 + ai * 128 + m * 16) * DEXP + col0) = w; }
    }
};
constexpr int RT_WS = (1024 + 8) * 2;
constexpr int RT_LO = 32 * RT_WS, RT_BIAS = 2 * RT_LO, RT_SCR = RT_BIAS + 256, RT_SCR_W = 16 * 33 * 4 + 64;
__device__ __forceinline__ void phase_route(const KArgs& a, LAS unsigned char* lds, int l, int nrows) {
    const int tid = OTID(), lane = tid & 63, wave = tid >> 6, blk = OBLK(), G = OGRID(), g = lane >> 4, r16 = lane & 15;
    LAS unsigned* lcnt = (LAS unsigned*)(lds + RT_SCR + 8 * RT_SCR_W);
    LAS float* biasl = (LAS float*)(lds + RT_BIAS);
    LAS float* lg = (LAS float*)(lds + RT_SCR + wave * RT_SCR_W); LAS float* rsl = lg + 16 * 33;
    if (tid < 32) lcnt[tid] = 0u;
    const int ntile = nrows >> 4, per = (ntile + G - 1) / G, t0 = blk * per, t1 = (t0 + per < ntile) ? t0 + per : ntile;
    const float* xl = a.out; const float* xc = (const float*)(a.ws + WS_XC);
    unsigned* tokE = (unsigned*)(a.ws + WS_TOK + TOK_E); unsigned* tokS = (unsigned*)(a.ws + WS_TOK + TOK_SLOT); f32x2* tokW = (f32x2*)(a.ws + WS_TOK + TOK_W);
    float* tokR = (float*)(a.ws + WS_TOK + TOK_RSTD);
    int curb = -1;
    for (int tb = t0; tb < t1; tb += NWAVES) {
        const int tile = tb + wave; const bool act = tile < t1;
        const int bidx = row_modidx((tb << 4));
        const int blast = row_modidx(((tb + NWAVES - 1 < t1 ? tb + NWAVES - 1 : t1 - 1) << 4) + 15);
        for (int bsel = bidx; bsel <= blast; ++bsel) {
            if (bsel != curb) {
                __syncthreads();
                const float* mod = (const float*)(a.ws + WS_MOD) + (size_t)(l * 9 + bsel) * 6144; const float* gain = a.in[I_NORM2] + l * D;
                for (int idx = tid; idx < 32 * 1024; idx += NTHR) { const int e = idx >> 10, k = idx & 1023; const float w = a.in[I_WROUTER][k * 32 + e] * gain[k] * (1.0f + mod[4 * 1024 + k]);
                    const unsigned hi = pk2(w, w) & 0xffffu; const float lo = w - bf2f((bf16_t)hi);
                    *(LAS bf16_t*)(lds + e * RT_WS + k * 2) = (bf16_t)hi; *(LAS bf16_t*)(lds + RT_LO + e * RT_WS + k * 2) = (bf16_t)(pk2(lo, lo) & 0xffffu); }
                { const int e = tid & 31, part = tid >> 5; float s = 0.f;
                  for (int k = part * 64; k < part * 64 + 64; ++k) s += mod[3 * 1024 + k] * a.in[I_WROUTER][k * 32 + e];
                  LAS float* part_s = (LAS float*)(lds + RT_SCR); part_s[part * 32 + e] = s; }
                __syncthreads();
                if (tid < 32) { float s = 0.f; for (int p = 0; p < 16; ++p) s += ((LAS float*)(lds + RT_SCR))[p * 32 + tid]; biasl[tid] = s; }
                __syncthreads();
                curb = bsel;
            }
            if (act && row_modidx(tile << 4) == bsel) {
                const int row = (tile << 4) + r16;
                const float* xr = row < ML ? xl + (size_t)row * D : xc + (size_t)(row - ML) * D;
                f32x4 acc0 = (f32x4){0.f, 0.f, 0.f, 0.f}, acc1 = acc0; float ss = 0.f;
#pragma unroll 4
                for (int ks = 0; ks < 32; ++ks) {
                    const f32x4 xa = *(const f32x4*)(xr + ks * 32 + 8 * g), xb = *(const f32x4*)(xr + ks * 32 + 8 * g + 4);
                    ss += (xa.x * xa.x + xa.y * xa.y) + (xa.z * xa.z + xa.w * xa.w) + (xb.x * xb.x + xb.y * xb.y) + (xb.z * xb.z + xb.w * xb.w);
                    u32x4 hw; hw.x = pk2(xa.x, xa.y); hw.y = pk2(xa.z, xa.w); hw.z = pk2(xb.x, xb.y); hw.w = pk2(xb.z, xb.w);
                    u32x4 lw; lw.x = pk2(xa.x - bflo(hw.x), xa.y - bfhi(hw.x)); lw.y = pk2(xa.z - bflo(hw.y), xa.w - bfhi(hw.y)); lw.z = pk2(xb.x - bflo(hw.z), xb.y - bfhi(hw.z)); lw.w = pk2(xb.z - bflo(hw.w), xb.w - bfhi(hw.w));
                    const bf16x8 Ah = __builtin_bit_cast(bf16x8, hw), Al = __builtin_bit_cast(bf16x8, lw);
                    const LAS unsigned char* wp = lds + r16 * RT_WS + (ks * 32 + 8 * g) * 2;
                    const bf16x8 B0h = *(const LAS bf16x8*)wp, B1h = *(const LAS bf16x8*)(wp + 16 * RT_WS), B0l = *(const LAS bf16x8*)(wp + RT_LO), B1l = *(const LAS bf16x8*)(wp + RT_LO + 16 * RT_WS);
                    acc0 = __builtin_amdgcn_mfma_f32_16x16x32_bf16(Ah, B0h, acc0, 0, 0, 0); acc0 = __builtin_amdgcn_mfma_f32_16x16x32_bf16(Al, B0h, acc0, 0, 0, 0); acc0 = __builtin_amdgcn_mfma_f32_16x16x32_bf16(Ah, B0l, acc0, 0, 0, 0);
                    acc1 = __builtin_amdgcn_mfma_f32_16x16x32_bf16(Ah, B1h, acc1, 0, 0, 0); acc1 = __builtin_amdgcn_mfma_f32_16x16x32_bf16(Al, B1h, acc1, 0, 0, 0); acc1 = __builtin_amdgcn_mfma_f32_16x16x32_bf16(Ah, B1l, acc1, 0, 0, 0);
                }
                ss += __shfl_xor(ss, 16); ss += __shfl_xor(ss, 32);
                const float rstd = rsqrtf(ss * (1.f / 1024.f) + EPS);
                if (g == 0) { rsl[r16] = rstd; tokR[row] = rstd; }
                LDS_WAIT(); asm volatile("" ::: "memory");
#pragma unroll
                for (int j = 0; j < 4; ++j) { const float rs = rsl[4 * g + j]; lg[(4 * g + j) * 33 + r16] = acc0[j] * rs + biasl[r16]; lg[(4 * g + j) * 33 + 16 + r16] = acc1[j] * rs + biasl[16 + r16]; }
                LDS_WAIT(); asm volatile("" ::: "memory");
                if (lane < 16) {
                    const int rrow = (tile << 4) + lane;
                    float sc[32], bestg = -1e30f; int gi = 0;
#pragma unroll
                    for (int e = 0; e < 32; ++e) sc[e] = sigmoidf_(lg[lane * 33 + e]);
#pragma unroll
                    for (int gg = 0; gg < 8; ++gg) {
                        float s4[4];
#pragma unroll
                        for (int j = 0; j < 4; ++j) s4[j] = sc[gg * 4 + j] + a.in[I_RBIAS][gg * 4 + j];
                        const float m01 = fmaxf(s4[0], s4[1]), n01 = fminf(s4[0], s4[1]), m23 = fmaxf(s4[2], s4[3]), n23 = fminf(s4[2], s4[3]);
                        const float top = fmaxf(m01, m23), second = fmaxf(fminf(m01, m23), (m01 >= m23) ? n01 : n23);
                        const float gs = top + second;
                        if (gs > bestg) { bestg = gs; gi = gg; }
                    }
                    float s4[4], w4[4];
#pragma unroll
                    for (int j = 0; j < 4; ++j) { float sv = 0.f, wv = 0.f;
#pragma unroll
                        for (int gg = 0; gg < 8; ++gg) { if (gg == gi) { sv = sc[gg * 4 + j] + a.in[I_RBIAS][gg * 4 + j]; wv = sc[gg * 4 + j]; } }
                        s4[j] = sv; w4[j] = wv; }
                    int i0 = 0; float v0 = s4[0];
#pragma unroll
                    for (int j = 1; j < 4; ++j) if (s4[j] > v0) { v0 = s4[j]; i0 = j; }
                    int i1 = -1; float v1 = -1e30f;
#pragma unroll
                    for (int j = 0; j < 4; ++j) if (j != i0 && s4[j] > v1) { v1 = s4[j]; i1 = j; }
                    float w0 = 0.f, w1 = 0.f;
#pragma unroll
                    for (int j = 0; j < 4; ++j) { if (j == i0) w0 = w4[j]; if (j == i1) w1 = w4[j]; }
                    const float inv = 1.0f / (w0 + w1);
                    const int e0 = gi * 4 + i0, e1 = gi * 4 + i1;
                    const unsigned s0 = __hip_atomic_fetch_add(&lcnt[e0], 1u, __ATOMIC_RELAXED, __HIP_MEMORY_SCOPE_WORKGROUP), s1 = __hip_atomic_fetch_add(&lcnt[e1], 1u, __ATOMIC_RELAXED, __HIP_MEMORY_SCOPE_WORKGROUP);
                    tokE[rrow] = (unsigned)e0 | ((unsigned)e1 << 8); tokS[rrow] = s0 | (s1 << 16); tokW[rrow] = (f32x2){w0 * inv, w1 * inv};
                }
            }
        }
    }
    __syncthreads();
    if (tid < 32) ((unsigned*)(a.ws + WS_TOK + TOK_BCNT))[blk * 32 + tid] = lcnt[tid];
}

__device__ __forceinline__ void phase_gather(const KArgs& a, LAS unsigned char* lds, int l, int nrows) {
    const int tid = OTID(), lane = tid & 63, wave = tid >> 6, blk = OBLK(), G = OGRID();
    LAS unsigned* tot = (LAS unsigned*)lds;
    LAS unsigned* bef = tot + 32;
    LAS unsigned* base = tot + 64;
    const unsigned* bc = (const unsigned*)(a.ws + WS_TOK + TOK_BCNT);
    { LAS unsigned* ptot = tot + 96; LAS unsigned* pbef = ptot + 512;
      const int e = tid & 31, part = tid >> 5; unsigned t = 0u, bf = 0u;
#pragma unroll
      for (int k = 0; k < 16; ++k) { const int g = part * 16 + k; const unsigned c = (g < G) ? bc[g * 32 + e] : 0u; t += c; bf += (g < blk) ? c : 0u; }
      ptot[tid] = t; pbef[tid] = bf;
      __syncthreads();
      if (tid < 32) { unsigned tt = 0u, bb = 0u;
#pragma unroll
          for (int p = 0; p < 16; ++p) { tt += ptot[p * 32 + tid]; bb += pbef[p * 32 + tid]; }
          tot[tid] = tt; bef[tid] = bb; } }
    __syncthreads();
    if (tid == 0) {
        unsigned pos = 0u; int* tile_e = (int*)(a.ws + WS_TOK + TOK_TILE);
#pragma unroll 1
        for (int e = 0; e < 32; ++e) { base[e] = pos + bef[e]; const unsigned nt = (tot[e] + 255u) >> 8;
            if (blk == 0) tile_e[e] = (int)(pos >> 8);
            pos += nt << 8; }
        if (blk == 0) tile_e[32] = (int)(pos >> 8);
    }
    __syncthreads();
    const unsigned* tokE = (const unsigned*)(a.ws + WS_TOK + TOK_E); const unsigned* tokS = (const unsigned*)(a.ws + WS_TOK + TOK_SLOT); u32x2* tokP = (u32x2*)(a.ws + WS_TOK + TOK_POS);
    const float* tokR = (const float*)(a.ws + WS_TOK + TOK_RSTD);
    bf16_t* xb = (bf16_t*)(a.ws + WS_XB);
    const float* xl = a.out; const float* xc = (const float*)(a.ws + WS_XC);
    const int ntile = nrows >> 4, per = (ntile + G - 1) / G, r0 = blk * per * 16, r1 = ((blk + 1) * per * 16 < nrows) ? (blk + 1) * per * 16 : nrows;
    unsigned en = 0u, sn = 0u; float rn = 0.f;
    if (r0 + wave < r1) { en = tokE[r0 + wave]; sn = tokS[r0 + wave]; rn = tokR[r0 + wave]; }
    for (int row = r0 + wave; row < r1; row += NWAVES) {
        const unsigned e = en, s = sn; const float rstd_pre = rn;
        if (row + NWAVES < r1) { en = tokE[row + NWAVES]; sn = tokS[row + NWAVES]; rn = tokR[row + NWAVES]; }
        const unsigned p0 = base[e & 255u] + (s & 0xffffu), p1 = base[(e >> 8) & 255u] + (s >> 16);
        const float* xr = row < ML ? xl + (size_t)row * D : xc + (size_t)(row - ML) * D;
        const float rstd = rstd_pre;
        const float* mod = (const float*)(a.ws + WS_MOD) + (size_t)(l * 9 + row_modidx(row)) * 6144; const float* gain = a.in[I_NORM2] + l * D;
#pragma unroll
        for (int j = 0; j < 4; ++j) {
            const f32x4 x = ((const f32x4*)xr)[lane + 64 * j], gv = ((const f32x4*)gain)[lane + 64 * j], s1 = ((const f32x4*)(mod + 4 * 1024))[lane + 64 * j], s0 = ((const f32x4*)(mod + 3 * 1024))[lane + 64 * j];
            const f32x4 y = (x * rstd * gv) * (s1 + 1.0f) + s0;
            u32x2 o; o.x = pk2(y.x, y.y); o.y = pk2(y.z, y.w);
            ((u32x2*)(xb + (size_t)p0 * D))[lane + 64 * j] = o; ((u32x2*)(xb + (size_t)p1 * D))[lane + 64 * j] = o;
        }
        if (lane == 0) tokP[row] = (u32x2){p0, p1};
    }
}

__device__ __forceinline__ void phase_combine(const KArgs& a, int l, int nrows) {
    const int tid = OTID(), lane = tid & 63, wave = tid >> 6;
    const int gw = OBLK() * NWAVES + wave, NGW = OGRID() * NWAVES;
    const u32x2* tokP = (const u32x2*)(a.ws + WS_TOK + TOK_POS); const f32x2* tokW = (const f32x2*)(a.ws + WS_TOK + TOK_W);
    const bf16_t* yb = (const bf16_t*)(a.ws + WS_YB); bf16_t* hl = (bf16_t*)(a.ws + WS_HL);
    u32x2 pn = (u32x2){0u, 0u}; f32x2 wn = (f32x2){0.f, 0.f};
    if (gw < nrows) { pn = tokP[gw]; wn = tokW[gw]; }
    for (int row = gw; row < nrows; row += NGW) {
        float* xr = row < ML ? a.out + (size_t)row * D : (float*)(a.ws + WS_XC) + (size_t)(row - ML) * D;
        const u32x2 p = pn; const f32x2 w = wn;
        if (row + NGW < nrows) { pn = tokP[row + NGW]; wn = tokW[row + NGW]; }
        const float* mod = (const float*)(a.ws + WS_MOD) + (size_t)(l * 9 + row_modidx(row)) * 6144;
        f32x4 v[4];
#pragma unroll
        for (int j = 0; j < 4; ++j) {
            const f32x4 x = ((const f32x4*)xr)[lane + 64 * j], g2 = ((const f32x4*)(mod + 5 * 1024))[lane + 64 * j];
            const u32x2 y0 = ((const u32x2*)(yb + (size_t)p.x * D))[lane + 64 * j], y1 = ((const u32x2*)(yb + (size_t)p.y * D))[lane + 64 * j];
            f32x4 m; m.x = w.x * bflo(y0.x) + w.y * bflo(y1.x); m.y = w.x * bfhi(y0.x) + w.y * bfhi(y1.x); m.z = w.x * bflo(y0.y) + w.y * bflo(y1.y); m.w = w.x * bfhi(y0.y) + w.y * bfhi(y1.y);
            v[j] = x + g2 * m; ((f32x4*)xr)[lane + 64 * j] = v[j];
        }
        if (l == 0) { const float* mod1 = (const float*)(a.ws + WS_MOD) + (size_t)(9 + row_modidx(row)) * 6144;
            modulate_store(v, a.in[I_NORM1] + D, mod1, mod1 + 1024, hl + (size_t)row * D, lane); }
    }
}
#ifndef MK_PER_PHASE
#define MK_PER_PHASE 0
#endif
#ifndef PROBE_DUP
#define PROBE_DUP 0
#endif
#define DUPON(k) ((PROBE_DUP >> (k)) & 1)
#define DUPBAR() do { if (use_bar) xcd_barrier(bar); } while (0)
#ifndef RERUN_K
#define RERUN_K 0
#endif
#define RERUN(k, l, ctx_out, mrows) do { if (RERUN_K == (k)) { DUPBAR(); ph_modulate1(ka, (l), MA); DUPBAR(); ph_gemm_in(ka, lds, (l)); DUPBAR(); ph_prep(ka, (l)); \
        if ((k) >= 3) { DUPBAR(); ph_mixers(ka, lds, (l), ctx_out); } if ((k) >= 4) { DUPBAR(); ph_gdnscan(ka, lds, (l), ctx_out, (l) + 2); } \
        if ((k) >= 5) { DUPBAR(); ph_post(ka, lds, (l), mrows); } } } while (0)
constexpr int NPH_LAYER = 14, NPHASES = 1 + 2 * NPH_LAYER;

__device__ NOINL void ph_prologue(KAP ka, LAS unsigned char* lds) { const KArgs a = load_kargs(ka); phase_prologue(a, lds); }
__device__ NOINL void ph_modulate1(KAP ka, int l, int nrows) { const KArgs a = load_kargs(ka); phase_modulate1(a, l, nrows); }
__device__ NOINL void ph_prep(KAP ka, int l) { const KArgs a = load_kargs(ka); phase_prep(a, l); }
__device__ NOINL void ph_mixers(KAP ka, LAS unsigned char* lds, int l, bool ctx_out) { phase_mixers(ka, lds, l, ctx_out); }
__device__ NOINL void ph_gdnscan(KAP ka, LAS unsigned char* lds, int l, bool ctx_out, int qslot) { phase_scan_attn(ka, lds, l, ctx_out, qslot); }
__device__ NOINL void ph_post(KAP ka, LAS unsigned char* lds, int l, int mrows) { { const int blk = OBLK(), G = OGRID(); for (int u = blk; u < 32 * 34; u += G) { if (mrows == ML && (u % 34) < 2) continue; call_retout(ka, lds, l, u); } }
    const KArgs a = load_kargs(ka); phase_post(a, l, mrows); }
__device__ NOINL void ph_gemm_in(KAP ka, LAS unsigned char* lds, int l) { const KArgs a = load_kargs(ka);
    const bf16_t* wsm = (const bf16_t*)(a.ws + WS_WSM);
    SchedPlain S; S.init(a.ws + WS_HL, 1024, wsm + WSM_IN / 2, 1024, MA, ZP, OGRID(), OBLK());
    EpiStore<0> E{(bf16_t*)(a.ws + WS_Z), ZP};
    pg8::gemm_phase<EpiStore<0>, SchedPlain, true>(lds, 1024, 1024, 1024, S, E); }
__device__ NOINL void ph_gemm_gate(KAP ka, LAS unsigned char* lds, int l, int mrows) { const KArgs a = load_kargs(ka);
    const bf16_t* wsm = (const bf16_t*)(a.ws + WS_WSM);
    SchedPlain S; S.init(a.ws + WS_HL, 1024, wsm + WSM_MERGE / 2, 1024, mrows, 4096, OGRID(), OBLK());
    EpiStore<1> E{(bf16_t*)(a.ws + WS_Z), ZP};
    pg8::gemm_phase<EpiStore<1>, SchedPlain, true>(lds, 1024, 1024, 1024, S, E); }
__device__ NOINL void ph_gemm_branch(KAP ka, LAS unsigned char* lds, int l, int mrows) { const KArgs a = load_kargs(ka);
    const bf16_t* wsm = (const bf16_t*)(a.ws + WS_WSM);
    SchedBranch S{(const char*)(a.ws + WS_Z), (const char*)(wsm + WSM_BR / 2), (mrows / 256) * 4, OGRID(), OBLK()};
    EpiBranch E{(bf16_t*)(a.ws + WS_HL), (const bf16_t*)(a.ws + WS_Z)};
    pg8::gemm_phase<EpiBranch, SchedBranch, true>(lds, 512, ZP, 512, S, E); }
__device__ NOINL void ph_gemm_out(KAP ka, LAS unsigned char* lds, int l, int mrows) { const KArgs a = load_kargs(ka);
    const bf16_t* wsm = (const bf16_t*)(a.ws + WS_WSM);
    SchedPlain S; S.init(a.ws + WS_HL, 1024, wsm + WSM_OUT / 2, 1024, mrows, 1024, OGRID(), OBLK());
    EpiResid E{l == 0 ? a.in[I_X] : a.out, l == 0 ? a.in[I_CTX] : (const float*)(a.ws + WS_XC), a.out, (float*)(a.ws + WS_XC), (const float*)(a.ws + WS_MOD) + (size_t)l * 9 * 6144 + 2 * 1024};
    pg8::gemm_phase<EpiResid, SchedPlain, true>(lds, 1024, 1024, 1024, S, E); }
#ifndef EXPC_SPLIT
#define EXPC_SPLIT 14000
#endif
__device__ NOINL void ph_expconv(KAP ka, LAS unsigned char* lds, int l, int lo, int hi, int blk0) { const KArgs a = load_kargs(ka); expert_convert_range(a, lds, l, lo, hi, blk0); }
__device__ NOINL void ph_route(KAP ka, LAS unsigned char* lds, int l, int mrows) { const KArgs a = load_kargs(ka); phase_route(a, lds, l, mrows); if (l == 0) { __syncthreads(); small_weight_convert(a, lds, 1); } }
__device__ NOINL void ph_gather(KAP ka, LAS unsigned char* lds, int l, int mrows) { const KArgs a = load_kargs(ka); phase_gather(a, lds, l, mrows); }
__device__ NOINL void ph_gemm_gu(KAP ka, LAS unsigned char* lds) { const KArgs a = load_kargs(ka);
    const int* tile_e = (const int*)(a.ws + WS_TOK + TOK_TILE);
    SchedMoe S; S.A0 = (const char*)(a.ws + WS_XB); S.W0 = (const char*)(a.ws + WS_WGU); S.tile_start = tile_e; S.tA = (size_t)256 * 1024 * 2; S.eB = (size_t)1024 * 1024 * 2; S.tB = (size_t)256 * 1024 * 2; S.G = OGRID(); S.c = OBLK(); S.init();
    EpiAct E{(bf16_t*)(a.ws + WS_ACT)};
    pg8::gemm_phase<EpiAct, SchedMoe, true>(lds, 1024, 1024, 1024, S, E); }
__device__ NOINL void ph_gemm_dn(KAP ka, LAS unsigned char* lds) { const KArgs a = load_kargs(ka);
    const int* tile_e = (const int*)(a.ws + WS_TOK + TOK_TILE);
    SchedMoe S; S.A0 = (const char*)(a.ws + WS_ACT); S.W0 = (const char*)(a.ws + WS_WDN); S.tile_start = tile_e; S.tA = (size_t)256 * 512 * 2; S.eB = (size_t)1024 * 512 * 2; S.tB = (size_t)256 * 512 * 2; S.G = OGRID(); S.c = OBLK(); S.init();
    EpiStore<0> E{(bf16_t*)(a.ws + WS_YB), 1024};
    pg8::gemm_phase<EpiStore<0>, SchedMoe, true>(lds, 512, 512, 512, S, E); }
__device__ NOINL void ph_combine(KAP ka, int l, int mrows) { const KArgs a = load_kargs(ka); phase_combine(a, l, mrows); }

__global__ void __launch_bounds__(NTHR, 2) fwd_kernel(KArgs a) {
    extern __shared__ __attribute__((aligned(16))) unsigned char lds_raw[];
    LAS unsigned char* lds = (LAS unsigned char*)lds_raw;
    KAP ka = (KAP)__builtin_amdgcn_kernarg_segment_ptr();
    const int tid = OTID();
    volatile LAS unsigned* ctlw = (volatile LAS unsigned*)(lds + LDS_CTL);
    if (tid < 64) ctlw[tid] = 0u;
    __syncthreads();
    const int lo = a.ph_lo, hi = a.ph_hi;
    const bool use_bar = (hi - lo) > 1;
    XcdBarrier bar; bar.bar = (unsigned*)(a.ws + WS_CTL) + CW_BAR; bar.x = 0u; bar.st = ctlw + 8;
    if (use_bar) bar = xcd_barrier_post((unsigned*)(a.ws + WS_CTL) + CW_BAR, ctlw + 8);
#define IN(k) (lo <= (k) && (k) < hi)
#define SEAM(k) do { if (use_bar && (k) + 1 < hi) xcd_barrier(bar); } while (0)
    if (IN(0)) { ph_prologue(ka, lds); SEAM(0); }
#define LAYER_BODY(l) do { \
        constexpr int pb = 1 + (l) * NPH_LAYER; constexpr bool ctx_out = ((l) == 0); constexpr int mrows = ctx_out ? MA : ML; \
        if ((l) == 0 && IN(pb + 0)) { ph_modulate1(ka, (l), MA); SEAM(pb + 0); }     \
        if (IN(pb + 1)) { ph_gemm_in(ka, lds, (l)); if (RERUN_K == 1) { DUPBAR(); ph_modulate1(ka, (l), MA); DUPBAR(); ph_gemm_in(ka, lds, (l)); } SEAM(pb + 1); } \
        if (IN(pb + 2)) { ph_prep(ka, (l)); RERUN(2, l, ctx_out, mrows); SEAM(pb + 2); } \
        if (IN(pb + 3)) { ph_mixers(ka, lds, (l), ctx_out); RERUN(3, l, ctx_out, mrows); SEAM(pb + 3); } \
        if (IN(pb + 4)) { ph_gdnscan(ka, lds, (l), ctx_out, (l)); RERUN(4, l, ctx_out, mrows); SEAM(pb + 4); } \
        if (IN(pb + 5)) { ph_post(ka, lds, (l), mrows); RERUN(5, l, ctx_out, mrows); SEAM(pb + 5); } \
        if (IN(pb + 6)) { ph_gemm_gate(ka, lds, (l), mrows); if ((l) == 0) ph_expconv(ka, lds, (l), 0, 4400, 128); SEAM(pb + 6); } \
        if (IN(pb + 7)) { ph_gemm_branch(ka, lds, (l), mrows); if ((l) == 0) ph_expconv(ka, lds, (l), 4400, 4400 + EXPC_SPLIT, 32); SEAM(pb + 7); } \
        if (IN(pb + 8)) { ph_gemm_out(ka, lds, (l), mrows); ph_expconv(ka, lds, (l), (l) == 0 ? 4400 + EXPC_SPLIT : 0, EXPC_ITEMS, 0); SEAM(pb + 8); } \
        if (IN(pb + 9)) { ph_route(ka, lds, (l), mrows); if (DUPON(9)) { DUPBAR(); ph_route(ka, lds, (l), mrows); } SEAM(pb + 9); } \
        if (IN(pb + 10)) { ph_gather(ka, lds, (l), mrows); if (DUPON(10)) { DUPBAR(); ph_gather(ka, lds, (l), mrows); } SEAM(pb + 10); } \
        if (IN(pb + 11)) { ph_gemm_gu(ka, lds); if (DUPON(11)) { DUPBAR(); ph_gemm_gu(ka, lds); } SEAM(pb + 11); } \
        if (IN(pb + 12)) { ph_gemm_dn(ka, lds); if (DUPON(12)) { DUPBAR(); ph_gemm_dn(ka, lds); } if (RERUN_K == 12) { DUPBAR(); ph_route(ka, lds, (l), mrows); DUPBAR(); ph_gather(ka, lds, (l), mrows); DUPBAR(); ph_gemm_gu(ka, lds); DUPBAR(); ph_gemm_dn(ka, lds); } SEAM(pb + 12); } \
        if (IN(pb + 13)) { ph_combine(ka, (l), mrows); SEAM(pb + 13); } \
    } while (0)
    LAYER_BODY(0);
    LAYER_BODY(1);
#undef LAYER_BODY
#undef IN
#undef SEAM
}

extern "C" void kernel_launch(void* const* d_in, const int* in_sizes, int n_in, void* d_out, int out_size, void* d_ws, size_t ws_size, hipStream_t stream) {
    static int grid = 0;
    if (grid == 0) {
        if (n_in != 29 || in_sizes[0] != ML * D || out_size != ML * D || ws_size < WS_END) {
            fprintf(stderr, "kernel_launch: unexpected problem (n_in %d, in0 %d, out %d, ws %zu < %zu); nothing launched\n", n_in, n_in > 0 ? in_sizes[0] : -1, out_size, ws_size, (size_t)WS_END); grid = -1; return; }
        int dev = 0, cus = 0, per_cu = 0;
        if (hipGetDevice(&dev) != hipSuccess || hipDeviceGetAttribute(&cus, hipDeviceAttributeMultiprocessorCount, dev) != hipSuccess) { grid = -1; return; }
        if (hipFuncSetAttribute((const void*)fwd_kernel, hipFuncAttributeMaxDynamicSharedMemorySize, LDS_BYTES) != hipSuccess) { fprintf(stderr, "kernel_launch: hipFuncSetAttribute failed\n"); grid = -1; return; }
        if (hipOccupancyMaxActiveBlocksPerMultiprocessor(&per_cu, (const void*)fwd_kernel, NTHR, LDS_BYTES) != hipSuccess || per_cu < 1) {
            fprintf(stderr, "kernel_launch: occupancy query says %d workgroups per CU\n", per_cu); }
        (void)hipGetLastError();
        grid = cus;
        if (grid > 256) grid = 256;
    }
    if (grid < 0) return;
    if (hipMemsetAsync((char*)d_ws + WS_CTL, 0, CTL_ZERO_BYTES, stream) != hipSuccess) return;
    KArgs a{};
    for (int i = 0; i < 29; ++i) a.in[i] = (const float*)d_in[i];
    a.out = (float*)d_out; a.ws = (unsigned char*)d_ws;
#if MK_PER_PHASE
    for (int k = 0; k < NPHASES; ++k) { if (k == 1 + NPH_LAYER) continue; a.ph_lo = k; a.ph_hi = k + 1; hipLaunchKernelGGL(fwd_kernel, dim3(grid), dim3(NTHR), LDS_BYTES, stream, a); }
#else
    a.ph_lo = 0; a.ph_hi = NPHASES;
    hipLaunchKernelGGL(fwd_kernel, dim3(grid), dim3(NTHR), LDS_BYTES, stream, a);
#endif
}
```

```cpp
#include <hip/hip_runtime.h>
#include <cstdio>
#include <cstdint>

#define LAS __attribute__((address_space(3)))
#define GAS __attribute__((address_space(1)))
typedef unsigned short bf16_t;
typedef short bf16x8 __attribute__((ext_vector_type(8)));
typedef short s16x4 __attribute__((ext_vector_type(4)));
typedef float f32x4 __attribute__((ext_vector_type(4)));
typedef float f32x2 __attribute__((ext_vector_type(2)));
typedef unsigned u32x4 __attribute__((ext_vector_type(4)));
typedef unsigned u32x2 __attribute__((ext_vector_type(2)));

typedef __bf16 bf16x2_t __attribute__((ext_vector_type(2)));
__device__ __forceinline__ unsigned pk2(float lo, float hi) { const f32x2 v = {lo, hi}; const bf16x2_t b = __builtin_convertvector(v, bf16x2_t); return __builtin_bit_cast(unsigned, b); }
__device__ __forceinline__ unsigned f2bf(float f) { return pk2(f, f) & 0xffffu; }
__device__ __forceinline__ float bflo(unsigned u) { return __builtin_bit_cast(float, u << 16); }
__device__ __forceinline__ float bfhi(unsigned u) { return __builtin_bit_cast(float, u & 0xffff0000u); }
__device__ __forceinline__ float bf2f(bf16_t h) { return __builtin_bit_cast(float, (unsigned)h << 16); }
__device__ __forceinline__ float sigmoidf_(float x) { return 1.0f / (1.0f + __expf(-x)); }
__device__ __forceinline__ float siluf_(float x) { return x / (1.0f + __expf(-x)); }
__device__ __forceinline__ float sigmoid_fast(float x) { return __builtin_amdgcn_rcpf(1.0f + __expf(-x)); }
__device__ __forceinline__ float silu_fast(float x) { return x * __builtin_amdgcn_rcpf(1.0f + __expf(-x)); }

__device__ __forceinline__ bf16x8 cat8(u32x2 lo, u32x2 hi) { u32x4 w; w.x = lo.x; w.y = lo.y; w.z = hi.x; w.w = hi.y; return __builtin_bit_cast(bf16x8, w); }
__device__ __forceinline__ int OTID() { int t = threadIdx.x; asm volatile("" : "+v"(t)); return t; }
__device__ __forceinline__ int OBLK() { int t = blockIdx.x; asm volatile("" : "+s"(t)); return t; }
__device__ __forceinline__ int OGRID() { int t = gridDim.x; asm volatile("" : "+s"(t)); return t; }

namespace pg8 {
constexpr int BM = 256, BK = 64, HALF = 128, HTB = HALF * BK * 2, STAGE_BYTES = 8 * HTB, NXCD = 8, WGM = 8;
__host__ __device__ __forceinline__ int lds_byte(int r, int c) { const int st = (r >> 4) * 2 + (c >> 5), rr = r & 15, cc = c & 31, ob = rr * 64 + cc * 2; return st * 1024 + (ob ^ (((ob >> 9) & 1) << 5)); }
__host__ __device__ __forceinline__ void stage_rc(int b, int& R, int& C) { const int st = b / 1024, sb = b % 1024, swz = sb ^ (((sb >> 9) & 1) << 5); R = (st >> 1) * 16 + swz / 64; C = (st & 1) * 32 + (swz % 64) / 2; }
__host__ __device__ __forceinline__ int perm32(int rho) { const int n = rho >> 4, i = rho & 15; return 8 * (i >> 2) + 4 * n + (i & 3); }

struct Unit { int pm, pn, aux; };

template <class Epi, class Sched, bool ALIGN_EPI>
__device__ __forceinline__ void gemm_phase(LAS unsigned char* lds, const int K, const int lda, const int ldb, const Sched& S, const Epi& E) {
    const int tid = OTID(), wid = __builtin_amdgcn_readfirstlane(tid >> 6), lane = tid & 63, wr = wid >> 2, wc = wid & 3, fr = lane & 15, fq = lane >> 4;
    const int nt = K / BK;
    unsigned voffA[2], voffB[2];
#pragma unroll
    for (int i = 0; i < 2; ++i) { int R, C; stage_rc(tid * 16 + i * 8192, R, C); const int Rb = (R & ~31) + perm32(R & 31);
        voffA[i] = (unsigned)(R * lda + C) * 2u; voffB[i] = (unsigned)(Rb * ldb + C) * 2u; }
    const size_t kstep = (size_t)(BK * 2);
    const size_t hstepA = (size_t)HALF * lda * 2, hstepB = (size_t)HALF * ldb * 2;
    const unsigned ldsw = (unsigned)wid * 1024u;
    const int aoff = lds_byte(wr * 64 + fr, fq * 8), boff = lds_byte(wc * 32 + fr, fq * 8);
#define PG8_SA(b, h) (((b) * 2 + (h)) * HTB)
#define PG8_SB(b, h) ((4 + (b) * 2 + (h)) * HTB)
#define PG8_STAGE(bufoff, gbase, voff) do { _Pragma("unroll") for (int _i = 0; _i < 2; ++_i) \
        __builtin_amdgcn_global_load_lds((const unsigned*)((const char*)(gbase) + (voff)[_i]), (LAS unsigned*)(lds + (bufoff) + ldsw + _i * 8192), 16, 0, 0); } while (0)
#define PG8_LDA(dst, b, h) do { _Pragma("unroll") for (int m = 0; m < 4; ++m) _Pragma("unroll") for (int k = 0; k < 2; ++k) dst[m][k] = *(const LAS bf16x8*)(lds + PG8_SA(b, h) + aoff + m * 2048 + k * 1024); } while (0)
#define PG8_LDB(dst, b, h) do { _Pragma("unroll") for (int n = 0; n < 2; ++n) _Pragma("unroll") for (int k = 0; k < 2; ++k) dst[n][k] = *(const LAS bf16x8*)(lds + PG8_SB(b, h) + boff + n * 2048 + k * 1024); } while (0)
#define PG8_MMA(ai, bj, At, Bt) do { __builtin_amdgcn_s_setprio(1); _Pragma("unroll") for (int m = 0; m < 4; ++m) _Pragma("unroll") for (int n = 0; n < 2; ++n) _Pragma("unroll") for (int k = 0; k < 2; ++k) \
        acc[ai][bj][m][n] = __builtin_amdgcn_mfma_f32_16x16x32_bf16(Bt[n][k], At[m][k], acc[ai][bj][m][n], 0, 0, 0); __builtin_amdgcn_s_setprio(0); } while (0)
#define PG8_WAIT_V(n) asm volatile("s_waitcnt vmcnt(" #n ")" ::: "memory")
#define PG8_WAIT_L(n) asm volatile("s_waitcnt lgkmcnt(" #n ")" ::: "memory")
#define PG8_BAR __builtin_amdgcn_s_barrier()
#define PG8_SCHED __builtin_amdgcn_sched_barrier(0)
    Unit cur, nxt; int ui = 0;
    if (!S.next(0, cur)) return;
    f32x4 acc[2][2][4][2];
#pragma unroll
    for (int a = 0; a < 2; ++a)
#pragma unroll
        for (int b = 0; b < 2; ++b)
#pragma unroll
            for (int m = 0; m < 4; ++m)
#pragma unroll
                for (int n = 0; n < 2; ++n) acc[a][b][m][n] = (f32x4){0.f, 0.f, 0.f, 0.f};
    bf16x8 At[4][2], B0[2][2], B1[2][2];
    const char* cA = S.A(cur); const char* cB = S.B(cur);
    PG8_STAGE(PG8_SB(0, 0), cB, voffB); PG8_STAGE(PG8_SB(0, 1), cB + hstepB, voffB); PG8_STAGE(PG8_SA(0, 0), cA, voffA); PG8_STAGE(PG8_SA(0, 1), cA + hstepA, voffA);
    if (wr == 1) PG8_BAR;
    PG8_WAIT_V(2); PG8_BAR;
    PG8_STAGE(PG8_SB(1, 0), cB + kstep, voffB); PG8_STAGE(PG8_SA(1, 0), cA + kstep, voffA); PG8_STAGE(PG8_SB(1, 1), cB + hstepB + kstep, voffB);
    PG8_WAIT_V(6); PG8_BAR;
    for (;;) {
        const bool has_next = S.next(ui + 1, nxt);
        const char* nA = has_next ? S.A(nxt) : cA; const char* nB = has_next ? S.B(nxt) : cB;
        for (int t = 0; t < nt; t += 2) {
            const bool last = (t == nt - 2);
            const char* a1 = cA + (size_t)(t + 1) * kstep;
            const char* a2 = last ? nA : cA + (size_t)(t + 2) * kstep; const char* b2 = last ? nB : cB + (size_t)(t + 2) * kstep;
            const char* a3 = a2 + kstep; const char* b3 = b2 + kstep;
            PG8_LDB(B0, 0, 0); PG8_LDB(B1, 0, 1); PG8_SCHED; PG8_LDA(At, 0, 0); PG8_STAGE(PG8_SA(1, 1), a1 + hstepA, voffA);
            PG8_WAIT_V(8); PG8_WAIT_L(0); PG8_BAR; PG8_MMA(0, 0, At, B0); PG8_MMA(0, 1, At, B1); PG8_BAR; PG8_SCHED;
            PG8_LDA(At, 0, 1); PG8_STAGE(PG8_SB(0, 0), b2, voffB); PG8_STAGE(PG8_SB(0, 1), b2 + hstepB, voffB); PG8_STAGE(PG8_SA(0, 0), a2, voffA);
            PG8_WAIT_V(8); PG8_WAIT_L(0); PG8_BAR; PG8_MMA(1, 0, At, B0); PG8_MMA(1, 1, At, B1); PG8_BAR; PG8_SCHED;
            PG8_LDB(B0, 1, 0); PG8_LDB(B1, 1, 1); PG8_SCHED; PG8_LDA(At, 1, 0); PG8_STAGE(PG8_SA(0, 1), a2 + hstepA, voffA);
            PG8_WAIT_V(8); PG8_WAIT_L(0); PG8_BAR; PG8_MMA(0, 0, At, B0); PG8_MMA(0, 1, At, B1); PG8_BAR; PG8_SCHED;
            PG8_LDA(At, 1, 1); PG8_STAGE(PG8_SB(1, 0), b3, voffB); PG8_STAGE(PG8_SB(1, 1), b3 + hstepB, voffB); PG8_STAGE(PG8_SA(1, 0), a3, voffA);
            PG8_WAIT_V(8); PG8_WAIT_L(0); PG8_BAR; PG8_MMA(1, 0, At, B0); PG8_MMA(1, 1, At, B1); PG8_BAR; PG8_SCHED;
        }
        if constexpr (ALIGN_EPI) { if (wr == 0) PG8_BAR; }
        E(acc, cur, wr, wc, fr, fq);
        if (!has_next) break;
        if constexpr (!Epi::INPLACE) {
#pragma unroll
        for (int a = 0; a < 2; ++a)
#pragma unroll
            for (int b = 0; b < 2; ++b)
#pragma unroll
                for (int m = 0; m < 4; ++m)
#pragma unroll
                    for (int n = 0; n < 2; ++n) acc[a][b][m][n] = (f32x4){0.f, 0.f, 0.f, 0.f};
        }
        cur = nxt; cA = nA; cB = nB; ++ui;
        if constexpr (ALIGN_EPI) { if (wr == 1) PG8_BAR; }
    }
    PG8_WAIT_V(0);
    if constexpr (!ALIGN_EPI) { if (wr == 0) PG8_BAR; }
    PG8_BAR;
#undef PG8_SA
#undef PG8_SB
#undef PG8_STAGE
#undef PG8_LDA
#undef PG8_LDB
#undef PG8_MMA
#undef PG8_WAIT_V
#undef PG8_WAIT_L
#undef PG8_BAR
#undef PG8_SCHED
}
}
#define XB_TMO      128
#define XB_XCNT(j)  (256  + 64 * (j))
#define XB_XSUB(j)  (1280 + 64 * (j))
#define XB_XGEN(j)  (2304 + 64 * (j))
#define XB_TOP      3328
#define XB_TOPGEN   3392
#define XCD_BAR_WORDS 3456
#define XB_SPIN_CAP (1u << 22)
__device__ __forceinline__ unsigned xb_ld(unsigned* p)              { return __hip_atomic_load(p, __ATOMIC_RELAXED, __HIP_MEMORY_SCOPE_AGENT); }
__device__ __forceinline__ unsigned xb_add(unsigned* p, unsigned v) { return __hip_atomic_fetch_add(p, v, __ATOMIC_RELAXED, __HIP_MEMORY_SCOPE_AGENT); }
__device__ __forceinline__ unsigned xb_xcc_id() { return (unsigned)__builtin_amdgcn_s_getreg((3 << 11) | 20) & 0xFu; }
#define XB_SPIN(cond, bar) do { unsigned _sp = 0; while (cond) { __builtin_amdgcn_s_sleep(1); \
    if ((++_sp & 255u) == 0u) { if (xb_ld(&(bar)[XB_TMO])) break; if (_sp > XB_SPIN_CAP) { atomicAdd(&(bar)[XB_TMO], 1u); break; } } } } while (0)
struct XcdBarrier { unsigned* bar; unsigned x; volatile LAS unsigned* st; };
__device__ __forceinline__ XcdBarrier xcd_barrier_post(unsigned* bar, volatile LAS unsigned* st) {
    XcdBarrier b; b.bar = bar; b.x = xb_xcc_id(); b.st = st;
    if (threadIdx.x == 0) (void)xb_add(&bar[XB_XCNT(b.x)], 1u);
    return b;
}
__device__ __forceinline__ void xcd_barrier_complete(unsigned* bar, unsigned x, unsigned& nloc, unsigned& nx) {
    const unsigned G = gridDim.x * gridDim.y * gridDim.z;
    unsigned sum, cnt, mine, sp = 0u;
    for (;;) {
        sum = 0u; cnt = 0u; mine = 0u;
#pragma unroll 1
        for (unsigned j = 0; j < 16; ++j) { const unsigned c = xb_ld(&bar[XB_XCNT(j)]); sum += c; cnt += (c > 0u) ? 1u : 0u; mine = (j == x) ? c : mine; }
        if (sum == G) break;
        __builtin_amdgcn_s_sleep(1);
        if ((++sp & 255u) == 0u) { if (xb_ld(&bar[XB_TMO])) break; if (sp > XB_SPIN_CAP) { atomicAdd(&bar[XB_TMO], 1u); break; } }
    }
    nloc = mine > 0u ? mine : 1u; nx = cnt > 0u ? cnt : 1u;
}
__device__ __forceinline__ void xcd_barrier_impl(unsigned* bbar, unsigned bx, volatile LAS unsigned* bst) {
    XcdBarrier b; b.bar = bbar; b.x = bx; b.st = bst;
    asm volatile("s_waitcnt vmcnt(0)" ::: "memory");
    __syncthreads();
    if (threadIdx.x == 0) {
        unsigned* bar = b.bar;
        __builtin_amdgcn_s_waitcnt(0);
        unsigned nloc = b.st[0], nx = b.st[1];
        if (nloc == 0u) { xcd_barrier_complete(bar, b.x, nloc, nx); b.st[0] = nloc; b.st[1] = nx; }
        const unsigned old = xb_add(&bar[XB_XSUB(b.x)], 1u);
        const unsigned gen = old / nloc;
        if (old + 1u == (gen + 1u) * nloc) {
            __builtin_amdgcn_fence(__ATOMIC_RELEASE, "agent");
            asm volatile("s_waitcnt vmcnt(0)" ::: "memory");
            const unsigned og = xb_add(&bar[XB_TOP], 1u);
            const unsigned tg = og / nx;
            if (og + 1u == (tg + 1u) * nx) xb_add(&bar[XB_TOPGEN], 1u);
            else XB_SPIN(xb_ld(&bar[XB_TOPGEN]) == tg, bar);
            __builtin_amdgcn_fence(__ATOMIC_ACQUIRE, "agent");
            xb_add(&bar[XB_XGEN(b.x)], 1u);
            asm volatile("s_waitcnt vmcnt(0)" ::: "memory");
        } else {
            XB_SPIN(xb_ld(&bar[XB_XGEN(b.x)]) == gen, bar);
            __builtin_amdgcn_fence(__ATOMIC_ACQUIRE, "agent");
            asm volatile("s_waitcnt vmcnt(0)" ::: "memory");
        }
    }
    __syncthreads();
}
__device__ __forceinline__ void xcd_barrier(const XcdBarrier& b) { xcd_barrier_impl(b.bar, b.x, b.st); }

constexpr int D = 1024, NBATCH = 8, SEQ = 4096, CTXL = 256, ML = NBATCH * SEQ, MC = NBATCH * CTXL, MA = ML + MC;
constexpr int ZP = 6144, PP = 1536;
constexpr int C_RQ = 0, C_RK = 256, C_RV = 512, C_RG = 1024, C_WQ = 1536, C_WK = 2048, C_WV = 2176, C_NQ = 2304, C_NK = 2816, C_NV = 3328,
              C_GQ = 3840, C_GK = 4352, C_GV = 4864, C_GG = 5376, C_GA = 5888, C_GB = 5896;
constexpr int C_GSUM = 3840;
constexpr int Y_RET = C_RG, Y_WIN = C_WQ, Y_NA = C_NQ, Y_GDN = C_GG;
__host__ __device__ __forceinline__ int dead_tile(int gt) { return gt < 4 ? gt : (gt == 4 ? 8 : (gt < 15 ? gt + 6 : 23)); }
__device__ __forceinline__ int utile_off(int i, int col) { const int a_ = i >> 5, g_ = (i >> 3) & 3, p_ = (i >> 2) & 1, j_ = i & 3; const int rt_ = 2 * a_ + p_, lane_ = 16 * g_ + (col & 15), ch_ = col >> 6, c_ = (col >> 4) & 3;
    return ((((rt_ * 2 + ch_) * 64 + lane_) * 4 + c_) * 4 + j_); }
constexpr float EPS = 1e-6f;
constexpr int NEXP = 32, DEXP = 512, MAXT = 304;
constexpr int NWAVES = 8, NTHR = 512;

constexpr size_t MiB = 1u << 20;
constexpr size_t WS_CTL = 0, CTL_ZERO_BYTES = 1 * MiB;
constexpr size_t WS_ROPE = 1 * MiB;
constexpr size_t WS_MOD = 2 * MiB;
constexpr size_t WS_XC = 3 * MiB;
constexpr size_t WS_GB = 11 * MiB;
constexpr size_t WS_TOK = 14 * MiB;
constexpr size_t WS_WSM = 16 * MiB;
constexpr size_t WSM_IN = 0, WSM_MERGE = 12 * MiB, WSM_BR = 20 * MiB, WSM_OUT = 24 * MiB;
constexpr size_t WS_KVT = 42 * MiB;
constexpr size_t WS_HL = 76 * MiB;
constexpr size_t WS_Z = 144 * MiB;
constexpr size_t WS_P = 552 * MiB;
constexpr size_t WS_GC2 = 654 * MiB;
constexpr size_t WS_END = 656 * MiB;
constexpr size_t WS_WGU = WS_P, WS_WDN = WS_P + 64 * MiB;
constexpr size_t WS_XB = WS_Z, WS_ACT = WS_Z + 152 * MiB, WS_YB = WS_Z + 228 * MiB;
static_assert(WS_YB + (size_t)MAXT * 256 * 1024 * 2 <= WS_P && WS_WDN + (size_t)32 * 1024 * 512 * 2 <= WS_P + (size_t)MA * PP * 2, "moe overlay");
static_assert(WS_HL + (size_t)MA * 1024 * 2 <= WS_Z && WS_Z + (size_t)MA * ZP * 2 <= WS_P && WS_P + (size_t)MA * PP * 2 <= WS_END, "ws map");
constexpr size_t TOK_E = 0, TOK_SLOT = 256 * 1024, TOK_W = 512 * 1024, TOK_POS = 1024 * 1024, TOK_BCNT = 1536 * 1024, TOK_TILE = 1600 * 1024, TOK_RSTD = 1664 * 1024;
constexpr int CW_BAR = 1024;

constexpr int LDS_BYTES = 163840 - 1024;
constexpr int LDS_CTL = LDS_BYTES - 256;
struct KArgs { const float* in[29]; float* out; unsigned char* ws; int ph_lo, ph_hi; };
enum { I_X = 0, I_C, I_CTX, I_CCTX, I_WMOD, I_BMOD, I_NORM1, I_NORM2, I_WIN, I_RDECAY, I_RGN, I_WQN, I_WKN, I_WSINK, I_NQN, I_NKN, I_RPB, I_GCONV, I_GALOG, I_GDT, I_GNORM,
       I_WBR, I_WMERGE, I_WOUT, I_WROUTER, I_RBIAS, I_WEG, I_WEU, I_WED };

__device__ __forceinline__ float wave_sum(float v) {
#pragma unroll
    for (int o = 1; o < 64; o <<= 1) v += __shfl_xor(v, o);
    return v;
}
__device__ __forceinline__ float sum16(float v) { v += __shfl_xor(v, 1); v += __shfl_xor(v, 2); v += __shfl_xor(v, 4); v += __shfl_xor(v, 8); return v; }
#define LDS_WAIT() asm volatile("s_waitcnt lgkmcnt(0)" ::: "memory")

__device__ __forceinline__ int merge_row(int sc) { const int br = sc >> 10, oc = sc & 1023; return (oc >> 6) * 256 + (br >> 1) * 128 + ((oc >> 4) & 3) * 32 + ((oc >> 2) & 3) * 8 + (br & 1) * 4 + (oc & 3); }
template <bool MERGE = false>
__device__ __forceinline__ void transpose_item(const float* W, int ldw, int ncols, int k0, int n0, bf16_t* WT, int ldt, int dst_row0, LAS float* scr, int lane) {
    const int nn = n0 + (lane & 31);
#pragma unroll 8
    for (int i = 0; i < 32; ++i) { const int kk = 2 * i + (lane >> 5); scr[kk * 33 + (lane & 31)] = (nn < ncols) ? W[(size_t)(k0 + kk) * ldw + nn] : 0.f; }
    LDS_WAIT(); asm volatile("" ::: "memory");
    const int c = lane & 7;
#pragma unroll
    for (int j = 0; j < 4; ++j) { const int n = (lane >> 3) + 8 * j; const LAS float* s = scr + (8 * c) * 33 + n;
        u32x4 o; o.x = pk2(s[0 * 33], s[1 * 33]); o.y = pk2(s[2 * 33], s[3 * 33]); o.z = pk2(s[4 * 33], s[5 * 33]); o.w = pk2(s[6 * 33], s[7 * 33]);
        *(u32x4*)(WT + (size_t)(MERGE ? merge_row(dst_row0 + n) : dst_row0 + n) * ldt + k0 + 8 * c) = o; }
    LDS_WAIT(); asm volatile("" ::: "memory");
}

__device__ __forceinline__ void small_weight_convert(const KArgs& a, LAS unsigned char* lds, int l) {
    const int tid = OTID(), lane = tid & 63, wave = tid >> 6, G = OGRID(), blk = OBLK();
    unsigned char* ws = a.ws;
    LAS float* scr = (LAS float*)(lds + 65536 + wave * 8448);
    const int gw = blk * NWAVES + wave, NGW = G * NWAVES;
    constexpr int I_IN = 16 * 192, I_MG = 16 * 128, I_BR = 4 * 8 * 32, I_OUT = 16 * 32, I_LAYER = I_IN + I_MG + I_BR + I_OUT;
    bf16_t* wsm = (bf16_t*)(ws + WS_WSM);
    for (int it = gw; it < I_LAYER; it += NGW) {
        int r = it;
        if (r < I_IN) { const int kb = r / 192, nb = r % 192; transpose_item(a.in[I_WIN] + (size_t)l * 1024 * 5904, 5904, 5904, kb * 64, nb * 32, wsm + WSM_IN / 2, 1024, nb * 32, scr, lane); continue; } r -= I_IN;
        if (r < I_MG) { const int kb = r / 128, nb = r % 128; transpose_item<true>(a.in[I_WMERGE] + (size_t)l * 1024 * 4096, 4096, 4096, kb * 64, nb * 32, wsm + WSM_MERGE / 2, 1024, nb * 32, scr, lane); continue; } r -= I_MG;
        if (r < I_BR) { const int br = r / 256, q = r % 256, kb = q / 32, nb = q % 32;
            transpose_item(a.in[I_WBR] + (size_t)(l * 4 + br) * 512 * 1024, 1024, 1024, kb * 64, nb * 32, wsm + WSM_BR / 2 + (size_t)br * 1024 * 512, 512, nb * 32, scr, lane); continue; } r -= I_BR;
        { const int kb = r / 32, nb = r % 32; transpose_item(a.in[I_WOUT] + (size_t)l * 1024 * 1024, 1024, 1024, kb * 64, nb * 32, wsm + WSM_OUT / 2, 1024, nb * 32, scr, lane); }
    }
}

__device__ __forceinline__ void phase_prologue(const KArgs& a, LAS unsigned char* lds) {
    const int tid = OTID(), lane = tid & 63, wave = tid >> 6, G = OGRID(), blk = OBLK();
    unsigned char* ws = a.ws;
    { float* cs = (float*)(ws + WS_ROPE); float* sn = cs + 4096 * 32;
      for (int idx = blk * NTHR + tid; idx < 4096 * 32; idx += G * NTHR) { const int t = idx >> 5, i = idx & 31; const float pos = (float)((i < 16) ? (t >> 6) : (t & 63));
          const float inv = exp2f(-(float)(i & 15) * (13.287712379549449f / 16.0f)); const float ang = pos * inv; cs[idx] = cosf(ang); sn[idx] = sinf(ang); } }
    if (blk < 192) {
        const int l = blk / 96, cg = blk % 96;
        LAS float* sc = (LAS float*)lds; LAS float* red = (LAS float*)(lds + 40960);
        for (int idx = tid; idx < 9 * 1024; idx += NTHR) { const int v = idx >> 10, k = idx & 1023; const float cv = (v < 8) ? a.in[I_C][v * 1024 + k] : a.in[I_CCTX][k]; sc[idx] = siluf_(cv); }
        __syncthreads();
        const float* wm = a.in[I_WMOD] + (size_t)l * 1024 * 6144 + cg * 64 + lane;
        float acc[9];
#pragma unroll
        for (int v = 0; v < 9; ++v) acc[v] = 0.f;
#pragma unroll 8
        for (int kk = 0; kk < 128; ++kk) { const int k = wave * 128 + kk; const float w = wm[(size_t)k * 6144];
#pragma unroll
            for (int v = 0; v < 9; ++v) acc[v] += sc[v * 1024 + k] * w; }
#pragma unroll
        for (int v = 0; v < 9; ++v) red[(wave * 9 + v) * 64 + lane] = acc[v];
        __syncthreads();
        for (int idx = tid; idx < 576; idx += NTHR) { const int v = idx >> 6, ln = idx & 63; float s = a.in[I_BMOD][l * 6144 + cg * 64 + ln];
#pragma unroll
            for (int w = 0; w < 8; ++w) s += red[(w * 9 + v) * 64 + ln];
            ((float*)(ws + WS_MOD))[(size_t)(l * 9 + v) * 6144 + cg * 64 + ln] = s; }
        __syncthreads();
    }
    small_weight_convert(a, lds, 0);
}

constexpr int EXPC_ITEMS = 3 * 8192;
__device__ __forceinline__ void expert_convert_range(const KArgs& a, LAS unsigned char* lds, int l, int lo, int hi, int blk0) {
    const int tid = OTID(), lane = tid & 63, wave = tid >> 6, blk = OBLK(), G = OGRID();
    if (G <= blk0) blk0 = 0;
    if (blk < blk0) return;
    LAS float* scr = (LAS float*)(lds + 65536 + wave * 8448);
    bf16_t* wgu = (bf16_t*)(a.ws + WS_WGU); bf16_t* wdn = (bf16_t*)(a.ws + WS_WDN);
    const int gw = (blk - blk0) * NWAVES + wave, NGW = (G - blk0) * NWAVES;
    for (int it = lo + gw; it < hi; it += NGW) {
        const int which = it / 8192, r = it % 8192, e = r / 256, q = r % 256;
        if (which < 2) { const int kb = q / 16, nb = q % 16, n0 = nb * 32;
            transpose_item(a.in[which == 0 ? I_WEG : I_WEU] + (size_t)(l * 32 + e) * 1024 * 512, 512, 512, kb * 64, n0, wgu + (size_t)e * 1024 * 1024, 1024, 256 * (n0 >> 7) + (n0 & 127) + which * 128, scr, lane); }
        else { const int kb = q / 32, nb = q % 32; transpose_item(a.in[I_WED] + (size_t)(l * 32 + e) * 512 * 1024, 1024, 1024, kb * 64, nb * 32, wdn + (size_t)e * 1024 * 512, 512, nb * 32, scr, lane); }
    }
}

__device__ __forceinline__ void modulate_store(const f32x4 (&v)[4], const float* gain, const float* sh, const float* sc, bf16_t* orow, int lane) {
    float ss = 0.f;
#pragma unroll
    for (int j = 0; j < 4; ++j) ss += (v[j].x * v[j].x + v[j].y * v[j].y) + (v[j].z * v[j].z + v[j].w * v[j].w);
    const float rstd = rsqrtf(wave_sum(ss) * (1.f / 1024.f) + EPS);
#pragma unroll
    for (int j = 0; j < 4; ++j) {
        const f32x4 g = ((const f32x4*)gain)[lane + 64 * j], s1 = ((const f32x4*)sc)[lane + 64 * j], s0 = ((const f32x4*)sh)[lane + 64 * j];
        const f32x4 y = (v[j] * rstd * g) * (s1 + 1.0f) + s0;
        u32x2 o; o.x = pk2(y.x, y.y); o.y = pk2(y.z, y.w);
        ((u32x2*)orow)[lane + 64 * j] = o;
    }
}
__device__ __forceinline__ int row_modidx(int row) { return row < ML ? (row >> 12) : 8; }

__device__ __forceinline__ void phase_modulate1(const KArgs& a, int l, int nrows) {
    const int tid = OTID(), lane = tid & 63, wave = tid >> 6;
    const int gw = OBLK() * NWAVES + wave, NGW = OGRID() * NWAVES;
    const float* xl = (l == 0) ? a.in[I_X] : a.out; const float* xc = (l == 0) ? a.in[I_CTX] : (const float*)(a.ws + WS_XC);
    bf16_t* hl = (bf16_t*)(a.ws + WS_HL);
    for (int row = gw; row < nrows; row += NGW) {
        const float* xr = row < ML ? xl + (size_t)row * D : xc + (size_t)(row - ML) * D;
        f32x4 v[4];
#pragma unroll
        for (int j = 0; j < 4; ++j) v[j] = ((const f32x4*)xr)[lane + 64 * j];
        const float* mod = (const float*)(a.ws + WS_MOD) + (size_t)(l * 9 + row_modidx(row)) * 6144;
        modulate_store(v, a.in[I_NORM1] + l * D, mod, mod + 1024, hl + (size_t)row * D, lane);
    }
}
__device__ __forceinline__ void unpack8(const u32x4 u, float (&x)[8]) { x[0] = bflo(u.x); x[1] = bfhi(u.x); x[2] = bflo(u.y); x[3] = bfhi(u.y); x[4] = bflo(u.z); x[5] = bfhi(u.z); x[6] = bflo(u.w); x[7] = bfhi(u.w); }
__device__ __forceinline__ u32x4 pack8(const float (&x)[8]) { u32x4 u; u.x = pk2(x[0], x[1]); u.y = pk2(x[2], x[3]); u.z = pk2(x[4], x[5]); u.w = pk2(x[6], x[7]); return u; }
__device__ __forceinline__ void head64_pass16(bf16_t* zr, int hbase, const float* wqn, const float* wkn, const float* nqn, const float* nkn, bool lat, const float* cs, const float* sn, int lane) {
    const int hidx = hbase + (lane >> 2), p = lane & 3; const bool act = hidx < 34;
    const int col = (hidx < 8 ? hidx * 64 : (hidx < 18 ? C_WQ + (hidx - 8) * 64 : C_NQ + (hidx - 18) * 64)) + 8 * p;
    const float* gain = hidx < 8 ? nullptr : (hidx < 16 ? wqn : (hidx < 18 ? wkn : (hidx < 26 ? nqn : nkn)));
    const bool rope = lat && hidx < 18;
    const float scale = (hidx >= 4 && hidx < 8) ? 0.125f : (((hidx >= 8 && hidx < 16) || (hidx >= 18 && hidx < 26)) ? 0.125f * 1.4426950408889634f : 1.0f);
    float x1[8], x2[8];
    { u32x4 u1 = (u32x4){0u, 0u, 0u, 0u}, u2 = u1; if (act) { u1 = *(const u32x4*)(zr + col); u2 = *(const u32x4*)(zr + col + 32); } unpack8(u1, x1); unpack8(u2, x2); }
    float ss = 0.f;
#pragma unroll
    for (int e = 0; e < 8; ++e) ss += x1[e] * x1[e] + x2[e] * x2[e];
    ss += __shfl_xor(ss, 1); ss += __shfl_xor(ss, 2);
    if (gain) { const float r = rsqrtf(ss * (1.f / 64.f) + EPS);
        const f32x4 g0 = *(const f32x4*)(gain + 8 * p), g1 = *(const f32x4*)(gain + 8 * p + 4), g2 = *(const f32x4*)(gain + 32 + 8 * p), g3 = *(const f32x4*)(gain + 36 + 8 * p);
#pragma unroll
        for (int e = 0; e < 4; ++e) { x1[e] *= r * g0[e]; x1[e + 4] *= r * g1[e]; x2[e] *= r * g2[e]; x2[e + 4] *= r * g3[e]; } }
    if (rope) { const f32x4 c0 = *(const f32x4*)(cs + 8 * p), c1 = *(const f32x4*)(cs + 8 * p + 4), s0 = *(const f32x4*)(sn + 8 * p), s1 = *(const f32x4*)(sn + 8 * p + 4);
#pragma unroll
        for (int e = 0; e < 8; ++e) { const float c = e < 4 ? c0[e & 3] : c1[e & 3], sv = e < 4 ? s0[e & 3] : s1[e & 3]; const float y1 = x1[e] * c - x2[e] * sv, y2 = x1[e] * sv + x2[e] * c; x1[e] = y1; x2[e] = y2; } }
#pragma unroll
    for (int e = 0; e < 8; ++e) { x1[e] *= scale; x2[e] *= scale; }
    if (act) { *(u32x4*)(zr + col) = pack8(x1); *(u32x4*)(zr + col + 32) = pack8(x2); }
}
__device__ __forceinline__ void phase_prep(const KArgs& a, int l) {
    const int tid = OTID(), lane = tid & 63, wave = tid >> 6;
    const int gw = OBLK() * NWAVES + wave, NGW = OGRID() * NWAVES;
    bf16_t* Z = (bf16_t*)(a.ws + WS_Z); bf16_t* P = (bf16_t*)(a.ws + WS_P);
    const float* cs0 = (const float*)(a.ws + WS_ROPE); const float* sn0 = cs0 + 4096 * 32;
    float* GBa = (float*)(a.ws + WS_GB); float* GBb = GBa + (size_t)MA * 8;
    const float* wqn = a.in[I_WQN] + l * 64; const float* wkn = a.in[I_WKN] + l * 64; const float* nqn = a.in[I_NQN] + l * 64; const float* nkn = a.in[I_NKN] + l * 64;
    const float* cw = a.in[I_GCONV] + (size_t)l * 3 * 1536;
    for (int row = gw; row < MA; row += NGW) {
        const bool lat = row < ML; const int t = lat ? (row & 4095) : ((row - ML) & 255); const int slen = lat ? 4096 : 256;
        bf16_t* zr = Z + (size_t)row * ZP;
        const float* cs = cs0 + t * 32; const float* sn = sn0 + t * 32;
#pragma unroll
        for (int ps = 0; ps < 3; ++ps) {
            const int c = (ps * 4 + (lane >> 4)) * 128 + (lane & 15) * 8; const bf16_t* zc = zr + C_GQ + c;
            const u32x4 zero = (u32x4){0u, 0u, 0u, 0u};
            const u32x4 uc = *(const u32x4*)zc, up = (t > 0) ? *(const u32x4*)(zc - ZP) : zero, un = (t < slen - 1) ? *(const u32x4*)(zc + ZP) : zero;
            float xp[8], xc[8], xn[8], y[8]; unpack8(up, xp); unpack8(uc, xc); unpack8(un, xn);
            const f32x4 w00 = *(const f32x4*)(cw + c), w01 = *(const f32x4*)(cw + c + 4), w10 = *(const f32x4*)(cw + 1536 + c), w11 = *(const f32x4*)(cw + 1536 + c + 4), w20 = *(const f32x4*)(cw + 3072 + c), w21 = *(const f32x4*)(cw + 3072 + c + 4);
            float ss = 0.f;
#pragma unroll
            for (int e = 0; e < 8; ++e) { const float w0 = e < 4 ? w00[e & 3] : w01[e & 3], w1 = e < 4 ? w10[e & 3] : w11[e & 3], w2 = e < 4 ? w20[e & 3] : w21[e & 3];
                y[e] = silu_fast(w0 * xp[e] + w1 * xc[e] + w2 * xn[e]); ss += y[e] * y[e]; }
            if (ps < 2) { ss += __shfl_xor(ss, 1); ss += __shfl_xor(ss, 2); ss += __shfl_xor(ss, 4); ss += __shfl_xor(ss, 8);
                const float r = rsqrtf(ss + EPS) * (ps == 0 ? 0.08838834764831845f : 1.0f);
#pragma unroll
                for (int e = 0; e < 8; ++e) y[e] *= r; }
            *(u32x4*)(P + (size_t)row * PP + c) = pack8(y);
        }
        if (lane < 8) {
            const float av = bf2f(zr[C_GA + lane]) + a.in[I_GDT][l * 8 + lane], bv = bf2f(zr[C_GB + lane]);
            const float sp = fmaxf(av, 0.f) + log1pf(__expf(-fabsf(av)));
            const float g = -__expf(a.in[I_GALOG][l * 8 + lane]) * sp;
            GBa[(size_t)row * 8 + lane] = g; GBb[(size_t)row * 8 + lane] = sigmoidf_(bv);
        }
        head64_pass16(zr, 0, wqn, wkn, nqn, nkn, lat, cs, sn, lane);
        head64_pass16(zr, 16, wqn, wkn, nqn, nkn, lat, cs, sn, lane);
        head64_pass16(zr, 32, wqn, wkn, nqn, nkn, lat, cs, sn, lane);
    }
}

__device__ __forceinline__ void phase_post(const KArgs& a, int l, int nrows) {
    const int tid = OTID(), lane = tid & 63, wave = tid >> 6;
    const int gw = OBLK() * NWAVES + wave, NGW = OGRID() * NWAVES;
    bf16_t* Z = (bf16_t*)(a.ws + WS_Z);
    const float* gnm = a.in[I_GNORM] + l * 128;
    for (int row = gw; row < nrows; row += NGW) {
        bf16_t* zr = Z + (size_t)row * ZP;
#pragma unroll
        for (int h = 0; h < 4; ++h) {
            const int c = h * 128 + lane * 2;
            { const unsigned ug = *(const unsigned*)(zr + C_GG + c);
              const int ci = (row < ML ? row : row - ML) & 63; const bf16_t* zblk = zr - (size_t)ci * ZP;
              const int e0 = utile_off(ci, lane * 2), e1 = utile_off(ci, lane * 2 + 1);
              const bf16_t* p0 = zblk + (size_t)(e0 >> 7) * ZP + h * 128 + (e0 & 127); const bf16_t* p1 = zblk + (size_t)(e1 >> 7) * ZP + h * 128 + (e1 & 127);
              const float oa = bf2f(p0[C_GQ]) + bf2f(p0[C_GK]), ob = bf2f(p1[C_GQ]) + bf2f(p1[C_GK]); const float r = rsqrtf(wave_sum(oa * oa + ob * ob) * (1.f / 128.f) + EPS);
              *(unsigned*)(zr + Y_GDN + c) = pk2(oa * r * gnm[lane * 2] * silu_fast(bflo(ug)), ob * r * gnm[lane * 2 + 1] * silu_fast(bfhi(ug))); }
        }
    }
}
constexpr int AT_TILE = 4096;
constexpr int AT_BUF = 2 * AT_TILE;
constexpr int AT_TABOFF = 2 * AT_BUF;
constexpr int AT_WAVE_BYTES = 2 * AT_BUF + 2048;
template <int NQ> struct AttnSt { f32x4 O[NQ][4]; float m[NQ], l[NQ]; bf16x8 Q[NQ][2]; };
__device__ __forceinline__ void stage_issue(const char* zb, const unsigned (&rp)[4], int kcolb, int vcolb, LAS unsigned char* buf) {
    asm volatile("s_waitcnt lgkmcnt(0)" ::: "memory");
#pragma unroll
    for (int c = 0; c < 4; ++c) {
        __builtin_amdgcn_global_load_lds((const unsigned*)(zb + rp[c] + kcolb), (LAS unsigned*)(buf + c * 1024), 16, 0, 0);
        __builtin_amdgcn_global_load_lds((const unsigned*)(zb + rp[c] + vcolb), (LAS unsigned*)(buf + AT_TILE + c * 1024), 16, 0, 0);
    }
}
__device__ __forceinline__ int at_piece_off(int lane) { const int row = lane >> 3; return (((lane & 7) ^ (row & 7)) * 16); }
__device__ __forceinline__ s16x4 lds_tr16(const LAS unsigned char* p) { return __builtin_bit_cast(s16x4, __builtin_amdgcn_ds_read_tr16_b64_v4i16((LAS s16x4*)p)); }

struct AttnAddr { unsigned k0, k1, v[4]; };
__device__ __forceinline__ unsigned lds_u32(const LAS unsigned char* p) { return (unsigned)(unsigned long long)p; }
__device__ __forceinline__ AttnAddr attn_addr(int lane) {
    const int g = lane >> 4, r16 = lane & 15, qq = r16 >> 2, pp = r16 & 3, row = 4 * g + qq; AttnAddr A;
    A.k0 = r16 * 128 + ((g ^ (r16 & 7)) * 16); A.k1 = r16 * 128 + (((4 + g) ^ (r16 & 7)) * 16);
#pragma unroll
    for (int dt = 0; dt < 4; ++dt) A.v[dt] = row * 128 + (((dt * 2 + (pp >> 1)) ^ (row & 7)) * 16) + (pp & 1) * 8;
    return A;
}
struct AttnFrag { bf16x8 kf[2][2]; bf16x8 vf[4]; };
__device__ __forceinline__ void attn_read(AttnFrag& F, const LAS unsigned char* kl, int lane) {
    const AttnAddr AD = attn_addr(lane);
    const unsigned base = lds_u32(kl);
    u32x4 k00, k01, k10, k11; u32x2 vl0, vh0, vl1, vh1, vl2, vh2, vl3, vh3;
    asm volatile(
        "ds_read_b128 %0, %12\n\t" "ds_read_b128 %1, %13\n\t" "ds_read_b128 %2, %12 offset:2048\n\t" "ds_read_b128 %3, %13 offset:2048\n\t"
        "ds_read_b64_tr_b16 %4, %14 offset:4096\n\t" "ds_read_b64_tr_b16 %5, %14 offset:6144\n\t"
        "ds_read_b64_tr_b16 %6, %15 offset:4096\n\t" "ds_read_b64_tr_b16 %7, %15 offset:6144\n\t"
        "ds_read_b64_tr_b16 %8, %16 offset:4096\n\t" "ds_read_b64_tr_b16 %9, %16 offset:6144\n\t"
        "ds_read_b64_tr_b16 %10, %17 offset:4096\n\t" "ds_read_b64_tr_b16 %11, %17 offset:6144\n\t"
        "s_waitcnt lgkmcnt(0)"
        : "=&v"(k00), "=&v"(k01), "=&v"(k10), "=&v"(k11), "=&v"(vl0), "=&v"(vh0), "=&v"(vl1), "=&v"(vh1), "=&v"(vl2), "=&v"(vh2), "=&v"(vl3), "=&v"(vh3)
        : "v"(base + AD.k0), "v"(base + AD.k1), "v"(base + AD.v[0]), "v"(base + AD.v[1]), "v"(base + AD.v[2]), "v"(base + AD.v[3])
        : "memory");
    F.kf[0][0] = __builtin_bit_cast(bf16x8, k00); F.kf[0][1] = __builtin_bit_cast(bf16x8, k01); F.kf[1][0] = __builtin_bit_cast(bf16x8, k10); F.kf[1][1] = __builtin_bit_cast(bf16x8, k11);
    F.vf[0] = cat8(vl0, vh0); F.vf[1] = cat8(vl1, vh1); F.vf[2] = cat8(vl2, vh2); F.vf[3] = cat8(vl3, vh3);
}
template <int NQ, class BiasF>
__device__ __forceinline__ void attn_compute(AttnSt<NQ>& st, const AttnFrag& F, const BiasF& bias, int lane) {
    const int g = lane >> 4, r16 = lane & 15;
#pragma unroll
    for (int qi = 0; qi < NQ; ++qi) {
        if (bias.skip(qi)) continue;
        const bf16x8 Q0 = st.Q[qi][0], Q1 = st.Q[qi][1];
        f32x4 s0 = (f32x4){0.f, 0.f, 0.f, 0.f}, s1 = (f32x4){0.f, 0.f, 0.f, 0.f};
        s0 = __builtin_amdgcn_mfma_f32_16x16x32_bf16(F.kf[0][0], Q0, s0, 0, 0, 0);
        s0 = __builtin_amdgcn_mfma_f32_16x16x32_bf16(F.kf[0][1], Q1, s0, 0, 0, 0);
        s1 = __builtin_amdgcn_mfma_f32_16x16x32_bf16(F.kf[1][0], Q0, s1, 0, 0, 0);
        s1 = __builtin_amdgcn_mfma_f32_16x16x32_bf16(F.kf[1][1], Q1, s1, 0, 0, 0);
        if (BiasF::HAS_BIAS && !bias.nobias()) { f32x4 b0, b1; bias.get(qi, r16, g, b0, b1); s0 = s0 + b0; s1 = s1 + b1; }
        float mx = fmaxf(fmaxf(fmaxf(s0[0], s0[1]), fmaxf(s0[2], s0[3])), fmaxf(fmaxf(s1[0], s1[1]), fmaxf(s1[2], s1[3])));
        mx = fmaxf(mx, __shfl_xor(mx, 16)); mx = fmaxf(mx, __shfl_xor(mx, 32));
        const float mnew = fmaxf(st.m[qi], mx), alpha = __builtin_amdgcn_exp2f(st.m[qi] - mnew);
        float p0[4], p1[4], ps = 0.f;
#pragma unroll
        for (int j = 0; j < 4; ++j) { p0[j] = __builtin_amdgcn_exp2f(s0[j] - mnew); p1[j] = __builtin_amdgcn_exp2f(s1[j] - mnew); ps += p0[j] + p1[j]; }
        st.l[qi] = st.l[qi] * alpha + ps; st.m[qi] = mnew;
        u32x4 pw; pw.x = pk2(p0[0], p0[1]); pw.y = pk2(p0[2], p0[3]); pw.z = pk2(p1[0], p1[1]); pw.w = pk2(p1[2], p1[3]);
        const bf16x8 pf = __builtin_bit_cast(bf16x8, pw);
        if (__builtin_amdgcn_ballot_w64(alpha != 1.0f) != 0ull) {
#pragma unroll
            for (int dt = 0; dt < 4; ++dt) st.O[qi][dt] = st.O[qi][dt] * alpha; }
#pragma unroll
        for (int dt = 0; dt < 4; ++dt) st.O[qi][dt] = __builtin_amdgcn_mfma_f32_16x16x32_bf16(F.vf[dt], pf, st.O[qi][dt], 0, 0, 0);
    }
}
template <int NQ> __device__ __forceinline__ void attn_init(AttnSt<NQ>& st) {
#pragma unroll
    for (int qi = 0; qi < NQ; ++qi) { st.m[qi] = -1e4f; st.l[qi] = 0.f;
#pragma unroll
        for (int dt = 0; dt < 4; ++dt) st.O[qi][dt] = (f32x4){0.f, 0.f, 0.f, 0.f}; }
}
template <int NQ> __device__ __forceinline__ void attn_store(AttnSt<NQ>& st, int qi, bf16_t* orow, int lane) {
    const int g = lane >> 4;
    float lt = st.l[qi]; lt += __shfl_xor(lt, 16); lt += __shfl_xor(lt, 32);
    const float inv = 1.0f / lt;
#pragma unroll
    for (int dt = 0; dt < 4; ++dt) { const f32x4 o = st.O[qi][dt] * inv; u32x2 w; w.x = pk2(o[0], o[1]); w.y = pk2(o[2], o[3]); *(u32x2*)(orow + dt * 16 + 4 * g) = w; }
}
constexpr float LOG2E = 1.4426950408889634f;
struct BiasZero { static constexpr bool HAS_BIAS = false; __device__ __forceinline__ bool skip(int) const { return false; } __device__ __forceinline__ bool nobias() const { return true; }
    __device__ __forceinline__ void get(int, int, int, f32x4& b0, f32x4& b1) const { b0 = (f32x4){0.f, 0.f, 0.f, 0.f}; b1 = b0; } };
struct BiasWin { static constexpr bool HAS_BIAS = true; int d0; int kstart; bool interior;
    __device__ __forceinline__ bool skip(int) const { return false; } __device__ __forceinline__ bool nobias() const { return interior; }
    __device__ __forceinline__ float one(int q, int kk) const { const int kp = kstart + kk, dd = d0 + kk - q; return (kp >= 0 && kp < SEQ && dd <= 128 && dd >= -128) ? 0.f : -1e30f; }
    __device__ __forceinline__ void get(int, int q, int g, f32x4& b0, f32x4& b1) const {
#pragma unroll
        for (int j = 0; j < 4; ++j) { b0[j] = one(q, 4 * g + j); b1[j] = one(q, 16 + 4 * g + j); } } };
struct BiasNA { static constexpr bool HAS_BIAS = true; unsigned tabaddr; int rowoff31; int c0;
    __device__ __forceinline__ bool skip(int qi) const { return (qi == 0 && c0 != 0) || (qi == 3 && c0 == 0); } __device__ __forceinline__ bool nobias() const { return false; }
    __device__ __forceinline__ void get(int qi, int q, int g, f32x4& b0, f32x4& b1) const {
        const int qc = qi * 16 + q; int cst = qc - 8; cst = cst < 0 ? 0 : (cst > 48 ? 48 : cst);
        const int kc0 = c0 + 4 * g;
        const unsigned ad = tabaddr + (unsigned)((rowoff31 + kc0 - qc + 15) * 4);
        u32x2 t0, t1, t2, t3;
        asm volatile("ds_read2_b32 %0, %4 offset1:1\n\t" "ds_read2_b32 %1, %4 offset0:2 offset1:3\n\t" "ds_read2_b32 %2, %4 offset0:16 offset1:17\n\t" "ds_read2_b32 %3, %4 offset0:18 offset1:19\n\t" "s_waitcnt lgkmcnt(0)"
                     : "=&v"(t0), "=&v"(t1), "=&v"(t2), "=&v"(t3) : "v"(ad) : "memory");
        const float v0[4] = {__builtin_bit_cast(float, t0.x), __builtin_bit_cast(float, t0.y), __builtin_bit_cast(float, t1.x), __builtin_bit_cast(float, t1.y)};
        const float v1[4] = {__builtin_bit_cast(float, t2.x), __builtin_bit_cast(float, t2.y), __builtin_bit_cast(float, t3.x), __builtin_bit_cast(float, t3.y)};
#pragma unroll
        for (int j = 0; j < 4; ++j) { const int ka = kc0 + j, kb = kc0 + 16 + j;
            b0[j] = (ka >= cst && ka < cst + 16) ? v0[j] : -1e30f; b1[j] = (kb >= cst && kb < cst + 16) ? v1[j] : -1e30f; } } };

template <int NQ>
__device__ __forceinline__ void attn_ctx_steps(AttnSt<NQ>& st, const bf16_t* Z, int row0, int kcol, int vcol, int nsteps, LAS unsigned char* kl, int lane) {
    const char* zb = (const char*)Z;
    unsigned rp[4];
#pragma unroll
    for (int c = 0; c < 4; ++c) rp[c] = (unsigned)(row0 + (lane >> 3) + c * 8) * (unsigned)(ZP * 2) + (unsigned)at_piece_off(lane);
    stage_issue(zb, rp, kcol * 2, vcol * 2, kl);
    for (int s = 0; s < nsteps; ++s) {
        if (s + 1 < nsteps) {
#pragma unroll
            for (int c = 0; c < 4; ++c) rp[c] += 32u * (unsigned)(ZP * 2);
            stage_issue(zb, rp, kcol * 2, vcol * 2, kl + ((s + 1) & 1) * AT_BUF);
            asm volatile("s_waitcnt vmcnt(8)" ::: "memory");
        } else asm volatile("s_waitcnt vmcnt(0)" ::: "memory");
        AttnFrag F; attn_read(F, kl + (s & 1) * AT_BUF, lane);
        attn_compute<NQ>(st, F, BiasZero(), lane);
    }
}

__device__ __forceinline__ void win_item(const KArgs& a, int l, int item, bool ctxq, LAS unsigned char* kl, int lane) {
    asm volatile("" : "+v"(lane));
    bf16_t* Z = (bf16_t*)(a.ws + WS_Z);
    int b, gi, qt;
    if (!ctxq) { b = item >> 9; gi = (item >> 8) & 1; qt = item & 255; } else { b = item >> 5; gi = (item >> 4) & 1; qt = item & 15; }
    const int t0 = qt * 16, r16 = lane & 15;
    const int qrow0 = (ctxq ? ML + b * CTXL : b * SEQ) + t0, qrow = qrow0 + r16;
    const char* zb = (const char*)Z; const int g = lane >> 4;
    AttnSt<4> st; attn_init<4>(st);
#pragma unroll
    for (int qi = 0; qi < 4; ++qi) { const bf16_t* qp = Z + (size_t)qrow * ZP + C_WQ + (gi * 4 + qi) * 64 + g * 8;
        st.Q[qi][0] = *(const bf16x8*)qp; st.Q[qi][1] = *(const bf16x8*)(qp + 32); st.m[qi] = a.in[I_WSINK][l * 8 + gi * 4 + qi] * LOG2E; st.l[qi] = 1.0f; }
    const int kcol = C_WK + gi * 64, vcol = C_WV + gi * 64;
    if (!ctxq) {
        int s0 = 0, s1 = 9;
        { const int ks = t0 - 128; while (s0 < s1 && ks + 32 * s0 + 31 < 0) ++s0; while (s1 > s0 && ks + 32 * (s1 - 1) >= SEQ) --s1; }
        unsigned rp[4];
#define WIN_RP(s_) do { _Pragma("unroll") for (int c = 0; c < 4; ++c) { int kp = t0 - 128 + 32 * (s_) + c * 8 + (lane >> 3); kp = kp < 0 ? 0 : (kp > SEQ - 1 ? SEQ - 1 : kp); rp[c] = (unsigned)(b * SEQ + kp) * (unsigned)(ZP * 2) + (unsigned)at_piece_off(lane); } } while (0)
        WIN_RP(s0); stage_issue(zb, rp, kcol * 2, vcol * 2, kl + (s0 & 1) * AT_BUF);
        for (int s = s0; s < s1; ++s) {
            if (s + 1 < s1) { WIN_RP(s + 1); stage_issue(zb, rp, kcol * 2, vcol * 2, kl + ((s + 1) & 1) * AT_BUF); asm volatile("s_waitcnt vmcnt(8)" ::: "memory"); }
            else asm volatile("s_waitcnt vmcnt(0)" ::: "memory");
            AttnFrag F; attn_read(F, kl + (s & 1) * AT_BUF, lane);
            const int kstart = t0 - 128 + 32 * s;
            BiasWin bw; bw.kstart = kstart; bw.d0 = kstart - t0; bw.interior = (kstart >= 0 && kstart + 31 < SEQ && kstart >= t0 + 15 - 128 && kstart + 31 <= t0 + 128);
            attn_compute<4>(st, F, bw, lane);
        }
#undef WIN_RP
    }
    attn_ctx_steps<4>(st, Z, ML + b * CTXL, kcol, vcol, 8, kl, lane);
#pragma unroll
    for (int qi = 0; qi < 4; ++qi) attn_store<4>(st, qi, Z + (size_t)qrow * ZP + Y_WIN + (gi * 4 + qi) * 64, lane);
}

__device__ __forceinline__ void na_item(const KArgs& a, int l, int item, bool ctxq, LAS unsigned char* kl, int lane) {
    asm volatile("" : "+v"(lane));
    bf16_t* Z = (bf16_t*)(a.ws + WS_Z);
    int b, h, r;
    if (!ctxq) { b = item >> 9; h = (item >> 6) & 7; r = item & 63; } else { b = item >> 5; h = (item >> 2) & 7; r = item & 3; }
    const int r16 = lane & 15;
    const int qbase = (ctxq ? ML + b * CTXL : b * SEQ) + r * 64, qrow0 = qbase + r16;
    const char* zb = (const char*)Z; const int g = lane >> 4;
    AttnSt<4> st; attn_init<4>(st);
#pragma unroll
    for (int qi = 0; qi < 4; ++qi) { const bf16_t* qp = Z + (size_t)(qrow0 + qi * 16) * ZP + C_NQ + h * 64 + g * 8; st.Q[qi][0] = *(const bf16x8*)qp; st.Q[qi][1] = *(const bf16x8*)(qp + 32); }
    const int kcol = C_NK + h * 64, vcol = C_NV + h * 64;
    if (!ctxq) {
        LAS float* tab = (LAS float*)(kl + AT_TABOFF);
        const float* rpbp = a.in[I_RPB] + (size_t)(l * 8 + h) * 465;
        for (int i = lane; i < 465; i += 64) tab[i] = rpbp[i] * LOG2E;
        int rs = r - 4; rs = rs < 0 ? 0 : (rs > 56 ? 56 : rs);
        unsigned rp[4];
#pragma unroll
        for (int c = 0; c < 4; ++c) rp[c] = (unsigned)(b * SEQ + rs * 64 + (lane >> 3) + c * 8) * (unsigned)(ZP * 2) + (unsigned)at_piece_off(lane);
        stage_issue(zb, rp, kcol * 2, vcol * 2, kl);
        for (int s = 0; s < 16; ++s) {
            if (s + 1 < 16) {
#pragma unroll
                for (int c = 0; c < 4; ++c) rp[c] += 32u * (unsigned)(ZP * 2);
                stage_issue(zb, rp, kcol * 2, vcol * 2, kl + ((s + 1) & 1) * AT_BUF);
                asm volatile("s_waitcnt vmcnt(8)" ::: "memory");
            } else asm volatile("s_waitcnt vmcnt(0)" ::: "memory");
            AttnFrag F; attn_read(F, kl + (s & 1) * AT_BUF, lane);
            BiasNA bn; bn.tabaddr = lds_u32((const LAS unsigned char*)tab); bn.rowoff31 = (rs + (s >> 1) - r + 7) * 31; bn.c0 = (s & 1) * 32;
            attn_compute<4>(st, F, bn, lane);
        }
    }
    attn_ctx_steps<4>(st, Z, ML + b * CTXL, kcol, vcol, 8, kl, lane);
#pragma unroll
    for (int qi = 0; qi < 4; ++qi) attn_store<4>(st, qi, Z + (size_t)(qrow0 + qi * 16) * ZP + Y_NA + h * 64, lane);
}
constexpr int RT_VS = 288, RT_KS = 160, RT_SS = 144;
__device__ __forceinline__ size_t kvt_off(int bh, int dir, int ch) { return (((size_t)bh * 2 + dir) * 34 + ch) * 8192; }
__device__ __forceinline__ float log_sigmoidf_(float x) { return -(fmaxf(-x, 0.f) + log1pf(__expf(-fabsf(x)))); }
__device__ __forceinline__ int ret_row0(int b, int ch) { return ch < 2 ? ML + b * CTXL + ch * 128 : b * SEQ + (ch - 2) * 128; }

__device__ __forceinline__ void ret_kv_unit(const KArgs& a, LAS unsigned char* lds, int l, int unit) {
    const int tid = OTID(), lane = tid & 63, wave = tid >> 6, g = lane >> 4, r16 = lane & 15;
    const int bh = unit / 34, ch = unit % 34, b = bh >> 2, h = bh & 3;
    const bf16_t* Z = (const bf16_t*)(a.ws + WS_Z);
    const int row0 = ret_row0(b, ch);
    const float lgf = log_sigmoidf_(a.in[I_RDECAY][l * 8 + h]), lgb = log_sigmoidf_(a.in[I_RDECAY][l * 8 + 4 + h]);
    LAS unsigned char* Vl = lds; LAS unsigned char* Kf = lds + 128 * RT_VS; LAS unsigned char* Kb = Kf + 128 * RT_KS;
#pragma unroll
    for (int i = 0; i < 4; ++i) { const int p = tid + i * 512, r = p >> 4, c = p & 15;
        *(LAS u32x4*)(Vl + r * RT_VS + c * 16) = *(const u32x4*)(Z + (size_t)(row0 + r) * ZP + C_RV + h * 128 + c * 8); }
#pragma unroll
    for (int i = 0; i < 2; ++i) { const int p = tid + i * 512, r = p >> 3, c = p & 7;
        const u32x4 kv = *(const u32x4*)(Z + (size_t)(row0 + r) * ZP + C_RK + h * 64 + c * 8);
        const float df = __expf(lgf * (float)(127 - r)), db = __expf(lgb * (float)r);
        u32x4 of, ob;
        of.x = pk2(bflo(kv.x) * df, bfhi(kv.x) * df); of.y = pk2(bflo(kv.y) * df, bfhi(kv.y) * df); of.z = pk2(bflo(kv.z) * df, bfhi(kv.z) * df); of.w = pk2(bflo(kv.w) * df, bfhi(kv.w) * df);
        ob.x = pk2(bflo(kv.x) * db, bfhi(kv.x) * db); ob.y = pk2(bflo(kv.y) * db, bfhi(kv.y) * db); ob.z = pk2(bflo(kv.z) * db, bfhi(kv.z) * db); ob.w = pk2(bflo(kv.w) * db, bfhi(kv.w) * db);
        *(LAS u32x4*)(Kf + r * RT_KS + c * 16) = of; *(LAS u32x4*)(Kb + r * RT_KS + c * 16) = ob; }
    __syncthreads();
    f32x4 acc[2][4];
#pragma unroll
    for (int d = 0; d < 2; ++d)
#pragma unroll
        for (int t = 0; t < 4; ++t) acc[d][t] = (f32x4){0.f, 0.f, 0.f, 0.f};
    const int qq = r16 >> 2, pp = r16 & 3;
#pragma unroll
    for (int ks = 0; ks < 4; ++ks) {
        const int tr0 = ks * 32 + 4 * g + qq;
        const s16x4 alo = lds_tr16(Vl + tr0 * RT_VS + (wave * 16 + 4 * pp) * 2), ahi = lds_tr16(Vl + (tr0 + 16) * RT_VS + (wave * 16 + 4 * pp) * 2);
        const bf16x8 A = (bf16x8){alo[0], alo[1], alo[2], alo[3], ahi[0], ahi[1], ahi[2], ahi[3]};
#pragma unroll
        for (int t = 0; t < 4; ++t) {
            const s16x4 flo = lds_tr16(Kf + tr0 * RT_KS + (t * 16 + 4 * pp) * 2), fhi = lds_tr16(Kf + (tr0 + 16) * RT_KS + (t * 16 + 4 * pp) * 2);
            const s16x4 blo = lds_tr16(Kb + tr0 * RT_KS + (t * 16 + 4 * pp) * 2), bhi = lds_tr16(Kb + (tr0 + 16) * RT_KS + (t * 16 + 4 * pp) * 2);
            acc[0][t] = __builtin_amdgcn_mfma_f32_16x16x32_bf16(A, (bf16x8){flo[0], flo[1], flo[2], flo[3], fhi[0], fhi[1], fhi[2], fhi[3]}, acc[0][t], 0, 0, 0);
            acc[1][t] = __builtin_amdgcn_mfma_f32_16x16x32_bf16(A, (bf16x8){blo[0], blo[1], blo[2], blo[3], bhi[0], bhi[1], bhi[2], bhi[3]}, acc[1][t], 0, 0, 0);
        }
    }
    bf16_t* kvt = (bf16_t*)(a.ws + WS_KVT);
#pragma unroll
    for (int d = 0; d < 2; ++d) { bf16_t* o = kvt + kvt_off(bh, d, ch);
#pragma unroll
        for (int t = 0; t < 4; ++t)
#pragma unroll
            for (int j = 0; j < 4; ++j) o[(wave * 16 + 4 * g + j) * 64 + t * 16 + r16] = (bf16_t)f2bf(acc[d][t][j]); }
    __syncthreads();
}

__device__ __forceinline__ void ret_out_unit(const KArgs& a, LAS unsigned char* lds, int l, int unit) {
    const int tid = OTID(), lane = tid & 63, wave = tid >> 6, g = lane >> 4, r16 = lane & 15;
    const int bh = unit / 34, ch = unit % 34, b = bh >> 2, h = bh & 3;
    bf16_t* Z = (bf16_t*)(a.ws + WS_Z);
    const bf16_t* kvt = (const bf16_t*)(a.ws + WS_KVT);
    const int row0 = ret_row0(b, ch);
    const float lgf = log_sigmoidf_(a.in[I_RDECAY][l * 8 + h]), lgb = log_sigmoidf_(a.in[I_RDECAY][l * 8 + 4 + h]);
    LAS unsigned char* Vl = lds; LAS unsigned char* Sf = lds + 128 * RT_VS; LAS unsigned char* Sb = Sf + 128 * RT_SS;
#pragma unroll
    for (int i = 0; i < 4; ++i) { const int p = tid + i * 512, r = p >> 4, c = p & 15;
        *(LAS u32x4*)(Vl + r * RT_VS + c * 16) = *(const u32x4*)(Z + (size_t)(row0 + r) * ZP + C_RV + h * 128 + c * 8); }
    { const int dv = tid >> 2, dk0 = (tid & 3) * 16;
#pragma unroll
      for (int d = 0; d < 2; ++d) {
          float s[16];
#pragma unroll
          for (int e = 0; e < 16; ++e) s[e] = 0.f;
          const float gC = __expf((d == 0 ? lgf : lgb) * 128.0f);
          const int ord = (d == 0) ? ch : (ch < 2 ? 1 - ch : 35 - ch);
          for (int o = 0; o < ord; o += 8) {
              u32x4 x0[8], x1[8];
#pragma unroll
              for (int k = 0; k < 8; ++k) { const int oo = (o + k < ord) ? o + k : ord - 1; const int ci = (d == 0) ? oo : (oo < 2 ? 1 - oo : 35 - oo);
                  const u32x4* src = (const u32x4*)(kvt + kvt_off(bh, d, ci) + dv * 64 + dk0); x0[k] = src[0]; x1[k] = src[1]; }
#pragma unroll
              for (int k = 0; k < 8; ++k) if (o + k < ord) {
                  s[0] = s[0] * gC + bflo(x0[k].x); s[1] = s[1] * gC + bfhi(x0[k].x); s[2] = s[2] * gC + bflo(x0[k].y); s[3] = s[3] * gC + bfhi(x0[k].y);
                  s[4] = s[4] * gC + bflo(x0[k].z); s[5] = s[5] * gC + bfhi(x0[k].z); s[6] = s[6] * gC + bflo(x0[k].w); s[7] = s[7] * gC + bfhi(x0[k].w);
                  s[8] = s[8] * gC + bflo(x1[k].x); s[9] = s[9] * gC + bfhi(x1[k].x); s[10] = s[10] * gC + bflo(x1[k].y); s[11] = s[11] * gC + bfhi(x1[k].y);
                  s[12] = s[12] * gC + bflo(x1[k].z); s[13] = s[13] * gC + bfhi(x1[k].z); s[14] = s[14] * gC + bflo(x1[k].w); s[15] = s[15] * gC + bfhi(x1[k].w);
              }
          }
          u32x4 w0, w1; w0.x = pk2(s[0], s[1]); w0.y = pk2(s[2], s[3]); w0.z = pk2(s[4], s[5]); w0.w = pk2(s[6], s[7]);
          w1.x = pk2(s[8], s[9]); w1.y = pk2(s[10], s[11]); w1.z = pk2(s[12], s[13]); w1.w = pk2(s[14], s[15]);
          LAS unsigned char* S = (d == 0) ? Sf : Sb;
          *(LAS u32x4*)(S + dv * RT_SS + dk0 * 2) = w0; *(LAS u32x4*)(S + dv * RT_SS + dk0 * 2 + 16) = w1;
      } }
    __syncthreads();
    const int qi = wave * 16 + r16;
    const bf16_t* qp = Z + (size_t)(row0 + qi) * ZP + C_RQ + h * 64 + g * 8;
    const bf16x8 Q0 = *(const bf16x8*)qp, Q1 = *(const bf16x8*)(qp + 32);
    bf16x8 Kf[8][2];
#pragma unroll
    for (int kt = 0; kt < 8; ++kt) { const bf16_t* kp = Z + (size_t)(row0 + kt * 16 + r16) * ZP + C_RK + h * 64 + g * 8; Kf[kt][0] = *(const bf16x8*)kp; Kf[kt][1] = *(const bf16x8*)(kp + 32); }
    f32x4 O[8];
#pragma unroll
    for (int dt = 0; dt < 8; ++dt) O[dt] = (f32x4){0.f, 0.f, 0.f, 0.f};
    const int qq = r16 >> 2, pp = r16 & 3;
#pragma unroll
    for (int ks = 0; ks < 4; ++ks) {
        u32x4 pw;
#pragma unroll
        for (int half = 0; half < 2; ++half) {
            const int kt = 2 * ks + half;
            f32x4 s = (f32x4){0.f, 0.f, 0.f, 0.f};
            s = __builtin_amdgcn_mfma_f32_16x16x32_bf16(Kf[kt][0], Q0, s, 0, 0, 0);
            s = __builtin_amdgcn_mfma_f32_16x16x32_bf16(Kf[kt][1], Q1, s, 0, 0, 0);
            float p[4];
#pragma unroll
            for (int j = 0; j < 4; ++j) { const int diff = qi - (kt * 16 + 4 * g + j);
                const float df = (diff >= 0) ? __expf(lgf * (float)diff) : 0.f, db = (diff <= 0) ? __expf(lgb * (float)(-diff)) : 0.f; p[j] = s[j] * (df + db); }
            if (half == 0) { pw.x = pk2(p[0], p[1]); pw.y = pk2(p[2], p[3]); } else { pw.z = pk2(p[0], p[1]); pw.w = pk2(p[2], p[3]); }
        }
        const bf16x8 pf = __builtin_bit_cast(bf16x8, pw);
        const int tr0 = ks * 32 + 4 * g + qq;
#pragma unroll
        for (int dt = 0; dt < 8; ++dt) {
            const s16x4 lo = lds_tr16(Vl + tr0 * RT_VS + (dt * 16 + 4 * pp) * 2), hi = lds_tr16(Vl + (tr0 + 16) * RT_VS + (dt * 16 + 4 * pp) * 2);
            O[dt] = __builtin_amdgcn_mfma_f32_16x16x32_bf16((bf16x8){lo[0], lo[1], lo[2], lo[3], hi[0], hi[1], hi[2], hi[3]}, pf, O[dt], 0, 0, 0);
        }
    }
    { const float dqf = __expf(lgf * (float)(qi + 1)), dqb = __expf(lgb * (float)(128 - qi));
#pragma unroll
      for (int dt = 0; dt < 8; ++dt) {
          f32x4 tf = (f32x4){0.f, 0.f, 0.f, 0.f}, tb = (f32x4){0.f, 0.f, 0.f, 0.f};
          const LAS unsigned char* sf = Sf + (dt * 16 + r16) * RT_SS + g * 16; const LAS unsigned char* sb = Sb + (dt * 16 + r16) * RT_SS + g * 16;
          tf = __builtin_amdgcn_mfma_f32_16x16x32_bf16(*(const LAS bf16x8*)sf, Q0, tf, 0, 0, 0); tf = __builtin_amdgcn_mfma_f32_16x16x32_bf16(*(const LAS bf16x8*)(sf + 64), Q1, tf, 0, 0, 0);
          tb = __builtin_amdgcn_mfma_f32_16x16x32_bf16(*(const LAS bf16x8*)sb, Q0, tb, 0, 0, 0); tb = __builtin_amdgcn_mfma_f32_16x16x32_bf16(*(const LAS bf16x8*)(sb + 64), Q1, tb, 0, 0, 0);
          O[dt] = O[dt] + tf * dqf + tb * dqb;
      } }
    float sm = 0.f;
#pragma unroll
    for (int dt = 0; dt < 8; ++dt) sm += (O[dt][0] + O[dt][1]) + (O[dt][2] + O[dt][3]);
    sm += __shfl_xor(sm, 16); sm += __shfl_xor(sm, 32);
    const float mean = sm * (1.f / 128.f);
    float sq = 0.f;
#pragma unroll
    for (int dt = 0; dt < 8; ++dt) { const f32x4 dd = O[dt] - mean; sq += (dd[0] * dd[0] + dd[1] * dd[1]) + (dd[2] * dd[2] + dd[3] * dd[3]); }
    sq += __shfl_xor(sq, 16); sq += __shfl_xor(sq, 32);
    const float rstd = rsqrtf(sq * (1.f / 128.f) + EPS);
    const float* gn = a.in[I_RGN] + l * 512 + h * 128;
    bf16_t* yrow = Z + (size_t)(row0 + qi) * ZP + Y_RET + h * 128;
#pragma unroll
    for (int dt = 0; dt < 8; ++dt) { const int c = dt * 16 + 4 * g;
        const u32x2 gt = *(const u32x2*)(yrow + c); const f32x4 gv = *(const f32x4*)(gn + c);
        u32x2 w; w.x = pk2((O[dt][0] - mean) * rstd * gv[0] * silu_fast(bflo(gt.x)), (O[dt][1] - mean) * rstd * gv[1] * silu_fast(bfhi(gt.x)));
        w.y = pk2((O[dt][2] - mean) * rstd * gv[2] * silu_fast(bflo(gt.y)), (O[dt][3] - mean) * rstd * gv[3] * silu_fast(bfhi(gt.y)));
        *(u32x2*)(yrow + c) = w; }
    __syncthreads();
}
constexpr int C_UF = C_GQ, C_UB = C_GK, C_WF = C_GV, C_AQ = 5888;
__device__ __forceinline__ int gdn_row0(int b, int c) { return c < 4 ? ML + b * CTXL + c * 64 : b * SEQ + (c - 4) * 64; }

__device__ __forceinline__ void gdn_prep_unit(const KArgs& a, LAS unsigned char* lds, int unit) {
    const int tid = OTID(), lane = tid & 63, wave = tid >> 6, g = lane >> 4, r16 = lane & 15;
    const int bh = unit / 68, c = unit % 68, b = bh >> 2, h = bh & 3;
    const int row0 = gdn_row0(b, c);
    bf16_t* Z = (bf16_t*)(a.ws + WS_Z); bf16_t* P = (bf16_t*)(a.ws + WS_P);
    float* GBa = (float*)(a.ws + WS_GB); const float* GBb = GBa + (size_t)MA * 8;
    LAS float* KK = (LAS float*)lds; LAS float* QK = KK + 4096; LAS float* AF = QK + 4096; LAS float* AB = AF + 4096;
    LAS float* gcs = AB + 4096;
    LAS float* bes = gcs + 128;
    if (tid < 128) { const int d = tid >> 6, i = tid & 63; const size_t o = (size_t)(row0 + i) * 8 + d * 4 + h; gcs[tid] = GBa[o]; bes[tid] = GBb[o]; }
    __syncthreads();
    if (wave < 2) { float v = gcs[tid];
#pragma unroll
        for (int off = 1; off < 64; off <<= 1) { const float t = (wave == 0) ? __shfl_up(v, off) : __shfl_down(v, off); if ((wave == 0) ? (lane >= off) : (lane + off < 64)) v += t; }
        gcs[tid] = v; }
    { const int rt = wave & 3; const bf16_t* ap = P + (size_t)(row0 + rt * 16 + r16) * PP + (wave < 4 ? 512 : 0) + h * 128 + g * 8;
      bf16x8 A[4];
#pragma unroll
      for (int ks = 0; ks < 4; ++ks) A[ks] = *(const bf16x8*)(ap + ks * 32);
      LAS float* M = (wave < 4) ? KK : QK;
#pragma unroll
      for (int ct = 0; ct < 4; ++ct) { const bf16_t* bp = P + (size_t)(row0 + ct * 16 + r16) * PP + 512 + h * 128 + g * 8;
          f32x4 acc = (f32x4){0.f, 0.f, 0.f, 0.f};
#pragma unroll
          for (int ks = 0; ks < 4; ++ks) acc = __builtin_amdgcn_mfma_f32_16x16x32_bf16(A[ks], *(const bf16x8*)(bp + ks * 32), acc, 0, 0, 0);
#pragma unroll
          for (int j = 0; j < 4; ++j) M[(rt * 16 + 4 * g + j) * 64 + ct * 16 + r16] = acc[j]; } }
    __syncthreads();
    if (tid < 128) { const int d = tid >> 6, i = tid & 63; ((float*)(a.ws + WS_GC2))[(size_t)(d * 4 + h) * MA + row0 + i] = gcs[tid]; }
#pragma unroll
    for (int e = 0; e < 8; ++e) { const int idx = tid + 512 * e, i = idx >> 6, j = idx & 63;
        const float kk = KK[idx], qk = QK[idx];
        const float ef = __expf(fminf(gcs[i] - gcs[j], 0.f)), eb = __expf(fminf(gcs[64 + i] - gcs[64 + j], 0.f));
        const float af = (j < i) ? bes[i] * kk * ef : 0.f, ab = (j > i) ? bes[64 + i] * kk * eb : 0.f;
        AF[idx] = af; AB[(63 - i) * 64 + (63 - j)] = ab;
        ((LAS bf16_t*)(lds + 66560))[idx] = (bf16_t)f2bf(-af); ((LAS bf16_t*)(lds + 66560))[4096 + (63 - i) * 64 + (63 - j)] = (bf16_t)f2bf(-ab);
        Z[(size_t)(row0 + i) * ZP + C_AQ + h * 64 + j] = (bf16_t)f2bf(qk * (j < i ? ef : (j > i ? eb : 1.0f))); }
    LAS bf16_t* NAm = (LAS bf16_t*)(lds + 66560);
    LAS bf16_t* TL = (LAS bf16_t*)(lds + 82944);
    __syncthreads();
    { const int dd = wave >> 2, bb = wave & 3; const LAS float* Am = (dd ? AB : AF) + (bb * 16) * 64 + bb * 16;
      if (lane < 16) { float t[16];
#pragma unroll
          for (int i = 0; i < 16; ++i) { float acc = (i == lane) ? 1.f : 0.f;
#pragma unroll
              for (int j = 0; j < i; ++j) acc -= Am[i * 64 + j] * t[j];
              t[i] = acc; }
#pragma unroll
          for (int i = 0; i < 16; ++i) TL[((dd * 4 + bb) * 16 + i) * 16 + lane] = (bf16_t)f2bf(t[i]); } }
    const int d = wave >> 2, part = wave & 3; const bool isw = part >= 2;
    f32x4 R[4][4];
#pragma unroll
    for (int bk = 0; bk < 4; ++bk)
#pragma unroll
        for (int j = 0; j < 4; ++j) { const int ip = bk * 16 + 4 * g + j, tok = d ? 63 - ip : ip;
            const float f = isw ? bes[d * 64 + tok] * __expf(gcs[d * 64 + tok]) : bes[d * 64 + tok];
            const bf16_t* src = P + (size_t)(row0 + tok) * PP + (isw ? 512 : 1024) + h * 128 + (part & 1) * 64 + r16;
#pragma unroll
            for (int ct = 0; ct < 4; ++ct) R[bk][ct][j] = f * bf2f(src[ct * 16]); }
    asm volatile("s_waitcnt vmcnt(0)" ::: "memory");
    __syncthreads();
    { const LAS bf16_t* Nd = NAm + d * 4096; const LAS bf16_t* Td = TL + d * 1024;
      const u32x2 zero2 = (u32x2){0u, 0u};
#pragma unroll
      for (int bk = 0; bk < 4; ++bk) {
#pragma unroll
          for (int c0 = 0; c0 < 4; c0 += 2) if (c0 < bk) {
              const u32x2 alo = *(const LAS u32x2*)(Nd + (bk * 16 + r16) * 64 + c0 * 16 + 4 * g);
              const u32x2 ahi = (c0 + 1 < bk) ? *(const LAS u32x2*)(Nd + (bk * 16 + r16) * 64 + (c0 + 1) * 16 + 4 * g) : zero2;
              const bf16x8 Af = cat8(alo, ahi);
#pragma unroll
              for (int ct = 0; ct < 4; ++ct) { u32x2 blo, bhi = zero2; blo.x = pk2(R[c0][ct][0], R[c0][ct][1]); blo.y = pk2(R[c0][ct][2], R[c0][ct][3]);
                  if (c0 + 1 < bk) { bhi.x = pk2(R[c0 + 1][ct][0], R[c0 + 1][ct][1]); bhi.y = pk2(R[c0 + 1][ct][2], R[c0 + 1][ct][3]); }
                  R[bk][ct] = __builtin_amdgcn_mfma_f32_16x16x32_bf16(Af, cat8(blo, bhi), R[bk][ct], 0, 0, 0); } }
          const bf16x8 Tf = cat8(*(const LAS u32x2*)(Td + (bk * 16 + r16) * 16 + 4 * g), zero2);
#pragma unroll
          for (int ct = 0; ct < 4; ++ct) { u32x2 blo; blo.x = pk2(R[bk][ct][0], R[bk][ct][1]); blo.y = pk2(R[bk][ct][2], R[bk][ct][3]);
              R[bk][ct] = __builtin_amdgcn_mfma_f32_16x16x32_bf16(Tf, cat8(blo, zero2), (f32x4){0.f, 0.f, 0.f, 0.f}, 0, 0, 0); }
      } }
#pragma unroll
    for (int bk = 0; bk < 4; ++bk)
#pragma unroll
        for (int j = 0; j < 4; ++j) { const int ip = bk * 16 + 4 * g + j, tok = d ? 63 - ip : ip;
            if (isw) { bf16_t* dst = (d == 0 ? Z + (size_t)(row0 + tok) * ZP + C_WF : P + (size_t)(row0 + tok) * PP + 1024) + h * 128 + (part & 1) * 64 + r16;
#pragma unroll
                for (int ct = 0; ct < 4; ++ct) dst[ct * 16] = (bf16_t)f2bf(R[bk][ct][j]); }
            else {
#pragma unroll
                for (int ct = 0; ct < 4; ++ct) { const int e = utile_off(tok, (part & 1) * 64 + ct * 16 + r16);
                    Z[(size_t)(row0 + (e >> 7)) * ZP + (d == 0 ? C_UF : C_UB) + h * 128 + (e & 127)] = (bf16_t)f2bf(R[bk][ct][j]); } } }
    __syncthreads();
}

constexpr int GS_SF = 0, GS_VF = 32768, GS_VE = 49152, GS_KB = 65536;
struct GsRegs { bf16x8 W[4], Q[4], AQ[2]; u32x4 K[2]; float u[4][4], gc[4], gl; };
__device__ __forceinline__ void gdn_scan_unit(const KArgs& a, LAS unsigned char* lds, int unit, bool ctx_out) {
    const int tid = OTID(), lane = tid & 63, wave = tid >> 6, g = lane >> 4, r16 = lane & 15, rt = wave & 3, ch = wave >> 2;
    const int bh = unit >> 1, d = unit & 1, b = bh >> 2, h = bh & 3;
    bf16_t* Z = (bf16_t*)(a.ws + WS_Z); const bf16_t* P = (const bf16_t*)(a.ws + WS_P);
    const float* GBa = (const float*)(a.ws + WS_GB);
    const bf16_t* Wb = d == 0 ? (const bf16_t*)Z + C_WF : P + 1024; const int Wp = d == 0 ? ZP : PP;
    const int ubase = (d == 0 ? C_UF : C_UB) + h * 128, ue0 = ((rt * 2 + ch) * 64 + lane) * 16;
    const float* GC2 = (const float*)(a.ws + WS_GC2) + (size_t)(d * 4 + h) * MA;
    const int rhoA = 32 * (rt >> 1) + 8 * (r16 >> 2) + 4 * (rt & 1) + (r16 & 3);
    const int rhoC = 32 * (rt >> 1) + 8 * g + 4 * (rt & 1);
    f32x4 Sa[4], Sb[4];
#pragma unroll
    for (int c = 0; c < 4; ++c) { Sa[c] = (f32x4){0.f, 0.f, 0.f, 0.f}; Sb[c] = Sa[c]; }
#define GS_ROW0(s_) gdn_row0(b, d == 0 ? (s_) : ((s_) < 4 ? 3 - (s_) : 71 - (s_)))
#define GS_LOAD_WQ(R, s_) do { const int r0_ = GS_ROW0(s_); const size_t ra_ = (size_t)(r0_ + rhoA); \
        _Pragma("unroll") for (int ks = 0; ks < 4; ++ks) { R.W[ks] = *(const bf16x8*)(Wb + ra_ * Wp + h * 128 + ks * 32 + 8 * g); R.Q[ks] = *(const bf16x8*)(P + ra_ * PP + h * 128 + ks * 32 + 8 * g); } \
        { const f32x4 gv_ = *(const f32x4*)(GC2 + r0_ + rhoC); R.gc[0] = gv_[0]; R.gc[1] = gv_[1]; R.gc[2] = gv_[2]; R.gc[3] = gv_[3]; } \
        { const bf16_t* up_ = Z + (size_t)(r0_ + (ue0 >> 7)) * ZP + ubase + (ue0 & 127); const u32x4 ua_ = *(const u32x4*)up_, ub_ = *(const u32x4*)(up_ + 8); \
          R.u[0][0] = bflo(ua_.x); R.u[0][1] = bfhi(ua_.x); R.u[0][2] = bflo(ua_.y); R.u[0][3] = bfhi(ua_.y); R.u[1][0] = bflo(ua_.z); R.u[1][1] = bfhi(ua_.z); R.u[1][2] = bflo(ua_.w); R.u[1][3] = bfhi(ua_.w); \
          R.u[2][0] = bflo(ub_.x); R.u[2][1] = bfhi(ub_.x); R.u[2][2] = bflo(ub_.y); R.u[2][3] = bfhi(ub_.y); R.u[3][0] = bflo(ub_.z); R.u[3][1] = bfhi(ub_.z); R.u[3][2] = bflo(ub_.w); R.u[3][3] = bfhi(ub_.w); } \
        R.gl = GC2[r0_ + (d == 0 ? 63 : 0)]; } while (0)
#define GS_LOAD_AQ(R, s_) do { const int r0_ = GS_ROW0(s_); const size_t ra_ = (size_t)(r0_ + rhoA); \
        _Pragma("unroll") for (int k2 = 0; k2 < 2; ++k2) { u32x4 w_ = *(const u32x4*)(Z + ra_ * ZP + C_AQ + h * 64 + k2 * 32 + 8 * g); const int j0_ = k2 * 32 + 8 * g; \
              \
            w_.x &= ((d == 0 ? (j0_ + 0 <= rhoA) : (j0_ + 0 >= rhoA)) ? 0x0000ffffu : 0u) | ((d == 0 ? (j0_ + 1 <= rhoA) : (j0_ + 1 >= rhoA)) ? 0xffff0000u : 0u); \
            w_.y &= ((d == 0 ? (j0_ + 2 <= rhoA) : (j0_ + 2 >= rhoA)) ? 0x0000ffffu : 0u) | ((d == 0 ? (j0_ + 3 <= rhoA) : (j0_ + 3 >= rhoA)) ? 0xffff0000u : 0u); \
            w_.z &= ((d == 0 ? (j0_ + 4 <= rhoA) : (j0_ + 4 >= rhoA)) ? 0x0000ffffu : 0u) | ((d == 0 ? (j0_ + 5 <= rhoA) : (j0_ + 5 >= rhoA)) ? 0xffff0000u : 0u); \
            w_.w &= ((d == 0 ? (j0_ + 6 <= rhoA) : (j0_ + 6 >= rhoA)) ? 0x0000ffffu : 0u) | ((d == 0 ? (j0_ + 7 <= rhoA) : (j0_ + 7 >= rhoA)) ? 0xffff0000u : 0u); \
            R.AQ[k2] = __builtin_bit_cast(bf16x8, w_); } } while (0)
#define GS_LOAD_K(R, s_) do { const int r0_ = GS_ROW0(s_); \
        _Pragma("unroll") for (int cc = 0; cc < 2; ++cc) { const int row_ = wave * 8 + cc * 4 + (lane >> 4); \
            R.K[cc] = *(const u32x4*)(P + (size_t)(r0_ + row_) * PP + 512 + h * 128 + (lane & 15) * 8); } } while (0)
#define GS_LOAD(R, s_) do { GS_LOAD_WQ(R, s_); GS_LOAD_AQ(R, s_); GS_LOAD_K(R, s_); } while (0)
#define GS_BAR() do { asm volatile("s_waitcnt lgkmcnt(0)" ::: "memory"); __builtin_amdgcn_s_barrier(); asm volatile("" ::: "memory"); } while (0)
    const int qq = r16 >> 2, pp = r16 & 3;
#define GS_STEP(s_, PRE) do { const int s = (s_); \
        _Pragma("unroll") for (int c = 0; c < 4; ++c) { u32x4 w; w.x = pk2(Sa[c][0], Sa[c][1]); w.y = pk2(Sa[c][2], Sa[c][3]); w.z = pk2(Sb[c][0], Sb[c][1]); w.w = pk2(Sb[c][2], Sb[c][3]); \
            *(LAS u32x4*)(lds + GS_SF + ((rt * 8 + ch * 4 + c) * 64 + lane) * 16) = w; } \
        _Pragma("unroll") for (int cc = 0; cc < 2; ++cc) { const int row_ = wave * 8 + cc * 4 + (lane >> 4); \
            *(LAS u32x4*)(lds + GS_KB + (s & 1) * 16384 + row_ * 256 + (((lane & 15) ^ ((row_ & 3) << 2)) * 16)) = PRE.K[cc]; } \
        if (s + 1 < 68) GS_LOAD_K(PRE, s + 1); \
        GS_BAR(); \
        const int r0 = GS_ROW0(s); \
        f32x4 vacc[4], oacc[4]; \
        _Pragma("unroll") for (int c = 0; c < 4; ++c) { vacc[c] = (f32x4){0.f, 0.f, 0.f, 0.f}; oacc[c] = vacc[c]; } \
        { bf16x8 Bs[2][4]; \
          _Pragma("unroll") for (int c = 0; c < 4; ++c) Bs[0][c] = *(const LAS bf16x8*)(lds + GS_SF + ((0 * 8 + ch * 4 + c) * 64 + lane) * 16); \
          _Pragma("unroll") for (int ks = 0; ks < 4; ++ks) { \
              if (ks < 3) { _Pragma("unroll") for (int c = 0; c < 4; ++c) Bs[(ks + 1) & 1][c] = *(const LAS bf16x8*)(lds + GS_SF + (((ks + 1) * 8 + ch * 4 + c) * 64 + lane) * 16); } \
              __builtin_amdgcn_sched_barrier(0); \
              _Pragma("unroll") for (int c = 0; c < 4; ++c) { vacc[c] = __builtin_amdgcn_mfma_f32_16x16x32_bf16(PRE.W[ks], Bs[ks & 1][c], vacc[c], 0, 0, 0); oacc[c] = __builtin_amdgcn_mfma_f32_16x16x32_bf16(PRE.Q[ks], Bs[ks & 1][c], oacc[c], 0, 0, 0); } \
              __builtin_amdgcn_sched_barrier(0); } } \
        const float cd = __expf(PRE.gl); \
        float eg[4], ee[4]; \
        _Pragma("unroll") for (int j = 0; j < 4; ++j) { eg[j] = __expf(PRE.gc[j]); ee[j] = __expf(fminf(PRE.gl - PRE.gc[j], 0.f)); } \
        _Pragma("unroll") for (int c = 0; c < 4; ++c) { float vn[4], ve[4]; \
            _Pragma("unroll") for (int j = 0; j < 4; ++j) { vn[j] = PRE.u[c][j] - vacc[c][j]; oacc[c][j] *= eg[j]; ve[j] = vn[j] * ee[j]; } \
            u32x2 w; w.x = pk2(vn[0], vn[1]); w.y = pk2(vn[2], vn[3]); u32x2 e; e.x = pk2(ve[0], ve[1]); e.y = pk2(ve[2], ve[3]); \
            *(LAS u32x2*)(lds + GS_VF + (((rt >> 1) * 8 + ch * 4 + c) * 64 + lane) * 16 + (rt & 1) * 8) = w; \
            *(LAS u32x2*)(lds + GS_VE + (((rt >> 1) * 8 + ch * 4 + c) * 64 + lane) * 16 + (rt & 1) * 8) = e; } \
        if (s + 1 < 68) GS_LOAD_WQ(PRE, s + 1); \
        GS_BAR(); \
        const LAS unsigned char* kb = lds + GS_KB + (s & 1) * 16384; \
        _Pragma("unroll") for (int c = 0; c < 4; ++c) { Sa[c] = Sa[c] * cd; Sb[c] = Sb[c] * cd; } \
        _Pragma("unroll") for (int k2 = 0; k2 < 2; ++k2) { \
            const int rr = k2 * 32 + 8 * g + qq; const int pc = 4 * rt + pp; \
            bf16x8 Bv[4], Be[4]; \
            _Pragma("unroll") for (int c = 0; c < 4; ++c) { Bv[c] = *(const LAS bf16x8*)(lds + GS_VF + ((k2 * 8 + ch * 4 + c) * 64 + lane) * 16); Be[c] = *(const LAS bf16x8*)(lds + GS_VE + ((k2 * 8 + ch * 4 + c) * 64 + lane) * 16); } \
            const s16x4 alo = lds_tr16(kb + rr * 256 + ((pc ^ ((rr & 3) << 2)) * 16)), ahi = lds_tr16(kb + (rr + 4) * 256 + ((pc ^ (((rr + 4) & 3) << 2)) * 16)); \
            const s16x4 blo = lds_tr16(kb + rr * 256 + ((pc ^ ((rr & 3) << 2)) * 16) + 8), bhi = lds_tr16(kb + (rr + 4) * 256 + ((pc ^ (((rr + 4) & 3) << 2)) * 16) + 8); \
            const bf16x8 KTa = (bf16x8){alo[0], alo[1], alo[2], alo[3], ahi[0], ahi[1], ahi[2], ahi[3]}, KTb = (bf16x8){blo[0], blo[1], blo[2], blo[3], bhi[0], bhi[1], bhi[2], bhi[3]}; \
            __builtin_amdgcn_sched_barrier(0); \
            _Pragma("unroll") for (int c = 0; c < 4; ++c) { \
                oacc[c] = __builtin_amdgcn_mfma_f32_16x16x32_bf16(PRE.AQ[k2], Bv[c], oacc[c], 0, 0, 0); \
                Sa[c] = __builtin_amdgcn_mfma_f32_16x16x32_bf16(KTa, Be[c], Sa[c], 0, 0, 0); Sb[c] = __builtin_amdgcn_mfma_f32_16x16x32_bf16(KTb, Be[c], Sb[c], 0, 0, 0); } \
            __builtin_amdgcn_sched_barrier(0); \
        } \
        if (s + 1 < 68) GS_LOAD_AQ(PRE, s + 1); \
        if (s >= 4 || ctx_out) { \
            u32x4 oa_, ob_; oa_.x = pk2(oacc[0][0], oacc[0][1]); oa_.y = pk2(oacc[0][2], oacc[0][3]); oa_.z = pk2(oacc[1][0], oacc[1][1]); oa_.w = pk2(oacc[1][2], oacc[1][3]); \
            ob_.x = pk2(oacc[2][0], oacc[2][1]); ob_.y = pk2(oacc[2][2], oacc[2][3]); ob_.z = pk2(oacc[3][0], oacc[3][1]); ob_.w = pk2(oacc[3][2], oacc[3][3]); \
            bf16_t* op_ = Z + (size_t)(r0 + (ue0 >> 7)) * ZP + ubase + (ue0 & 127); *(u32x4*)op_ = oa_; *(u32x4*)(op_ + 8) = ob_; \
        } \
    } while (0)
    GsRegs RA;
    GS_LOAD(RA, 0);
    for (int s2 = 0; s2 < 68; s2 += 2) { GS_STEP(s2, RA); GS_STEP(s2 + 1, RA); }
#undef GS_STEP
#undef GS_BAR
#undef GS_ROW0
#undef GS_LOAD
#undef GS_LOAD_WQ
#undef GS_LOAD_AQ
#undef GS_LOAD_K
    __syncthreads();
}
typedef const __attribute__((address_space(4))) KArgs* KAP;
#define NOINL __forceinline__
__device__ __forceinline__ KArgs load_kargs(KAP kp) { unsigned long long kv = (unsigned long long)kp; asm volatile("" : "+s"(kv)); KAP ka = (KAP)kv; KArgs a;
#pragma unroll
    for (int i = 0; i < 29; ++i) a.in[i] = ka->in[i];
    a.out = ka->out; a.ws = ka->ws; a.ph_lo = ka->ph_lo; a.ph_hi = ka->ph_hi; return a; }
__device__ NOINL void call_gdnprep(KAP ka, LAS unsigned char* lds, int unit) { const KArgs a = load_kargs(ka); gdn_prep_unit(a, lds, unit); }
__device__ NOINL void call_gdnscan(KAP ka, LAS unsigned char* lds, int unit, bool ctx_out) { const KArgs a = load_kargs(ka); gdn_scan_unit(a, lds, unit, ctx_out); }
__device__ NOINL void call_retkv(KAP ka, LAS unsigned char* lds, int l, int unit) { const KArgs a = load_kargs(ka); ret_kv_unit(a, lds, l, unit); }
__device__ NOINL void call_retout(KAP ka, LAS unsigned char* lds, int l, int unit) { const KArgs a = load_kargs(ka); ret_out_unit(a, lds, l, unit); }
__device__ NOINL void call_na(KAP ka, int l, int item, bool ctxq, LAS unsigned char* kl, int lane) { const KArgs a = load_kargs(ka); na_item(a, l, item, ctxq, kl, lane); }
__device__ NOINL void call_win(KAP ka, int l, int item, bool ctxq, LAS unsigned char* kl, int lane) { const KArgs a = load_kargs(ka); win_item(a, l, item, ctxq, kl, lane); }
#ifndef SCAN_ONLY_M2
#define SCAN_ONLY_M2 0
#endif
constexpr int CW_WQ = 8192;
__device__ __forceinline__ void phase_mixers(KAP ka, LAS unsigned char* lds, int l, bool ctx_out) {
    const int blk = OBLK(), G = OGRID();
    for (int u = blk; u < 32 * 68; u += G) call_gdnprep(ka, lds, u);
    for (int u = blk; u < 32 * 34; u += G) call_retkv(ka, lds, l, u);
#if SCAN_ONLY_M2
    { const int tid = OTID(), lane = tid & 63, wave = tid >> 6; LAS unsigned char* kl = lds + wave * AT_WAVE_BYTES; const int gw = blk * NWAVES + wave, NGW = G * NWAVES;
      const int nitems = ctx_out ? 4096 + 4096 + 256 + 256 : 8192;
      for (int it = gw; it < nitems; it += NGW) { const bool cq = it >= 8192; const int j = cq ? it - 8192 : it; const bool isna = cq ? (j < 256) : (j < 4096); const int item = cq ? (j & 255) : (j & 4095);
          if (isna) call_na(ka, l, item, cq, kl, lane); else call_win(ka, l, item, cq, kl, lane); } }
#endif
}
__device__ __forceinline__ void phase_scan_attn(KAP ka, LAS unsigned char* lds, int l, bool ctx_out, int qslot) {
    const int tid = OTID(), lane = tid & 63, wave = tid >> 6, blk = OBLK(), G = OGRID();
    for (int u = blk; u < 64; u += G) call_gdnscan(ka, lds, (((u & 7) * 4 + ((u >> 3) >> 1)) << 1) | ((u >> 3) & 1), ctx_out);
#if SCAN_ONLY_M2
    return;
#endif
    LAS unsigned char* kl = lds + wave * AT_WAVE_BYTES;
    unsigned* ctr; { const KArgs a = load_kargs(ka); ctr = (unsigned*)(a.ws + WS_CTL) + CW_WQ + qslot * 1024 + (blk & 7) * 64; }
    const int xb = blk & 7;
    const int nper = ctx_out ? 512 + 512 + 32 + 32 : 1024;
    for (;;) {
        int k = 0; if (lane == 0) k = (int)__hip_atomic_fetch_add(ctr, 1u, __ATOMIC_RELAXED, __HIP_MEMORY_SCOPE_AGENT);
        k = __builtin_amdgcn_readfirstlane(k);
        if (k >= nper) break;
        const bool cq = k >= 1024; const int j = cq ? k - 1024 : k;
        const bool isna = cq ? (j < 32) : (j < 512);
        const int item = cq ? xb * 32 + (j & 31) : xb * 512 + (j & 511);
        if (isna) call_na(ka, l, item, cq, kl, lane);
        else call_win(ka, l, item, cq, kl, lane);
    }
}
using pg8::Unit;
struct SchedPlain {
    const char* A0; const char* B0; size_t tA, tB;
    int nM, nN, nwg, G, c;
    __device__ __forceinline__ void init(const void* A, int lda, const void* Bt, int ldb, int M, int N, int G_, int c_) {
        A0 = (const char*)A; B0 = (const char*)Bt; tA = (size_t)256 * lda * 2; tB = (size_t)256 * ldb * 2; nM = M / 256; nN = N / 256; nwg = nM * nN; G = G_; c = c_; }
    __device__ __forceinline__ bool next(int i, Unit& u) const {
        const long L = (long)i * G + c; if (L >= nwg) return false;
        int wgid = (int)L; { const int q = nwg / 8, r = nwg % 8, xcd = wgid % 8, off = wgid / 8; wgid = (xcd < r ? xcd * (q + 1) : r * (q + 1) + (xcd - r) * q) + off; }
        const int nig = 8 * nN, gid = wgid / nig, fm = gid * 8, gsz = (nM - fm) < 8 ? (nM - fm) : 8;
        u.pm = fm + ((wgid % nig) % gsz); u.pn = (wgid % nig) / gsz; u.aux = 0; return true; }
    __device__ __forceinline__ const char* A(const Unit& u) const { return A0 + (size_t)u.pm * tA; }
    __device__ __forceinline__ const char* B(const Unit& u) const { return B0 + (size_t)u.pn * tB; }
};
struct SchedBranch {
    const char* Z0; const char* W0; int ntiles, G, c;
    __device__ __forceinline__ bool next(int i, Unit& u) const { const int tile = (i >> 2) * G + c; if (tile >= ntiles) return false; u.pm = tile >> 2; u.pn = tile & 3; u.aux = i & 3; return true; }
    __device__ __forceinline__ const char* A(const Unit& u) const { const int yc = u.aux == 0 ? Y_RET : (u.aux == 1 ? Y_WIN : (u.aux == 2 ? Y_NA : Y_GDN)); return Z0 + ((size_t)u.pm * 256 * ZP + yc) * 2; }
    __device__ __forceinline__ const char* B(const Unit& u) const { return W0 + ((size_t)u.aux * 1024 * 512 + (size_t)u.pn * 256 * 512) * 2; }
};
struct SchedMoe {
    const char* A0; const char* W0; const int* tile_start; size_t tA, eB, tB; int G, c;
    int e_[4], t0_[4], cum_[5], rank_, nrank_;
    __device__ __forceinline__ void init() {
        const int x = c & 7; rank_ = c >> 3; nrank_ = G >> 3; cum_[0] = 0;
#pragma unroll
        for (int k = 0; k < 4; ++k) { e_[k] = x + 8 * k; t0_[k] = tile_start[e_[k]]; cum_[k + 1] = cum_[k] + (tile_start[e_[k] + 1] - t0_[k]); }
    }
    __device__ __forceinline__ bool next(int i, Unit& u) const {
        const int L = i * nrank_ + rank_; const int tt = L >> 2; if (tt >= cum_[4]) return false;
        const int k = (tt >= cum_[1]) + (tt >= cum_[2]) + (tt >= cum_[3]);
        int e = e_[0], t0 = t0_[0], cm = cum_[0];
        if (k == 1) { e = e_[1]; t0 = t0_[1]; cm = cum_[1]; } else if (k == 2) { e = e_[2]; t0 = t0_[2]; cm = cum_[2]; } else if (k == 3) { e = e_[3]; t0 = t0_[3]; cm = cum_[3]; }
        u.pm = t0 + (tt - cm); u.pn = L & 3; u.aux = e; return true; }
    __device__ __forceinline__ const char* A(const Unit& u) const { return A0 + (size_t)u.pm * tA; }
    __device__ __forceinline__ const char* B(const Unit& u) const { return W0 + (size_t)u.aux * eB + (size_t)u.pn * tB; }
};

template <int MODE  > struct EpiStore {
    static constexpr bool INPLACE = false;
    bf16_t* O; int ldc;
    __device__ __forceinline__ void operator()(const f32x4 (&acc)[2][2][4][2], const Unit& u, int wr, int wc, int fr, int fq) const {
        const int row0 = u.pm * 256 + wr * 64 + fr; const int colt = (MODE == 1 ? dead_tile(u.pn) : u.pn) * 256; const int col0 = colt + wc * 32 + 8 * fq;
#pragma unroll
        for (int ai = 0; ai < 2; ++ai)
#pragma unroll
            for (int m = 0; m < 4; ++m) { bf16_t* rowp = O + (size_t)(row0 + ai * 128 + m * 16) * ldc + col0;
#pragma unroll
                for (int bj = 0; bj < 2; ++bj) { f32x4 v0 = acc[ai][bj][m][0], v1 = acc[ai][bj][m][1];
                    if (MODE == 1) {
#pragma unroll
                        for (int e = 0; e < 4; ++e) { v0[e] = sigmoidf_(v0[e]); v1[e] = sigmoidf_(v1[e]); } }
                    u32x4 w; w.x = pk2(v0[0], v0[1]); w.y = pk2(v0[2], v0[3]); w.z = pk2(v1[0], v1[1]); w.w = pk2(v1[2], v1[3]);
                    *(u32x4*)(rowp + bj * 128) = w; } }
    }
};
struct EpiGateF {
    static constexpr bool INPLACE = false;
    bf16_t* Z;
    __device__ __forceinline__ void operator()(const f32x4 (&acc)[2][2][4][2], const Unit& u, int wr, int wc, int fr, int fq) const {
        const int row0 = u.pm * 256 + wr * 64 + fr; const int cw = (u.pn & 3) * 64 + wc * 16 + fq * 4; const int ct = u.pn >> 2;
        const int c0 = dead_tile(ct) * 256 + cw, c1 = dead_tile(4 + ct) * 256 + cw, c2 = dead_tile(8 + ct) * 256 + cw, c3 = dead_tile(12 + ct) * 256 + cw;
#pragma unroll
        for (int ai = 0; ai < 2; ++ai)
#pragma unroll
            for (int m = 0; m < 4; ++m) { bf16_t* rowp = Z + (size_t)(row0 + ai * 128 + m * 16) * ZP;
                float f0[4], f1[4], f2[4], f3[4];
#pragma unroll
                for (int e = 0; e < 4; ++e) {
                    const float g0 = sigmoid_fast(acc[ai][0][m][0][e]), g1 = fmaxf(sigmoid_fast(acc[ai][0][m][1][e]), 1e-30f), g2 = fmaxf(sigmoid_fast(acc[ai][1][m][0][e]), 1e-30f), g3 = fmaxf(sigmoid_fast(acc[ai][1][m][1][e]), 1e-30f);
                    f0[e] = g0 * __builtin_amdgcn_rcpf(g1); f1[e] = g1 * __builtin_amdgcn_rcpf(g2); f2[e] = g2 * __builtin_amdgcn_rcpf(g3); f3[e] = g3; }
                u32x2 w;
                w.x = pk2(f0[0], f0[1]); w.y = pk2(f0[2], f0[3]); *(u32x2*)(rowp + c0) = w;
                w.x = pk2(f1[0], f1[1]); w.y = pk2(f1[2], f1[3]); *(u32x2*)(rowp + c1) = w;
                w.x = pk2(f2[0], f2[1]); w.y = pk2(f2[2], f2[3]); *(u32x2*)(rowp + c2) = w;
                w.x = pk2(f3[0], f3[1]); w.y = pk2(f3[2], f3[3]); *(u32x2*)(rowp + c3) = w; }
    }
};
struct EpiBranch {
    static constexpr bool INPLACE = true;
    bf16_t* ACC; const bf16_t* Z;
    __device__ __forceinline__ void operator()(f32x4 (&acc)[2][2][4][2], const Unit& u, int wr, int wc, int fr, int fq) const {
        const int row0 = u.pm * 256 + wr * 64 + fr; const int gcol0 = dead_tile(u.aux * 4 + u.pn) * 256 + wc * 32 + 8 * fq, col0 = u.pn * 256 + wc * 32 + 8 * fq;
        const bool lastb = (u.aux == 3);
#pragma unroll
        for (int ai = 0; ai < 2; ++ai) {
            u32x4 gw[4][2];
#pragma unroll
            for (int m = 0; m < 4; ++m)
#pragma unroll
                for (int bj = 0; bj < 2; ++bj) gw[m][bj] = *(const u32x4*)(Z + (size_t)(row0 + ai * 128 + m * 16) * ZP + gcol0 + bj * 128);
#pragma unroll
            for (int m = 0; m < 4; ++m)
#pragma unroll
                for (int bj = 0; bj < 2; ++bj) { const u32x4 g = gw[m][bj];
                    f32x4 v0 = acc[ai][bj][m][0], v1 = acc[ai][bj][m][1];
                    v0[0] *= bflo(g.x); v0[1] *= bfhi(g.x); v0[2] *= bflo(g.y); v0[3] *= bfhi(g.y); v1[0] *= bflo(g.z); v1[1] *= bfhi(g.z); v1[2] *= bflo(g.w); v1[3] *= bfhi(g.w);
                    if (lastb) { u32x4 w; w.x = pk2(v0[0], v0[1]); w.y = pk2(v0[2], v0[3]); w.z = pk2(v1[0], v1[1]); w.w = pk2(v1[2], v1[3]);
                        *(u32x4*)(ACC + (size_t)(row0 + ai * 128 + m * 16) * D + col0 + bj * 128) = w; v0 = (f32x4){0.f, 0.f, 0.f, 0.f}; v1 = v0; }
                    acc[ai][bj][m][0] = v0; acc[ai][bj][m][1] = v1; }
        }
    }
};
struct EpiResid {
    static constexpr bool INPLACE = false;
    const float* xl_src; const float* xc_src; float* xl_dst; float* xc_dst; const float* mod_g;
    __device__ __forceinline__ void operator()(const f32x4 (&acc)[2][2][4][2], const Unit& u, int wr, int wc, int fr, int fq) const {
        const int row0 = u.pm * 256 + wr * 64 + fr; const int col0 = u.pn * 256 + wc * 32 + 8 * fq;
        const bool lat = u.pm < ML / 256; const float* src = lat ? xl_src : xc_src - (size_t)ML * D; float* dst = lat ? xl_dst : xc_dst - (size_t)ML * D;
        const float* gv = mod_g + (size_t)(lat ? (u.pm >> 4) : 8) * 6144;
        f32x4 gg[2][2];
#pragma unroll
        for (int bj = 0; bj < 2; ++bj) { gg[bj][0] = *(const f32x4*)(gv + col0 + bj * 128); gg[bj][1] = *(const f32x4*)(gv + col0 + bj * 128 + 4); }
#pragma unroll
        for (int ai = 0; ai < 2; ++ai) {
            f32x4 xv[4][2][2];
#pragma unroll
            for (int m = 0; m < 4; ++m)
#pragma unroll
                for (int bj = 0; bj < 2; ++bj) { const size_t o = (size_t)(row0 + ai * 128 + m * 16) * D + col0 + bj * 128; xv[m][bj][0] = *(const f32x4*)(src + o); xv[m][bj][1] = *(const f32x4*)(src + o + 4); }
#pragma unroll
            for (int m = 0; m < 4; ++m)
#pragma unroll
                for (int bj = 0; bj < 2; ++bj) { const size_t o = (size_t)(row0 + ai * 128 + m * 16) * D + col0 + bj * 128;
                    *(f32x4*)(dst + o) = xv[m][bj][0] + gg[bj][0] * acc[ai][bj][m][0]; *(f32x4*)(dst + o + 4) = xv[m][bj][1] + gg[bj][1] * acc[ai][bj][m][1]; }
        }
    }
};
struct EpiAct {
    static constexpr bool INPLACE = false;
    bf16_t* ACT;
    __device__ __forceinline__ void operator()(const f32x4 (&acc)[2][2][4][2], const Unit& u, int wr, int wc, int fr, int fq) const {
        const int row0 = u.pm * 256 + wr * 64 + fr; const int col0 = u.pn * 128 + wc * 32 + 8 * fq;
#pragma unroll
        for (int ai = 0; ai < 2; ++ai)
#pragma unroll
            for (int m = 0; m < 4; ++m) { const f32x4 g0 = acc[ai][0][m][0], g1 = acc[ai][0][m][1], u0 = acc[ai][1][m][0], u1 = acc[ai][1][m][1];
                u32x4 w; w.x = pk2(silu_fast(g0[0]) * u0[0], silu_fast(g0[1]) * u0[1]); w.y = pk2(silu_fast(g0[2]) * u0[2], silu_fast(g0[3]) * u0[3]);
                w.z = pk2(silu_fast(g1[0]) * u1[0], silu_fast(g1[1]) * u1[1]); w.w = pk2(silu_fast(g1[2]) * u1[2], silu_fast(g1[3]) * u1[3]);
                *(u32x4*)(ACT + (size_t)(row0 + ai * 128 + m * 16) * DEXP + col0) = w; }
    }
};
constexpr int RT_WS = (1024 + 8) * 2;
constexpr int RT_LO = 32 * RT_WS, RT_BIAS = 2 * RT_LO, RT_SCR = RT_BIAS + 256, RT_SCR_W = 16 * 33 * 4 + 64;
__device__ __forceinline__ void phase_route(const KArgs& a, LAS unsigned char* lds, int l, int nrows) {
    const int tid = OTID(), lane = tid & 63, wave = tid >> 6, blk = OBLK(), G = OGRID(), g = lane >> 4, r16 = lane & 15;
    LAS unsigned* lcnt = (LAS unsigned*)(lds + RT_SCR + 8 * RT_SCR_W);
    LAS float* biasl = (LAS float*)(lds + RT_BIAS);
    LAS float* lg = (LAS float*)(lds + RT_SCR + wave * RT_SCR_W); LAS float* rsl = lg + 16 * 33;
    if (tid < 32) lcnt[tid] = 0u;
    const int ntile = nrows >> 4, per = (ntile + G - 1) / G, t0 = blk * per, t1 = (t0 + per < ntile) ? t0 + per : ntile;
    const float* xl = a.out; const float* xc = (const float*)(a.ws + WS_XC);
    unsigned* tokE = (unsigned*)(a.ws + WS_TOK + TOK_E); unsigned* tokS = (unsigned*)(a.ws + WS_TOK + TOK_SLOT); f32x2* tokW = (f32x2*)(a.ws + WS_TOK + TOK_W);
    float* tokR = (float*)(a.ws + WS_TOK + TOK_RSTD);
    int curb = -1;
    for (int tb = t0; tb < t1; tb += NWAVES) {
        const int tile = tb + wave; const bool act = tile < t1;
        const int bidx = row_modidx((tb << 4));
        const int blast = row_modidx(((tb + NWAVES - 1 < t1 ? tb + NWAVES - 1 : t1 - 1) << 4) + 15);
        for (int bsel = bidx; bsel <= blast; ++bsel) {
            if (bsel != curb) {
                __syncthreads();
                const float* mod = (const float*)(a.ws + WS_MOD) + (size_t)(l * 9 + bsel) * 6144; const float* gain = a.in[I_NORM2] + l * D;
                for (int idx = tid; idx < 32 * 1024; idx += NTHR) { const int e = idx >> 10, k = idx & 1023; const float w = a.in[I_WROUTER][k * 32 + e] * gain[k] * (1.0f + mod[4 * 1024 + k]);
                    const unsigned hi = pk2(w, w) & 0xffffu; const float lo = w - bf2f((bf16_t)hi);
                    *(LAS bf16_t*)(lds + e * RT_WS + k * 2) = (bf16_t)hi; *(LAS bf16_t*)(lds + RT_LO + e * RT_WS + k * 2) = (bf16_t)(pk2(lo, lo) & 0xffffu); }
                { const int e = tid & 31, part = tid >> 5; float s = 0.f;
                  for (int k = part * 64; k < part * 64 + 64; ++k) s += mod[3 * 1024 + k] * a.in[I_WROUTER][k * 32 + e];
                  LAS float* part_s = (LAS float*)(lds + RT_SCR); part_s[part * 32 + e] = s; }
                __syncthreads();
                if (tid < 32) { float s = 0.f; for (int p = 0; p < 16; ++p) s += ((LAS float*)(lds + RT_SCR))[p * 32 + tid]; biasl[tid] = s; }
                __syncthreads();
                curb = bsel;
            }
            if (act && row_modidx(tile << 4) == bsel) {
                const int row = (tile << 4) + r16;
                const float* xr = row < ML ? xl + (size_t)row * D : xc + (size_t)(row - ML) * D;
                f32x4 acc0 = (f32x4){0.f, 0.f, 0.f, 0.f}, acc1 = acc0; float ss = 0.f;
#pragma unroll 4
                for (int ks = 0; ks < 32; ++ks) {
                    const f32x4 xa = *(const f32x4*)(xr + ks * 32 + 8 * g), xb = *(const f32x4*)(xr + ks * 32 + 8 * g + 4);
                    ss += (xa.x * xa.x + xa.y * xa.y) + (xa.z * xa.z + xa.w * xa.w) + (xb.x * xb.x + xb.y * xb.y) + (xb.z * xb.z + xb.w * xb.w);
                    u32x4 hw; hw.x = pk2(xa.x, xa.y); hw.y = pk2(xa.z, xa.w); hw.z = pk2(xb.x, xb.y); hw.w = pk2(xb.z, xb.w);
                    u32x4 lw; lw.x = pk2(xa.x - bflo(hw.x), xa.y - bfhi(hw.x)); lw.y = pk2(xa.z - bflo(hw.y), xa.w - bfhi(hw.y)); lw.z = pk2(xb.x - bflo(hw.z), xb.y - bfhi(hw.z)); lw.w = pk2(xb.z - bflo(hw.w), xb.w - bfhi(hw.w));
                    const bf16x8 Ah = __builtin_bit_cast(bf16x8, hw), Al = __builtin_bit_cast(bf16x8, lw);
                    const LAS unsigned char* wp = lds + r16 * RT_WS + (ks * 32 + 8 * g) * 2;
                    const bf16x8 B0h = *(const LAS bf16x8*)wp, B1h = *(const LAS bf16x8*)(wp + 16 * RT_WS), B0l = *(const LAS bf16x8*)(wp + RT_LO), B1l = *(const LAS bf16x8*)(wp + RT_LO + 16 * RT_WS);
                    acc0 = __builtin_amdgcn_mfma_f32_16x16x32_bf16(Ah, B0h, acc0, 0, 0, 0); acc0 = __builtin_amdgcn_mfma_f32_16x16x32_bf16(Al, B0h, acc0, 0, 0, 0); acc0 = __builtin_amdgcn_mfma_f32_16x16x32_bf16(Ah, B0l, acc0, 0, 0, 0);
                    acc1 = __builtin_amdgcn_mfma_f32_16x16x32_bf16(Ah, B1h, acc1, 0, 0, 0); acc1 = __builtin_amdgcn_mfma_f32_16x16x32_bf16(Al, B1h, acc1, 0, 0, 0); acc1 = __builtin_amdgcn_mfma_f32_16x16x32_bf16(Ah, B1l, acc1, 0, 0, 0);
                }
                ss += __shfl_xor(ss, 16); ss += __shfl_xor(ss, 32);
                const float rstd = rsqrtf(ss * (1.f / 1024.f) + EPS);
                if (g == 0) { rsl[r16] = rstd; tokR[row] = rstd; }
                LDS_WAIT(); asm volatile("" ::: "memory");
#pragma unroll
                for (int j = 0; j < 4; ++j) { const float rs = rsl[4 * g + j]; lg[(4 * g + j) * 33 + r16] = acc0[j] * rs + biasl[r16]; lg[(4 * g + j) * 33 + 16 + r16] = acc1[j] * rs + biasl[16 + r16]; }
                LDS_WAIT(); asm volatile("" ::: "memory");
                if (lane < 16) {
                    const int rrow = (tile << 4) + lane;
                    float sc[32], bestg = -1e30f; int gi = 0;
#pragma unroll
                    for (int e = 0; e < 32; ++e) sc[e] = sigmoidf_(lg[lane * 33 + e]);
#pragma unroll
                    for (int gg = 0; gg < 8; ++gg) {
                        float s4[4];
#pragma unroll
                        for (int j = 0; j < 4; ++j) s4[j] = sc[gg * 4 + j] + a.in[I_RBIAS][gg * 4 + j];
                        const float m01 = fmaxf(s4[0], s4[1]), n01 = fminf(s4[0], s4[1]), m23 = fmaxf(s4[2], s4[3]), n23 = fminf(s4[2], s4[3]);
                        const float top = fmaxf(m01, m23), second = fmaxf(fminf(m01, m23), (m01 >= m23) ? n01 : n23);
                        const float gs = top + second;
                        if (gs > bestg) { bestg = gs; gi = gg; }
                    }
                    float s4[4], w4[4];
#pragma unroll
                    for (int j = 0; j < 4; ++j) { float sv = 0.f, wv = 0.f;
#pragma unroll
                        for (int gg = 0; gg < 8; ++gg) { if (gg == gi) { sv = sc[gg * 4 + j] + a.in[I_RBIAS][gg * 4 + j]; wv = sc[gg * 4 + j]; } }
                        s4[j] = sv; w4[j] = wv; }
                    int i0 = 0; float v0 = s4[0];
#pragma unroll
                    for (int j = 1; j < 4; ++j) if (s4[j] > v0) { v0 = s4[j]; i0 = j; }
                    int i1 = -1; float v1 = -1e30f;
#pragma unroll
                    for (int j = 0; j < 4; ++j) if (j != i0 && s4[j] > v1) { v1 = s4[j]; i1 = j; }
                    float w0 = 0.f, w1 = 0.f;
#pragma unroll
                    for (int j = 0; j < 4; ++j) { if (j == i0) w0 = w4[j]; if (j == i1) w1 = w4[j]; }
                    const float inv = 1.0f / (w0 + w1);
                    const int e0 = gi * 4 + i0, e1 = gi * 4 + i1;
                    const unsigned s0 = __hip_atomic_fetch_add(&lcnt[e0], 1u, __ATOMIC_RELAXED, __HIP_MEMORY_SCOPE_WORKGROUP), s1 = __hip_atomic_fetch_add(&lcnt[e1], 1u, __ATOMIC_RELAXED, __HIP_MEMORY_SCOPE_WORKGROUP);
                    tokE[rrow] = (unsigned)e0 | ((unsigned)e1 << 8); tokS[rrow] = s0 | (s1 << 16); tokW[rrow] = (f32x2){w0 * inv, w1 * inv};
                }
            }
        }
    }
    __syncthreads();
    if (tid < 32) ((unsigned*)(a.ws + WS_TOK + TOK_BCNT))[blk * 32 + tid] = lcnt[tid];
}

__device__ __forceinline__ void phase_gather(const KArgs& a, LAS unsigned char* lds, int l, int nrows) {
    const int tid = OTID(), lane = tid & 63, wave = tid >> 6, blk = OBLK(), G = OGRID();
    LAS unsigned* tot = (LAS unsigned*)lds;
    LAS unsigned* bef = tot + 32;
    LAS unsigned* base = tot + 64;
    const unsigned* bc = (const unsigned*)(a.ws + WS_TOK + TOK_BCNT);
    { LAS unsigned* ptot = tot + 96; LAS unsigned* pbef = ptot + 512;
      const int e = tid & 31, part = tid >> 5; unsigned t = 0u, bf = 0u;
#pragma unroll
      for (int k = 0; k < 16; ++k) { const int g = part * 16 + k; const unsigned c = (g < G) ? bc[g * 32 + e] : 0u; t += c; bf += (g < blk) ? c : 0u; }
      ptot[tid] = t; pbef[tid] = bf;
      __syncthreads();
      if (tid < 32) { unsigned tt = 0u, bb = 0u;
#pragma unroll
          for (int p = 0; p < 16; ++p) { tt += ptot[p * 32 + tid]; bb += pbef[p * 32 + tid]; }
          tot[tid] = tt; bef[tid] = bb; } }
    __syncthreads();
    if (tid == 0) {
        unsigned pos = 0u; int* tile_e = (int*)(a.ws + WS_TOK + TOK_TILE);
#pragma unroll 1
        for (int e = 0; e < 32; ++e) { base[e] = pos + bef[e]; const unsigned nt = (tot[e] + 255u) >> 8;
            if (blk == 0) tile_e[e] = (int)(pos >> 8);
            pos += nt << 8; }
        if (blk == 0) tile_e[32] = (int)(pos >> 8);
    }
    __syncthreads();
    const unsigned* tokE = (const unsigned*)(a.ws + WS_TOK + TOK_E); const unsigned* tokS = (const unsigned*)(a.ws + WS_TOK + TOK_SLOT); u32x2* tokP = (u32x2*)(a.ws + WS_TOK + TOK_POS);
    const float* tokR = (const float*)(a.ws + WS_TOK + TOK_RSTD);
    bf16_t* xb = (bf16_t*)(a.ws + WS_XB);
    const float* xl = a.out; const float* xc = (const float*)(a.ws + WS_XC);
    const int ntile = nrows >> 4, per = (ntile + G - 1) / G, r0 = blk * per * 16, r1 = ((blk + 1) * per * 16 < nrows) ? (blk + 1) * per * 16 : nrows;
    unsigned en = 0u, sn = 0u; float rn = 0.f;
    if (r0 + wave < r1) { en = tokE[r0 + wave]; sn = tokS[r0 + wave]; rn = tokR[r0 + wave]; }
    for (int row = r0 + wave; row < r1; row += NWAVES) {
        const unsigned e = en, s = sn; const float rstd_pre = rn;
        if (row + NWAVES < r1) { en = tokE[row + NWAVES]; sn = tokS[row + NWAVES]; rn = tokR[row + NWAVES]; }
        const unsigned p0 = base[e & 255u] + (s & 0xffffu), p1 = base[(e >> 8) & 255u] + (s >> 16);
        const float* xr = row < ML ? xl + (size_t)row * D : xc + (size_t)(row - ML) * D;
        const float rstd = rstd_pre;
        const float* mod = (const float*)(a.ws + WS_MOD) + (size_t)(l * 9 + row_modidx(row)) * 6144; const float* gain = a.in[I_NORM2] + l * D;
#pragma unroll
        for (int j = 0; j < 4; ++j) {
            const f32x4 x = ((const f32x4*)xr)[lane + 64 * j], gv = ((const f32x4*)gain)[lane + 64 * j], s1 = ((const f32x4*)(mod + 4 * 1024))[lane + 64 * j], s0 = ((const f32x4*)(mod + 3 * 1024))[lane + 64 * j];
            const f32x4 y = (x * rstd * gv) * (s1 + 1.0f) + s0;
            u32x2 o; o.x = pk2(y.x, y.y); o.y = pk2(y.z, y.w);
            ((u32x2*)(xb + (size_t)p0 * D))[lane + 64 * j] = o; ((u32x2*)(xb + (size_t)p1 * D))[lane + 64 * j] = o;
        }
        if (lane == 0) tokP[row] = (u32x2){p0, p1};
    }
}

__device__ __forceinline__ void phase_combine(const KArgs& a, int l, int nrows) {
    const int tid = OTID(), lane = tid & 63, wave = tid >> 6;
    const int gw = OBLK() * NWAVES + wave, NGW = OGRID() * NWAVES;
    const u32x2* tokP = (const u32x2*)(a.ws + WS_TOK + TOK_POS); const f32x2* tokW = (const f32x2*)(a.ws + WS_TOK + TOK_W);
    const bf16_t* yb = (const bf16_t*)(a.ws + WS_YB); bf16_t* hl = (bf16_t*)(a.ws + WS_HL);
    u32x2 pn = (u32x2){0u, 0u}; f32x2 wn = (f32x2){0.f, 0.f};
    if (gw < nrows) { pn = tokP[gw]; wn = tokW[gw]; }
    for (int row = gw; row < nrows; row += NGW) {
        float* xr = row < ML ? a.out + (size_t)row * D : (float*)(a.ws + WS_XC) + (size_t)(row - ML) * D;
        const u32x2 p = pn; const f32x2 w = wn;
        if (row + NGW < nrows) { pn = tokP[row + NGW]; wn = tokW[row + NGW]; }
        const float* mod = (const float*)(a.ws + WS_MOD) + (size_t)(l * 9 + row_modidx(row)) * 6144;
        f32x4 v[4];
#pragma unroll
        for (int j = 0; j < 4; ++j) {
            const f32x4 x = ((const f32x4*)xr)[lane + 64 * j], g2 = ((const f32x4*)(mod + 5 * 1024))[lane + 64 * j];
            const u32x2 y0 = ((const u32x2*)(yb + (size_t)p.x * D))[lane + 64 * j], y1 = ((const u32x2*)(yb + (size_t)p.y * D))[lane + 64 * j];
            f32x4 m; m.x = w.x * bflo(y0.x) + w.y * bflo(y1.x); m.y = w.x * bfhi(y0.x) + w.y * bfhi(y1.x); m.z = w.x * bflo(y0.y) + w.y * bflo(y1.y); m.w = w.x * bfhi(y0.y) + w.y * bfhi(y1.y);
            v[j] = x + g2 * m; ((f32x4*)xr)[lane + 64 * j] = v[j];
        }
        if (l == 0) { const float* mod1 = (const float*)(a.ws + WS_MOD) + (size_t)(9 + row_modidx(row)) * 6144;
            modulate_store(v, a.in[I_NORM1] + D, mod1, mod1 + 1024, hl + (size_t)row * D, lane); }
    }
}
#ifndef MK_PER_PHASE
#define MK_PER_PHASE 0
#endif
#ifndef PROBE_DUP
#define PROBE_DUP 0
#endif
#define DUPON(k) ((PROBE_DUP >> (k)) & 1)
#define DUPBAR() do { if (use_bar) xcd_barrier(bar); } while (0)
#ifndef RERUN_K
#define RERUN_K 0
#endif
#define RERUN(k, l, ctx_out, mrows) do { if (RERUN_K == (k)) { DUPBAR(); ph_modulate1(ka, (l), MA); DUPBAR(); ph_gemm_in(ka, lds, (l)); DUPBAR(); ph_prep(ka, (l)); \
        if ((k) >= 3) { DUPBAR(); ph_mixers(ka, lds, (l), ctx_out); } if ((k) >= 4) { DUPBAR(); ph_gdnscan(ka, lds, (l), ctx_out, (l) + 2); } \
        if ((k) >= 5) { DUPBAR(); ph_post(ka, lds, (l), mrows); } } } while (0)
constexpr int NPH_LAYER = 14, NPHASES = 1 + 2 * NPH_LAYER;

__device__ NOINL void ph_prologue(KAP ka, LAS unsigned char* lds) { const KArgs a = load_kargs(ka); phase_prologue(a, lds); }
__device__ NOINL void ph_modulate1(KAP ka, int l, int nrows) { const KArgs a = load_kargs(ka); phase_modulate1(a, l, nrows); }
__device__ NOINL void ph_prep(KAP ka, int l) { const KArgs a = load_kargs(ka); phase_prep(a, l); }
__device__ NOINL void ph_mixers(KAP ka, LAS unsigned char* lds, int l, bool ctx_out) { phase_mixers(ka, lds, l, ctx_out); }
__device__ NOINL void ph_gdnscan(KAP ka, LAS unsigned char* lds, int l, bool ctx_out, int qslot) { phase_scan_attn(ka, lds, l, ctx_out, qslot); }
__device__ NOINL void ph_post(KAP ka, LAS unsigned char* lds, int l, int mrows) { { const int blk = OBLK(), G = OGRID(); for (int u = blk; u < 32 * 34; u += G) { if (mrows == ML && (u % 34) < 2) continue; call_retout(ka, lds, l, u); } }
    const KArgs a = load_kargs(ka); phase_post(a, l, mrows); }
__device__ NOINL void ph_gemm_in(KAP ka, LAS unsigned char* lds, int l) { const KArgs a = load_kargs(ka);
    const bf16_t* wsm = (const bf16_t*)(a.ws + WS_WSM);
    SchedPlain S; S.init(a.ws + WS_HL, 1024, wsm + WSM_IN / 2, 1024, MA, ZP, OGRID(), OBLK());
    EpiStore<0> E{(bf16_t*)(a.ws + WS_Z), ZP};
    pg8::gemm_phase<EpiStore<0>, SchedPlain, true>(lds, 1024, 1024, 1024, S, E); }
__device__ NOINL void ph_gemm_gate(KAP ka, LAS unsigned char* lds, int l, int mrows) { const KArgs a = load_kargs(ka);
    const bf16_t* wsm = (const bf16_t*)(a.ws + WS_WSM);
    SchedPlain S; S.init(a.ws + WS_HL, 1024, wsm + WSM_MERGE / 2, 1024, mrows, 4096, OGRID(), OBLK());
    EpiGateF E{(bf16_t*)(a.ws + WS_Z)};
    pg8::gemm_phase<EpiGateF, SchedPlain, true>(lds, 1024, 1024, 1024, S, E); }
__device__ NOINL void ph_gemm_branch(KAP ka, LAS unsigned char* lds, int l, int mrows) { const KArgs a = load_kargs(ka);
    const bf16_t* wsm = (const bf16_t*)(a.ws + WS_WSM);
    SchedBranch S{(const char*)(a.ws + WS_Z), (const char*)(wsm + WSM_BR / 2), (mrows / 256) * 4, OGRID(), OBLK()};
    EpiBranch E{(bf16_t*)(a.ws + WS_HL), (const bf16_t*)(a.ws + WS_Z)};
    pg8::gemm_phase<EpiBranch, SchedBranch, true>(lds, 512, ZP, 512, S, E); }
__device__ NOINL void ph_gemm_out(KAP ka, LAS unsigned char* lds, int l, int mrows) { const KArgs a = load_kargs(ka);
    const bf16_t* wsm = (const bf16_t*)(a.ws + WS_WSM);
    SchedPlain S; S.init(a.ws + WS_HL, 1024, wsm + WSM_OUT / 2, 1024, mrows, 1024, OGRID(), OBLK());
    EpiResid E{l == 0 ? a.in[I_X] : a.out, l == 0 ? a.in[I_CTX] : (const float*)(a.ws + WS_XC), a.out, (float*)(a.ws + WS_XC), (const float*)(a.ws + WS_MOD) + (size_t)l * 9 * 6144 + 2 * 1024};
    pg8::gemm_phase<EpiResid, SchedPlain, true>(lds, 1024, 1024, 1024, S, E); }
#ifndef EXPC_SPLIT
#define EXPC_SPLIT 14000
#endif
__device__ NOINL void ph_expconv(KAP ka, LAS unsigned char* lds, int l, int lo, int hi, int blk0) { const KArgs a = load_kargs(ka); expert_convert_range(a, lds, l, lo, hi, blk0); }
__device__ NOINL void ph_route(KAP ka, LAS unsigned char* lds, int l, int mrows) { const KArgs a = load_kargs(ka); phase_route(a, lds, l, mrows); if (l == 0) { __syncthreads(); small_weight_convert(a, lds, 1); } }
__device__ NOINL void ph_gather(KAP ka, LAS unsigned char* lds, int l, int mrows) { const KArgs a = load_kargs(ka); phase_gather(a, lds, l, mrows); }
__device__ NOINL void ph_gemm_gu(KAP ka, LAS unsigned char* lds) { const KArgs a = load_kargs(ka);
    const int* tile_e = (const int*)(a.ws + WS_TOK + TOK_TILE);
    SchedMoe S; S.A0 = (const char*)(a.ws + WS_XB); S.W0 = (const char*)(a.ws + WS_WGU); S.tile_start = tile_e; S.tA = (size_t)256 * 1024 * 2; S.eB = (size_t)1024 * 1024 * 2; S.tB = (size_t)256 * 1024 * 2; S.G = OGRID(); S.c = OBLK(); S.init();
    EpiAct E{(bf16_t*)(a.ws + WS_ACT)};
    pg8::gemm_phase<EpiAct, SchedMoe, true>(lds, 1024, 1024, 1024, S, E); }
__device__ NOINL void ph_gemm_dn(KAP ka, LAS unsigned char* lds) { const KArgs a = load_kargs(ka);
    const int* tile_e = (const int*)(a.ws + WS_TOK + TOK_TILE);
    SchedMoe S; S.A0 = (const char*)(a.ws + WS_ACT); S.W0 = (const char*)(a.ws + WS_WDN); S.tile_start = tile_e; S.tA = (size_t)256 * 512 * 2; S.eB = (size_t)1024 * 512 * 2; S.tB = (size_t)256 * 512 * 2; S.G = OGRID(); S.c = OBLK(); S.init();
    EpiStore<0> E{(bf16_t*)(a.ws + WS_YB), 1024};
    pg8::gemm_phase<EpiStore<0>, SchedMoe, true>(lds, 512, 512, 512, S, E); }
__device__ NOINL void ph_combine(KAP ka, int l, int mrows) { const KArgs a = load_kargs(ka); phase_combine(a, l, mrows); }

__global__ void __launch_bounds__(NTHR, 2) fwd_kernel(KArgs a) {
    extern __shared__ __attribute__((aligned(16))) unsigned char lds_raw[];
    LAS unsigned char* lds = (LAS unsigned char*)lds_raw;
    KAP ka = (KAP)__builtin_amdgcn_kernarg_segment_ptr();
    const int tid = OTID();
    volatile LAS unsigned* ctlw = (volatile LAS unsigned*)(lds + LDS_CTL);
    if (tid < 64) ctlw[tid] = 0u;
    __syncthreads();
    const int lo = a.ph_lo, hi = a.ph_hi;
    const bool use_bar = (hi - lo) > 1;
    XcdBarrier bar; bar.bar = (unsigned*)(a.ws + WS_CTL) + CW_BAR; bar.x = 0u; bar.st = ctlw + 8;
    if (use_bar) bar = xcd_barrier_post((unsigned*)(a.ws + WS_CTL) + CW_BAR, ctlw + 8);
#define IN(k) (lo <= (k) && (k) < hi)
#define SEAM(k) do { if (use_bar && (k) + 1 < hi) xcd_barrier(bar); } while (0)
    if (IN(0)) { ph_prologue(ka, lds); SEAM(0); }
#define LAYER_BODY(l) do { \
        constexpr int pb = 1 + (l) * NPH_LAYER; constexpr bool ctx_out = ((l) == 0); constexpr int mrows = ctx_out ? MA : ML; \
        if ((l) == 0 && IN(pb + 0)) { ph_modulate1(ka, (l), MA); SEAM(pb + 0); }     \
        if (IN(pb + 1)) { ph_gemm_in(ka, lds, (l)); if (RERUN_K == 1) { DUPBAR(); ph_modulate1(ka, (l), MA); DUPBAR(); ph_gemm_in(ka, lds, (l)); } SEAM(pb + 1); } \
        if (IN(pb + 2)) { ph_prep(ka, (l)); RERUN(2, l, ctx_out, mrows); SEAM(pb + 2); } \
        if (IN(pb + 3)) { ph_mixers(ka, lds, (l), ctx_out); RERUN(3, l, ctx_out, mrows); SEAM(pb + 3); } \
        if (IN(pb + 4)) { ph_gdnscan(ka, lds, (l), ctx_out, (l)); RERUN(4, l, ctx_out, mrows); SEAM(pb + 4); } \
        if (IN(pb + 5)) { ph_post(ka, lds, (l), mrows); RERUN(5, l, ctx_out, mrows); SEAM(pb + 5); } \
        if (IN(pb + 6)) { ph_gemm_gate(ka, lds, (l), mrows); if ((l) == 0) ph_expconv(ka, lds, (l), 0, 4400, 128); SEAM(pb + 6); } \
        if (IN(pb + 7)) { ph_gemm_branch(ka, lds, (l), mrows); if ((l) == 0) ph_expconv(ka, lds, (l), 4400, 4400 + EXPC_SPLIT, 32); SEAM(pb + 7); } \
        if (IN(pb + 8)) { ph_gemm_out(ka, lds, (l), mrows); ph_expconv(ka, lds, (l), (l) == 0 ? 4400 + EXPC_SPLIT : 0, EXPC_ITEMS, 0); SEAM(pb + 8); } \
        if (IN(pb + 9)) { ph_route(ka, lds, (l), mrows); if (DUPON(9)) { DUPBAR(); ph_route(ka, lds, (l), mrows); } SEAM(pb + 9); } \
        if (IN(pb + 10)) { ph_gather(ka, lds, (l), mrows); if (DUPON(10)) { DUPBAR(); ph_gather(ka, lds, (l), mrows); } SEAM(pb + 10); } \
        if (IN(pb + 11)) { ph_gemm_gu(ka, lds); if (DUPON(11)) { DUPBAR(); ph_gemm_gu(ka, lds); } SEAM(pb + 11); } \
        if (IN(pb + 12)) { ph_gemm_dn(ka, lds); if (DUPON(12)) { DUPBAR(); ph_gemm_dn(ka, lds); } if (RERUN_K == 12) { DUPBAR(); ph_route(ka, lds, (l), mrows); DUPBAR(); ph_gather(ka, lds, (l), mrows); DUPBAR(); ph_gemm_gu(ka, lds); DUPBAR(); ph_gemm_dn(ka, lds); } SEAM(pb + 12); } \
        if (IN(pb + 13)) { ph_combine(ka, (l), mrows); SEAM(pb + 13); } \
    } while (0)
    LAYER_BODY(0);
    LAYER_BODY(1);
#undef LAYER_BODY
#undef IN
#undef SEAM
}

extern "C" void kernel_launch(void* const* d_in, const int* in_sizes, int n_in, void* d_out, int out_size, void* d_ws, size_t ws_size, hipStream_t stream) {
    static int grid = 0;
    if (grid == 0) {
        if (n_in != 29 || in_sizes[0] != ML * D || out_size != ML * D || ws_size < WS_END) {
            fprintf(stderr, "kernel_launch: unexpected problem (n_in %d, in0 %d, out %d, ws %zu < %zu); nothing launched\n", n_in, n_in > 0 ? in_sizes[0] : -1, out_size, ws_size, (size_t)WS_END); grid = -1; return; }
        int dev = 0, cus = 0, per_cu = 0;
        if (hipGetDevice(&dev) != hipSuccess || hipDeviceGetAttribute(&cus, hipDeviceAttributeMultiprocessorCount, dev) != hipSuccess) { grid = -1; return; }
        if (hipFuncSetAttribute((const void*)fwd_kernel, hipFuncAttributeMaxDynamicSharedMemorySize, LDS_BYTES) != hipSuccess) { fprintf(stderr, "kernel_launch: hipFuncSetAttribute failed\n"); grid = -1; return; }
        if (hipOccupancyMaxActiveBlocksPerMultiprocessor(&per_cu, (const void*)fwd_kernel, NTHR, LDS_BYTES) != hipSuccess || per_cu < 1) {
            fprintf(stderr, "kernel_launch: occupancy query says %d workgroups per CU\n", per_cu); }
        (void)hipGetLastError();
        grid = cus;
        if (grid > 256) grid = 256;
    }
    if (grid < 0) return;
    if (hipMemsetAsync((char*)d_ws + WS_CTL, 0, CTL_ZERO_BYTES, stream) != hipSuccess) return;
    KArgs a{};
    for (int i = 0; i < 29; ++i) a.in[i] = (const float*)d_in[i];
    a.out = (float*)d_out; a.ws = (unsigned char*)d_ws;
#if MK_PER_PHASE
    for (int k = 0; k < NPHASES; ++k) { if (k == 1 + NPH_LAYER) continue; a.ph_lo = k; a.ph_hi = k + 1; hipLaunchKernelGGL(fwd_kernel, dim3(grid), dim3(NTHR), LDS_BYTES, stream, a); }
#else
    a.ph_lo = 0; a.ph_hi = NPHASES;
    hipLaunchKernelGGL(fwd_kernel, dim3(grid), dim3(NTHR), LDS_BYTES, stream, a);
#endif
}
```

```cpp
#include <hip/hip_runtime.h>
#include <cstdio>
#include <cstdint>

#define LAS __attribute__((address_space(3)))
#define GAS __attribute__((address_space(1)))
typedef unsigned short bf16_t;
typedef short bf16x8 __attribute__((ext_vector_type(8)));
typedef short s16x4 __attribute__((ext_vector_type(4)));
typedef float f32x4 __attribute__((ext_vector_type(4)));
typedef float f32x2 __attribute__((ext_vector_type(2)));
typedef unsigned u32x4 __attribute__((ext_vector_type(4)));
typedef unsigned u32x2 __attribute__((ext_vector_type(2)));

typedef __bf16 bf16x2_t __attribute__((ext_vector_type(2)));
__device__ __forceinline__ unsigned pk2(float lo, float hi) { const f32x2 v = {lo, hi}; const bf16x2_t b = __builtin_convertvector(v, bf16x2_t); return __builtin_bit_cast(unsigned, b); }
__device__ __forceinline__ unsigned f2bf(float f) { return pk2(f, f) & 0xffffu; }
__device__ __forceinline__ float bflo(unsigned u) { return __builtin_bit_cast(float, u << 16); }
__device__ __forceinline__ float bfhi(unsigned u) { return __builtin_bit_cast(float, u & 0xffff0000u); }
__device__ __forceinline__ float bf2f(bf16_t h) { return __builtin_bit_cast(float, (unsigned)h << 16); }
__device__ __forceinline__ float sigmoidf_(float x) { return 1.0f / (1.0f + __expf(-x)); }
__device__ __forceinline__ float siluf_(float x) { return x / (1.0f + __expf(-x)); }
__device__ __forceinline__ float sigmoid_fast(float x) { return __builtin_amdgcn_rcpf(1.0f + __expf(-x)); }
__device__ __forceinline__ float silu_fast(float x) { return x * __builtin_amdgcn_rcpf(1.0f + __expf(-x)); }

__device__ __forceinline__ bf16x8 cat8(u32x2 lo, u32x2 hi) { u32x4 w; w.x = lo.x; w.y = lo.y; w.z = hi.x; w.w = hi.y; return __builtin_bit_cast(bf16x8, w); }
__device__ __forceinline__ int OTID() { int t = threadIdx.x; asm volatile("" : "+v"(t)); return t; }
__device__ __forceinline__ int OBLK() { int t = blockIdx.x; asm volatile("" : "+s"(t)); return t; }
__device__ __forceinline__ int OGRID() { int t = gridDim.x; asm volatile("" : "+s"(t)); return t; }

namespace pg8 {
constexpr int BM = 256, BK = 64, HALF = 128, HTB = HALF * BK * 2, STAGE_BYTES = 8 * HTB, NXCD = 8, WGM = 8;
__host__ __device__ __forceinline__ int lds_byte(int r, int c) { const int st = (r >> 4) * 2 + (c >> 5), rr = r & 15, cc = c & 31, ob = rr * 64 + cc * 2; return st * 1024 + (ob ^ (((ob >> 9) & 1) << 5)); }
__host__ __device__ __forceinline__ void stage_rc(int b, int& R, int& C) { const int st = b / 1024, sb = b % 1024, swz = sb ^ (((sb >> 9) & 1) << 5); R = (st >> 1) * 16 + swz / 64; C = (st & 1) * 32 + (swz % 64) / 2; }
__host__ __device__ __forceinline__ int perm32(int rho) { const int n = rho >> 4, i = rho & 15; return 8 * (i >> 2) + 4 * n + (i & 3); }

struct Unit { int pm, pn, aux; };

template <class Epi, class Sched, bool ALIGN_EPI>
__device__ __forceinline__ void gemm_phase(LAS unsigned char* lds, const int K, const int lda, const int ldb, const Sched& S, const Epi& E) {
    const int tid = OTID(), wid = __builtin_amdgcn_readfirstlane(tid >> 6), lane = tid & 63, wr = wid >> 2, wc = wid & 3, fr = lane & 15, fq = lane >> 4;
    const int nt = K / BK;
    unsigned voffA[2], voffB[2];
#pragma unroll
    for (int i = 0; i < 2; ++i) { int R, C; stage_rc(tid * 16 + i * 8192, R, C); const int Rb = (R & ~31) + perm32(R & 31);
        voffA[i] = (unsigned)(R * lda + C) * 2u; voffB[i] = (unsigned)(Rb * ldb + C) * 2u; }
    const size_t kstep = (size_t)(BK * 2);
    const size_t hstepA = (size_t)HALF * lda * 2, hstepB = (size_t)HALF * ldb * 2;
    const unsigned ldsw = (unsigned)wid * 1024u;
    const int aoff = lds_byte(wr * 64 + fr, fq * 8), boff = lds_byte(wc * 32 + fr, fq * 8);
#define PG8_SA(b, h) (((b) * 2 + (h)) * HTB)
#define PG8_SB(b, h) ((4 + (b) * 2 + (h)) * HTB)
#define PG8_STAGE(bufoff, gbase, voff) do { _Pragma("unroll") for (int _i = 0; _i < 2; ++_i) \
        __builtin_amdgcn_global_load_lds((const unsigned*)((const char*)(gbase) + (voff)[_i]), (LAS unsigned*)(lds + (bufoff) + ldsw + _i * 8192), 16, 0, 0); } while (0)
#define PG8_LDA(dst, b, h) do { _Pragma("unroll") for (int m = 0; m < 4; ++m) _Pragma("unroll") for (int k = 0; k < 2; ++k) dst[m][k] = *(const LAS bf16x8*)(lds + PG8_SA(b, h) + aoff + m * 2048 + k * 1024); } while (0)
#define PG8_LDB(dst, b, h) do { _Pragma("unroll") for (int n = 0; n < 2; ++n) _Pragma("unroll") for (int k = 0; k < 2; ++k) dst[n][k] = *(const LAS bf16x8*)(lds + PG8_SB(b, h) + boff + n * 2048 + k * 1024); } while (0)
#define PG8_MMA(ai, bj, At, Bt) do { __builtin_amdgcn_s_setprio(1); _Pragma("unroll") for (int m = 0; m < 4; ++m) _Pragma("unroll") for (int n = 0; n < 2; ++n) _Pragma("unroll") for (int k = 0; k < 2; ++k) \
        acc[ai][bj][m][n] = __builtin_amdgcn_mfma_f32_16x16x32_bf16(Bt[n][k], At[m][k], acc[ai][bj][m][n], 0, 0, 0); __builtin_amdgcn_s_setprio(0); } while (0)
#define PG8_WAIT_V(n) asm volatile("s_waitcnt vmcnt(" #n ")" ::: "memory")
#define PG8_WAIT_L(n) asm volatile("s_waitcnt lgkmcnt(" #n ")" ::: "memory")
#define PG8_BAR __builtin_amdgcn_s_barrier()
#define PG8_SCHED __builtin_amdgcn_sched_barrier(0)
    Unit cur, nxt; int ui = 0;
    if (!S.next(0, cur)) return;
    f32x4 acc[2][2][4][2];
#pragma unroll
    for (int a = 0; a < 2; ++a)
#pragma unroll
        for (int b = 0; b < 2; ++b)
#pragma unroll
            for (int m = 0; m < 4; ++m)
#pragma unroll
                for (int n = 0; n < 2; ++n) acc[a][b][m][n] = (f32x4){0.f, 0.f, 0.f, 0.f};
    bf16x8 At[4][2], B0[2][2], B1[2][2];
    const char* cA = S.A(cur); const char* cB = S.B(cur);
    PG8_STAGE(PG8_SB(0, 0), cB, voffB); PG8_STAGE(PG8_SB(0, 1), cB + hstepB, voffB); PG8_STAGE(PG8_SA(0, 0), cA, voffA); PG8_STAGE(PG8_SA(0, 1), cA + hstepA, voffA);
    if (wr == 1) PG8_BAR;
    PG8_WAIT_V(2); PG8_BAR;
    PG8_STAGE(PG8_SB(1, 0), cB + kstep, voffB); PG8_STAGE(PG8_SA(1, 0), cA + kstep, voffA); PG8_STAGE(PG8_SB(1, 1), cB + hstepB + kstep, voffB);
    PG8_WAIT_V(6); PG8_BAR;
    for (;;) {
        const bool has_next = S.next(ui + 1, nxt);
        const char* nA = has_next ? S.A(nxt) : cA; const char* nB = has_next ? S.B(nxt) : cB;
        for (int t = 0; t < nt; t += 2) {
            const bool last = (t == nt - 2);
            const char* a1 = cA + (size_t)(t + 1) * kstep;
            const char* a2 = last ? nA : cA + (size_t)(t + 2) * kstep; const char* b2 = last ? nB : cB + (size_t)(t + 2) * kstep;
            const char* a3 = a2 + kstep; const char* b3 = b2 + kstep;
            PG8_LDB(B0, 0, 0); PG8_LDB(B1, 0, 1); PG8_SCHED; PG8_LDA(At, 0, 0); PG8_STAGE(PG8_SA(1, 1), a1 + hstepA, voffA);
            PG8_WAIT_V(8); PG8_WAIT_L(0); PG8_BAR; PG8_MMA(0, 0, At, B0); PG8_MMA(0, 1, At, B1); PG8_BAR; PG8_SCHED;
            PG8_LDA(At, 0, 1); PG8_STAGE(PG8_SB(0, 0), b2, voffB); PG8_STAGE(PG8_SB(0, 1), b2 + hstepB, voffB); PG8_STAGE(PG8_SA(0, 0), a2, voffA);
            PG8_WAIT_V(8); PG8_WAIT_L(0); PG8_BAR; PG8_MMA(1, 0, At, B0); PG8_MMA(1, 1, At, B1); PG8_BAR; PG8_SCHED;
            PG8_LDB(B0, 1, 0); PG8_LDB(B1, 1, 1); PG8_SCHED; PG8_LDA(At, 1, 0); PG8_STAGE(PG8_SA(0, 1), a2 + hstepA, voffA);
            PG8_WAIT_V(8); PG8_WAIT_L(0); PG8_BAR; PG8_MMA(0, 0, At, B0); PG8_MMA(0, 1, At, B1); PG8_BAR; PG8_SCHED;
            PG8_LDA(At, 1, 1); PG8_STAGE(PG8_SB(1, 0), b3, voffB); PG8_STAGE(PG8_SB(1, 1), b3 + hstepB, voffB); PG8_STAGE(PG8_SA(1, 0), a3, voffA);
            PG8_WAIT_V(8); PG8_WAIT_L(0); PG8_BAR; PG8_MMA(1, 0, At, B0); PG8_MMA(1, 1, At, B1); PG8_BAR; PG8_SCHED;
        }
        if constexpr (ALIGN_EPI) { if (wr == 0) PG8_BAR; }
        E(acc, cur, wr, wc, fr, fq);
        if (!has_next) break;
        if constexpr (!Epi::INPLACE) {
#pragma unroll
        for (int a = 0; a < 2; ++a)
#pragma unroll
            for (int b = 0; b < 2; ++b)
#pragma unroll
                for (int m = 0; m < 4; ++m)
#pragma unroll
                    for (int n = 0; n < 2; ++n) acc[a][b][m][n] = (f32x4){0.f, 0.f, 0.f, 0.f};
        }
        cur = nxt; cA = nA; cB = nB; ++ui;
        if constexpr (ALIGN_EPI) { if (wr == 1) PG8_BAR; }
    }
    PG8_WAIT_V(0);
    if constexpr (!ALIGN_EPI) { if (wr == 0) PG8_BAR; }
    PG8_BAR;
#undef PG8_SA
#undef PG8_SB
#undef PG8_STAGE
#undef PG8_LDA
#undef PG8_LDB
#undef PG8_MMA
#undef PG8_WAIT_V
#undef PG8_WAIT_L
#undef PG8_BAR
#undef PG8_SCHED
}
}
#define XB_TMO      128
#define XB_XCNT(j)  (256  + 64 * (j))
#define XB_XSUB(j)  (1280 + 64 * (j))
#define XB_XGEN(j)  (2304 + 64 * (j))
#define XB_TOP      3328
#define XB_TOPGEN   3392
#define XCD_BAR_WORDS 3456
#define XB_SPIN_CAP (1u << 22)
__device__ __forceinline__ unsigned xb_ld(unsigned* p)              { return __hip_atomic_load(p, __ATOMIC_RELAXED, __HIP_MEMORY_SCOPE_AGENT); }
__device__ __forceinline__ unsigned xb_add(unsigned* p, unsigned v) { return __hip_atomic_fetch_add(p, v, __ATOMIC_RELAXED, __HIP_MEMORY_SCOPE_AGENT); }
__device__ __forceinline__ unsigned xb_xcc_id() { return (unsigned)__builtin_amdgcn_s_getreg((3 << 11) | 20) & 0xFu; }
#define XB_SPIN(cond, bar) do { unsigned _sp = 0; while (cond) { __builtin_amdgcn_s_sleep(1); \
    if ((++_sp & 255u) == 0u) { if (xb_ld(&(bar)[XB_TMO])) break; if (_sp > XB_SPIN_CAP) { atomicAdd(&(bar)[XB_TMO], 1u); break; } } } } while (0)
struct XcdBarrier { unsigned* bar; unsigned x; volatile LAS unsigned* st; };
__device__ __forceinline__ XcdBarrier xcd_barrier_post(unsigned* bar, volatile LAS unsigned* st) {
    XcdBarrier b; b.bar = bar; b.x = xb_xcc_id(); b.st = st;
    if (threadIdx.x == 0) (void)xb_add(&bar[XB_XCNT(b.x)], 1u);
    return b;
}
__device__ __forceinline__ void xcd_barrier_complete(unsigned* bar, unsigned x, unsigned& nloc, unsigned& nx) {
    const unsigned G = gridDim.x * gridDim.y * gridDim.z;
    unsigned sum, cnt, mine, sp = 0u;
    for (;;) {
        sum = 0u; cnt = 0u; mine = 0u;
#pragma unroll 1
        for (unsigned j = 0; j < 16; ++j) { const unsigned c = xb_ld(&bar[XB_XCNT(j)]); sum += c; cnt += (c > 0u) ? 1u : 0u; mine = (j == x) ? c : mine; }
        if (sum == G) break;
        __builtin_amdgcn_s_sleep(1);
        if ((++sp & 255u) == 0u) { if (xb_ld(&bar[XB_TMO])) break; if (sp > XB_SPIN_CAP) { atomicAdd(&bar[XB_TMO], 1u); break; } }
    }
    nloc = mine > 0u ? mine : 1u; nx = cnt > 0u ? cnt : 1u;
}
__device__ __forceinline__ void xcd_barrier_impl(unsigned* bbar, unsigned bx, volatile LAS unsigned* bst) {
    XcdBarrier b; b.bar = bbar; b.x = bx; b.st = bst;
    asm volatile("s_waitcnt vmcnt(0)" ::: "memory");
    __syncthreads();
    if (threadIdx.x == 0) {
        unsigned* bar = b.bar;
        __builtin_amdgcn_s_waitcnt(0);
        unsigned nloc = b.st[0], nx = b.st[1];
        if (nloc == 0u) { xcd_barrier_complete(bar, b.x, nloc, nx); b.st[0] = nloc; b.st[1] = nx; }
        const unsigned old = xb_add(&bar[XB_XSUB(b.x)], 1u);
        const unsigned gen = old / nloc;
        if (old + 1u == (gen + 1u) * nloc) {
            __builtin_amdgcn_fence(__ATOMIC_RELEASE, "agent");
            asm volatile("s_waitcnt vmcnt(0)" ::: "memory");
            const unsigned og = xb_add(&bar[XB_TOP], 1u);
            const unsigned tg = og / nx;
            if (og + 1u == (tg + 1u) * nx) xb_add(&bar[XB_TOPGEN], 1u);
            else XB_SPIN(xb_ld(&bar[XB_TOPGEN]) == tg, bar);
            __builtin_amdgcn_fence(__ATOMIC_ACQUIRE, "agent");
            xb_add(&bar[XB_XGEN(b.x)], 1u);
            asm volatile("s_waitcnt vmcnt(0)" ::: "memory");
        } else {
            XB_SPIN(xb_ld(&bar[XB_XGEN(b.x)]) == gen, bar);
            __builtin_amdgcn_fence(__ATOMIC_ACQUIRE, "agent");
            asm volatile("s_waitcnt vmcnt(0)" ::: "memory");
        }
    }
    __syncthreads();
}
__device__ __forceinline__ void xcd_barrier(const XcdBarrier& b) { xcd_barrier_impl(b.bar, b.x, b.st); }

constexpr int D = 1024, NBATCH = 8, SEQ = 4096, CTXL = 256, ML = NBATCH * SEQ, MC = NBATCH * CTXL, MA = ML + MC;
constexpr int ZP = 6144, PP = 1536;
constexpr int C_RQ = 0, C_RK = 256, C_RV = 512, C_RG = 1024, C_WQ = 1536, C_WK = 2048, C_WV = 2176, C_NQ = 2304, C_NK = 2816, C_NV = 3328,
              C_GQ = 3840, C_GK = 4352, C_GV = 4864, C_GG = 5376, C_GA = 5888, C_GB = 5896;
constexpr int C_GSUM = 3840;
constexpr int Y_RET = C_RG, Y_WIN = C_WQ, Y_NA = C_NQ, Y_GDN = C_GG;
__host__ __device__ __forceinline__ int dead_tile(int gt) { return gt < 4 ? gt : (gt == 4 ? 8 : (gt < 15 ? gt + 6 : 23)); }
__device__ __forceinline__ int utile_off(int i, int col) { const int a_ = i >> 5, g_ = (i >> 3) & 3, p_ = (i >> 2) & 1, j_ = i & 3; const int rt_ = 2 * a_ + p_, lane_ = 16 * g_ + (col & 15), ch_ = col >> 6, c_ = (col >> 4) & 3;
    return ((((rt_ * 2 + ch_) * 64 + lane_) * 4 + c_) * 4 + j_); }
constexpr float EPS = 1e-6f;
constexpr int NEXP = 32, DEXP = 512, MAXT = 304;
constexpr int NWAVES = 8, NTHR = 512;

constexpr size_t MiB = 1u << 20;
constexpr size_t WS_CTL = 0, CTL_ZERO_BYTES = 1 * MiB;
constexpr size_t WS_ROPE = 1 * MiB;
constexpr size_t WS_MOD = 2 * MiB;
constexpr size_t WS_XC = 3 * MiB;
constexpr size_t WS_GB = 11 * MiB;
constexpr size_t WS_TOK = 14 * MiB;
constexpr size_t WS_WSM = 16 * MiB;
constexpr size_t WSM_IN = 0, WSM_MERGE = 12 * MiB, WSM_BR = 20 * MiB, WSM_OUT = 24 * MiB;
constexpr size_t WS_KVT = 42 * MiB;
constexpr size_t WS_HL = 76 * MiB;
constexpr size_t WS_Z = 144 * MiB;
constexpr size_t WS_P = 552 * MiB;
constexpr size_t WS_GC2 = 654 * MiB;
constexpr size_t WS_END = 656 * MiB;
constexpr size_t WS_WGU = WS_P, WS_WDN = WS_P + 64 * MiB;
constexpr size_t WS_XB = WS_Z, WS_ACT = WS_Z + 152 * MiB, WS_YB = WS_Z + 228 * MiB;
static_assert(WS_YB + (size_t)MAXT * 256 * 1024 * 2 <= WS_P && WS_WDN + (size_t)32 * 1024 * 512 * 2 <= WS_P + (size_t)MA * PP * 2, "moe overlay");
static_assert(WS_HL + (size_t)MA * 1024 * 2 <= WS_Z && WS_Z + (size_t)MA * ZP * 2 <= WS_P && WS_P + (size_t)MA * PP * 2 <= WS_END, "ws map");
constexpr size_t TOK_E = 0, TOK_SLOT = 256 * 1024, TOK_W = 512 * 1024, TOK_POS = 1024 * 1024, TOK_BCNT = 1536 * 1024, TOK_TILE = 1600 * 1024, TOK_RSTD = 1664 * 1024;
constexpr int CW_BAR = 1024;

constexpr int LDS_BYTES = 163840 - 1024;
constexpr int LDS_CTL = LDS_BYTES - 256;
struct KArgs { const float* in[29]; float* out; unsigned char* ws; int ph_lo, ph_hi; };
enum { I_X = 0, I_C, I_CTX, I_CCTX, I_WMOD, I_BMOD, I_NORM1, I_NORM2, I_WIN, I_RDECAY, I_RGN, I_WQN, I_WKN, I_WSINK, I_NQN, I_NKN, I_RPB, I_GCONV, I_GALOG, I_GDT, I_GNORM,
       I_WBR, I_WMERGE, I_WOUT, I_WROUTER, I_RBIAS, I_WEG, I_WEU, I_WED };

__device__ __forceinline__ float wave_sum(float v) {
#pragma unroll
    for (int o = 1; o < 64; o <<= 1) v += __shfl_xor(v, o);
    return v;
}
__device__ __forceinline__ float sum16(float v) { v += __shfl_xor(v, 1); v += __shfl_xor(v, 2); v += __shfl_xor(v, 4); v += __shfl_xor(v, 8); return v; }
#define LDS_WAIT() asm volatile("s_waitcnt lgkmcnt(0)" ::: "memory")

__device__ __forceinline__ int merge_row(int sc) { const int br = sc >> 10, oc = sc & 1023; return (oc >> 6) * 256 + (br >> 1) * 128 + ((oc >> 4) & 3) * 32 + ((oc >> 2) & 3) * 8 + (br & 1) * 4 + (oc & 3); }
__host__ __device__ __forceinline__ bool win_head_tile(int t) { return t < 2 || (t >= 6 && t <= 12); }
__device__ __forceinline__ int win_row(int sc) { const int t = sc >> 8, w = sc & 255; return win_head_tile(t) ? (sc & ~255) + ((w >> 5) & 1) * 128 + (w >> 6) * 32 + (w & 31) : sc; }
template <int MERGE = 0>
__device__ __forceinline__ void transpose_item(const float* W, int ldw, int ncols, int k0, int n0, bf16_t* WT, int ldt, int dst_row0, LAS float* scr, int lane) {
    const int nn = n0 + (lane & 31);
    { float v[32]; const float* wp = W + (size_t)(k0 + (lane >> 5)) * ldw + (nn < ncols ? nn : 0);
#pragma unroll
      for (int i = 0; i < 32; ++i) v[i] = wp[(size_t)(2 * i) * ldw];
#pragma unroll
      for (int i = 0; i < 32; ++i) { const int kk = 2 * i + (lane >> 5); scr[kk * 33 + (lane & 31)] = (nn < ncols) ? v[i] : 0.f; } }
    LDS_WAIT(); asm volatile("" ::: "memory");
    const int c = lane & 7;
#pragma unroll
    for (int j = 0; j < 4; ++j) { const int n = (lane >> 3) + 8 * j; const LAS float* s = scr + (8 * c) * 33 + n;
        u32x4 o; o.x = pk2(s[0 * 33], s[1 * 33]); o.y = pk2(s[2 * 33], s[3 * 33]); o.z = pk2(s[4 * 33], s[5 * 33]); o.w = pk2(s[6 * 33], s[7 * 33]);
        *(u32x4*)(WT + (size_t)(MERGE == 1 ? merge_row(dst_row0 + n) : (MERGE == 2 ? win_row(dst_row0 + n) : dst_row0 + n)) * ldt + k0 + 8 * c) = o; }
    LDS_WAIT(); asm volatile("" ::: "memory");
}

__device__ __forceinline__ void small_weight_convert(const KArgs& a, LAS unsigned char* lds, int l) {
    const int tid = OTID(), lane = tid & 63, wave = tid >> 6, G = OGRID(), blk = OBLK();
    unsigned char* ws = a.ws;
    LAS float* scr = (LAS float*)(lds + 65536 + wave * 8448);
    const int gw = blk * NWAVES + wave, NGW = G * NWAVES;
    constexpr int I_IN = 16 * 192, I_MG = 16 * 128, I_BR = 4 * 8 * 32, I_OUT = 16 * 32, I_LAYER = I_IN + I_MG + I_BR + I_OUT;
    bf16_t* wsm = (bf16_t*)(ws + WS_WSM);
    for (int it = gw; it < I_LAYER; it += NGW) {
        int r = it;
        if (r < I_IN) { const int kb = r / 192, nb = r % 192; transpose_item<2>(a.in[I_WIN] + (size_t)l * 1024 * 5904, 5904, 5904, kb * 64, nb * 32, wsm + WSM_IN / 2, 1024, nb * 32, scr, lane); continue; } r -= I_IN;
        if (r < I_MG) { const int kb = r / 128, nb = r % 128; transpose_item<1>(a.in[I_WMERGE] + (size_t)l * 1024 * 4096, 4096, 4096, kb * 64, nb * 32, wsm + WSM_MERGE / 2, 1024, nb * 32, scr, lane); continue; } r -= I_MG;
        if (r < I_BR) { const int br = r / 256, q = r % 256, kb = q / 32, nb = q % 32;
            transpose_item(a.in[I_WBR] + (size_t)(l * 4 + br) * 512 * 1024, 1024, 1024, kb * 64, nb * 32, wsm + WSM_BR / 2 + (size_t)br * 1024 * 512, 512, nb * 32, scr, lane); continue; } r -= I_BR;
        { const int kb = r / 32, nb = r % 32; transpose_item(a.in[I_WOUT] + (size_t)l * 1024 * 1024, 1024, 1024, kb * 64, nb * 32, wsm + WSM_OUT / 2, 1024, nb * 32, scr, lane); }
    }
}

__device__ __forceinline__ void phase_prologue(const KArgs& a, LAS unsigned char* lds) {
    const int tid = OTID(), lane = tid & 63, wave = tid >> 6, G = OGRID(), blk = OBLK();
    unsigned char* ws = a.ws;
    { float* cs = (float*)(ws + WS_ROPE); float* sn = cs + 4096 * 32;
      for (int idx = blk * NTHR + tid; idx < 4096 * 32; idx += G * NTHR) { const int t = idx >> 5, i = idx & 31; const float pos = (float)((i < 16) ? (t >> 6) : (t & 63));
          const float inv = exp2f(-(float)(i & 15) * (13.287712379549449f / 16.0f)); const float ang = pos * inv; cs[idx] = cosf(ang); sn[idx] = sinf(ang); } }
    if (blk < 192) {
        const int l = blk / 96, cg = blk % 96;
        LAS float* sc = (LAS float*)lds; LAS float* red = (LAS float*)(lds + 40960);
        for (int idx = tid; idx < 9 * 1024; idx += NTHR) { const int v = idx >> 10, k = idx & 1023; const float cv = (v < 8) ? a.in[I_C][v * 1024 + k] : a.in[I_CCTX][k]; sc[idx] = siluf_(cv); }
        __syncthreads();
        const float* wm = a.in[I_WMOD] + (size_t)l * 1024 * 6144 + cg * 64 + lane;
        float acc[9];
#pragma unroll
        for (int v = 0; v < 9; ++v) acc[v] = 0.f;
#pragma unroll 32
        for (int kk = 0; kk < 128; ++kk) { const int k = wave * 128 + kk; const float w = wm[(size_t)k * 6144];
#pragma unroll
            for (int v = 0; v < 9; ++v) acc[v] += sc[v * 1024 + k] * w; }
#pragma unroll
        for (int v = 0; v < 9; ++v) red[(wave * 9 + v) * 64 + lane] = acc[v];
        __syncthreads();
        for (int idx = tid; idx < 576; idx += NTHR) { const int v = idx >> 6, ln = idx & 63; float s = a.in[I_BMOD][l * 6144 + cg * 64 + ln];
#pragma unroll
            for (int w = 0; w < 8; ++w) s += red[(w * 9 + v) * 64 + ln];
            ((float*)(ws + WS_MOD))[(size_t)(l * 9 + v) * 6144 + cg * 64 + ln] = s; }
        __syncthreads();
    }
    small_weight_convert(a, lds, 0);
}

constexpr int EXPC_ITEMS = 3 * 8192;
__device__ __forceinline__ void expert_convert_range(const KArgs& a, LAS unsigned char* lds, int l, int lo, int hi, int blk0) {
    const int tid = OTID(), lane = tid & 63, wave = tid >> 6, blk = OBLK(), G = OGRID();
    if (G <= blk0) blk0 = 0;
    if (blk < blk0) return;
    LAS float* scr = (LAS float*)(lds + 65536 + wave * 8448);
    bf16_t* wgu = (bf16_t*)(a.ws + WS_WGU); bf16_t* wdn = (bf16_t*)(a.ws + WS_WDN);
    const int gw = (blk - blk0) * NWAVES + wave, NGW = (G - blk0) * NWAVES;
    for (int it = lo + gw; it < hi; it += NGW) {
        const int which = it / 8192, r = it % 8192, e = r / 256, q = r % 256;
        if (which < 2) { const int kb = q / 16, nb = q % 16, n0 = nb * 32;
            transpose_item(a.in[which == 0 ? I_WEG : I_WEU] + (size_t)(l * 32 + e) * 1024 * 512, 512, 512, kb * 64, n0, wgu + (size_t)e * 1024 * 1024, 1024, 256 * (n0 >> 7) + (n0 & 127) + which * 128, scr, lane); }
        else { const int kb = q / 32, nb = q % 32; transpose_item(a.in[I_WED] + (size_t)(l * 32 + e) * 512 * 1024, 1024, 1024, kb * 64, nb * 32, wdn + (size_t)e * 1024 * 512, 512, nb * 32, scr, lane); }
    }
}

__device__ __forceinline__ void modulate_store(const f32x4 (&v)[4], const float* gain, const float* sh, const float* sc, bf16_t* orow, int lane) {
    float ss = 0.f;
#pragma unroll
    for (int j = 0; j < 4; ++j) ss += (v[j].x * v[j].x + v[j].y * v[j].y) + (v[j].z * v[j].z + v[j].w * v[j].w);
    const float rstd = rsqrtf(wave_sum(ss) * (1.f / 1024.f) + EPS);
    f32x4 gq[4], s1q[4], s0q[4];
#pragma unroll
    for (int j = 0; j < 4; ++j) { gq[j] = ((const f32x4*)gain)[lane + 64 * j]; s1q[j] = ((const f32x4*)sc)[lane + 64 * j]; s0q[j] = ((const f32x4*)sh)[lane + 64 * j]; }
#pragma unroll
    for (int j = 0; j < 4; ++j) {
        const f32x4 g = gq[j], s1 = s1q[j], s0 = s0q[j];
        const f32x4 y = (v[j] * rstd * g) * (s1 + 1.0f) + s0;
        u32x2 o; o.x = pk2(y.x, y.y); o.y = pk2(y.z, y.w);
        ((u32x2*)orow)[lane + 64 * j] = o;
    }
}
__device__ __forceinline__ int row_modidx(int row) { return row < ML ? (row >> 12) : 8; }

__device__ __forceinline__ void phase_modulate1(const KArgs& a, int l, int nrows) {
    const int tid = OTID(), lane = tid & 63, wave = tid >> 6;
    const int gw = OBLK() * NWAVES + wave, NGW = OGRID() * NWAVES;
    const float* xl = (l == 0) ? a.in[I_X] : a.out; const float* xc = (l == 0) ? a.in[I_CTX] : (const float*)(a.ws + WS_XC);
    bf16_t* hl = (bf16_t*)(a.ws + WS_HL);
    for (int row = gw; row < nrows; row += NGW) {
        const float* xr = row < ML ? xl + (size_t)row * D : xc + (size_t)(row - ML) * D;
        f32x4 v[4];
#pragma unroll
        for (int j = 0; j < 4; ++j) v[j] = ((const f32x4*)xr)[lane + 64 * j];
        const float* mod = (const float*)(a.ws + WS_MOD) + (size_t)(l * 9 + row_modidx(row)) * 6144;
        modulate_store(v, a.in[I_NORM1] + l * D, mod, mod + 1024, hl + (size_t)row * D, lane);
    }
}
__device__ __forceinline__ void unpack8(const u32x4 u, float (&x)[8]) { x[0] = bflo(u.x); x[1] = bfhi(u.x); x[2] = bflo(u.y); x[3] = bfhi(u.y); x[4] = bflo(u.z); x[5] = bfhi(u.z); x[6] = bflo(u.w); x[7] = bfhi(u.w); }
__device__ __forceinline__ u32x4 pack8(const float (&x)[8]) { u32x4 u; u.x = pk2(x[0], x[1]); u.y = pk2(x[2], x[3]); u.z = pk2(x[4], x[5]); u.w = pk2(x[6], x[7]); return u; }
__device__ __forceinline__ int head64_col(int hbase, int lane) { const int hidx = hbase + (lane >> 2), p = lane & 3; return (hidx < 8 ? hidx * 64 : (hidx < 18 ? C_WQ + (hidx - 8) * 64 : C_NQ + (hidx - 18) * 64)) + 8 * p; }
__device__ __forceinline__ void head64_load(const bf16_t* zr, int hbase, int lane, u32x4& u1, u32x4& u2) { const bool act = hbase + (lane >> 2) < 34; const int col = head64_col(hbase, lane);
    u1 = (u32x4){0u, 0u, 0u, 0u}; u2 = u1; if (act) { u1 = *(const u32x4*)(zr + col); u2 = *(const u32x4*)(zr + col + 32); } }
__device__ __forceinline__ void head64_pass16(bf16_t* zr, int hbase, const float* wqn, const float* wkn, const float* nqn, const float* nkn, bool lat, const float* cs, const float* sn, int lane, const u32x4 u1, const u32x4 u2) {
    const int hidx = hbase + (lane >> 2), p = lane & 3; const bool act = hidx < 34;
    const int col = (hidx < 8 ? hidx * 64 : (hidx < 18 ? C_WQ + (hidx - 8) * 64 : C_NQ + (hidx - 18) * 64)) + 8 * p;
    const float* gain = hidx < 8 ? nullptr : (hidx < 16 ? wqn : (hidx < 18 ? wkn : (hidx < 26 ? nqn : nkn)));
    const bool rope = lat && hidx < 18;
    const float scale = (hidx >= 4 && hidx < 8) ? 0.125f : (((hidx >= 8 && hidx < 16) || (hidx >= 18 && hidx < 26)) ? 0.125f * 1.4426950408889634f : 1.0f);
    float x1[8], x2[8];
    unpack8(u1, x1); unpack8(u2, x2);
    float ss = 0.f;
#pragma unroll
    for (int e = 0; e < 8; ++e) ss += x1[e] * x1[e] + x2[e] * x2[e];
    ss += __shfl_xor(ss, 1); ss += __shfl_xor(ss, 2);
    if (gain) { const float r = rsqrtf(ss * (1.f / 64.f) + EPS);
        const f32x4 g0 = *(const f32x4*)(gain + 8 * p), g1 = *(const f32x4*)(gain + 8 * p + 4), g2 = *(const f32x4*)(gain + 32 + 8 * p), g3 = *(const f32x4*)(gain + 36 + 8 * p);
#pragma unroll
        for (int e = 0; e < 4; ++e) { x1[e] *= r * g0[e]; x1[e + 4] *= r * g1[e]; x2[e] *= r * g2[e]; x2[e + 4] *= r * g3[e]; } }
    if (rope) { const f32x4 c0 = *(const f32x4*)(cs + 8 * p), c1 = *(const f32x4*)(cs + 8 * p + 4), s0 = *(const f32x4*)(sn + 8 * p), s1 = *(const f32x4*)(sn + 8 * p + 4);
#pragma unroll
        for (int e = 0; e < 8; ++e) { const float c = e < 4 ? c0[e & 3] : c1[e & 3], sv = e < 4 ? s0[e & 3] : s1[e & 3]; const float y1 = x1[e] * c - x2[e] * sv, y2 = x1[e] * sv + x2[e] * c; x1[e] = y1; x2[e] = y2; } }
#pragma unroll
    for (int e = 0; e < 8; ++e) { x1[e] *= scale; x2[e] *= scale; }
    if (act) { *(u32x4*)(zr + col) = pack8(x1); *(u32x4*)(zr + col + 32) = pack8(x2); }
}
__device__ __forceinline__ void phase_prep(const KArgs& a, int l) {
    const int tid = OTID(), lane = tid & 63, wave = tid >> 6;
    const int gw = OBLK() * NWAVES + wave, NGW = OGRID() * NWAVES;
    bf16_t* Z = (bf16_t*)(a.ws + WS_Z); bf16_t* P = (bf16_t*)(a.ws + WS_P);
    const float* cs0 = (const float*)(a.ws + WS_ROPE); const float* sn0 = cs0 + 4096 * 32;
    float* GBa = (float*)(a.ws + WS_GB); float* GBb = GBa + (size_t)MA * 8;
    const float* wqn = a.in[I_WQN] + l * 64; const float* wkn = a.in[I_WKN] + l * 64; const float* nqn = a.in[I_NQN] + l * 64; const float* nkn = a.in[I_NKN] + l * 64;
    const float* cw = a.in[I_GCONV] + (size_t)l * 3 * 1536;
    for (int row = gw; row < MA; row += NGW) {
        const bool lat = row < ML; const int t = lat ? (row & 4095) : ((row - ML) & 255); const int slen = lat ? 4096 : 256;
        bf16_t* zr = Z + (size_t)row * ZP;
        const float* cs = cs0 + t * 32; const float* sn = sn0 + t * 32;
        const u32x4 zero = (u32x4){0u, 0u, 0u, 0u};
        u32x4 guc[3], gup[3], gun[3];
#pragma unroll
        for (int ps = 0; ps < 3; ++ps) { const int c = (ps * 4 + (lane >> 4)) * 128 + (lane & 15) * 8; const bf16_t* zc = zr + C_GQ + c;
            guc[ps] = *(const u32x4*)zc; gup[ps] = (t > 0) ? *(const u32x4*)(zc - ZP) : zero; gun[ps] = (t < slen - 1) ? *(const u32x4*)(zc + ZP) : zero; }
        float gav = 0.f, gbv = 0.f; if (lane < 8) { gav = bf2f(zr[C_GA + lane]); gbv = bf2f(zr[C_GB + lane]); }
#pragma unroll
        for (int ps = 0; ps < 3; ++ps) {
            const int c = (ps * 4 + (lane >> 4)) * 128 + (lane & 15) * 8;
            float xp[8], xc[8], xn[8], y[8]; unpack8(gup[ps], xp); unpack8(guc[ps], xc); unpack8(gun[ps], xn);
            const f32x4 w00 = *(const f32x4*)(cw + c), w01 = *(const f32x4*)(cw + c + 4), w10 = *(const f32x4*)(cw + 1536 + c), w11 = *(const f32x4*)(cw + 1536 + c + 4), w20 = *(const f32x4*)(cw + 3072 + c), w21 = *(const f32x4*)(cw + 3072 + c + 4);
            float ss = 0.f;
#pragma unroll
            for (int e = 0; e < 8; ++e) { const float w0 = e < 4 ? w00[e & 3] : w01[e & 3], w1 = e < 4 ? w10[e & 3] : w11[e & 3], w2 = e < 4 ? w20[e & 3] : w21[e & 3];
                y[e] = silu_fast(w0 * xp[e] + w1 * xc[e] + w2 * xn[e]); ss += y[e] * y[e]; }
            if (ps < 2) { ss += __shfl_xor(ss, 1); ss += __shfl_xor(ss, 2); ss += __shfl_xor(ss, 4); ss += __shfl_xor(ss, 8);
                const float r = rsqrtf(ss + EPS) * (ps == 0 ? 0.08838834764831845f : 1.0f);
#pragma unroll
                for (int e = 0; e < 8; ++e) y[e] *= r; }
            *(u32x4*)(P + (size_t)row * PP + c) = pack8(y);
        }
        if (lane < 8) {
            const float av = gav + a.in[I_GDT][l * 8 + lane], bv = gbv;
            const float sp = fmaxf(av, 0.f) + log1pf(__expf(-fabsf(av)));
            const float g = -__expf(a.in[I_GALOG][l * 8 + lane]) * sp;
            GBa[(size_t)row * 8 + lane] = g; GBb[(size_t)row * 8 + lane] = sigmoidf_(bv);
        }
    }
}

constexpr int GPO_RS = 272;
__device__ __forceinline__ void phase_post(const KArgs& a, LAS unsigned char* lds, int l, int nrows) {
    const int tid = OTID(), lane = tid & 63, wave = tid >> 6, g = lane >> 4, r16 = lane & 15;
    const int gw = OBLK() * NWAVES + wave, NGW = OGRID() * NWAVES;
    bf16_t* Z = (bf16_t*)(a.ws + WS_Z);
    const float* gnm = a.in[I_GNORM] + l * 128;
    LAS unsigned char* img = lds + wave * (64 * GPO_RS);
    const f32x4 gn0 = *(const f32x4*)(gnm + r16 * 8), gn1 = *(const f32x4*)(gnm + r16 * 8 + 4);
    const int nunits = (nrows >> 6) * 4;
    for (int u = gw; u < nunits; u += NGW) {
        const int chunk = u >> 2, h = u & 3;
        bf16_t* zblk = Z + (size_t)chunk * 64 * ZP;
        u32x4 rf[8][2], rb[8][2];
#pragma unroll
        for (int sb = 0; sb < 8; ++sb) { const bf16_t* p = zblk + (size_t)(sb * 8 + (lane >> 3)) * ZP + h * 128 + (lane & 7) * 16;
            rf[sb][0] = *(const u32x4*)(p + C_GQ); rf[sb][1] = *(const u32x4*)(p + C_GQ + 8); rb[sb][0] = *(const u32x4*)(p + C_GK); rb[sb][1] = *(const u32x4*)(p + C_GK + 8); }
#pragma unroll
        for (int rt = 0; rt < 4; ++rt) {
            float v[2][4][4]; float ss[4] = {0.f, 0.f, 0.f, 0.f};
#pragma unroll
            for (int ch = 0; ch < 2; ++ch) { const int sb = rt * 2 + ch;
#pragma unroll
                for (int hf = 0; hf < 2; ++hf) { const u32x4 f = rf[sb][hf], bq = rb[sb][hf];
                    v[ch][2 * hf][0] = bflo(f.x) + bflo(bq.x); v[ch][2 * hf][1] = bfhi(f.x) + bfhi(bq.x); v[ch][2 * hf][2] = bflo(f.y) + bflo(bq.y); v[ch][2 * hf][3] = bfhi(f.y) + bfhi(bq.y);
                    v[ch][2 * hf + 1][0] = bflo(f.z) + bflo(bq.z); v[ch][2 * hf + 1][1] = bfhi(f.z) + bfhi(bq.z); v[ch][2 * hf + 1][2] = bflo(f.w) + bflo(bq.w); v[ch][2 * hf + 1][3] = bfhi(f.w) + bfhi(bq.w); } }
#pragma unroll
            for (int j = 0; j < 4; ++j) {
#pragma unroll
                for (int ch = 0; ch < 2; ++ch)
#pragma unroll
                    for (int ct = 0; ct < 4; ++ct) ss[j] += v[ch][ct][j] * v[ch][ct][j];
                ss[j] += __shfl_xor(ss[j], 1); ss[j] += __shfl_xor(ss[j], 2); ss[j] += __shfl_xor(ss[j], 4); ss[j] += __shfl_xor(ss[j], 8);
                const float r = rsqrtf(ss[j] * (1.f / 128.f) + EPS);
                const int row = 32 * (rt >> 1) + 8 * g + 4 * (rt & 1) + j;
#pragma unroll
                for (int ch = 0; ch < 2; ++ch)
#pragma unroll
                    for (int ct = 0; ct < 4; ++ct) *(LAS bf16_t*)(img + row * GPO_RS + (ch * 64 + ct * 16 + r16) * 2) = (bf16_t)f2bf(v[ch][ct][j] * r);
            }
        }
        u32x4 gt[16];
#pragma unroll
        for (int i = 0; i < 16; ++i) gt[i] = *(const u32x4*)(zblk + (size_t)(i * 4 + g) * ZP + C_GG + h * 128 + r16 * 8);
#pragma unroll
        for (int i = 0; i < 16; ++i) { const int row = i * 4 + g;
            const u32x4 o = *(const LAS u32x4*)(img + row * GPO_RS + r16 * 16); const u32x4 q = gt[i];
            u32x4 w;
            w.x = pk2(bflo(o.x) * gn0[0] * silu_fast(bflo(q.x)), bfhi(o.x) * gn0[1] * silu_fast(bfhi(q.x))); w.y = pk2(bflo(o.y) * gn0[2] * silu_fast(bflo(q.y)), bfhi(o.y) * gn0[3] * silu_fast(bfhi(q.y)));
            w.z = pk2(bflo(o.z) * gn1[0] * silu_fast(bflo(q.z)), bfhi(o.z) * gn1[1] * silu_fast(bfhi(q.z))); w.w = pk2(bflo(o.w) * gn1[2] * silu_fast(bflo(q.w)), bfhi(o.w) * gn1[3] * silu_fast(bfhi(q.w)));
            *(u32x4*)(zblk + (size_t)row * ZP + Y_GDN + h * 128 + r16 * 8) = w; }
    }
}
constexpr int AT_TILE = 4096;
constexpr int AT_BUF = 2 * AT_TILE;
constexpr int AT_TABOFF = 2 * AT_BUF;
constexpr int AT_WAVE_BYTES = 2 * AT_BUF + 2048;
template <int NQ> struct AttnSt { f32x4 O[NQ][4]; float m[NQ], l[NQ]; bf16x8 Q[NQ][2]; };
__device__ __forceinline__ void stage_issue(const char* zb, const unsigned (&rp)[4], int kcolb, int vcolb, LAS unsigned char* buf) {
    asm volatile("s_waitcnt lgkmcnt(0)" ::: "memory");
#pragma unroll
    for (int c = 0; c < 4; ++c) {
        __builtin_amdgcn_global_load_lds((const unsigned*)(zb + rp[c] + kcolb), (LAS unsigned*)(buf + c * 1024), 16, 0, 0);
        __builtin_amdgcn_global_load_lds((const unsigned*)(zb + rp[c] + vcolb), (LAS unsigned*)(buf + AT_TILE + c * 1024), 16, 0, 0);
    }
}
__device__ __forceinline__ int at_piece_off(int lane) { const int row = lane >> 3; return (((lane & 7) ^ (row & 7)) * 16); }
__device__ __forceinline__ s16x4 lds_tr16(const LAS unsigned char* p) { return __builtin_bit_cast(s16x4, __builtin_amdgcn_ds_read_tr16_b64_v4i16((LAS s16x4*)p)); }

struct AttnAddr { unsigned k0, k1, v[4]; };
__device__ __forceinline__ unsigned lds_u32(const LAS unsigned char* p) { return (unsigned)(unsigned long long)p; }
__device__ __forceinline__ AttnAddr attn_addr(int lane) {
    const int g = lane >> 4, r16 = lane & 15, qq = r16 >> 2, pp = r16 & 3, row = 4 * g + qq; AttnAddr A;
    A.k0 = r16 * 128 + ((g ^ (r16 & 7)) * 16); A.k1 = r16 * 128 + (((4 + g) ^ (r16 & 7)) * 16);
#pragma unroll
    for (int dt = 0; dt < 4; ++dt) A.v[dt] = row * 128 + (((dt * 2 + (pp >> 1)) ^ (row & 7)) * 16) + (pp & 1) * 8;
    return A;
}
struct AttnFrag { bf16x8 kf[2][2]; bf16x8 vf[4]; };
__device__ __forceinline__ void attn_read(AttnFrag& F, const LAS unsigned char* kl, int lane) {
    const AttnAddr AD = attn_addr(lane);
    const unsigned base = lds_u32(kl);
    u32x4 k00, k01, k10, k11; u32x2 vl0, vh0, vl1, vh1, vl2, vh2, vl3, vh3;
    asm volatile(
        "ds_read_b128 %0, %12\n\t" "ds_read_b128 %1, %13\n\t" "ds_read_b128 %2, %12 offset:2048\n\t" "ds_read_b128 %3, %13 offset:2048\n\t"
        "ds_read_b64_tr_b16 %4, %14 offset:4096\n\t" "ds_read_b64_tr_b16 %5, %14 offset:6144\n\t"
        "ds_read_b64_tr_b16 %6, %15 offset:4096\n\t" "ds_read_b64_tr_b16 %7, %15 offset:6144\n\t"
        "ds_read_b64_tr_b16 %8, %16 offset:4096\n\t" "ds_read_b64_tr_b16 %9, %16 offset:6144\n\t"
        "ds_read_b64_tr_b16 %10, %17 offset:4096\n\t" "ds_read_b64_tr_b16 %11, %17 offset:6144\n\t"
        "s_waitcnt lgkmcnt(0)"
        : "=&v"(k00), "=&v"(k01), "=&v"(k10), "=&v"(k11), "=&v"(vl0), "=&v"(vh0), "=&v"(vl1), "=&v"(vh1), "=&v"(vl2), "=&v"(vh2), "=&v"(vl3), "=&v"(vh3)
        : "v"(base + AD.k0), "v"(base + AD.k1), "v"(base + AD.v[0]), "v"(base + AD.v[1]), "v"(base + AD.v[2]), "v"(base + AD.v[3])
        : "memory");
    F.kf[0][0] = __builtin_bit_cast(bf16x8, k00); F.kf[0][1] = __builtin_bit_cast(bf16x8, k01); F.kf[1][0] = __builtin_bit_cast(bf16x8, k10); F.kf[1][1] = __builtin_bit_cast(bf16x8, k11);
    F.vf[0] = cat8(vl0, vh0); F.vf[1] = cat8(vl1, vh1); F.vf[2] = cat8(vl2, vh2); F.vf[3] = cat8(vl3, vh3);
}
template <int NQ, int MASK, class BiasF>
__device__ __forceinline__ void attn_compute_m(AttnSt<NQ>& st, const AttnFrag& F, const BiasF& bias, bool useb, int lane) {
    const int g = lane >> 4, r16 = lane & 15;
    f32x4 s0[NQ], s1[NQ]; float mx[NQ];
#pragma unroll
    for (int qi = 0; qi < NQ; ++qi) if ((MASK >> qi) & 1) {
        const float nmo = -st.m[qi]; const f32x4 nm = (f32x4){nmo, nmo, nmo, nmo};
        s0[qi] = __builtin_amdgcn_mfma_f32_16x16x32_bf16(F.kf[0][0], st.Q[qi][0], nm, 0, 0, 0);
        s0[qi] = __builtin_amdgcn_mfma_f32_16x16x32_bf16(F.kf[0][1], st.Q[qi][1], s0[qi], 0, 0, 0);
        s1[qi] = __builtin_amdgcn_mfma_f32_16x16x32_bf16(F.kf[1][0], st.Q[qi][0], nm, 0, 0, 0);
        s1[qi] = __builtin_amdgcn_mfma_f32_16x16x32_bf16(F.kf[1][1], st.Q[qi][1], s1[qi], 0, 0, 0); }
    if (BiasF::HAS_BIAS && useb) {
#pragma unroll
        for (int qi = 0; qi < NQ; ++qi) if ((MASK >> qi) & 1) { f32x4 b0, b1; bias.get(qi, r16, g, b0, b1); s0[qi] = s0[qi] + b0; s1[qi] = s1[qi] + b1; } }
#pragma unroll
    for (int qi = 0; qi < NQ; ++qi) if ((MASK >> qi) & 1) {
        float m_ = fmaxf(fmaxf(s0[qi][0], s0[qi][1]), s0[qi][2]); m_ = fmaxf(fmaxf(m_, s0[qi][3]), s1[qi][0]); m_ = fmaxf(fmaxf(m_, s1[qi][1]), s1[qi][2]); mx[qi] = fmaxf(m_, s1[qi][3]); }
#pragma unroll
    for (int qi = 0; qi < NQ; ++qi) if ((MASK >> qi) & 1) mx[qi] = fmaxf(mx[qi], __shfl_xor(mx[qi], 16));
#pragma unroll
    for (int qi = 0; qi < NQ; ++qi) if ((MASK >> qi) & 1) mx[qi] = fmaxf(mx[qi], __shfl_xor(mx[qi], 32));
    bool grow = false;
#pragma unroll
    for (int qi = 0; qi < NQ; ++qi) if ((MASK >> qi) & 1) grow = grow || (mx[qi] > 8.0f);
    if (__builtin_amdgcn_ballot_w64(grow) != 0ull) {
#pragma unroll
        for (int qi = 0; qi < NQ; ++qi) if ((MASK >> qi) & 1) {
            const float dm = fmaxf(mx[qi], 0.f), alpha = __builtin_amdgcn_exp2f(-dm);
            st.l[qi] *= alpha; st.m[qi] += dm;
#pragma unroll
            for (int dt = 0; dt < 4; ++dt) st.O[qi][dt] = st.O[qi][dt] * alpha;
            s0[qi] = s0[qi] - dm; s1[qi] = s1[qi] - dm; } }
    bf16x8 pf[NQ];
#pragma unroll
    for (int qi = 0; qi < NQ; ++qi) if ((MASK >> qi) & 1) {
        float p0[4], p1[4], ps = 0.f;
#pragma unroll
        for (int j = 0; j < 4; ++j) { p0[j] = __builtin_amdgcn_exp2f(s0[qi][j]); p1[j] = __builtin_amdgcn_exp2f(s1[qi][j]); ps += p0[j] + p1[j]; }
        st.l[qi] += ps;
        u32x4 pw; pw.x = pk2(p0[0], p0[1]); pw.y = pk2(p0[2], p0[3]); pw.z = pk2(p1[0], p1[1]); pw.w = pk2(p1[2], p1[3]);
        pf[qi] = __builtin_bit_cast(bf16x8, pw); }
#pragma unroll
    for (int qi = 0; qi < NQ; ++qi) if ((MASK >> qi) & 1) {
#pragma unroll
        for (int dt = 0; dt < 4; ++dt) st.O[qi][dt] = __builtin_amdgcn_mfma_f32_16x16x32_bf16(F.vf[dt], pf[qi], st.O[qi][dt], 0, 0, 0); }
}
template <int NQ, class BiasF>
__device__ __forceinline__ void attn_compute(AttnSt<NQ>& st, const AttnFrag& F, const BiasF& bias, int lane) {
    const bool useb = BiasF::HAS_BIAS && !bias.nobias();
    if constexpr (BiasF::HAS_SKIP && NQ == 4) {
        if (!bias.skip(0)) attn_compute_m<NQ, 0x1, BiasF>(st, F, bias, useb, lane);
        attn_compute_m<NQ, 0x2, BiasF>(st, F, bias, useb, lane); attn_compute_m<NQ, 0x4, BiasF>(st, F, bias, useb, lane);
        if (!bias.skip(3)) attn_compute_m<NQ, 0x8, BiasF>(st, F, bias, useb, lane);
    } else {
        if constexpr (NQ == 4) { attn_compute_m<NQ, 0x3, BiasF>(st, F, bias, useb, lane); attn_compute_m<NQ, 0xC, BiasF>(st, F, bias, useb, lane); }
        else attn_compute_m<NQ, (1 << NQ) - 1, BiasF>(st, F, bias, useb, lane);
    }
}
template <int NQ> __device__ __forceinline__ void attn_init(AttnSt<NQ>& st) {
#pragma unroll
    for (int qi = 0; qi < NQ; ++qi) { st.m[qi] = -64.0f;      st.l[qi] = 0.f;
#pragma unroll
        for (int dt = 0; dt < 4; ++dt) st.O[qi][dt] = (f32x4){0.f, 0.f, 0.f, 0.f}; }
}
template <int NQ> __device__ __forceinline__ void attn_store(AttnSt<NQ>& st, int qi, bf16_t* orow, int lane) {
    const int g = lane >> 4;
    float lt = st.l[qi]; lt += __shfl_xor(lt, 16); lt += __shfl_xor(lt, 32);
    const float inv = 1.0f / lt;
#pragma unroll
    for (int dt = 0; dt < 4; ++dt) { const f32x4 o = st.O[qi][dt] * inv; u32x2 w; w.x = pk2(o[0], o[1]); w.y = pk2(o[2], o[3]); *(u32x2*)(orow + dt * 16 + 4 * g) = w; }
}
constexpr float LOG2E = 1.4426950408889634f;
struct BiasZero { static constexpr bool HAS_BIAS = false, HAS_SKIP = false; __device__ __forceinline__ bool skip(int) const { return false; } __device__ __forceinline__ bool nobias() const { return true; }
    __device__ __forceinline__ void get(int, int, int, f32x4& b0, f32x4& b1) const { b0 = (f32x4){0.f, 0.f, 0.f, 0.f}; b1 = b0; } };
struct BiasWin { static constexpr bool HAS_BIAS = true, HAS_SKIP = false; int d0; int kstart; bool interior;
    __device__ __forceinline__ bool skip(int) const { return false; } __device__ __forceinline__ bool nobias() const { return interior; }
    __device__ __forceinline__ float one(int q, int kk) const { const int kp = kstart + kk, dd = d0 + kk - q; return (kp >= 0 && kp < SEQ && dd <= 128 && dd >= -128) ? 0.f : -1e30f; }
    __device__ __forceinline__ void get(int, int q, int g, f32x4& b0, f32x4& b1) const {
#pragma unroll
        for (int j = 0; j < 4; ++j) { b0[j] = one(q, 4 * g + j); b1[j] = one(q, 16 + 4 * g + j); } } };
struct BiasNA { static constexpr bool HAS_BIAS = true, HAS_SKIP = true; unsigned tabaddr; int rowoff31; int c0;
    __device__ __forceinline__ bool skip(int qi) const { return (qi == 0 && c0 != 0) || (qi == 3 && c0 == 0); } __device__ __forceinline__ bool nobias() const { return false; }
    __device__ __forceinline__ void get(int qi, int q, int g, f32x4& b0, f32x4& b1) const {
        const int qc = qi * 16 + q; int cst = qc - 8; cst = cst < 0 ? 0 : (cst > 48 ? 48 : cst);
        const int kc0 = c0 + 4 * g;
        const unsigned ad = tabaddr + (unsigned)((rowoff31 + kc0 - qc + 15) * 4);
        u32x2 t0, t1, t2, t3;
        asm volatile("ds_read2_b32 %0, %4 offset1:1\n\t" "ds_read2_b32 %1, %4 offset0:2 offset1:3\n\t" "ds_read2_b32 %2, %4 offset0:16 offset1:17\n\t" "ds_read2_b32 %3, %4 offset0:18 offset1:19\n\t" "s_waitcnt lgkmcnt(0)"
                     : "=&v"(t0), "=&v"(t1), "=&v"(t2), "=&v"(t3) : "v"(ad) : "memory");
        const float v0[4] = {__builtin_bit_cast(float, t0.x), __builtin_bit_cast(float, t0.y), __builtin_bit_cast(float, t1.x), __builtin_bit_cast(float, t1.y)};
        const float v1[4] = {__builtin_bit_cast(float, t2.x), __builtin_bit_cast(float, t2.y), __builtin_bit_cast(float, t3.x), __builtin_bit_cast(float, t3.y)};
#pragma unroll
        for (int j = 0; j < 4; ++j) { const int ka = kc0 + j, kb = kc0 + 16 + j;
            b0[j] = (ka >= cst && ka < cst + 16) ? v0[j] : -1e30f; b1[j] = (kb >= cst && kb < cst + 16) ? v1[j] : -1e30f; } } };

template <int NQ>
__device__ __forceinline__ void attn_ctx_steps(AttnSt<NQ>& st, const bf16_t* Z, int row0, int kcol, int vcol, int nsteps, LAS unsigned char* kl, int lane) {
    const char* zb = (const char*)Z;
    unsigned rp[4];
#pragma unroll
    for (int c = 0; c < 4; ++c) rp[c] = (unsigned)(row0 + (lane >> 3) + c * 8) * (unsigned)(ZP * 2) + (unsigned)at_piece_off(lane);
    stage_issue(zb, rp, kcol * 2, vcol * 2, kl);
    for (int s = 0; s < nsteps; ++s) {
        if (s + 1 < nsteps) {
#pragma unroll
            for (int c = 0; c < 4; ++c) rp[c] += 32u * (unsigned)(ZP * 2);
            stage_issue(zb, rp, kcol * 2, vcol * 2, kl + ((s + 1) & 1) * AT_BUF);
            asm volatile("s_waitcnt vmcnt(8)" ::: "memory");
        } else asm volatile("s_waitcnt vmcnt(0)" ::: "memory");
        AttnFrag F; attn_read(F, kl + (s & 1) * AT_BUF, lane);
        attn_compute<NQ>(st, F, BiasZero(), lane);
    }
}

__device__ __forceinline__ void win_item(const KArgs& a, int l, int item, bool ctxq, LAS unsigned char* kl, int lane) {
    asm volatile("" : "+v"(lane));
    bf16_t* Z = (bf16_t*)(a.ws + WS_Z);
    int b, gi, qt;
    if (!ctxq) { b = item >> 9; gi = (item >> 8) & 1; qt = item & 255; } else { b = item >> 5; gi = (item >> 4) & 1; qt = item & 15; }
    const int t0 = qt * 16, r16 = lane & 15;
    const int qrow0 = (ctxq ? ML + b * CTXL : b * SEQ) + t0, qrow = qrow0 + r16;
    const char* zb = (const char*)Z; const int g = lane >> 4;
    AttnSt<4> st; attn_init<4>(st);
#pragma unroll
    for (int qi = 0; qi < 4; ++qi) { const bf16_t* qp = Z + (size_t)qrow * ZP + C_WQ + (gi * 4 + qi) * 64 + g * 8;
        st.Q[qi][0] = *(const bf16x8*)qp; st.Q[qi][1] = *(const bf16x8*)(qp + 32); st.m[qi] = a.in[I_WSINK][l * 8 + gi * 4 + qi] * LOG2E; st.l[qi] = (g == 0) ? 1.0f : 0.f; }
    const int kcol = C_WK + gi * 64, vcol = C_WV + gi * 64;
    int s0 = 0, s1 = 0;
    if (!ctxq) { s1 = 9; const int ks = t0 - 128; while (s0 < s1 && ks + 32 * s0 + 31 < 0) ++s0; while (s1 > s0 && ks + 32 * (s1 - 1) >= SEQ) --s1; }
    const int nl = s1 - s0, n = nl + 8;
    unsigned rp[4];
#define AT_ISSUE(i_) do { const int ii_ = (i_); _Pragma("unroll") for (int c = 0; c < 4; ++c) { int row_; \
        if (ii_ < nl) { int kp = t0 - 128 + 32 * (s0 + ii_) + c * 8 + (lane >> 3); kp = kp < 0 ? 0 : (kp > SEQ - 1 ? SEQ - 1 : kp); row_ = b * SEQ + kp; } \
        else row_ = ML + b * CTXL + 32 * (ii_ - nl) + c * 8 + (lane >> 3); \
        rp[c] = (unsigned)row_ * (unsigned)(ZP * 2) + (unsigned)at_piece_off(lane); } \
        stage_issue(zb, rp, kcol * 2, vcol * 2, kl + (ii_ & 1) * AT_BUF); } while (0)
    AT_ISSUE(0); AT_ISSUE(1);
    for (int i = 0; i < nl; ++i) {
        asm volatile("s_waitcnt vmcnt(8)" ::: "memory");
        AttnFrag F; attn_read(F, kl + (i & 1) * AT_BUF, lane);
        AT_ISSUE(i + 2);
        const int kstart = t0 - 128 + 32 * (s0 + i);
        BiasWin bw; bw.kstart = kstart; bw.d0 = kstart - t0; bw.interior = (kstart >= 0 && kstart + 31 < SEQ && kstart >= t0 + 15 - 128 && kstart + 31 <= t0 + 128);
        attn_compute<4>(st, F, bw, lane);
    }
    for (int i = nl; i < n; ++i) {
        if (i + 1 < n) asm volatile("s_waitcnt vmcnt(8)" ::: "memory"); else asm volatile("s_waitcnt vmcnt(0)" ::: "memory");
        AttnFrag F; attn_read(F, kl + (i & 1) * AT_BUF, lane);
        if (i + 2 < n) AT_ISSUE(i + 2);
        attn_compute<4>(st, F, BiasZero(), lane);
    }
#undef AT_ISSUE
#pragma unroll
    for (int qi = 0; qi < 4; ++qi) attn_store<4>(st, qi, Z + (size_t)qrow * ZP + Y_WIN + (gi * 4 + qi) * 64, lane);
}

__device__ __forceinline__ void na_item(const KArgs& a, int l, int item, bool ctxq, LAS unsigned char* kl, int lane) {
    asm volatile("" : "+v"(lane));
    bf16_t* Z = (bf16_t*)(a.ws + WS_Z);
    int b, h, r;
    if (!ctxq) { b = item >> 9; h = (item >> 6) & 7; r = item & 63; } else { b = item >> 5; h = (item >> 2) & 7; r = item & 3; }
    const int r16 = lane & 15;
    const int qbase = (ctxq ? ML + b * CTXL : b * SEQ) + r * 64, qrow0 = qbase + r16;
    const char* zb = (const char*)Z; const int g = lane >> 4;
    AttnSt<4> st; attn_init<4>(st);
#pragma unroll
    for (int qi = 0; qi < 4; ++qi) { const bf16_t* qp = Z + (size_t)(qrow0 + qi * 16) * ZP + C_NQ + h * 64 + g * 8; st.Q[qi][0] = *(const bf16x8*)qp; st.Q[qi][1] = *(const bf16x8*)(qp + 32); }
    const int kcol = C_NK + h * 64, vcol = C_NV + h * 64;
    LAS float* tab = (LAS float*)(kl + AT_TABOFF);
    int rs = r - 4; rs = rs < 0 ? 0 : (rs > 56 ? 56 : rs);
    if (!ctxq) { const float* rpbp = a.in[I_RPB] + (size_t)(l * 8 + h) * 465; for (int i = lane; i < 465; i += 64) tab[i] = rpbp[i] * LOG2E; }
    const int nl = ctxq ? 0 : 16, n = nl + 8;
    unsigned rp[4];
#define AT_ISSUE(i_) do { const int ii_ = (i_); _Pragma("unroll") for (int c = 0; c < 4; ++c) { \
        const int row_ = (ii_ < nl) ? b * SEQ + rs * 64 + 32 * ii_ + c * 8 + (lane >> 3) : ML + b * CTXL + 32 * (ii_ - nl) + c * 8 + (lane >> 3); \
        rp[c] = (unsigned)row_ * (unsigned)(ZP * 2) + (unsigned)at_piece_off(lane); } \
        stage_issue(zb, rp, kcol * 2, vcol * 2, kl + (ii_ & 1) * AT_BUF); } while (0)
    AT_ISSUE(0); AT_ISSUE(1);
    for (int i = 0; i < nl; ++i) {
        asm volatile("s_waitcnt vmcnt(8)" ::: "memory");
        AttnFrag F; attn_read(F, kl + (i & 1) * AT_BUF, lane);
        AT_ISSUE(i + 2);
        BiasNA bn; bn.tabaddr = lds_u32((const LAS unsigned char*)tab); bn.rowoff31 = (rs + (i >> 1) - r + 7) * 31; bn.c0 = (i & 1) * 32;
        attn_compute<4>(st, F, bn, lane);
    }
    for (int i = nl; i < n; ++i) {
        if (i + 1 < n) asm volatile("s_waitcnt vmcnt(8)" ::: "memory"); else asm volatile("s_waitcnt vmcnt(0)" ::: "memory");
        AttnFrag F; attn_read(F, kl + (i & 1) * AT_BUF, lane);
        if (i + 2 < n) AT_ISSUE(i + 2);
        attn_compute<4>(st, F, BiasZero(), lane);
    }
#undef AT_ISSUE
#pragma unroll
    for (int qi = 0; qi < 4; ++qi) attn_store<4>(st, qi, Z + (size_t)(qrow0 + qi * 16) * ZP + Y_NA + h * 64, lane);
}
constexpr int RT_VS = 288, RT_KS = 160, RT_SS = 144;
__device__ __forceinline__ size_t kvt_off(int bh, int dir, int ch) { return (((size_t)bh * 2 + dir) * 34 + ch) * 8192; }
__device__ __forceinline__ float log_sigmoidf_(float x) { return -(fmaxf(-x, 0.f) + log1pf(__expf(-fabsf(x)))); }
__device__ __forceinline__ int ret_row0(int b, int ch) { return ch < 2 ? ML + b * CTXL + ch * 128 : b * SEQ + (ch - 2) * 128; }

struct RkPre { u32x4 v[4], k[2]; };
__device__ __forceinline__ void ret_kv_load(const KArgs& a, int unit, RkPre& R) {
    const int tid = OTID(); const int bh = unit / 34, ch = unit % 34, b = bh >> 2, h = bh & 3; const bf16_t* Z = (const bf16_t*)(a.ws + WS_Z); const int row0 = ret_row0(b, ch);
#pragma unroll
    for (int i = 0; i < 4; ++i) { const int p = tid + i * 512, r = p >> 4, c = p & 15; R.v[i] = *(const u32x4*)(Z + (size_t)(row0 + r) * ZP + C_RV + h * 128 + c * 8); }
#pragma unroll
    for (int i = 0; i < 2; ++i) { const int p = tid + i * 512, r = p >> 3, c = p & 7; R.k[i] = *(const u32x4*)(Z + (size_t)(row0 + r) * ZP + C_RK + h * 64 + c * 8); }
}
__device__ __forceinline__ void ret_kv_unit(const KArgs& a, LAS unsigned char* lds, int l, int unit, const RkPre& PRE) {
    const int tid = OTID(), lane = tid & 63, wave = tid >> 6, g = lane >> 4, r16 = lane & 15;
    const int bh = unit / 34, ch = unit % 34, b = bh >> 2, h = bh & 3;
    const bf16_t* Z = (const bf16_t*)(a.ws + WS_Z);
    const int row0 = ret_row0(b, ch);
    const float lgf = log_sigmoidf_(a.in[I_RDECAY][l * 8 + h]), lgb = log_sigmoidf_(a.in[I_RDECAY][l * 8 + 4 + h]);
    LAS unsigned char* Vl = lds; LAS unsigned char* Kf = lds + 128 * RT_VS; LAS unsigned char* Kb = Kf + 128 * RT_KS;
#pragma unroll
    for (int i = 0; i < 4; ++i) { const int p = tid + i * 512, r = p >> 4, c = p & 15; *(LAS u32x4*)(Vl + r * RT_VS + c * 16) = PRE.v[i]; }
#pragma unroll
    for (int i = 0; i < 2; ++i) { const int p = tid + i * 512, r = p >> 3, c = p & 7;
        const u32x4 kv = PRE.k[i];
        const float df = __expf(lgf * (float)(127 - r)), db = __expf(lgb * (float)r);
        u32x4 of, ob;
        of.x = pk2(bflo(kv.x) * df, bfhi(kv.x) * df); of.y = pk2(bflo(kv.y) * df, bfhi(kv.y) * df); of.z = pk2(bflo(kv.z) * df, bfhi(kv.z) * df); of.w = pk2(bflo(kv.w) * df, bfhi(kv.w) * df);
        ob.x = pk2(bflo(kv.x) * db, bfhi(kv.x) * db); ob.y = pk2(bflo(kv.y) * db, bfhi(kv.y) * db); ob.z = pk2(bflo(kv.z) * db, bfhi(kv.z) * db); ob.w = pk2(bflo(kv.w) * db, bfhi(kv.w) * db);
        *(LAS u32x4*)(Kf + r * RT_KS + c * 16) = of; *(LAS u32x4*)(Kb + r * RT_KS + c * 16) = ob; }
    __syncthreads();
    f32x4 acc[2][4];
#pragma unroll
    for (int d = 0; d < 2; ++d)
#pragma unroll
        for (int t = 0; t < 4; ++t) acc[d][t] = (f32x4){0.f, 0.f, 0.f, 0.f};
    const int qq = r16 >> 2, pp = r16 & 3;
#pragma unroll
    for (int ks = 0; ks < 4; ++ks) {
        const int tr0 = ks * 32 + 4 * g + qq;
        const s16x4 alo = lds_tr16(Vl + tr0 * RT_VS + (wave * 16 + 4 * pp) * 2), ahi = lds_tr16(Vl + (tr0 + 16) * RT_VS + (wave * 16 + 4 * pp) * 2);
        const bf16x8 A = (bf16x8){alo[0], alo[1], alo[2], alo[3], ahi[0], ahi[1], ahi[2], ahi[3]};
#pragma unroll
        for (int t = 0; t < 4; ++t) {
            const s16x4 flo = lds_tr16(Kf + tr0 * RT_KS + (t * 16 + 4 * pp) * 2), fhi = lds_tr16(Kf + (tr0 + 16) * RT_KS + (t * 16 + 4 * pp) * 2);
            const s16x4 blo = lds_tr16(Kb + tr0 * RT_KS + (t * 16 + 4 * pp) * 2), bhi = lds_tr16(Kb + (tr0 + 16) * RT_KS + (t * 16 + 4 * pp) * 2);
            acc[0][t] = __builtin_amdgcn_mfma_f32_16x16x32_bf16(A, (bf16x8){flo[0], flo[1], flo[2], flo[3], fhi[0], fhi[1], fhi[2], fhi[3]}, acc[0][t], 0, 0, 0);
            acc[1][t] = __builtin_amdgcn_mfma_f32_16x16x32_bf16(A, (bf16x8){blo[0], blo[1], blo[2], blo[3], bhi[0], bhi[1], bhi[2], bhi[3]}, acc[1][t], 0, 0, 0);
        }
    }
    bf16_t* kvt = (bf16_t*)(a.ws + WS_KVT);
    LAS unsigned char* tw = lds + 81920 + wave * 4608;
#pragma unroll
    for (int d = 0; d < 2; ++d)
#pragma unroll
        for (int t = 0; t < 4; ++t)
#pragma unroll
            for (int j = 0; j < 4; ++j) *(LAS bf16_t*)(tw + d * 2304 + (4 * g + j) * 144 + (t * 16 + r16) * 2) = (bf16_t)f2bf(acc[d][t][j]);
#pragma unroll
    for (int d = 0; d < 2; ++d) { bf16_t* o = kvt + kvt_off(bh, d, ch) + (size_t)(wave * 16) * 64;
#pragma unroll
        for (int i = 0; i < 2; ++i) { const int idx = lane + 64 * i, r = idx >> 3, c8 = idx & 7; *(u32x4*)(o + r * 64 + c8 * 8) = *(const LAS u32x4*)(tw + d * 2304 + r * 144 + c8 * 16); } }
    __syncthreads();
}

__device__ __forceinline__ void ret_prefix(const KArgs& a, int l, int blk0) {
    const int tid = OTID(), blk = OBLK(), G = OGRID();
    if (G <= blk0) blk0 = 0;
    if (blk < blk0) return;
    bf16_t* kvt = (bf16_t*)(a.ws + WS_KVT);
    for (int gt = (blk - blk0) * NTHR + tid; gt < 64 * 1024; gt += (G - blk0) * NTHR) {
        const int pair = gt >> 10, e8 = gt & 1023, d = pair & 1, h = (pair >> 1) & 3;
        const float gC = __expf(log_sigmoidf_(a.in[I_RDECAY][l * 8 + d * 4 + h]) * 128.0f);
        bf16_t* base = kvt + (size_t)pair * 34 * 8192 + e8 * 8;
        float s[8];
#pragma unroll
        for (int e = 0; e < 8; ++e) s[e] = 0.f;
#pragma unroll
        for (int half = 0; half < 2; ++half) {
            u32x4 x[17];
#pragma unroll
            for (int k = 0; k < 17; ++k) { const int oo = half * 17 + k; const int ci = (d == 0) ? oo : (oo < 2 ? 1 - oo : 35 - oo); x[k] = *(const u32x4*)(base + (size_t)ci * 8192); }
#pragma unroll
            for (int k = 0; k < 17; ++k) { const int oo = half * 17 + k; const int ci = (d == 0) ? oo : (oo < 2 ? 1 - oo : 35 - oo);
                u32x4 w; w.x = pk2(s[0], s[1]); w.y = pk2(s[2], s[3]); w.z = pk2(s[4], s[5]); w.w = pk2(s[6], s[7]);
                *(u32x4*)(base + (size_t)ci * 8192) = w;
                s[0] = s[0] * gC + bflo(x[k].x); s[1] = s[1] * gC + bfhi(x[k].x); s[2] = s[2] * gC + bflo(x[k].y); s[3] = s[3] * gC + bfhi(x[k].y);
                s[4] = s[4] * gC + bflo(x[k].z); s[5] = s[5] * gC + bfhi(x[k].z); s[6] = s[6] * gC + bflo(x[k].w); s[7] = s[7] * gC + bfhi(x[k].w); }
        }
    }
}

__device__ __forceinline__ void ret_out_unit(const KArgs& a, LAS unsigned char* lds, int l, int unit) {
    const int tid = OTID(), lane = tid & 63, wave = tid >> 6, g = lane >> 4, r16 = lane & 15;
    const int bh = unit / 34, ch = unit % 34, b = bh >> 2, h = bh & 3;
    bf16_t* Z = (bf16_t*)(a.ws + WS_Z);
    const bf16_t* kvt = (const bf16_t*)(a.ws + WS_KVT);
    const int row0 = ret_row0(b, ch);
    const float lgf = log_sigmoidf_(a.in[I_RDECAY][l * 8 + h]), lgb = log_sigmoidf_(a.in[I_RDECAY][l * 8 + 4 + h]);
    LAS unsigned char* Vl = lds; LAS unsigned char* Sf = lds + 128 * RT_VS; LAS unsigned char* Sb = Sf + 128 * RT_SS;
    u32x4 vst[4];
#pragma unroll
    for (int i = 0; i < 4; ++i) { const int p = tid + i * 512, r = p >> 4, c = p & 15; vst[i] = *(const u32x4*)(Z + (size_t)(row0 + r) * ZP + C_RV + h * 128 + c * 8); }
    u32x4 sst[4];
    { const int dv = tid >> 2, dk0 = (tid & 3) * 16;
      const u32x4* sf = (const u32x4*)(kvt + kvt_off(bh, 0, ch) + dv * 64 + dk0); const u32x4* sb = (const u32x4*)(kvt + kvt_off(bh, 1, ch) + dv * 64 + dk0);
      sst[0] = sf[0]; sst[1] = sf[1]; sst[2] = sb[0]; sst[3] = sb[1]; }
    const int qi = wave * 16 + r16;
    const bf16_t* qp = Z + (size_t)(row0 + qi) * ZP + C_RQ + h * 64 + g * 8;
    const bf16x8 Q0 = *(const bf16x8*)qp, Q1 = *(const bf16x8*)(qp + 32);
    bf16x8 Kf[8][2];
#pragma unroll
    for (int kt = 0; kt < 8; ++kt) { const bf16_t* kp = Z + (size_t)(row0 + kt * 16 + r16) * ZP + C_RK + h * 64 + g * 8; Kf[kt][0] = *(const bf16x8*)kp; Kf[kt][1] = *(const bf16x8*)(kp + 32); }
    const float* gn = a.in[I_RGN] + l * 512 + h * 128;
    bf16_t* yrow = Z + (size_t)(row0 + qi) * ZP + Y_RET + h * 128;
#pragma unroll
    for (int i = 0; i < 4; ++i) { const int p = tid + i * 512, r = p >> 4, c = p & 15; *(LAS u32x4*)(Vl + r * RT_VS + c * 16) = vst[i]; }
    { const int dv = tid >> 2, dk0 = (tid & 3) * 16;
      *(LAS u32x4*)(Sf + dv * RT_SS + dk0 * 2) = sst[0]; *(LAS u32x4*)(Sf + dv * RT_SS + dk0 * 2 + 16) = sst[1];
      *(LAS u32x4*)(Sb + dv * RT_SS + dk0 * 2) = sst[2]; *(LAS u32x4*)(Sb + dv * RT_SS + dk0 * 2 + 16) = sst[3]; }
    __syncthreads();
    float dcf[4], dcb[4], dcd[4];
#pragma unroll
    for (int j = 0; j < 4; ++j) { const int dl = r16 - 4 * g - j; dcf[j] = __expf(lgf * (float)dl); dcb[j] = __expf(-lgb * (float)dl); dcd[j] = (dl >= 0 ? dcf[j] : 0.f) + (dl <= 0 ? dcb[j] : 0.f); }
    f32x4 O[8];
#pragma unroll
    for (int dt = 0; dt < 8; ++dt) O[dt] = (f32x4){0.f, 0.f, 0.f, 0.f};
    const int qq = r16 >> 2, pp = r16 & 3;
#pragma unroll
    for (int ks = 0; ks < 4; ++ks) {
        u32x4 pw;
#pragma unroll
        for (int half = 0; half < 2; ++half) {
            const int kt = 2 * ks + half;
            f32x4 s = (f32x4){0.f, 0.f, 0.f, 0.f};
            s = __builtin_amdgcn_mfma_f32_16x16x32_bf16(Kf[kt][0], Q0, s, 0, 0, 0);
            s = __builtin_amdgcn_mfma_f32_16x16x32_bf16(Kf[kt][1], Q1, s, 0, 0, 0);
            float p[4];
            {
                const int dk = __builtin_amdgcn_readfirstlane(wave) - kt;
                if (dk > 0) { const float E = __expf(lgf * (float)(16 * dk));
#pragma unroll
                    for (int j = 0; j < 4; ++j) p[j] = s[j] * (E * dcf[j]); }
                else if (dk < 0) { const float E = __expf(lgb * (float)(-16 * dk));
#pragma unroll
                    for (int j = 0; j < 4; ++j) p[j] = s[j] * (E * dcb[j]); }
                else {
#pragma unroll
                    for (int j = 0; j < 4; ++j) p[j] = s[j] * dcd[j]; } }
            if (half == 0) { pw.x = pk2(p[0], p[1]); pw.y = pk2(p[2], p[3]); } else { pw.z = pk2(p[0], p[1]); pw.w = pk2(p[2], p[3]); }
        }
        const bf16x8 pf = __builtin_bit_cast(bf16x8, pw);
        const int tr0 = ks * 32 + 4 * g + qq;
#pragma unroll
        for (int dt = 0; dt < 8; ++dt) {
            const s16x4 lo = lds_tr16(Vl + tr0 * RT_VS + (dt * 16 + 4 * pp) * 2), hi = lds_tr16(Vl + (tr0 + 16) * RT_VS + (dt * 16 + 4 * pp) * 2);
            O[dt] = __builtin_amdgcn_mfma_f32_16x16x32_bf16((bf16x8){lo[0], lo[1], lo[2], lo[3], hi[0], hi[1], hi[2], hi[3]}, pf, O[dt], 0, 0, 0);
        }
    }
    { const float dqf = __expf(lgf * (float)(qi + 1)), dqb = __expf(lgb * (float)(128 - qi));
#pragma unroll
      for (int dt = 0; dt < 8; ++dt) {
          f32x4 tf = (f32x4){0.f, 0.f, 0.f, 0.f}, tb = (f32x4){0.f, 0.f, 0.f, 0.f};
          const LAS unsigned char* sf = Sf + (dt * 16 + r16) * RT_SS + g * 16; const LAS unsigned char* sb = Sb + (dt * 16 + r16) * RT_SS + g * 16;
          tf = __builtin_amdgcn_mfma_f32_16x16x32_bf16(*(const LAS bf16x8*)sf, Q0, tf, 0, 0, 0); tf = __builtin_amdgcn_mfma_f32_16x16x32_bf16(*(const LAS bf16x8*)(sf + 64), Q1, tf, 0, 0, 0);
          tb = __builtin_amdgcn_mfma_f32_16x16x32_bf16(*(const LAS bf16x8*)sb, Q0, tb, 0, 0, 0); tb = __builtin_amdgcn_mfma_f32_16x16x32_bf16(*(const LAS bf16x8*)(sb + 64), Q1, tb, 0, 0, 0);
          O[dt] = O[dt] + tf * dqf + tb * dqb;
      } }
    float sm = 0.f;
#pragma unroll
    for (int dt = 0; dt < 8; ++dt) sm += (O[dt][0] + O[dt][1]) + (O[dt][2] + O[dt][3]);
    sm += __shfl_xor(sm, 16); sm += __shfl_xor(sm, 32);
    const float mean = sm * (1.f / 128.f);
    float sq = 0.f;
#pragma unroll
    for (int dt = 0; dt < 8; ++dt) { const f32x4 dd = O[dt] - mean; sq += (dd[0] * dd[0] + dd[1] * dd[1]) + (dd[2] * dd[2] + dd[3] * dd[3]); }
    sq += __shfl_xor(sq, 16); sq += __shfl_xor(sq, 32);
    const float rstd = rsqrtf(sq * (1.f / 128.f) + EPS);
    u32x2 gtv[8]; f32x4 gvv[8];
#pragma unroll
    for (int dt = 0; dt < 8; ++dt) { gtv[dt] = *(const u32x2*)(yrow + dt * 16 + 4 * g); gvv[dt] = *(const f32x4*)(gn + dt * 16 + 4 * g); }
#pragma unroll
    for (int dt = 0; dt < 8; ++dt) { const int c = dt * 16 + 4 * g;
        const u32x2 gt = gtv[dt]; const f32x4 gv = gvv[dt];
        u32x2 w; w.x = pk2((O[dt][0] - mean) * rstd * gv[0] * silu_fast(bflo(gt.x)), (O[dt][1] - mean) * rstd * gv[1] * silu_fast(bfhi(gt.x)));
        w.y = pk2((O[dt][2] - mean) * rstd * gv[2] * silu_fast(bflo(gt.y)), (O[dt][3] - mean) * rstd * gv[3] * silu_fast(bfhi(gt.y)));
        *(u32x2*)(yrow + c) = w; }
    __syncthreads();
}
constexpr int C_UF = C_GQ, C_UB = C_GK, C_WF = C_GV, C_AQ = 5888;
__device__ __forceinline__ int gdn_row0(int b, int c) { return c < 4 ? ML + b * CTXL + c * 64 : b * SEQ + (c - 4) * 64; }

constexpr int GP_SQ = 90112, GP_RS = 288, GP_SK = GP_SQ + 64 * GP_RS, GP_SV = GP_SK + 64 * GP_RS, GP_WS = 144;
struct GpPre { u32x4 st[3][2]; float gc, be; };
__device__ __forceinline__ void gdn_prep_load(const KArgs& a, int unit, GpPre& R) {
    const int tid = OTID(); const int bh = unit / 68, c = unit % 68, b = bh >> 2, h = bh & 3; const int row0 = gdn_row0(b, c);
    const bf16_t* P = (const bf16_t*)(a.ws + WS_P); const float* GBa = (const float*)(a.ws + WS_GB); const float* GBb = GBa + (size_t)MA * 8;
#pragma unroll
    for (int m = 0; m < 3; ++m)
#pragma unroll
        for (int i = 0; i < 2; ++i) { const int p = tid + i * 512, r = p >> 4, c16 = p & 15; R.st[m][i] = *(const u32x4*)(P + (size_t)(row0 + r) * PP + m * 512 + h * 128 + c16 * 8); }
    R.gc = 0.f; R.be = 0.f;
    if (tid < 128) { const int d = tid >> 6, i = tid & 63; const size_t o = (size_t)(row0 + i) * 8 + d * 4 + h; R.gc = GBa[o]; R.be = GBb[o]; }
}
__device__ __forceinline__ void gdn_prep_unit(const KArgs& a, LAS unsigned char* lds, int unit, const GpPre& PRE) {
    const int tid = OTID(), lane = tid & 63, wave = tid >> 6, g = lane >> 4, r16 = lane & 15;
    const int bh = unit / 68, c = unit % 68, b = bh >> 2, h = bh & 3;
    const int row0 = gdn_row0(b, c);
    bf16_t* Z = (bf16_t*)(a.ws + WS_Z); bf16_t* P = (bf16_t*)(a.ws + WS_P);
    float* GBa = (float*)(a.ws + WS_GB); const float* GBb = GBa + (size_t)MA * 8;
    LAS float* KK = (LAS float*)lds; LAS float* QK = KK + 4096; LAS float* AF = QK + 4096; LAS float* AB = AF + 4096;
    LAS float* gcs = AB + 4096;
    LAS float* bes = gcs + 128;
    { if (tid < 128) { gcs[tid] = PRE.gc; bes[tid] = PRE.be; }
#pragma unroll
      for (int m = 0; m < 3; ++m)
#pragma unroll
          for (int i = 0; i < 2; ++i) { const int p = tid + i * 512, r = p >> 4, c16 = p & 15; *(LAS u32x4*)(lds + GP_SQ + m * 64 * GP_RS + r * GP_RS + c16 * 16) = PRE.st[m][i]; } }
    __syncthreads();
    if (wave < 2) { float v = gcs[tid];
#pragma unroll
        for (int off = 1; off < 64; off <<= 1) { const float t = (wave == 0) ? __shfl_up(v, off) : __shfl_down(v, off); if ((wave == 0) ? (lane >= off) : (lane + off < 64)) v += t; }
        gcs[tid] = v; }
    { const int rt = wave & 3; const LAS unsigned char* ap = lds + (wave < 4 ? GP_SK : GP_SQ) + (rt * 16 + r16) * GP_RS + g * 16;
      bf16x8 A[4];
#pragma unroll
      for (int ks = 0; ks < 4; ++ks) A[ks] = *(const LAS bf16x8*)(ap + ks * 64);
      LAS float* M = (wave < 4) ? KK : QK;
#pragma unroll
      for (int ct = 0; ct < 4; ++ct) { const LAS unsigned char* bp = lds + GP_SK + (ct * 16 + r16) * GP_RS + g * 16;
          f32x4 acc = (f32x4){0.f, 0.f, 0.f, 0.f};
#pragma unroll
          for (int ks = 0; ks < 4; ++ks) acc = __builtin_amdgcn_mfma_f32_16x16x32_bf16(A[ks], *(const LAS bf16x8*)(bp + ks * 64), acc, 0, 0, 0);
#pragma unroll
          for (int j = 0; j < 4; ++j) M[(rt * 16 + 4 * g + j) * 64 + ct * 16 + r16] = acc[j]; } }
    __syncthreads();
    if (tid < 128) { const int d = tid >> 6, i = tid & 63; ((float*)(a.ws + WS_GC2))[(size_t)(d * 4 + h) * MA + row0 + i] = gcs[tid]; }
    { const int i = tid >> 3, j0 = (tid & 7) * 8;
      const f32x4 kk0 = *(const LAS f32x4*)(KK + i * 64 + j0), kk1 = *(const LAS f32x4*)(KK + i * 64 + j0 + 4), qk0 = *(const LAS f32x4*)(QK + i * 64 + j0), qk1 = *(const LAS f32x4*)(QK + i * 64 + j0 + 4);
      const f32x4 gf0 = *(const LAS f32x4*)(gcs + j0), gf1 = *(const LAS f32x4*)(gcs + j0 + 4), gb0 = *(const LAS f32x4*)(gcs + 64 + j0), gb1 = *(const LAS f32x4*)(gcs + 64 + j0 + 4);
      const float gfi = gcs[i], gbi = gcs[64 + i], bfi = bes[i], bbi = bes[64 + i];
      float af[8], ab[8], aq[8];
#pragma unroll
      for (int e = 0; e < 8; ++e) { const int j = j0 + e; const float kk = e < 4 ? kk0[e & 3] : kk1[e & 3], qk = e < 4 ? qk0[e & 3] : qk1[e & 3], gfj = e < 4 ? gf0[e & 3] : gf1[e & 3], gbj = e < 4 ? gb0[e & 3] : gb1[e & 3];
          const float ef = __expf(fminf(gfi - gfj, 0.f)), eb = __expf(fminf(gbi - gbj, 0.f));
          af[e] = (j < i) ? bfi * kk * ef : 0.f; ab[e] = (j > i) ? bbi * kk * eb : 0.f;
          aq[e] = qk * (j < i ? ef : (j > i ? eb : 1.0f)); }
      *(LAS f32x4*)(AF + i * 64 + j0) = (f32x4){af[0], af[1], af[2], af[3]}; *(LAS f32x4*)(AF + i * 64 + j0 + 4) = (f32x4){af[4], af[5], af[6], af[7]};
      *(LAS f32x4*)(AB + (63 - i) * 64 + 56 - j0) = (f32x4){ab[7], ab[6], ab[5], ab[4]}; *(LAS f32x4*)(AB + (63 - i) * 64 + 60 - j0) = (f32x4){ab[3], ab[2], ab[1], ab[0]};
      u32x4 w; w.x = pk2(-af[0], -af[1]); w.y = pk2(-af[2], -af[3]); w.z = pk2(-af[4], -af[5]); w.w = pk2(-af[6], -af[7]);
      *(LAS u32x4*)(lds + 66560 + (i * 64 + j0) * 2) = w;
      w.x = pk2(-ab[7], -ab[6]); w.y = pk2(-ab[5], -ab[4]); w.z = pk2(-ab[3], -ab[2]); w.w = pk2(-ab[1], -ab[0]);
      *(LAS u32x4*)(lds + 66560 + (4096 + (63 - i) * 64 + 56 - j0) * 2) = w;
      w.x = pk2(aq[0], aq[1]); w.y = pk2(aq[2], aq[3]); w.z = pk2(aq[4], aq[5]); w.w = pk2(aq[6], aq[7]);
      *(u32x4*)(Z + (size_t)(row0 + i) * ZP + C_AQ + h * 64 + j0) = w; }
    LAS bf16_t* NAm = (LAS bf16_t*)(lds + 66560);
    LAS bf16_t* TL = (LAS bf16_t*)(lds + 82944);
    __syncthreads();
    { const int dd = wave >> 2, bb = wave & 3; const LAS float* Am = (dd ? AB : AF) + (bb * 16) * 64 + bb * 16;
      if (lane < 16) { float t[16];
#pragma unroll
          for (int i = 0; i < 16; ++i) { float acc = (i == lane) ? 1.f : 0.f;
#pragma unroll
              for (int j = 0; j < i; ++j) acc -= Am[i * 64 + j] * t[j];
              t[i] = acc; }
#pragma unroll
          for (int i = 0; i < 16; ++i) TL[((dd * 4 + bb) * 16 + i) * 16 + lane] = (bf16_t)f2bf(t[i]); } }
    const int d = wave >> 2, part = wave & 3; const bool isw = part >= 2;
    f32x4 R[4][4];
    { const int qq = r16 >> 2, pp = r16 & 3; const LAS unsigned char* sx = lds + (isw ? GP_SK : GP_SV) + ((part & 1) * 64 + 4 * pp) * 2;
#pragma unroll
      for (int bk = 0; bk < 4; ++bk) { const int rb = d ? 60 - 16 * bk - 4 * g : 16 * bk + 4 * g;
          float f[4];
#pragma unroll
          for (int j = 0; j < 4; ++j) { const int tok = d ? rb + 3 - j : rb + j; f[j] = isw ? bes[d * 64 + tok] * __expf(gcs[d * 64 + tok]) : bes[d * 64 + tok]; }
#pragma unroll
          for (int ct = 0; ct < 4; ++ct) { const s16x4 v4 = lds_tr16(sx + (rb + qq) * GP_RS + ct * 32);
#pragma unroll
              for (int j = 0; j < 4; ++j) R[bk][ct][j] = f[j] * bf2f((bf16_t)(d ? v4[3 - j] : v4[j])); } } }
    __syncthreads();
    { const LAS bf16_t* Nd = NAm + d * 4096; const LAS bf16_t* Td = TL + d * 1024;
      const u32x2 zero2 = (u32x2){0u, 0u};
#pragma unroll
      for (int bk = 0; bk < 4; ++bk) {
#pragma unroll
          for (int c0 = 0; c0 < 4; c0 += 2) if (c0 < bk) {
              const u32x2 alo = *(const LAS u32x2*)(Nd + (bk * 16 + r16) * 64 + c0 * 16 + 4 * g);
              const u32x2 ahi = (c0 + 1 < bk) ? *(const LAS u32x2*)(Nd + (bk * 16 + r16) * 64 + (c0 + 1) * 16 + 4 * g) : zero2;
              const bf16x8 Af = cat8(alo, ahi);
#pragma unroll
              for (int ct = 0; ct < 4; ++ct) { u32x2 blo, bhi = zero2; blo.x = pk2(R[c0][ct][0], R[c0][ct][1]); blo.y = pk2(R[c0][ct][2], R[c0][ct][3]);
                  if (c0 + 1 < bk) { bhi.x = pk2(R[c0 + 1][ct][0], R[c0 + 1][ct][1]); bhi.y = pk2(R[c0 + 1][ct][2], R[c0 + 1][ct][3]); }
                  R[bk][ct] = __builtin_amdgcn_mfma_f32_16x16x32_bf16(Af, cat8(blo, bhi), R[bk][ct], 0, 0, 0); } }
          const bf16x8 Tf = cat8(*(const LAS u32x2*)(Td + (bk * 16 + r16) * 16 + 4 * g), zero2);
#pragma unroll
          for (int ct = 0; ct < 4; ++ct) { u32x2 blo; blo.x = pk2(R[bk][ct][0], R[bk][ct][1]); blo.y = pk2(R[bk][ct][2], R[bk][ct][3]);
              R[bk][ct] = __builtin_amdgcn_mfma_f32_16x16x32_bf16(Tf, cat8(blo, zero2), (f32x4){0.f, 0.f, 0.f, 0.f}, 0, 0, 0); }
      } }
    if (isw) {
        LAS unsigned char* wt = lds + GP_SQ + (d * 2 + (part & 1)) * 64 * GP_WS;
#pragma unroll
        for (int bk = 0; bk < 4; ++bk)
#pragma unroll
            for (int j = 0; j < 4; ++j) { const int ip = bk * 16 + 4 * g + j, tok = d ? 63 - ip : ip;
#pragma unroll
                for (int ct = 0; ct < 4; ++ct) *(LAS bf16_t*)(wt + tok * GP_WS + (ct * 16 + r16) * 2) = (bf16_t)f2bf(R[bk][ct][j]); }
        bf16_t* dst0 = (d == 0 ? Z + (size_t)row0 * ZP + C_WF : P + (size_t)row0 * PP + 1024) + h * 128 + (part & 1) * 64; const int dp = d == 0 ? ZP : PP;
#pragma unroll
        for (int i = 0; i < 8; ++i) { const int idx = lane + 64 * i, r = idx >> 3, c8 = idx & 7; *(u32x4*)(dst0 + (size_t)r * dp + c8 * 8) = *(const LAS u32x4*)(wt + r * GP_WS + c8 * 16); }
    } else {
#pragma unroll
        for (int bk = 0; bk < 4; ++bk) { const int i0 = d ? 60 - 16 * bk - 4 * g : 16 * bk + 4 * g; const int e0 = utile_off(i0, (part & 1) * 64 + r16);
            u32x4 lo, hi;
            if (d == 0) { lo.x = pk2(R[bk][0][0], R[bk][0][1]); lo.y = pk2(R[bk][0][2], R[bk][0][3]); lo.z = pk2(R[bk][1][0], R[bk][1][1]); lo.w = pk2(R[bk][1][2], R[bk][1][3]);
                          hi.x = pk2(R[bk][2][0], R[bk][2][1]); hi.y = pk2(R[bk][2][2], R[bk][2][3]); hi.z = pk2(R[bk][3][0], R[bk][3][1]); hi.w = pk2(R[bk][3][2], R[bk][3][3]); }
            else        { lo.x = pk2(R[bk][0][3], R[bk][0][2]); lo.y = pk2(R[bk][0][1], R[bk][0][0]); lo.z = pk2(R[bk][1][3], R[bk][1][2]); lo.w = pk2(R[bk][1][1], R[bk][1][0]);
                          hi.x = pk2(R[bk][2][3], R[bk][2][2]); hi.y = pk2(R[bk][2][1], R[bk][2][0]); hi.z = pk2(R[bk][3][3], R[bk][3][2]); hi.w = pk2(R[bk][3][1], R[bk][3][0]); }
            bf16_t* up = Z + (size_t)(row0 + (e0 >> 7)) * ZP + (d == 0 ? C_UF : C_UB) + h * 128 + (e0 & 127);
            *(u32x4*)up = lo; *(u32x4*)(up + 8) = hi; }
    }
    __syncthreads();
}

constexpr int GS_SF = 0, GS_VF = 32768, GS_VE = 49152, GS_KB = 65536;
struct GsRegs { bf16x8 W[4], Q[4], AQ[2]; u32x4 K[2]; float u[4][4], gc[4], gl; };
__device__ __forceinline__ void gdn_scan_unit(const KArgs& a, LAS unsigned char* lds, int unit, bool ctx_out) {
    const int tid = OTID(), lane = tid & 63, wave = tid >> 6, g = lane >> 4, r16 = lane & 15, rt = wave & 3, ch = wave >> 2;
    const int bh = unit >> 1, d = unit & 1, b = bh >> 2, h = bh & 3;
    bf16_t* Z = (bf16_t*)(a.ws + WS_Z); const bf16_t* P = (const bf16_t*)(a.ws + WS_P);
    const float* GBa = (const float*)(a.ws + WS_GB);
    const bf16_t* Wb = d == 0 ? (const bf16_t*)Z + C_WF : P + 1024; const int Wp = d == 0 ? ZP : PP;
    const int ubase = (d == 0 ? C_UF : C_UB) + h * 128, ue0 = ((rt * 2 + ch) * 64 + lane) * 16;
    const float* GC2 = (const float*)(a.ws + WS_GC2) + (size_t)(d * 4 + h) * MA;
    const int rhoA = 32 * (rt >> 1) + 8 * (r16 >> 2) + 4 * (rt & 1) + (r16 & 3);
    const int rhoC = 32 * (rt >> 1) + 8 * g + 4 * (rt & 1);
    f32x4 Sa[4], Sb[4];
#pragma unroll
    for (int c = 0; c < 4; ++c) { Sa[c] = (f32x4){0.f, 0.f, 0.f, 0.f}; Sb[c] = Sa[c]; }
#define GS_ROW0(s_) gdn_row0(b, d == 0 ? (s_) : ((s_) < 4 ? 3 - (s_) : 71 - (s_)))
#define GS_LOAD_WQ(R, s_) do { const int r0_ = GS_ROW0(s_); const size_t ra_ = (size_t)(r0_ + rhoA); \
        _Pragma("unroll") for (int ks = 0; ks < 4; ++ks) { R.W[ks] = *(const bf16x8*)(Wb + ra_ * Wp + h * 128 + ks * 32 + 8 * g); R.Q[ks] = *(const bf16x8*)(P + ra_ * PP + h * 128 + ks * 32 + 8 * g); } \
        { const f32x4 gv_ = *(const f32x4*)(GC2 + r0_ + rhoC); R.gc[0] = gv_[0]; R.gc[1] = gv_[1]; R.gc[2] = gv_[2]; R.gc[3] = gv_[3]; } \
        { const bf16_t* up_ = Z + (size_t)(r0_ + (ue0 >> 7)) * ZP + ubase + (ue0 & 127); const u32x4 ua_ = *(const u32x4*)up_, ub_ = *(const u32x4*)(up_ + 8); \
          R.u[0][0] = bflo(ua_.x); R.u[0][1] = bfhi(ua_.x); R.u[0][2] = bflo(ua_.y); R.u[0][3] = bfhi(ua_.y); R.u[1][0] = bflo(ua_.z); R.u[1][1] = bfhi(ua_.z); R.u[1][2] = bflo(ua_.w); R.u[1][3] = bfhi(ua_.w); \
          R.u[2][0] = bflo(ub_.x); R.u[2][1] = bfhi(ub_.x); R.u[2][2] = bflo(ub_.y); R.u[2][3] = bfhi(ub_.y); R.u[3][0] = bflo(ub_.z); R.u[3][1] = bfhi(ub_.z); R.u[3][2] = bflo(ub_.w); R.u[3][3] = bfhi(ub_.w); } \
        R.gl = GC2[r0_ + (d == 0 ? 63 : 0)]; } while (0)
#define GS_LOAD_AQ(R, s_) do { const int r0_ = GS_ROW0(s_); const size_t ra_ = (size_t)(r0_ + rhoA); \
        _Pragma("unroll") for (int k2 = 0; k2 < 2; ++k2) { u32x4 w_ = *(const u32x4*)(Z + ra_ * ZP + C_AQ + h * 64 + k2 * 32 + 8 * g); const int j0_ = k2 * 32 + 8 * g; \
              \
            w_.x &= ((d == 0 ? (j0_ + 0 <= rhoA) : (j0_ + 0 >= rhoA)) ? 0x0000ffffu : 0u) | ((d == 0 ? (j0_ + 1 <= rhoA) : (j0_ + 1 >= rhoA)) ? 0xffff0000u : 0u); \
            w_.y &= ((d == 0 ? (j0_ + 2 <= rhoA) : (j0_ + 2 >= rhoA)) ? 0x0000ffffu : 0u) | ((d == 0 ? (j0_ + 3 <= rhoA) : (j0_ + 3 >= rhoA)) ? 0xffff0000u : 0u); \
            w_.z &= ((d == 0 ? (j0_ + 4 <= rhoA) : (j0_ + 4 >= rhoA)) ? 0x0000ffffu : 0u) | ((d == 0 ? (j0_ + 5 <= rhoA) : (j0_ + 5 >= rhoA)) ? 0xffff0000u : 0u); \
            w_.w &= ((d == 0 ? (j0_ + 6 <= rhoA) : (j0_ + 6 >= rhoA)) ? 0x0000ffffu : 0u) | ((d == 0 ? (j0_ + 7 <= rhoA) : (j0_ + 7 >= rhoA)) ? 0xffff0000u : 0u); \
            R.AQ[k2] = __builtin_bit_cast(bf16x8, w_); } } while (0)
#define GS_LOAD_K(R, s_) do { const int r0_ = GS_ROW0(s_); \
        _Pragma("unroll") for (int cc = 0; cc < 2; ++cc) { const int row_ = wave * 8 + cc * 4 + (lane >> 4); \
            R.K[cc] = *(const u32x4*)(P + (size_t)(r0_ + row_) * PP + 512 + h * 128 + (lane & 15) * 8); } } while (0)
#define GS_LOAD(R, s_) do { GS_LOAD_WQ(R, s_); GS_LOAD_AQ(R, s_); GS_LOAD_K(R, s_); } while (0)
#define GS_BAR() do { asm volatile("s_waitcnt lgkmcnt(0)" ::: "memory"); __builtin_amdgcn_s_barrier(); asm volatile("" ::: "memory"); } while (0)
    const int qq = r16 >> 2, pp = r16 & 3;
#define GS_STEP(s_, PRE) do { const int s = (s_); \
        _Pragma("unroll") for (int c = 0; c < 4; ++c) { u32x4 w; w.x = pk2(Sa[c][0], Sa[c][1]); w.y = pk2(Sa[c][2], Sa[c][3]); w.z = pk2(Sb[c][0], Sb[c][1]); w.w = pk2(Sb[c][2], Sb[c][3]); \
            *(LAS u32x4*)(lds + GS_SF + ((rt * 8 + ch * 4 + c) * 64 + lane) * 16) = w; } \
        _Pragma("unroll") for (int cc = 0; cc < 2; ++cc) { const int row_ = wave * 8 + cc * 4 + (lane >> 4); \
            *(LAS u32x4*)(lds + GS_KB + (s & 1) * 16384 + row_ * 256 + (((lane & 15) ^ ((row_ & 3) << 2)) * 16)) = PRE.K[cc]; } \
        if (s + 1 < 68) GS_LOAD_K(PRE, s + 1); \
        GS_BAR(); \
        const int r0 = GS_ROW0(s); \
        f32x4 vacc[4], oacc[4]; \
        _Pragma("unroll") for (int c = 0; c < 4; ++c) { vacc[c] = (f32x4){0.f, 0.f, 0.f, 0.f}; oacc[c] = vacc[c]; } \
        { bf16x8 Bs[2][4]; \
          _Pragma("unroll") for (int c = 0; c < 4; ++c) Bs[0][c] = *(const LAS bf16x8*)(lds + GS_SF + ((0 * 8 + ch * 4 + c) * 64 + lane) * 16); \
          _Pragma("unroll") for (int ks = 0; ks < 4; ++ks) { \
              if (ks < 3) { _Pragma("unroll") for (int c = 0; c < 4; ++c) Bs[(ks + 1) & 1][c] = *(const LAS bf16x8*)(lds + GS_SF + (((ks + 1) * 8 + ch * 4 + c) * 64 + lane) * 16); } \
              __builtin_amdgcn_sched_barrier(0); \
              _Pragma("unroll") for (int c = 0; c < 4; ++c) { vacc[c] = __builtin_amdgcn_mfma_f32_16x16x32_bf16(PRE.W[ks], Bs[ks & 1][c], vacc[c], 0, 0, 0); oacc[c] = __builtin_amdgcn_mfma_f32_16x16x32_bf16(PRE.Q[ks], Bs[ks & 1][c], oacc[c], 0, 0, 0); } \
              __builtin_amdgcn_sched_barrier(0); } } \
        const float cd = __expf(PRE.gl); \
        float eg[4], ee[4]; \
        _Pragma("unroll") for (int j = 0; j < 4; ++j) { eg[j] = __expf(PRE.gc[j]); ee[j] = __expf(fminf(PRE.gl - PRE.gc[j], 0.f)); } \
        _Pragma("unroll") for (int c = 0; c < 4; ++c) { float vn[4], ve[4]; \
            _Pragma("unroll") for (int j = 0; j < 4; ++j) { vn[j] = PRE.u[c][j] - vacc[c][j]; oacc[c][j] *= eg[j]; ve[j] = vn[j] * ee[j]; } \
            u32x2 w; w.x = pk2(vn[0], vn[1]); w.y = pk2(vn[2], vn[3]); u32x2 e; e.x = pk2(ve[0], ve[1]); e.y = pk2(ve[2], ve[3]); \
            *(LAS u32x2*)(lds + GS_VF + (((rt >> 1) * 8 + ch * 4 + c) * 64 + lane) * 16 + (rt & 1) * 8) = w; \
            *(LAS u32x2*)(lds + GS_VE + (((rt >> 1) * 8 + ch * 4 + c) * 64 + lane) * 16 + (rt & 1) * 8) = e; } \
        if (s + 1 < 68) GS_LOAD_WQ(PRE, s + 1); \
        GS_BAR(); \
        const LAS unsigned char* kb = lds + GS_KB + (s & 1) * 16384; \
        _Pragma("unroll") for (int c = 0; c < 4; ++c) { Sa[c] = Sa[c] * cd; Sb[c] = Sb[c] * cd; } \
        _Pragma("unroll") for (int k2 = 0; k2 < 2; ++k2) { \
            const int rr = k2 * 32 + 8 * g + qq; const int pc = 4 * rt + pp; \
            bf16x8 Bv[4], Be[4]; \
            _Pragma("unroll") for (int c = 0; c < 4; ++c) { Bv[c] = *(const LAS bf16x8*)(lds + GS_VF + ((k2 * 8 + ch * 4 + c) * 64 + lane) * 16); Be[c] = *(const LAS bf16x8*)(lds + GS_VE + ((k2 * 8 + ch * 4 + c) * 64 + lane) * 16); } \
            const s16x4 alo = lds_tr16(kb + rr * 256 + ((pc ^ ((rr & 3) << 2)) * 16)), ahi = lds_tr16(kb + (rr + 4) * 256 + ((pc ^ (((rr + 4) & 3) << 2)) * 16)); \
            const s16x4 blo = lds_tr16(kb + rr * 256 + ((pc ^ ((rr & 3) << 2)) * 16) + 8), bhi = lds_tr16(kb + (rr + 4) * 256 + ((pc ^ (((rr + 4) & 3) << 2)) * 16) + 8); \
            const bf16x8 KTa = (bf16x8){alo[0], alo[1], alo[2], alo[3], ahi[0], ahi[1], ahi[2], ahi[3]}, KTb = (bf16x8){blo[0], blo[1], blo[2], blo[3], bhi[0], bhi[1], bhi[2], bhi[3]}; \
            __builtin_amdgcn_sched_barrier(0); \
            _Pragma("unroll") for (int c = 0; c < 4; ++c) { \
                oacc[c] = __builtin_amdgcn_mfma_f32_16x16x32_bf16(PRE.AQ[k2], Bv[c], oacc[c], 0, 0, 0); \
                Sa[c] = __builtin_amdgcn_mfma_f32_16x16x32_bf16(KTa, Be[c], Sa[c], 0, 0, 0); Sb[c] = __builtin_amdgcn_mfma_f32_16x16x32_bf16(KTb, Be[c], Sb[c], 0, 0, 0); } \
            __builtin_amdgcn_sched_barrier(0); \
        } \
        if (s + 1 < 68) GS_LOAD_AQ(PRE, s + 1); \
        if (s >= 4 || ctx_out) { \
            u32x4 oa_, ob_; oa_.x = pk2(oacc[0][0], oacc[0][1]); oa_.y = pk2(oacc[0][2], oacc[0][3]); oa_.z = pk2(oacc[1][0], oacc[1][1]); oa_.w = pk2(oacc[1][2], oacc[1][3]); \
            ob_.x = pk2(oacc[2][0], oacc[2][1]); ob_.y = pk2(oacc[2][2], oacc[2][3]); ob_.z = pk2(oacc[3][0], oacc[3][1]); ob_.w = pk2(oacc[3][2], oacc[3][3]); \
            bf16_t* op_ = Z + (size_t)(r0 + (ue0 >> 7)) * ZP + ubase + (ue0 & 127); *(u32x4*)op_ = oa_; *(u32x4*)(op_ + 8) = ob_; \
        } \
    } while (0)
    GsRegs RA;
    GS_LOAD(RA, 0);
    for (int s2 = 0; s2 < 68; s2 += 2) { GS_STEP(s2, RA); GS_STEP(s2 + 1, RA); }
#undef GS_STEP
#undef GS_BAR
#undef GS_ROW0
#undef GS_LOAD
#undef GS_LOAD_WQ
#undef GS_LOAD_AQ
#undef GS_LOAD_K
    __syncthreads();
}
typedef const __attribute__((address_space(4))) KArgs* KAP;
#define NOINL __forceinline__
__device__ __forceinline__ KArgs load_kargs(KAP kp) { unsigned long long kv = (unsigned long long)kp; asm volatile("" : "+s"(kv)); KAP ka = (KAP)kv; KArgs a;
#pragma unroll
    for (int i = 0; i < 29; ++i) a.in[i] = ka->in[i];
    a.out = ka->out; a.ws = ka->ws; a.ph_lo = ka->ph_lo; a.ph_hi = ka->ph_hi; return a; }
__device__ NOINL void loop_gdnprep(KAP ka, LAS unsigned char* lds, int u0, int n, int step) { const KArgs a = load_kargs(ka);
    if (u0 >= n) return;
    GpPre cur; gdn_prep_load(a, u0, cur);
    for (int u = u0; u < n; u += step) { GpPre nx; gdn_prep_load(a, (u + step < n) ? u + step : u, nx); gdn_prep_unit(a, lds, u, cur); cur = nx; } }
__device__ NOINL void loop_retkv(KAP ka, LAS unsigned char* lds, int l, int u0, int n, int step) { const KArgs a = load_kargs(ka);
    if (u0 >= n) return;
    RkPre cur; ret_kv_load(a, u0, cur);
    for (int u = u0; u < n; u += step) { RkPre nx; ret_kv_load(a, (u + step < n) ? u + step : u, nx); ret_kv_unit(a, lds, l, u, cur); cur = nx; } }
__device__ NOINL void call_gdnscan(KAP ka, LAS unsigned char* lds, int unit, bool ctx_out) { const KArgs a = load_kargs(ka); gdn_scan_unit(a, lds, unit, ctx_out); }
__device__ NOINL void call_retprefix(KAP ka, int l) { const KArgs a = load_kargs(ka); ret_prefix(a, l, 64); }
__device__ NOINL void call_retout(KAP ka, LAS unsigned char* lds, int l, int unit) { const KArgs a = load_kargs(ka); ret_out_unit(a, lds, l, unit); }
__device__ NOINL void call_na(KAP ka, int l, int item, bool ctxq, LAS unsigned char* kl, int lane) { const KArgs a = load_kargs(ka); na_item(a, l, item, ctxq, kl, lane); }
__device__ NOINL void call_win(KAP ka, int l, int item, bool ctxq, LAS unsigned char* kl, int lane) { const KArgs a = load_kargs(ka); win_item(a, l, item, ctxq, kl, lane); }
#ifndef SCAN_ONLY_M2
#define SCAN_ONLY_M2 0
#endif
constexpr int CW_WQ = 8192;
__device__ __forceinline__ void phase_mixers(KAP ka, LAS unsigned char* lds, int l, bool ctx_out) {
    const int blk = OBLK(), G = OGRID();
    loop_gdnprep(ka, lds, blk, 32 * 68, G);
    loop_retkv(ka, lds, l, G - 1 - blk, 32 * 34, G);
#if SCAN_ONLY_M2
    { const int tid = OTID(), lane = tid & 63, wave = tid >> 6; LAS unsigned char* kl = lds + wave * AT_WAVE_BYTES; const int gw = blk * NWAVES + wave, NGW = G * NWAVES;
      const int nitems = ctx_out ? 4096 + 4096 + 256 + 256 : 8192;
      for (int it = gw; it < nitems; it += NGW) { const bool cq = it >= 8192; const int j = cq ? it - 8192 : it; const bool isna = cq ? (j < 256) : (j < 4096); const int item = cq ? (j & 255) : (j & 4095);
          if (isna) call_na(ka, l, item, cq, kl, lane); else call_win(ka, l, item, cq, kl, lane); } }
#endif
}
__device__ __forceinline__ void phase_scan_attn(KAP ka, LAS unsigned char* lds, int l, bool ctx_out, int qslot) {
    const int tid = OTID(), lane = tid & 63, wave = tid >> 6, blk = OBLK(), G = OGRID();
    for (int u = blk; u < 64; u += G) call_gdnscan(ka, lds, (((u & 7) * 4 + ((u >> 3) >> 1)) << 1) | ((u >> 3) & 1), ctx_out);
    call_retprefix(ka, l);
#if SCAN_ONLY_M2
    return;
#endif
    LAS unsigned char* kl = lds + wave * AT_WAVE_BYTES;
    unsigned* ctr; { const KArgs a = load_kargs(ka); ctr = (unsigned*)(a.ws + WS_CTL) + CW_WQ + qslot * 1024 + (blk & 7) * 64; }
    const int xb = blk & 7;
    const int nper = ctx_out ? 512 + 512 + 32 + 32 : 1024;
    for (;;) {
        int k = 0; if (lane == 0) k = (int)__hip_atomic_fetch_add(ctr, 1u, __ATOMIC_RELAXED, __HIP_MEMORY_SCOPE_AGENT);
        k = __builtin_amdgcn_readfirstlane(k);
        if (k >= nper) break;
        const bool cq = k >= 1024; const int j = cq ? k - 1024 : k;
        const bool isna = cq ? (j < 32) : (j < 512);
        const int item = cq ? xb * 32 + (j & 31) : xb * 512 + (j & 511);
        if (isna) call_na(ka, l, item, cq, kl, lane);
        else call_win(ka, l, item, cq, kl, lane);
    }
}
using pg8::Unit;
struct SchedPlain {
    const char* A0; const char* B0; size_t tA, tB;
    int nM, nN, nwg, G, c;
    __device__ __forceinline__ void init(const void* A, int lda, const void* Bt, int ldb, int M, int N, int G_, int c_) {
        A0 = (const char*)A; B0 = (const char*)Bt; tA = (size_t)256 * lda * 2; tB = (size_t)256 * ldb * 2; nM = M / 256; nN = N / 256; nwg = nM * nN; G = G_; c = c_; }
    __device__ __forceinline__ bool next(int i, Unit& u) const {
        const long L = (long)i * G + c; if (L >= nwg) return false;
        int wgid = (int)L; { const int q = nwg / 8, r = nwg % 8, xcd = wgid % 8, off = wgid / 8; wgid = (xcd < r ? xcd * (q + 1) : r * (q + 1) + (xcd - r) * q) + off; }
        const int nig = 8 * nN, gid = wgid / nig, fm = gid * 8, gsz = (nM - fm) < 8 ? (nM - fm) : 8;
        u.pm = fm + ((wgid % nig) % gsz); u.pn = (wgid % nig) / gsz; u.aux = 0; return true; }
    __device__ __forceinline__ const char* A(const Unit& u) const { return A0 + (size_t)u.pm * tA; }
    __device__ __forceinline__ const char* B(const Unit& u) const { return B0 + (size_t)u.pn * tB; }
};
struct SchedBranch {
    const char* Z0; const char* W0; int ntiles, G, c;
    __device__ __forceinline__ bool next(int i, Unit& u) const { const int tile = (i >> 2) * G + c; if (tile >= ntiles) return false; u.pm = tile >> 2; u.pn = tile & 3; u.aux = i & 3; return true; }
    __device__ __forceinline__ const char* A(const Unit& u) const { const int yc = u.aux == 0 ? Y_RET : (u.aux == 1 ? Y_WIN : (u.aux == 2 ? Y_NA : Y_GDN)); return Z0 + ((size_t)u.pm * 256 * ZP + yc) * 2; }
    __device__ __forceinline__ const char* B(const Unit& u) const { return W0 + ((size_t)u.aux * 1024 * 512 + (size_t)u.pn * 256 * 512) * 2; }
};
struct SchedMoe {
    const char* A0; const char* W0; const int* tile_start; size_t tA, eB, tB; int G, c;
    int e_[4], t0_[4], cum_[5], rank_, nrank_;
    __device__ __forceinline__ void init() {
        const int x = c & 7; rank_ = c >> 3; nrank_ = G >> 3; cum_[0] = 0;
#pragma unroll
        for (int k = 0; k < 4; ++k) { e_[k] = x + 8 * k; t0_[k] = tile_start[e_[k]]; cum_[k + 1] = cum_[k] + (tile_start[e_[k] + 1] - t0_[k]); }
    }
    __device__ __forceinline__ bool next(int i, Unit& u) const {
        const int L = i * nrank_ + rank_; const int tt = L >> 2; if (tt >= cum_[4]) return false;
        const int k = (tt >= cum_[1]) + (tt >= cum_[2]) + (tt >= cum_[3]);
        int e = e_[0], t0 = t0_[0], cm = cum_[0];
        if (k == 1) { e = e_[1]; t0 = t0_[1]; cm = cum_[1]; } else if (k == 2) { e = e_[2]; t0 = t0_[2]; cm = cum_[2]; } else if (k == 3) { e = e_[3]; t0 = t0_[3]; cm = cum_[3]; }
        u.pm = t0 + (tt - cm); u.pn = L & 3; u.aux = e; return true; }
    __device__ __forceinline__ const char* A(const Unit& u) const { return A0 + (size_t)u.pm * tA; }
    __device__ __forceinline__ const char* B(const Unit& u) const { return W0 + (size_t)u.aux * eB + (size_t)u.pn * tB; }
};

template <int MODE  > struct EpiStore {
    static constexpr bool INPLACE = false;
    bf16_t* O; int ldc;
    __device__ __forceinline__ void operator()(const f32x4 (&acc)[2][2][4][2], const Unit& u, int wr, int wc, int fr, int fq) const {
        const int row0 = u.pm * 256 + wr * 64 + fr; const int colt = (MODE == 1 ? dead_tile(u.pn) : u.pn) * 256; const int col0 = colt + wc * 32 + 8 * fq;
#pragma unroll
        for (int ai = 0; ai < 2; ++ai)
#pragma unroll
            for (int m = 0; m < 4; ++m) { bf16_t* rowp = O + (size_t)(row0 + ai * 128 + m * 16) * ldc + col0;
#pragma unroll
                for (int bj = 0; bj < 2; ++bj) { f32x4 v0 = acc[ai][bj][m][0], v1 = acc[ai][bj][m][1];
                    if (MODE == 1) {
#pragma unroll
                        for (int e = 0; e < 4; ++e) { v0[e] = sigmoidf_(v0[e]); v1[e] = sigmoidf_(v1[e]); } }
                    u32x4 w; w.x = pk2(v0[0], v0[1]); w.y = pk2(v0[2], v0[3]); w.z = pk2(v1[0], v1[1]); w.w = pk2(v1[2], v1[3]);
                    *(u32x4*)(rowp + bj * 128) = w; } }
    }
};
struct EpiIn {
    static constexpr bool INPLACE = false;
    bf16_t* Z; const float* wqn; const float* wkn; const float* nqn; const float* nkn; const float* cs0;
    __device__ __forceinline__ void operator()(const f32x4 (&acc)[2][2][4][2], const Unit& u, int wr, int wc, int fr, int fq) const {
        const int row0 = u.pm * 256 + wr * 64 + fr; const int T = u.pn;
        if (!win_head_tile(T)) {
            const int col0 = T * 256 + wc * 32 + 8 * fq;
#pragma unroll
            for (int ai = 0; ai < 2; ++ai)
#pragma unroll
                for (int m = 0; m < 4; ++m) { bf16_t* rowp = Z + (size_t)(row0 + ai * 128 + m * 16) * ZP + col0;
#pragma unroll
                    for (int bj = 0; bj < 2; ++bj) { const f32x4 v0 = acc[ai][bj][m][0], v1 = acc[ai][bj][m][1];
                        u32x4 w; w.x = pk2(v0[0], v0[1]); w.y = pk2(v0[2], v0[3]); w.z = pk2(v1[0], v1[1]); w.w = pk2(v1[2], v1[3]);
                        *(u32x4*)(rowp + bj * 128) = w; } }
            return;
        }
        const int hidx = (T < 2 ? T * 4 : (T < 9 ? 8 + (T - 6) * 4 : 18 + (T - 9) * 4)) + wc;
        const bool isv = (T == 8 && wc >= 2);
        const float* gain = (hidx < 8 || isv) ? nullptr : (hidx < 16 ? wqn : (hidx < 18 ? wkn : (hidx < 26 ? nqn : nkn)));
        const bool rope = (u.pm < ML / 256) && hidx < 18 && !isv;
        const float scale = isv ? 1.0f : ((hidx >= 4 && hidx < 8) ? 0.125f : (((hidx >= 8 && hidx < 16) || (hidx >= 18 && hidx < 26)) ? 0.125f * 1.4426950408889634f : 1.0f));
        const int col = T * 256 + wc * 64 + 8 * fq;
        f32x4 g0 = (f32x4){1.f, 1.f, 1.f, 1.f}, g1 = g0, g2 = g0, g3 = g0;
        if (gain) { g0 = *(const f32x4*)(gain + 8 * fq); g1 = *(const f32x4*)(gain + 8 * fq + 4); g2 = *(const f32x4*)(gain + 32 + 8 * fq); g3 = *(const f32x4*)(gain + 36 + 8 * fq); }
#pragma unroll
        for (int am = 0; am < 8; am += 2) {
            f32x4 c0[2], c1[2], s0[2], s1[2];
            if (rope) {
#pragma unroll
                for (int k = 0; k < 2; ++k) { const int ai = (am + k) >> 2, m = (am + k) & 3; const int t = (row0 + ai * 128 + m * 16) & 4095; const float* cs = cs0 + t * 32 + 8 * fq; const float* sn = cs + 4096 * 32;
                    c0[k] = *(const f32x4*)cs; c1[k] = *(const f32x4*)(cs + 4); s0[k] = *(const f32x4*)sn; s1[k] = *(const f32x4*)(sn + 4); } }
#pragma unroll
            for (int k = 0; k < 2; ++k) { const int ai = (am + k) >> 2, m = (am + k) & 3;
                f32x4 a0 = acc[ai][0][m][0], a1 = acc[ai][0][m][1], b0 = acc[ai][1][m][0], b1 = acc[ai][1][m][1];
                if (gain) {
                    const f32x4 q = a0 * a0 + a1 * a1 + b0 * b0 + b1 * b1; float ss = (q[0] + q[1]) + (q[2] + q[3]);
                    ss += __shfl_xor(ss, 16); ss += __shfl_xor(ss, 32);
                    const float r = rsqrtf(ss * (1.f / 64.f) + EPS);
                    a0 = a0 * (g0 * r); a1 = a1 * (g1 * r); b0 = b0 * (g2 * r); b1 = b1 * (g3 * r); }
                if (rope) { const f32x4 y0 = a0 * c0[k] - b0 * s0[k], y1 = a1 * c1[k] - b1 * s1[k], z0 = a0 * s0[k] + b0 * c0[k], z1 = a1 * s1[k] + b1 * c1[k]; a0 = y0; a1 = y1; b0 = z0; b1 = z1; }
                a0 = a0 * scale; a1 = a1 * scale; b0 = b0 * scale; b1 = b1 * scale;
                bf16_t* rowp = Z + (size_t)(row0 + ai * 128 + m * 16) * ZP + col;
                u32x4 w; w.x = pk2(a0[0], a0[1]); w.y = pk2(a0[2], a0[3]); w.z = pk2(a1[0], a1[1]); w.w = pk2(a1[2], a1[3]); *(u32x4*)rowp = w;
                w.x = pk2(b0[0], b0[1]); w.y = pk2(b0[2], b0[3]); w.z = pk2(b1[0], b1[1]); w.w = pk2(b1[2], b1[3]); *(u32x4*)(rowp + 32) = w;
            }
        }
    }
};
struct EpiGateF {
    static constexpr bool INPLACE = false;
    bf16_t* Z;
    __device__ __forceinline__ void operator()(const f32x4 (&acc)[2][2][4][2], const Unit& u, int wr, int wc, int fr, int fq) const {
        const int row0 = u.pm * 256 + wr * 64 + fr; const int cw = (u.pn & 3) * 64 + wc * 16 + fq * 4; const int ct = u.pn >> 2;
        const int c0 = dead_tile(ct) * 256 + cw, c1 = dead_tile(4 + ct) * 256 + cw, c2 = dead_tile(8 + ct) * 256 + cw, c3 = dead_tile(12 + ct) * 256 + cw;
#pragma unroll
        for (int ai = 0; ai < 2; ++ai)
#pragma unroll
            for (int m = 0; m < 4; ++m) { bf16_t* rowp = Z + (size_t)(row0 + ai * 128 + m * 16) * ZP;
                float f0[4], f1[4], f2[4], f3[4];
#pragma unroll
                for (int e = 0; e < 4; ++e) {
                    const float d0 = 1.0f + __expf(-acc[ai][0][m][0][e]), d1 = fminf(1.0f + __expf(-acc[ai][0][m][1][e]), 1e30f), d2 = fminf(1.0f + __expf(-acc[ai][1][m][0][e]), 1e30f), d3 = fminf(1.0f + __expf(-acc[ai][1][m][1][e]), 1e30f);
                    f0[e] = d1 * __builtin_amdgcn_rcpf(d0); f1[e] = d2 * __builtin_amdgcn_rcpf(d1); f2[e] = d3 * __builtin_amdgcn_rcpf(d2); f3[e] = __builtin_amdgcn_rcpf(d3); }
                u32x2 w;
                w.x = pk2(f0[0], f0[1]); w.y = pk2(f0[2], f0[3]); *(u32x2*)(rowp + c0) = w;
                w.x = pk2(f1[0], f1[1]); w.y = pk2(f1[2], f1[3]); *(u32x2*)(rowp + c1) = w;
                w.x = pk2(f2[0], f2[1]); w.y = pk2(f2[2], f2[3]); *(u32x2*)(rowp + c2) = w;
                w.x = pk2(f3[0], f3[1]); w.y = pk2(f3[2], f3[3]); *(u32x2*)(rowp + c3) = w; }
    }
};
struct EpiBranch {
    static constexpr bool INPLACE = true;
    bf16_t* ACC; const bf16_t* Z;
    __device__ __forceinline__ void operator()(f32x4 (&acc)[2][2][4][2], const Unit& u, int wr, int wc, int fr, int fq) const {
        const int row0 = u.pm * 256 + wr * 64 + fr; const int gcol0 = dead_tile(u.aux * 4 + u.pn) * 256 + wc * 32 + 8 * fq, col0 = u.pn * 256 + wc * 32 + 8 * fq;
        const bool lastb = (u.aux == 3);
#pragma unroll
        for (int ai = 0; ai < 2; ++ai) {
            u32x4 gw[4][2];
#pragma unroll
            for (int m = 0; m < 4; ++m)
#pragma unroll
                for (int bj = 0; bj < 2; ++bj) gw[m][bj] = *(const u32x4*)(Z + (size_t)(row0 + ai * 128 + m * 16) * ZP + gcol0 + bj * 128);
#pragma unroll
            for (int m = 0; m < 4; ++m)
#pragma unroll
                for (int bj = 0; bj < 2; ++bj) { const u32x4 g = gw[m][bj];
                    f32x4 v0 = acc[ai][bj][m][0], v1 = acc[ai][bj][m][1];
                    v0[0] *= bflo(g.x); v0[1] *= bfhi(g.x); v0[2] *= bflo(g.y); v0[3] *= bfhi(g.y); v1[0] *= bflo(g.z); v1[1] *= bfhi(g.z); v1[2] *= bflo(g.w); v1[3] *= bfhi(g.w);
                    if (lastb) { u32x4 w; w.x = pk2(v0[0], v0[1]); w.y = pk2(v0[2], v0[3]); w.z = pk2(v1[0], v1[1]); w.w = pk2(v1[2], v1[3]);
                        *(u32x4*)(ACC + (size_t)(row0 + ai * 128 + m * 16) * D + col0 + bj * 128) = w; v0 = (f32x4){0.f, 0.f, 0.f, 0.f}; v1 = v0; }
                    acc[ai][bj][m][0] = v0; acc[ai][bj][m][1] = v1; }
        }
    }
};
struct EpiResid {
    static constexpr bool INPLACE = false;
    const float* xl_src; const float* xc_src; float* xl_dst; float* xc_dst; const float* mod_g;
    __device__ __forceinline__ void operator()(const f32x4 (&acc)[2][2][4][2], const Unit& u, int wr, int wc, int fr, int fq) const {
        const int row0 = u.pm * 256 + wr * 64 + fr; const int col0 = u.pn * 256 + wc * 32 + 8 * fq;
        const bool lat = u.pm < ML / 256; const float* src = lat ? xl_src : xc_src - (size_t)ML * D; float* dst = lat ? xl_dst : xc_dst - (size_t)ML * D;
        const float* gv = mod_g + (size_t)(lat ? (u.pm >> 4) : 8) * 6144;
        f32x4 gg[2][2];
#pragma unroll
        for (int bj = 0; bj < 2; ++bj) { gg[bj][0] = *(const f32x4*)(gv + col0 + bj * 128); gg[bj][1] = *(const f32x4*)(gv + col0 + bj * 128 + 4); }
#pragma unroll
        for (int ai = 0; ai < 2; ++ai) {
            f32x4 xv[4][2][2];
#pragma unroll
            for (int m = 0; m < 4; ++m)
#pragma unroll
                for (int bj = 0; bj < 2; ++bj) { const size_t o = (size_t)(row0 + ai * 128 + m * 16) * D + col0 + bj * 128; xv[m][bj][0] = *(const f32x4*)(src + o); xv[m][bj][1] = *(const f32x4*)(src + o + 4); }
#pragma unroll
            for (int m = 0; m < 4; ++m)
#pragma unroll
                for (int bj = 0; bj < 2; ++bj) { const size_t o = (size_t)(row0 + ai * 128 + m * 16) * D + col0 + bj * 128;
                    *(f32x4*)(dst + o) = xv[m][bj][0] + gg[bj][0] * acc[ai][bj][m][0]; *(f32x4*)(dst + o + 4) = xv[m][bj][1] + gg[bj][1] * acc[ai][bj][m][1]; }
        }
    }
};
struct EpiAct {
    static constexpr bool INPLACE = false;
    bf16_t* ACT;
    __device__ __forceinline__ void operator()(const f32x4 (&acc)[2][2][4][2], const Unit& u, int wr, int wc, int fr, int fq) const {
        const int row0 = u.pm * 256 + wr * 64 + fr; const int col0 = u.pn * 128 + wc * 32 + 8 * fq;
#pragma unroll
        for (int ai = 0; ai < 2; ++ai)
#pragma unroll
            for (int m = 0; m < 4; ++m) { const f32x4 g0 = acc[ai][0][m][0], g1 = acc[ai][0][m][1], u0 = acc[ai][1][m][0], u1 = acc[ai][1][m][1];
                u32x4 w; w.x = pk2(silu_fast(g0[0]) * u0[0], silu_fast(g0[1]) * u0[1]); w.y = pk2(silu_fast(g0[2]) * u0[2], silu_fast(g0[3]) * u0[3]);
                w.z = pk2(silu_fast(g1[0]) * u1[0], silu_fast(g1[1]) * u1[1]); w.w = pk2(silu_fast(g1[2]) * u1[2], silu_fast(g1[3]) * u1[3]);
                *(u32x4*)(ACT + (size_t)(row0 + ai * 128 + m * 16) * DEXP + col0) = w; }
    }
};
constexpr int RT_WS = (1024 + 8) * 2;
constexpr int RT_LO = 32 * RT_WS, RT_BIAS = 2 * RT_LO, RT_SCR = RT_BIAS + 256, RT_SCR_W = 16 * 33 * 4 + 64;
__device__ __forceinline__ void phase_route(const KArgs& a, LAS unsigned char* lds, int l, int nrows) {
    const int tid = OTID(), lane = tid & 63, wave = tid >> 6, blk = OBLK(), G = OGRID(), g = lane >> 4, r16 = lane & 15;
    LAS unsigned* lcnt = (LAS unsigned*)(lds + RT_SCR + 8 * RT_SCR_W);
    LAS float* biasl = (LAS float*)(lds + RT_BIAS);
    LAS float* lg = (LAS float*)(lds + RT_SCR + wave * RT_SCR_W); LAS float* rsl = lg + 16 * 33;
    if (tid < 32) lcnt[tid] = 0u;
    const int ntile = nrows >> 4, per = (ntile + G - 1) / G, t0 = blk * per, t1 = (t0 + per < ntile) ? t0 + per : ntile;
    const float* xl = a.out; const float* xc = (const float*)(a.ws + WS_XC);
    unsigned* tokE = (unsigned*)(a.ws + WS_TOK + TOK_E); unsigned* tokS = (unsigned*)(a.ws + WS_TOK + TOK_SLOT); f32x2* tokW = (f32x2*)(a.ws + WS_TOK + TOK_W);
    float* tokR = (float*)(a.ws + WS_TOK + TOK_RSTD);
    int curb = -1;
    for (int tb = t0; tb < t1; tb += NWAVES) {
        const int tile = tb + wave; const bool act = tile < t1;
        const int bidx = row_modidx((tb << 4));
        const int blast = row_modidx(((tb + NWAVES - 1 < t1 ? tb + NWAVES - 1 : t1 - 1) << 4) + 15);
        for (int bsel = bidx; bsel <= blast; ++bsel) {
            if (bsel != curb) {
                __syncthreads();
                const float* mod = (const float*)(a.ws + WS_MOD) + (size_t)(l * 9 + bsel) * 6144; const float* gain = a.in[I_NORM2] + l * D;
                for (int idx = tid; idx < 32 * 1024; idx += NTHR) { const int e = idx >> 10, k = idx & 1023; const float w = a.in[I_WROUTER][k * 32 + e] * gain[k] * (1.0f + mod[4 * 1024 + k]);
                    const unsigned hi = pk2(w, w) & 0xffffu; const float lo = w - bf2f((bf16_t)hi);
                    *(LAS bf16_t*)(lds + e * RT_WS + k * 2) = (bf16_t)hi; *(LAS bf16_t*)(lds + RT_LO + e * RT_WS + k * 2) = (bf16_t)(pk2(lo, lo) & 0xffffu); }
                { const int e = tid & 31, part = tid >> 5; float s = 0.f;
                  for (int k = part * 64; k < part * 64 + 64; ++k) s += mod[3 * 1024 + k] * a.in[I_WROUTER][k * 32 + e];
                  LAS float* part_s = (LAS float*)(lds + RT_SCR); part_s[part * 32 + e] = s; }
                __syncthreads();
                if (tid < 32) { float s = 0.f; for (int p = 0; p < 16; ++p) s += ((LAS float*)(lds + RT_SCR))[p * 32 + tid]; biasl[tid] = s; }
                __syncthreads();
                curb = bsel;
            }
            if (act && row_modidx(tile << 4) == bsel) {
                const int row = (tile << 4) + r16;
                const float* xr = row < ML ? xl + (size_t)row * D : xc + (size_t)(row - ML) * D;
                f32x4 acc0 = (f32x4){0.f, 0.f, 0.f, 0.f}, acc1 = acc0; float ss = 0.f;
#pragma unroll 8
                for (int ks = 0; ks < 32; ++ks) {
                    const f32x4 xa = *(const f32x4*)(xr + ks * 32 + 8 * g), xb = *(const f32x4*)(xr + ks * 32 + 8 * g + 4);
                    ss += (xa.x * xa.x + xa.y * xa.y) + (xa.z * xa.z + xa.w * xa.w) + (xb.x * xb.x + xb.y * xb.y) + (xb.z * xb.z + xb.w * xb.w);
                    u32x4 hw; hw.x = pk2(xa.x, xa.y); hw.y = pk2(xa.z, xa.w); hw.z = pk2(xb.x, xb.y); hw.w = pk2(xb.z, xb.w);
                    u32x4 lw; lw.x = pk2(xa.x - bflo(hw.x), xa.y - bfhi(hw.x)); lw.y = pk2(xa.z - bflo(hw.y), xa.w - bfhi(hw.y)); lw.z = pk2(xb.x - bflo(hw.z), xb.y - bfhi(hw.z)); lw.w = pk2(xb.z - bflo(hw.w), xb.w - bfhi(hw.w));
                    const bf16x8 Ah = __builtin_bit_cast(bf16x8, hw), Al = __builtin_bit_cast(bf16x8, lw);
                    const LAS unsigned char* wp = lds + r16 * RT_WS + (ks * 32 + 8 * g) * 2;
                    const bf16x8 B0h = *(const LAS bf16x8*)wp, B1h = *(const LAS bf16x8*)(wp + 16 * RT_WS), B0l = *(const LAS bf16x8*)(wp + RT_LO), B1l = *(const LAS bf16x8*)(wp + RT_LO + 16 * RT_WS);
                    acc0 = __builtin_amdgcn_mfma_f32_16x16x32_bf16(Ah, B0h, acc0, 0, 0, 0); acc0 = __builtin_amdgcn_mfma_f32_16x16x32_bf16(Al, B0h, acc0, 0, 0, 0); acc0 = __builtin_amdgcn_mfma_f32_16x16x32_bf16(Ah, B0l, acc0, 0, 0, 0);
                    acc1 = __builtin_amdgcn_mfma_f32_16x16x32_bf16(Ah, B1h, acc1, 0, 0, 0); acc1 = __builtin_amdgcn_mfma_f32_16x16x32_bf16(Al, B1h, acc1, 0, 0, 0); acc1 = __builtin_amdgcn_mfma_f32_16x16x32_bf16(Ah, B1l, acc1, 0, 0, 0);
                }
                ss += __shfl_xor(ss, 16); ss += __shfl_xor(ss, 32);
                const float rstd = rsqrtf(ss * (1.f / 1024.f) + EPS);
                if (g == 0) { rsl[r16] = rstd; tokR[row] = rstd; }
                LDS_WAIT(); asm volatile("" ::: "memory");
#pragma unroll
                for (int j = 0; j < 4; ++j) { const float rs = rsl[4 * g + j]; lg[(4 * g + j) * 33 + r16] = acc0[j] * rs + biasl[r16]; lg[(4 * g + j) * 33 + 16 + r16] = acc1[j] * rs + biasl[16 + r16]; }
                LDS_WAIT(); asm volatile("" ::: "memory");
                if (lane < 16) {
                    const int rrow = (tile << 4) + lane;
                    float sc[32], bestg = -1e30f; int gi = 0;
#pragma unroll
                    for (int e = 0; e < 32; ++e) sc[e] = sigmoidf_(lg[lane * 33 + e]);
#pragma unroll
                    for (int gg = 0; gg < 8; ++gg) {
                        float s4[4];
#pragma unroll
                        for (int j = 0; j < 4; ++j) s4[j] = sc[gg * 4 + j] + a.in[I_RBIAS][gg * 4 + j];
                        const float m01 = fmaxf(s4[0], s4[1]), n01 = fminf(s4[0], s4[1]), m23 = fmaxf(s4[2], s4[3]), n23 = fminf(s4[2], s4[3]);
                        const float top = fmaxf(m01, m23), second = fmaxf(fminf(m01, m23), (m01 >= m23) ? n01 : n23);
                        const float gs = top + second;
                        if (gs > bestg) { bestg = gs; gi = gg; }
                    }
                    float s4[4], w4[4];
#pragma unroll
                    for (int j = 0; j < 4; ++j) { float sv = 0.f, wv = 0.f;
#pragma unroll
                        for (int gg = 0; gg < 8; ++gg) { if (gg == gi) { sv = sc[gg * 4 + j] + a.in[I_RBIAS][gg * 4 + j]; wv = sc[gg * 4 + j]; } }
                        s4[j] = sv; w4[j] = wv; }
                    int i0 = 0; float v0 = s4[0];
#pragma unroll
                    for (int j = 1; j < 4; ++j) if (s4[j] > v0) { v0 = s4[j]; i0 = j; }
                    int i1 = -1; float v1 = -1e30f;
#pragma unroll
                    for (int j = 0; j < 4; ++j) if (j != i0 && s4[j] > v1) { v1 = s4[j]; i1 = j; }
                    float w0 = 0.f, w1 = 0.f;
#pragma unroll
                    for (int j = 0; j < 4; ++j) { if (j == i0) w0 = w4[j]; if (j == i1) w1 = w4[j]; }
                    const float inv = 1.0f / (w0 + w1);
                    const int e0 = gi * 4 + i0, e1 = gi * 4 + i1;
                    const unsigned s0 = __hip_atomic_fetch_add(&lcnt[e0], 1u, __ATOMIC_RELAXED, __HIP_MEMORY_SCOPE_WORKGROUP), s1 = __hip_atomic_fetch_add(&lcnt[e1], 1u, __ATOMIC_RELAXED, __HIP_MEMORY_SCOPE_WORKGROUP);
                    tokE[rrow] = (unsigned)e0 | ((unsigned)e1 << 8); tokS[rrow] = s0 | (s1 << 16); tokW[rrow] = (f32x2){w0 * inv, w1 * inv};
                }
            }
        }
    }
    __syncthreads();
    if (tid < 32) ((unsigned*)(a.ws + WS_TOK + TOK_BCNT))[blk * 32 + tid] = lcnt[tid];
}

__device__ __forceinline__ void phase_gather(const KArgs& a, LAS unsigned char* lds, int l, int nrows) {
    const int tid = OTID(), lane = tid & 63, wave = tid >> 6, blk = OBLK(), G = OGRID();
    LAS unsigned* tot = (LAS unsigned*)lds;
    LAS unsigned* bef = tot + 32;
    LAS unsigned* base = tot + 64;
    const unsigned* bc = (const unsigned*)(a.ws + WS_TOK + TOK_BCNT);
    { LAS unsigned* ptot = tot + 96; LAS unsigned* pbef = ptot + 512;
      const int e = tid & 31, part = tid >> 5; unsigned t = 0u, bf = 0u;
#pragma unroll
      for (int k = 0; k < 16; ++k) { const int g = part * 16 + k; const unsigned c = (g < G) ? bc[g * 32 + e] : 0u; t += c; bf += (g < blk) ? c : 0u; }
      ptot[tid] = t; pbef[tid] = bf;
      __syncthreads();
      if (tid < 32) { unsigned tt = 0u, bb = 0u;
#pragma unroll
          for (int p = 0; p < 16; ++p) { tt += ptot[p * 32 + tid]; bb += pbef[p * 32 + tid]; }
          tot[tid] = tt; bef[tid] = bb; } }
    __syncthreads();
    if (tid == 0) {
        unsigned pos = 0u; int* tile_e = (int*)(a.ws + WS_TOK + TOK_TILE);
#pragma unroll 1
        for (int e = 0; e < 32; ++e) { base[e] = pos + bef[e]; const unsigned nt = (tot[e] + 255u) >> 8;
            if (blk == 0) tile_e[e] = (int)(pos >> 8);
            pos += nt << 8; }
        if (blk == 0) tile_e[32] = (int)(pos >> 8);
    }
    __syncthreads();
    const unsigned* tokE = (const unsigned*)(a.ws + WS_TOK + TOK_E); const unsigned* tokS = (const unsigned*)(a.ws + WS_TOK + TOK_SLOT); u32x2* tokP = (u32x2*)(a.ws + WS_TOK + TOK_POS);
    const float* tokR = (const float*)(a.ws + WS_TOK + TOK_RSTD);
    bf16_t* xb = (bf16_t*)(a.ws + WS_XB);
    const float* xl = a.out; const float* xc = (const float*)(a.ws + WS_XC);
    const int ntile = nrows >> 4, per = (ntile + G - 1) / G, r0 = blk * per * 16, r1 = ((blk + 1) * per * 16 < nrows) ? (blk + 1) * per * 16 : nrows;
    unsigned en = 0u, sn = 0u; float rn = 0.f;
    if (r0 + wave < r1) { en = tokE[r0 + wave]; sn = tokS[r0 + wave]; rn = tokR[r0 + wave]; }
    for (int row = r0 + wave; row < r1; row += NWAVES) {
        const unsigned e = en, s = sn; const float rstd_pre = rn;
        if (row + NWAVES < r1) { en = tokE[row + NWAVES]; sn = tokS[row + NWAVES]; rn = tokR[row + NWAVES]; }
        const unsigned p0 = base[e & 255u] + (s & 0xffffu), p1 = base[(e >> 8) & 255u] + (s >> 16);
        const float* xr = row < ML ? xl + (size_t)row * D : xc + (size_t)(row - ML) * D;
        const float rstd = rstd_pre;
        const float* mod = (const float*)(a.ws + WS_MOD) + (size_t)(l * 9 + row_modidx(row)) * 6144; const float* gain = a.in[I_NORM2] + l * D;
        f32x4 xv[4], gvv[4], s1v[4], s0v[4];
#pragma unroll
        for (int j = 0; j < 4; ++j) { xv[j] = ((const f32x4*)xr)[lane + 64 * j]; gvv[j] = ((const f32x4*)gain)[lane + 64 * j]; s1v[j] = ((const f32x4*)(mod + 4 * 1024))[lane + 64 * j]; s0v[j] = ((const f32x4*)(mod + 3 * 1024))[lane + 64 * j]; }
#pragma unroll
        for (int j = 0; j < 4; ++j) {
            const f32x4 x = xv[j], gv = gvv[j], s1 = s1v[j], s0 = s0v[j];
            const f32x4 y = (x * rstd * gv) * (s1 + 1.0f) + s0;
            u32x2 o; o.x = pk2(y.x, y.y); o.y = pk2(y.z, y.w);
            ((u32x2*)(xb + (size_t)p0 * D))[lane + 64 * j] = o; ((u32x2*)(xb + (size_t)p1 * D))[lane + 64 * j] = o;
        }
        if (lane == 0) tokP[row] = (u32x2){p0, p1};
    }
}

__device__ __forceinline__ void phase_combine(const KArgs& a, int l, int nrows) {
    const int tid = OTID(), lane = tid & 63, wave = tid >> 6;
    const int gw = OBLK() * NWAVES + wave, NGW = OGRID() * NWAVES;
    const u32x2* tokP = (const u32x2*)(a.ws + WS_TOK + TOK_POS); const f32x2* tokW = (const f32x2*)(a.ws + WS_TOK + TOK_W);
    const bf16_t* yb = (const bf16_t*)(a.ws + WS_YB); bf16_t* hl = (bf16_t*)(a.ws + WS_HL);
    u32x2 pn = (u32x2){0u, 0u}; f32x2 wn = (f32x2){0.f, 0.f};
    if (gw < nrows) { pn = tokP[gw]; wn = tokW[gw]; }
    for (int row = gw; row < nrows; row += NGW) {
        float* xr = row < ML ? a.out + (size_t)row * D : (float*)(a.ws + WS_XC) + (size_t)(row - ML) * D;
        const u32x2 p = pn; const f32x2 w = wn;
        if (row + NGW < nrows) { pn = tokP[row + NGW]; wn = tokW[row + NGW]; }
        const float* mod = (const float*)(a.ws + WS_MOD) + (size_t)(l * 9 + row_modidx(row)) * 6144;
        f32x4 v[4];
        f32x4 xv[4], g2v[4]; u32x2 y0v[4], y1v[4];
#pragma unroll
        for (int j = 0; j < 4; ++j) { xv[j] = ((const f32x4*)xr)[lane + 64 * j]; g2v[j] = ((const f32x4*)(mod + 5 * 1024))[lane + 64 * j];
            y0v[j] = ((const u32x2*)(yb + (size_t)p.x * D))[lane + 64 * j]; y1v[j] = ((const u32x2*)(yb + (size_t)p.y * D))[lane + 64 * j]; }
#pragma unroll
        for (int j = 0; j < 4; ++j) {
            const f32x4 x = xv[j], g2 = g2v[j];
            const u32x2 y0 = y0v[j], y1 = y1v[j];
            f32x4 m; m.x = w.x * bflo(y0.x) + w.y * bflo(y1.x); m.y = w.x * bfhi(y0.x) + w.y * bfhi(y1.x); m.z = w.x * bflo(y0.y) + w.y * bflo(y1.y); m.w = w.x * bfhi(y0.y) + w.y * bfhi(y1.y);
            v[j] = x + g2 * m; ((f32x4*)xr)[lane + 64 * j] = v[j];
        }
        if (l == 0) { const float* mod1 = (const float*)(a.ws + WS_MOD) + (size_t)(9 + row_modidx(row)) * 6144;
            modulate_store(v, a.in[I_NORM1] + D, mod1, mod1 + 1024, hl + (size_t)row * D, lane); }
    }
}
#ifndef MK_PER_PHASE
#define MK_PER_PHASE 0
#endif
#ifndef PROBE_DUP
#define PROBE_DUP 0
#endif
#define DUPON(k) ((PROBE_DUP >> (k)) & 1)
#define DUPBAR() do { if (use_bar) xcd_barrier(bar); } while (0)
#ifndef RERUN_K
#define RERUN_K 0
#endif
#define RERUN(k, l, ctx_out, mrows) do { if (RERUN_K == (k)) { DUPBAR(); ph_modulate1(ka, (l), MA); DUPBAR(); ph_gemm_in(ka, lds, (l)); DUPBAR(); ph_prep(ka, (l)); \
        if ((k) >= 3) { DUPBAR(); ph_mixers(ka, lds, (l), ctx_out); } if ((k) >= 4) { DUPBAR(); ph_gdnscan(ka, lds, (l), ctx_out, (l) + 2); } \
        if ((k) >= 5) { DUPBAR(); ph_post(ka, lds, (l), mrows); } } } while (0)
constexpr int NPH_LAYER = 14, NPHASES = 1 + 2 * NPH_LAYER;

#ifndef STAG_TICKS
#define STAG_TICKS 0
#endif
__device__ __forceinline__ void stagger(int mult) { const int g = (OBLK() >> 3) & 3; if (g == 0 || STAG_TICKS == 0) return; const unsigned long long lim = (unsigned long long)(g * mult);
    const unsigned long long t0 = __builtin_amdgcn_s_memrealtime(); while (__builtin_amdgcn_s_memrealtime() - t0 < lim) __builtin_amdgcn_s_sleep(4); }
__device__ NOINL void ph_prologue(KAP ka, LAS unsigned char* lds) { const KArgs a = load_kargs(ka); phase_prologue(a, lds); }
__device__ NOINL void ph_modulate1(KAP ka, int l, int nrows) { const KArgs a = load_kargs(ka); phase_modulate1(a, l, nrows); }
__device__ NOINL void ph_prep(KAP ka, int l) { const KArgs a = load_kargs(ka); phase_prep(a, l); }
__device__ NOINL void ph_mixers(KAP ka, LAS unsigned char* lds, int l, bool ctx_out) { phase_mixers(ka, lds, l, ctx_out); }
__device__ NOINL void ph_gdnscan(KAP ka, LAS unsigned char* lds, int l, bool ctx_out, int qslot) { phase_scan_attn(ka, lds, l, ctx_out, qslot); }
__device__ NOINL void ph_post(KAP ka, LAS unsigned char* lds, int l, int mrows) { { const int blk = OBLK(), G = OGRID(); const int nu = (mrows == ML) ? 32 * 32 : 32 * 34;
      for (int v = G - 1 - blk; v < nu; v += G) { const int u = (mrows == ML) ? (v >> 5) * 34 + 2 + (v & 31) : v; call_retout(ka, lds, l, u); } }
    __syncthreads(); const KArgs a = load_kargs(ka); phase_post(a, lds, l, mrows); }
__device__ NOINL void ph_gemm_in(KAP ka, LAS unsigned char* lds, int l) { const KArgs a = load_kargs(ka);
    const bf16_t* wsm = (const bf16_t*)(a.ws + WS_WSM);
    SchedPlain S; S.init(a.ws + WS_HL, 1024, wsm + WSM_IN / 2, 1024, MA, ZP, OGRID(), OBLK());
    EpiIn E{(bf16_t*)(a.ws + WS_Z), a.in[I_WQN] + l * 64, a.in[I_WKN] + l * 64, a.in[I_NQN] + l * 64, a.in[I_NKN] + l * 64, (const float*)(a.ws + WS_ROPE)};
    pg8::gemm_phase<EpiIn, SchedPlain, true>(lds, 1024, 1024, 1024, S, E); }
#ifndef PROBE_GK
#define PROBE_GK 0
#endif
__device__ NOINL void ph_gemm_in_probe(KAP ka, LAS unsigned char* lds, int l) { const KArgs a = load_kargs(ka);
    const bf16_t* wsm = (const bf16_t*)(a.ws + WS_WSM);
    SchedPlain S; S.init(a.ws + WS_HL, 1024, wsm + WSM_IN / 2, 1024, MA, ZP, OGRID(), OBLK());
    EpiStore<0> E{(bf16_t*)(a.ws + WS_Z), ZP};
    pg8::gemm_phase<EpiStore<0>, SchedPlain, true>(lds, PROBE_GK, 1024, 1024, S, E); }
__device__ NOINL void ph_gemm_gate(KAP ka, LAS unsigned char* lds, int l, int mrows) { const KArgs a = load_kargs(ka);
    const bf16_t* wsm = (const bf16_t*)(a.ws + WS_WSM);
    SchedPlain S; S.init(a.ws + WS_HL, 1024, wsm + WSM_MERGE / 2, 1024, mrows, 4096, OGRID(), OBLK());
    EpiGateF E{(bf16_t*)(a.ws + WS_Z)};
    pg8::gemm_phase<EpiGateF, SchedPlain, true>(lds, 1024, 1024, 1024, S, E); }
__device__ NOINL void ph_gemm_branch(KAP ka, LAS unsigned char* lds, int l, int mrows) { const KArgs a = load_kargs(ka);
    const bf16_t* wsm = (const bf16_t*)(a.ws + WS_WSM);
    SchedBranch S{(const char*)(a.ws + WS_Z), (const char*)(wsm + WSM_BR / 2), (mrows / 256) * 4, OGRID(), OBLK()};
    EpiBranch E{(bf16_t*)(a.ws + WS_HL), (const bf16_t*)(a.ws + WS_Z)};
    pg8::gemm_phase<EpiBranch, SchedBranch, true>(lds, 512, ZP, 512, S, E); }
__device__ NOINL void ph_gemm_out(KAP ka, LAS unsigned char* lds, int l, int mrows) { const KArgs a = load_kargs(ka);
    const bf16_t* wsm = (const bf16_t*)(a.ws + WS_WSM);
    SchedPlain S; S.init(a.ws + WS_HL, 1024, wsm + WSM_OUT / 2, 1024, mrows, 1024, OGRID(), OBLK());
    EpiResid E{l == 0 ? a.in[I_X] : a.out, l == 0 ? a.in[I_CTX] : (const float*)(a.ws + WS_XC), a.out, (float*)(a.ws + WS_XC), (const float*)(a.ws + WS_MOD) + (size_t)l * 9 * 6144 + 2 * 1024};
    pg8::gemm_phase<EpiResid, SchedPlain, true>(lds, 1024, 1024, 1024, S, E); }
#ifndef EXPC_SPLIT
#define EXPC_SPLIT 14000
#endif
__device__ NOINL void ph_expconv(KAP ka, LAS unsigned char* lds, int l, int lo, int hi, int blk0) { const KArgs a = load_kargs(ka); expert_convert_range(a, lds, l, lo, hi, blk0); }
__device__ NOINL void ph_route(KAP ka, LAS unsigned char* lds, int l, int mrows) { const KArgs a = load_kargs(ka); phase_route(a, lds, l, mrows); if (l == 0) { __syncthreads(); small_weight_convert(a, lds, 1); } }
__device__ NOINL void ph_gather(KAP ka, LAS unsigned char* lds, int l, int mrows) { const KArgs a = load_kargs(ka); phase_gather(a, lds, l, mrows); }
__device__ NOINL void ph_gemm_gu(KAP ka, LAS unsigned char* lds) { const KArgs a = load_kargs(ka);
    const int* tile_e = (const int*)(a.ws + WS_TOK + TOK_TILE);
    SchedMoe S; S.A0 = (const char*)(a.ws + WS_XB); S.W0 = (const char*)(a.ws + WS_WGU); S.tile_start = tile_e; S.tA = (size_t)256 * 1024 * 2; S.eB = (size_t)1024 * 1024 * 2; S.tB = (size_t)256 * 1024 * 2; S.G = OGRID(); S.c = OBLK(); S.init();
    EpiAct E{(bf16_t*)(a.ws + WS_ACT)};
    pg8::gemm_phase<EpiAct, SchedMoe, true>(lds, 1024, 1024, 1024, S, E); }
__device__ NOINL void ph_gemm_dn(KAP ka, LAS unsigned char* lds) { const KArgs a = load_kargs(ka);
    const int* tile_e = (const int*)(a.ws + WS_TOK + TOK_TILE);
    SchedMoe S; S.A0 = (const char*)(a.ws + WS_ACT); S.W0 = (const char*)(a.ws + WS_WDN); S.tile_start = tile_e; S.tA = (size_t)256 * 512 * 2; S.eB = (size_t)1024 * 512 * 2; S.tB = (size_t)256 * 512 * 2; S.G = OGRID(); S.c = OBLK(); S.init();
    EpiStore<0> E{(bf16_t*)(a.ws + WS_YB), 1024};
    pg8::gemm_phase<EpiStore<0>, SchedMoe, true>(lds, 512, 512, 512, S, E); }
__device__ NOINL void ph_combine(KAP ka, int l, int mrows) { const KArgs a = load_kargs(ka); phase_combine(a, l, mrows); }

__global__ void __launch_bounds__(NTHR, 2) fwd_kernel(KArgs a) {
    extern __shared__ __attribute__((aligned(16))) unsigned char lds_raw[];
    LAS unsigned char* lds = (LAS unsigned char*)lds_raw;
    KAP ka = (KAP)__builtin_amdgcn_kernarg_segment_ptr();
    const int tid = OTID();
    volatile LAS unsigned* ctlw = (volatile LAS unsigned*)(lds + LDS_CTL);
    if (tid < 64) ctlw[tid] = 0u;
    __syncthreads();
    const int lo = a.ph_lo, hi = a.ph_hi;
    const bool use_bar = (hi - lo) > 1;
    XcdBarrier bar; bar.bar = (unsigned*)(a.ws + WS_CTL) + CW_BAR; bar.x = 0u; bar.st = ctlw + 8;
    if (use_bar) bar = xcd_barrier_post((unsigned*)(a.ws + WS_CTL) + CW_BAR, ctlw + 8);
#define IN(k) (lo <= (k) && (k) < hi)
#define SEAM(k) do { if (use_bar && (k) + 1 < hi) xcd_barrier(bar); } while (0)
    if (IN(0)) { ph_prologue(ka, lds); SEAM(0); }
#define LAYER_BODY(l) do { \
        constexpr int pb = 1 + (l) * NPH_LAYER; constexpr bool ctx_out = ((l) == 0); constexpr int mrows = ctx_out ? MA : ML; \
        if ((l) == 0 && IN(pb + 0)) { ph_modulate1(ka, (l), MA); SEAM(pb + 0); }     \
        if (IN(pb + 1)) { if (PROBE_GK) { ph_gemm_in_probe(ka, lds, (l)); DUPBAR(); } ph_gemm_in(ka, lds, (l)); if (RERUN_K == 1) { DUPBAR(); ph_modulate1(ka, (l), MA); DUPBAR(); ph_gemm_in(ka, lds, (l)); } SEAM(pb + 1); } \
        if (IN(pb + 2)) { ph_prep(ka, (l)); RERUN(2, l, ctx_out, mrows); SEAM(pb + 2); } \
        if (IN(pb + 3)) { ph_mixers(ka, lds, (l), ctx_out); RERUN(3, l, ctx_out, mrows); SEAM(pb + 3); } \
        if (IN(pb + 4)) { ph_gdnscan(ka, lds, (l), ctx_out, (l)); RERUN(4, l, ctx_out, mrows); SEAM(pb + 4); } \
        if (IN(pb + 5)) { ph_post(ka, lds, (l), mrows); RERUN(5, l, ctx_out, mrows); SEAM(pb + 5); } \
        if (IN(pb + 6)) { ph_gemm_gate(ka, lds, (l), mrows); if ((l) == 0) ph_expconv(ka, lds, (l), 0, 4400, 128); SEAM(pb + 6); } \
        if (IN(pb + 7)) { ph_gemm_branch(ka, lds, (l), mrows); if ((l) == 0) ph_expconv(ka, lds, (l), 4400, 4400 + EXPC_SPLIT, 32); SEAM(pb + 7); } \
        if (IN(pb + 8)) { ph_gemm_out(ka, lds, (l), mrows); ph_expconv(ka, lds, (l), (l) == 0 ? 4400 + EXPC_SPLIT : 0, EXPC_ITEMS, (l) == 0 ? 32 : 0);     SEAM(pb + 8); } \
        if (IN(pb + 9)) { ph_route(ka, lds, (l), mrows); if (DUPON(9)) { DUPBAR(); ph_route(ka, lds, (l), mrows); } SEAM(pb + 9); } \
        if (IN(pb + 10)) { ph_gather(ka, lds, (l), mrows); if (DUPON(10)) { DUPBAR(); ph_gather(ka, lds, (l), mrows); } SEAM(pb + 10); } \
        if (IN(pb + 11)) { ph_gemm_gu(ka, lds); if (DUPON(11)) { DUPBAR(); ph_gemm_gu(ka, lds); } SEAM(pb + 11); } \
        if (IN(pb + 12)) { ph_gemm_dn(ka, lds); if (DUPON(12)) { DUPBAR(); ph_gemm_dn(ka, lds); } if (RERUN_K == 12) { DUPBAR(); ph_route(ka, lds, (l), mrows); DUPBAR(); ph_gather(ka, lds, (l), mrows); DUPBAR(); ph_gemm_gu(ka, lds); DUPBAR(); ph_gemm_dn(ka, lds); } SEAM(pb + 12); } \
        if (IN(pb + 13)) { ph_combine(ka, (l), mrows); SEAM(pb + 13); } \
    } while (0)
    LAYER_BODY(0);
    LAYER_BODY(1);
#undef LAYER_BODY
#undef IN
#undef SEAM
}

extern "C" void kernel_launch(void* const* d_in, const int* in_sizes, int n_in, void* d_out, int out_size, void* d_ws, size_t ws_size, hipStream_t stream) {
    static int grid = 0;
    if (grid == 0) {
        if (n_in != 29 || in_sizes[0] != ML * D || out_size != ML * D || ws_size < WS_END) {
            fprintf(stderr, "kernel_launch: unexpected problem (n_in %d, in0 %d, out %d, ws %zu < %zu); nothing launched\n", n_in, n_in > 0 ? in_sizes[0] : -1, out_size, ws_size, (size_t)WS_END); grid = -1; return; }
        int dev = 0, cus = 0, per_cu = 0;
        if (hipGetDevice(&dev) != hipSuccess || hipDeviceGetAttribute(&cus, hipDeviceAttributeMultiprocessorCount, dev) != hipSuccess) { grid = -1; return; }
        if (hipFuncSetAttribute((const void*)fwd_kernel, hipFuncAttributeMaxDynamicSharedMemorySize, LDS_BYTES) != hipSuccess) { fprintf(stderr, "kernel_launch: hipFuncSetAttribute failed\n"); grid = -1; return; }
        if (hipOccupancyMaxActiveBlocksPerMultiprocessor(&per_cu, (const void*)fwd_kernel, NTHR, LDS_BYTES) != hipSuccess || per_cu < 1) {
            fprintf(stderr, "kernel_launch: occupancy query says %d workgroups per CU\n", per_cu); }
        (void)hipGetLastError();
        grid = cus;
        if (grid > 256) grid = 256;
    }
    if (grid < 0) return;
    if (hipMemsetAsync((char*)d_ws + WS_CTL, 0, CTL_ZERO_BYTES, stream) != hipSuccess) return;
    KArgs a{};
    for (int i = 0; i < 29; ++i) a.in[i] = (const float*)d_in[i];
    a.out = (float*)d_out; a.ws = (unsigned char*)d_ws;
#if MK_PER_PHASE
    for (int k = 0; k < NPHASES; ++k) { if (k == 1 + NPH_LAYER) continue; a.ph_lo = k; a.ph_hi = k + 1; hipLaunchKernelGGL(fwd_kernel, dim3(grid), dim3(NTHR), LDS_BYTES, stream, a); }
#else
    a.ph_lo = 0; a.ph_hi = NPHASES;
    hipLaunchKernelGGL(fwd_kernel, dim3(grid), dim3(NTHR), LDS_BYTES, stream, a);
#endif
}
```

```cpp
#include <hip/hip_runtime.h>
#include <cstdio>
#include <cstdint>

#define LAS __attribute__((address_space(3)))
#define GAS __attribute__((address_space(1)))
typedef unsigned short bf16_t;
typedef short bf16x8 __attribute__((ext_vector_type(8)));
typedef short s16x4 __attribute__((ext_vector_type(4)));
typedef float f32x4 __attribute__((ext_vector_type(4)));
typedef float f32x2 __attribute__((ext_vector_type(2)));
typedef unsigned u32x4 __attribute__((ext_vector_type(4)));
typedef unsigned u32x2 __attribute__((ext_vector_type(2)));

typedef __bf16 bf16x2_t __attribute__((ext_vector_type(2)));
__device__ __forceinline__ unsigned pk2(float lo, float hi) { const f32x2 v = {lo, hi}; const bf16x2_t b = __builtin_convertvector(v, bf16x2_t); return __builtin_bit_cast(unsigned, b); }
__device__ __forceinline__ unsigned f2bf(float f) { return pk2(f, f) & 0xffffu; }
__device__ __forceinline__ float bflo(unsigned u) { return __builtin_bit_cast(float, u << 16); }
__device__ __forceinline__ float bfhi(unsigned u) { return __builtin_bit_cast(float, u & 0xffff0000u); }
__device__ __forceinline__ float bf2f(bf16_t h) { return __builtin_bit_cast(float, (unsigned)h << 16); }
__device__ __forceinline__ float sigmoidf_(float x) { return 1.0f / (1.0f + __expf(-x)); }
__device__ __forceinline__ float siluf_(float x) { return x / (1.0f + __expf(-x)); }
__device__ __forceinline__ float sigmoid_fast(float x) { return __builtin_amdgcn_rcpf(1.0f + __expf(-x)); }
__device__ __forceinline__ float silu_fast(float x) { return x * __builtin_amdgcn_rcpf(1.0f + __expf(-x)); }

__device__ __forceinline__ bf16x8 cat8(u32x2 lo, u32x2 hi) { u32x4 w; w.x = lo.x; w.y = lo.y; w.z = hi.x; w.w = hi.y; return __builtin_bit_cast(bf16x8, w); }
__device__ __forceinline__ int OTID() { int t = threadIdx.x; asm volatile("" : "+v"(t)); return t; }
__device__ __forceinline__ int OBLK() { int t = blockIdx.x; asm volatile("" : "+s"(t)); return t; }
__device__ __forceinline__ int OGRID() { int t = gridDim.x; asm volatile("" : "+s"(t)); return t; }

namespace pg8 {
constexpr int BM = 256, BK = 64, HALF = 128, HTB = HALF * BK * 2, STAGE_BYTES = 8 * HTB, NXCD = 8, WGM = 8;
__host__ __device__ __forceinline__ int lds_byte(int r, int c) { const int st = (r >> 4) * 2 + (c >> 5), rr = r & 15, cc = c & 31, ob = rr * 64 + cc * 2; return st * 1024 + (ob ^ (((ob >> 9) & 1) << 5)); }
__host__ __device__ __forceinline__ void stage_rc(int b, int& R, int& C) { const int st = b / 1024, sb = b % 1024, swz = sb ^ (((sb >> 9) & 1) << 5); R = (st >> 1) * 16 + swz / 64; C = (st & 1) * 32 + (swz % 64) / 2; }
__host__ __device__ __forceinline__ int perm32(int rho) { const int n = rho >> 4, i = rho & 15; return 8 * (i >> 2) + 4 * n + (i & 3); }

struct Unit { int pm, pn, aux; };

template <class Epi, class Sched, bool ALIGN_EPI>
__device__ __forceinline__ void gemm_phase(LAS unsigned char* lds, const int K, const int lda, const int ldb, const Sched& S, const Epi& E) {
    const int tid = OTID(), wid = __builtin_amdgcn_readfirstlane(tid >> 6), lane = tid & 63, wr = wid >> 2, wc = wid & 3, fr = lane & 15, fq = lane >> 4;
    const int nt = K / BK;
    unsigned voffA[2], voffB[2];
#pragma unroll
    for (int i = 0; i < 2; ++i) { int R, C; stage_rc(tid * 16 + i * 8192, R, C); const int Rb = (R & ~31) + perm32(R & 31);
        voffA[i] = (unsigned)(R * lda + C) * 2u; voffB[i] = (unsigned)(Rb * ldb + C) * 2u; }
    const size_t kstep = (size_t)(BK * 2);
    const size_t hstepA = (size_t)HALF * lda * 2, hstepB = (size_t)HALF * ldb * 2;
    const unsigned ldsw = (unsigned)wid * 1024u;
    const int aoff = lds_byte(wr * 64 + fr, fq * 8), boff = lds_byte(wc * 32 + fr, fq * 8);
#define PG8_SA(b, h) (((b) * 2 + (h)) * HTB)
#define PG8_SB(b, h) ((4 + (b) * 2 + (h)) * HTB)
#define PG8_STAGE(bufoff, gbase, voff) do { _Pragma("unroll") for (int _i = 0; _i < 2; ++_i) \
        __builtin_amdgcn_global_load_lds((const unsigned*)((const char*)(gbase) + (voff)[_i]), (LAS unsigned*)(lds + (bufoff) + ldsw + _i * 8192), 16, 0, 0); } while (0)
#define PG8_LDA(dst, b, h) do { _Pragma("unroll") for (int m = 0; m < 4; ++m) _Pragma("unroll") for (int k = 0; k < 2; ++k) dst[m][k] = *(const LAS bf16x8*)(lds + PG8_SA(b, h) + aoff + m * 2048 + k * 1024); } while (0)
#define PG8_LDB(dst, b, h) do { _Pragma("unroll") for (int n = 0; n < 2; ++n) _Pragma("unroll") for (int k = 0; k < 2; ++k) dst[n][k] = *(const LAS bf16x8*)(lds + PG8_SB(b, h) + boff + n * 2048 + k * 1024); } while (0)
#define PG8_MMA(ai, bj, At, Bt) do { __builtin_amdgcn_s_setprio(1); _Pragma("unroll") for (int m = 0; m < 4; ++m) _Pragma("unroll") for (int n = 0; n < 2; ++n) _Pragma("unroll") for (int k = 0; k < 2; ++k) \
        acc[ai][bj][m][n] = __builtin_amdgcn_mfma_f32_16x16x32_bf16(Bt[n][k], At[m][k], acc[ai][bj][m][n], 0, 0, 0); __builtin_amdgcn_s_setprio(0); } while (0)
#define PG8_WAIT_V(n) asm volatile("s_waitcnt vmcnt(" #n ")" ::: "memory")
#define PG8_WAIT_L(n) asm volatile("s_waitcnt lgkmcnt(" #n ")" ::: "memory")
#define PG8_BAR __builtin_amdgcn_s_barrier()
#define PG8_SCHED __builtin_amdgcn_sched_barrier(0)
    Unit cur, nxt; int ui = 0;
    if (!S.next(0, cur)) return;
    f32x4 acc[2][2][4][2];
#pragma unroll
    for (int a = 0; a < 2; ++a)
#pragma unroll
        for (int b = 0; b < 2; ++b)
#pragma unroll
            for (int m = 0; m < 4; ++m)
#pragma unroll
                for (int n = 0; n < 2; ++n) acc[a][b][m][n] = (f32x4){0.f, 0.f, 0.f, 0.f};
    bf16x8 At[4][2], B0[2][2], B1[2][2];
    const char* cA = S.A(cur); const char* cB = S.B(cur);
    PG8_STAGE(PG8_SB(0, 0), cB, voffB); PG8_STAGE(PG8_SB(0, 1), cB + hstepB, voffB); PG8_STAGE(PG8_SA(0, 0), cA, voffA); PG8_STAGE(PG8_SA(0, 1), cA + hstepA, voffA);
    if (wr == 1) PG8_BAR;
    PG8_WAIT_V(2); PG8_BAR;
    PG8_STAGE(PG8_SB(1, 0), cB + kstep, voffB); PG8_STAGE(PG8_SA(1, 0), cA + kstep, voffA); PG8_STAGE(PG8_SB(1, 1), cB + hstepB + kstep, voffB);
    PG8_WAIT_V(6); PG8_BAR;
    for (;;) {
        const bool has_next = S.next(ui + 1, nxt);
        const char* nA = has_next ? S.A(nxt) : cA; const char* nB = has_next ? S.B(nxt) : cB;
        for (int t = 0; t < nt; t += 2) {
            const bool last = (t == nt - 2);
            const char* a1 = cA + (size_t)(t + 1) * kstep;
            const char* a2 = last ? nA : cA + (size_t)(t + 2) * kstep; const char* b2 = last ? nB : cB + (size_t)(t + 2) * kstep;
            const char* a3 = a2 + kstep; const char* b3 = b2 + kstep;
            PG8_LDB(B0, 0, 0); PG8_LDB(B1, 0, 1); PG8_SCHED; PG8_LDA(At, 0, 0); PG8_STAGE(PG8_SA(1, 1), a1 + hstepA, voffA);
            PG8_WAIT_V(8); PG8_WAIT_L(0); PG8_BAR; PG8_MMA(0, 0, At, B0); PG8_MMA(0, 1, At, B1); PG8_BAR; PG8_SCHED;
            PG8_LDA(At, 0, 1); PG8_STAGE(PG8_SB(0, 0), b2, voffB); PG8_STAGE(PG8_SB(0, 1), b2 + hstepB, voffB); PG8_STAGE(PG8_SA(0, 0), a2, voffA);
            PG8_WAIT_V(8); PG8_WAIT_L(0); PG8_BAR; PG8_MMA(1, 0, At, B0); PG8_MMA(1, 1, At, B1); PG8_BAR; PG8_SCHED;
            PG8_LDB(B0, 1, 0); PG8_LDB(B1, 1, 1); PG8_SCHED; PG8_LDA(At, 1, 0); PG8_STAGE(PG8_SA(0, 1), a2 + hstepA, voffA);
            PG8_WAIT_V(8); PG8_WAIT_L(0); PG8_BAR; PG8_MMA(0, 0, At, B0); PG8_MMA(0, 1, At, B1); PG8_BAR; PG8_SCHED;
            PG8_LDA(At, 1, 1); PG8_STAGE(PG8_SB(1, 0), b3, voffB); PG8_STAGE(PG8_SB(1, 1), b3 + hstepB, voffB); PG8_STAGE(PG8_SA(1, 0), a3, voffA);
            PG8_WAIT_V(8); PG8_WAIT_L(0); PG8_BAR; PG8_MMA(1, 0, At, B0); PG8_MMA(1, 1, At, B1); PG8_BAR; PG8_SCHED;
        }
        if constexpr (ALIGN_EPI) { if (wr == 0) PG8_BAR; }
        E(acc, cur, wr, wc, fr, fq);
        if (!has_next) break;
        if constexpr (!Epi::INPLACE) {
#pragma unroll
        for (int a = 0; a < 2; ++a)
#pragma unroll
            for (int b = 0; b < 2; ++b)
#pragma unroll
                for (int m = 0; m < 4; ++m)
#pragma unroll
                    for (int n = 0; n < 2; ++n) acc[a][b][m][n] = (f32x4){0.f, 0.f, 0.f, 0.f};
        }
        cur = nxt; cA = nA; cB = nB; ++ui;
        if constexpr (ALIGN_EPI) { if (wr == 1) PG8_BAR; }
    }
    PG8_WAIT_V(0);
    if constexpr (!ALIGN_EPI) { if (wr == 0) PG8_BAR; }
    PG8_BAR;
#undef PG8_SA
#undef PG8_SB
#undef PG8_STAGE
#undef PG8_LDA
#undef PG8_LDB
#undef PG8_MMA
#undef PG8_WAIT_V
#undef PG8_WAIT_L
#undef PG8_BAR
#undef PG8_SCHED
}
}
#define XB_TMO      128
#define XB_XCNT(j)  (256  + 64 * (j))
#define XB_XSUB(j)  (1280 + 64 * (j))
#define XB_XGEN(j)  (2304 + 64 * (j))
#define XB_TOP      3328
#define XB_TOPGEN   3392
#define XCD_BAR_WORDS 3456
#define XB_SPIN_CAP (1u << 22)
__device__ __forceinline__ unsigned xb_ld(unsigned* p)              { return __hip_atomic_load(p, __ATOMIC_RELAXED, __HIP_MEMORY_SCOPE_AGENT); }
__device__ __forceinline__ unsigned xb_add(unsigned* p, unsigned v) { return __hip_atomic_fetch_add(p, v, __ATOMIC_RELAXED, __HIP_MEMORY_SCOPE_AGENT); }
__device__ __forceinline__ unsigned xb_xcc_id() { return (unsigned)__builtin_amdgcn_s_getreg((3 << 11) | 20) & 0xFu; }
#define XB_SPIN(cond, bar) do { unsigned _sp = 0; while (cond) { __builtin_amdgcn_s_sleep(1); \
    if ((++_sp & 255u) == 0u) { if (xb_ld(&(bar)[XB_TMO])) break; if (_sp > XB_SPIN_CAP) { atomicAdd(&(bar)[XB_TMO], 1u); break; } } } } while (0)
struct XcdBarrier { unsigned* bar; unsigned x; volatile LAS unsigned* st; };
__device__ __forceinline__ XcdBarrier xcd_barrier_post(unsigned* bar, volatile LAS unsigned* st) {
    XcdBarrier b; b.bar = bar; b.x = xb_xcc_id(); b.st = st;
    if (threadIdx.x == 0) (void)xb_add(&bar[XB_XCNT(b.x)], 1u);
    return b;
}
__device__ __forceinline__ void xcd_barrier_complete(unsigned* bar, unsigned x, unsigned& nloc, unsigned& nx) {
    const unsigned G = gridDim.x * gridDim.y * gridDim.z;
    unsigned sum, cnt, mine, sp = 0u;
    for (;;) {
        sum = 0u; cnt = 0u; mine = 0u;
#pragma unroll 1
        for (unsigned j = 0; j < 16; ++j) { const unsigned c = xb_ld(&bar[XB_XCNT(j)]); sum += c; cnt += (c > 0u) ? 1u : 0u; mine = (j == x) ? c : mine; }
        if (sum == G) break;
        __builtin_amdgcn_s_sleep(1);
        if ((++sp & 255u) == 0u) { if (xb_ld(&bar[XB_TMO])) break; if (sp > XB_SPIN_CAP) { atomicAdd(&bar[XB_TMO], 1u); break; } }
    }
    nloc = mine > 0u ? mine : 1u; nx = cnt > 0u ? cnt : 1u;
}
__device__ __forceinline__ void xcd_barrier_impl(unsigned* bbar, unsigned bx, volatile LAS unsigned* bst) {
    XcdBarrier b; b.bar = bbar; b.x = bx; b.st = bst;
    asm volatile("s_waitcnt vmcnt(0)" ::: "memory");
    __syncthreads();
    if (threadIdx.x == 0) {
        unsigned* bar = b.bar;
        __builtin_amdgcn_s_waitcnt(0);
        unsigned nloc = b.st[0], nx = b.st[1];
        if (nloc == 0u) { xcd_barrier_complete(bar, b.x, nloc, nx); b.st[0] = nloc; b.st[1] = nx; }
        const unsigned old = xb_add(&bar[XB_XSUB(b.x)], 1u);
        const unsigned gen = old / nloc;
        if (old + 1u == (gen + 1u) * nloc) {
            __builtin_amdgcn_fence(__ATOMIC_RELEASE, "agent");
            asm volatile("s_waitcnt vmcnt(0)" ::: "memory");
            const unsigned og = xb_add(&bar[XB_TOP], 1u);
            const unsigned tg = og / nx;
            if (og + 1u == (tg + 1u) * nx) xb_add(&bar[XB_TOPGEN], 1u);
            else XB_SPIN(xb_ld(&bar[XB_TOPGEN]) == tg, bar);
            __builtin_amdgcn_fence(__ATOMIC_ACQUIRE, "agent");
            xb_add(&bar[XB_XGEN(b.x)], 1u);
            asm volatile("s_waitcnt vmcnt(0)" ::: "memory");
        } else {
            XB_SPIN(xb_ld(&bar[XB_XGEN(b.x)]) == gen, bar);
            __builtin_amdgcn_fence(__ATOMIC_ACQUIRE, "agent");
            asm volatile("s_waitcnt vmcnt(0)" ::: "memory");
        }
    }
    __syncthreads();
}
__device__ __forceinline__ void xcd_barrier(const XcdBarrier& b) { xcd_barrier_impl(b.bar, b.x, b.st); }

constexpr int D = 1024, NBATCH = 8, SEQ = 4096, CTXL = 256, ML = NBATCH * SEQ, MC = NBATCH * CTXL, MA = ML + MC;
constexpr int ZP = 6144, PP = 1536;
constexpr int C_RQ = 0, C_RK = 256, C_RV = 512, C_RG = 1024, C_WQ = 1536, C_WK = 2048, C_WV = 2176, C_NQ = 2304, C_NK = 2816, C_NV = 3328,
              C_GQ = 3840, C_GK = 4352, C_GV = 4864, C_GG = 5376, C_GA = 5888, C_GB = 5896;
constexpr int C_GSUM = 3840;
constexpr int Y_RET = C_RG, Y_WIN = C_WQ, Y_NA = C_NQ, Y_GDN = C_GG;
__host__ __device__ __forceinline__ int dead_tile(int gt) { return gt < 4 ? gt : (gt == 4 ? 8 : (gt < 15 ? gt + 6 : 23)); }
__device__ __forceinline__ int utile_off(int i, int col) { const int a_ = i >> 5, g_ = (i >> 3) & 3, p_ = (i >> 2) & 1, j_ = i & 3; const int rt_ = 2 * a_ + p_, lane_ = 16 * g_ + (col & 15), ch_ = col >> 6, c_ = (col >> 4) & 3;
    return ((((rt_ * 2 + ch_) * 64 + lane_) * 4 + c_) * 4 + j_); }
constexpr float EPS = 1e-6f;
constexpr int NEXP = 32, DEXP = 512, MAXT = 304;
constexpr int NWAVES = 8, NTHR = 512;

constexpr size_t MiB = 1u << 20;
constexpr size_t WS_CTL = 0, CTL_ZERO_BYTES = 1 * MiB;
constexpr size_t WS_ROPE = 1 * MiB;
constexpr size_t WS_MOD = 2 * MiB;
constexpr size_t WS_XC = 3 * MiB;
constexpr size_t WS_GB = 11 * MiB;
constexpr size_t WS_TOK = 14 * MiB;
constexpr size_t WS_WSM = 16 * MiB;
constexpr size_t WSM_IN = 0, WSM_MERGE = 12 * MiB, WSM_BR = 20 * MiB, WSM_OUT = 24 * MiB;
constexpr size_t WS_KVT = 42 * MiB;
constexpr size_t WS_HL = 76 * MiB;
constexpr size_t WS_Z = 144 * MiB;
constexpr size_t WS_P = 552 * MiB;
constexpr size_t WS_GC2 = 654 * MiB;
constexpr size_t WS_END = 656 * MiB;
constexpr size_t WS_WGU = WS_P, WS_WDN = WS_P + 64 * MiB;
constexpr size_t WS_XB = WS_Z, WS_ACT = WS_Z + 152 * MiB, WS_YB = WS_Z + 228 * MiB;
static_assert(WS_YB + (size_t)MAXT * 256 * 1024 * 2 <= WS_P && WS_WDN + (size_t)32 * 1024 * 512 * 2 <= WS_P + (size_t)MA * PP * 2, "moe overlay");
static_assert(WS_HL + (size_t)MA * 1024 * 2 <= WS_Z && WS_Z + (size_t)MA * ZP * 2 <= WS_P && WS_P + (size_t)MA * PP * 2 <= WS_END, "ws map");
constexpr size_t TOK_E = 0, TOK_SLOT = 256 * 1024, TOK_W = 512 * 1024, TOK_POS = 1024 * 1024, TOK_BCNT = 1536 * 1024, TOK_TILE = 1600 * 1024, TOK_RSTD = 1664 * 1024;
constexpr int CW_BAR = 1024;

constexpr int LDS_BYTES = 163840 - 1024;
constexpr int LDS_CTL = LDS_BYTES - 256;
struct KArgs { const float* in[29]; float* out; unsigned char* ws; int ph_lo, ph_hi; };
enum { I_X = 0, I_C, I_CTX, I_CCTX, I_WMOD, I_BMOD, I_NORM1, I_NORM2, I_WIN, I_RDECAY, I_RGN, I_WQN, I_WKN, I_WSINK, I_NQN, I_NKN, I_RPB, I_GCONV, I_GALOG, I_GDT, I_GNORM,
       I_WBR, I_WMERGE, I_WOUT, I_WROUTER, I_RBIAS, I_WEG, I_WEU, I_WED };

__device__ __forceinline__ float wave_sum(float v) {
#pragma unroll
    for (int o = 1; o < 64; o <<= 1) v += __shfl_xor(v, o);
    return v;
}
__device__ __forceinline__ float sum16(float v) { v += __shfl_xor(v, 1); v += __shfl_xor(v, 2); v += __shfl_xor(v, 4); v += __shfl_xor(v, 8); return v; }
#define LDS_WAIT() asm volatile("s_waitcnt lgkmcnt(0)" ::: "memory")

__device__ __forceinline__ int merge_row(int sc) { const int br = sc >> 10, oc = sc & 1023; return (oc >> 6) * 256 + (br >> 1) * 128 + ((oc >> 4) & 3) * 32 + ((oc >> 2) & 3) * 8 + (br & 1) * 4 + (oc & 3); }
__host__ __device__ __forceinline__ bool win_head_tile(int t) { return t < 2 || (t >= 6 && t <= 12); }
__device__ __forceinline__ int win_row(int sc) { const int t = sc >> 8, w = sc & 255; return win_head_tile(t) ? (sc & ~255) + ((w >> 5) & 1) * 128 + (w >> 6) * 32 + (w & 31) : sc; }
template <int MERGE = 0>
__device__ __forceinline__ void transpose_item(const float* W, int ldw, int ncols, int k0, int n0, bf16_t* WT, int ldt, int dst_row0, LAS float* scr, int lane) {
    const int nn = n0 + (lane & 31);
    { float v[32]; const float* wp = W + (size_t)(k0 + (lane >> 5)) * ldw + (nn < ncols ? nn : 0);
#pragma unroll
      for (int i = 0; i < 32; ++i) v[i] = wp[(size_t)(2 * i) * ldw];
#pragma unroll
      for (int i = 0; i < 32; ++i) { const int kk = 2 * i + (lane >> 5); scr[kk * 33 + (lane & 31)] = (nn < ncols) ? v[i] : 0.f; } }
    LDS_WAIT(); asm volatile("" ::: "memory");
    const int c = lane & 7;
#pragma unroll
    for (int j = 0; j < 4; ++j) { const int n = (lane >> 3) + 8 * j; const LAS float* s = scr + (8 * c) * 33 + n;
        u32x4 o; o.x = pk2(s[0 * 33], s[1 * 33]); o.y = pk2(s[2 * 33], s[3 * 33]); o.z = pk2(s[4 * 33], s[5 * 33]); o.w = pk2(s[6 * 33], s[7 * 33]);
        *(u32x4*)(WT + (size_t)(MERGE == 1 ? merge_row(dst_row0 + n) : (MERGE == 2 ? win_row(dst_row0 + n) : dst_row0 + n)) * ldt + k0 + 8 * c) = o; }
    LDS_WAIT(); asm volatile("" ::: "memory");
}

__device__ __forceinline__ void small_weight_convert(const KArgs& a, LAS unsigned char* lds, int l) {
    const int tid = OTID(), lane = tid & 63, wave = tid >> 6, G = OGRID(), blk = OBLK();
    unsigned char* ws = a.ws;
    LAS float* scr = (LAS float*)(lds + 65536 + wave * 8448);
    const int gw = blk * NWAVES + wave, NGW = G * NWAVES;
    constexpr int I_IN = 16 * 192, I_MG = 16 * 128, I_BR = 4 * 8 * 32, I_OUT = 16 * 32, I_LAYER = I_IN + I_MG + I_BR + I_OUT;
    bf16_t* wsm = (bf16_t*)(ws + WS_WSM);
    for (int it = gw; it < I_LAYER; it += NGW) {
        int r = it;
        if (r < I_IN) { const int kb = r / 192, nb = r % 192; transpose_item<2>(a.in[I_WIN] + (size_t)l * 1024 * 5904, 5904, 5904, kb * 64, nb * 32, wsm + WSM_IN / 2, 1024, nb * 32, scr, lane); continue; } r -= I_IN;
        if (r < I_MG) { const int kb = r / 128, nb = r % 128; transpose_item<1>(a.in[I_WMERGE] + (size_t)l * 1024 * 4096, 4096, 4096, kb * 64, nb * 32, wsm + WSM_MERGE / 2, 1024, nb * 32, scr, lane); continue; } r -= I_MG;
        if (r < I_BR) { const int br = r / 256, q = r % 256, kb = q / 32, nb = q % 32;
            transpose_item(a.in[I_WBR] + (size_t)(l * 4 + br) * 512 * 1024, 1024, 1024, kb * 64, nb * 32, wsm + WSM_BR / 2 + (size_t)br * 1024 * 512, 512, nb * 32, scr, lane); continue; } r -= I_BR;
        { const int kb = r / 32, nb = r % 32; transpose_item(a.in[I_WOUT] + (size_t)l * 1024 * 1024, 1024, 1024, kb * 64, nb * 32, wsm + WSM_OUT / 2, 1024, nb * 32, scr, lane); }
    }
}

__device__ __forceinline__ void phase_prologue(const KArgs& a, LAS unsigned char* lds) {
    const int tid = OTID(), lane = tid & 63, wave = tid >> 6, G = OGRID(), blk = OBLK();
    unsigned char* ws = a.ws;
    { float* cs = (float*)(ws + WS_ROPE); float* sn = cs + 4096 * 32;
      for (int idx = blk * NTHR + tid; idx < 4096 * 32; idx += G * NTHR) { const int t = idx >> 5, i = idx & 31; const float pos = (float)((i < 16) ? (t >> 6) : (t & 63));
          const float inv = exp2f(-(float)(i & 15) * (13.287712379549449f / 16.0f)); const float ang = pos * inv; cs[idx] = cosf(ang); sn[idx] = sinf(ang); } }
    if (blk < 192) {
        const int l = blk / 96, cg = blk % 96;
        LAS float* sc = (LAS float*)lds; LAS float* red = (LAS float*)(lds + 40960);
        for (int idx = tid; idx < 9 * 1024; idx += NTHR) { const int v = idx >> 10, k = idx & 1023; const float cv = (v < 8) ? a.in[I_C][v * 1024 + k] : a.in[I_CCTX][k]; sc[idx] = siluf_(cv); }
        __syncthreads();
        const float* wm = a.in[I_WMOD] + (size_t)l * 1024 * 6144 + cg * 64 + lane;
        float acc[9];
#pragma unroll
        for (int v = 0; v < 9; ++v) acc[v] = 0.f;
#pragma unroll 32
        for (int kk = 0; kk < 128; ++kk) { const int k = wave * 128 + kk; const float w = wm[(size_t)k * 6144];
#pragma unroll
            for (int v = 0; v < 9; ++v) acc[v] += sc[v * 1024 + k] * w; }
#pragma unroll
        for (int v = 0; v < 9; ++v) red[(wave * 9 + v) * 64 + lane] = acc[v];
        __syncthreads();
        for (int idx = tid; idx < 576; idx += NTHR) { const int v = idx >> 6, ln = idx & 63; float s = a.in[I_BMOD][l * 6144 + cg * 64 + ln];
#pragma unroll
            for (int w = 0; w < 8; ++w) s += red[(w * 9 + v) * 64 + ln];
            ((float*)(ws + WS_MOD))[(size_t)(l * 9 + v) * 6144 + cg * 64 + ln] = s; }
        __syncthreads();
    }
    small_weight_convert(a, lds, 0);
}

constexpr int EXPC_ITEMS = 3 * 8192;
__device__ __forceinline__ void expert_convert_range(const KArgs& a, LAS unsigned char* lds, int l, int lo, int hi, int blk0) {
    const int tid = OTID(), lane = tid & 63, wave = tid >> 6, blk = OBLK(), G = OGRID();
    if (G <= blk0) blk0 = 0;
    if (blk < blk0) return;
    LAS float* scr = (LAS float*)(lds + 65536 + wave * 8448);
    bf16_t* wgu = (bf16_t*)(a.ws + WS_WGU); bf16_t* wdn = (bf16_t*)(a.ws + WS_WDN);
    const int gw = (blk - blk0) * NWAVES + wave, NGW = (G - blk0) * NWAVES;
    for (int it = lo + gw; it < hi; it += NGW) {
        const int which = it / 8192, r = it % 8192, e = r / 256, q = r % 256;
        if (which < 2) { const int kb = q / 16, nb = q % 16, n0 = nb * 32;
            transpose_item(a.in[which == 0 ? I_WEG : I_WEU] + (size_t)(l * 32 + e) * 1024 * 512, 512, 512, kb * 64, n0, wgu + (size_t)e * 1024 * 1024, 1024, 256 * (n0 >> 7) + (n0 & 127) + which * 128, scr, lane); }
        else { const int kb = q / 32, nb = q % 32; transpose_item(a.in[I_WED] + (size_t)(l * 32 + e) * 512 * 1024, 1024, 1024, kb * 64, nb * 32, wdn + (size_t)e * 1024 * 512, 512, nb * 32, scr, lane); }
    }
}

__device__ __forceinline__ void modulate_store(const f32x4 (&v)[4], const float* gain, const float* sh, const float* sc, bf16_t* orow, int lane) {
    float ss = 0.f;
#pragma unroll
    for (int j = 0; j < 4; ++j) ss += (v[j].x * v[j].x + v[j].y * v[j].y) + (v[j].z * v[j].z + v[j].w * v[j].w);
    const float rstd = rsqrtf(wave_sum(ss) * (1.f / 1024.f) + EPS);
    f32x4 gq[4], s1q[4], s0q[4];
#pragma unroll
    for (int j = 0; j < 4; ++j) { gq[j] = ((const f32x4*)gain)[lane + 64 * j]; s1q[j] = ((const f32x4*)sc)[lane + 64 * j]; s0q[j] = ((const f32x4*)sh)[lane + 64 * j]; }
#pragma unroll
    for (int j = 0; j < 4; ++j) {
        const f32x4 g = gq[j], s1 = s1q[j], s0 = s0q[j];
        const f32x4 y = (v[j] * rstd * g) * (s1 + 1.0f) + s0;
        u32x2 o; o.x = pk2(y.x, y.y); o.y = pk2(y.z, y.w);
        ((u32x2*)orow)[lane + 64 * j] = o;
    }
}
__device__ __forceinline__ int row_modidx(int row) { return row < ML ? (row >> 12) : 8; }

__device__ __forceinline__ void phase_modulate1(const KArgs& a, int l, int nrows) {
    const int tid = OTID(), lane = tid & 63, wave = tid >> 6;
    const int gw = OBLK() * NWAVES + wave, NGW = OGRID() * NWAVES;
    const float* xl = (l == 0) ? a.in[I_X] : a.out; const float* xc = (l == 0) ? a.in[I_CTX] : (const float*)(a.ws + WS_XC);
    bf16_t* hl = (bf16_t*)(a.ws + WS_HL);
    for (int row = gw; row < nrows; row += NGW) {
        const float* xr = row < ML ? xl + (size_t)row * D : xc + (size_t)(row - ML) * D;
        f32x4 v[4];
#pragma unroll
        for (int j = 0; j < 4; ++j) v[j] = ((const f32x4*)xr)[lane + 64 * j];
        const float* mod = (const float*)(a.ws + WS_MOD) + (size_t)(l * 9 + row_modidx(row)) * 6144;
        modulate_store(v, a.in[I_NORM1] + l * D, mod, mod + 1024, hl + (size_t)row * D, lane);
    }
}
__device__ __forceinline__ void unpack8(const u32x4 u, float (&x)[8]) { x[0] = bflo(u.x); x[1] = bfhi(u.x); x[2] = bflo(u.y); x[3] = bfhi(u.y); x[4] = bflo(u.z); x[5] = bfhi(u.z); x[6] = bflo(u.w); x[7] = bfhi(u.w); }
__device__ __forceinline__ u32x4 pack8(const float (&x)[8]) { u32x4 u; u.x = pk2(x[0], x[1]); u.y = pk2(x[2], x[3]); u.z = pk2(x[4], x[5]); u.w = pk2(x[6], x[7]); return u; }
__device__ __forceinline__ int head64_col(int hbase, int lane) { const int hidx = hbase + (lane >> 2), p = lane & 3; return (hidx < 8 ? hidx * 64 : (hidx < 18 ? C_WQ + (hidx - 8) * 64 : C_NQ + (hidx - 18) * 64)) + 8 * p; }
__device__ __forceinline__ void head64_load(const bf16_t* zr, int hbase, int lane, u32x4& u1, u32x4& u2) { const bool act = hbase + (lane >> 2) < 34; const int col = head64_col(hbase, lane);
    u1 = (u32x4){0u, 0u, 0u, 0u}; u2 = u1; if (act) { u1 = *(const u32x4*)(zr + col); u2 = *(const u32x4*)(zr + col + 32); } }
__device__ __forceinline__ void head64_pass16(bf16_t* zr, int hbase, const float* wqn, const float* wkn, const float* nqn, const float* nkn, bool lat, const float* cs, const float* sn, int lane, const u32x4 u1, const u32x4 u2) {
    const int hidx = hbase + (lane >> 2), p = lane & 3; const bool act = hidx < 34;
    const int col = (hidx < 8 ? hidx * 64 : (hidx < 18 ? C_WQ + (hidx - 8) * 64 : C_NQ + (hidx - 18) * 64)) + 8 * p;
    const float* gain = hidx < 8 ? nullptr : (hidx < 16 ? wqn : (hidx < 18 ? wkn : (hidx < 26 ? nqn : nkn)));
    const bool rope = lat && hidx < 18;
    const float scale = (hidx >= 4 && hidx < 8) ? 0.125f : (((hidx >= 8 && hidx < 16) || (hidx >= 18 && hidx < 26)) ? 0.125f * 1.4426950408889634f : 1.0f);
    float x1[8], x2[8];
    unpack8(u1, x1); unpack8(u2, x2);
    float ss = 0.f;
#pragma unroll
    for (int e = 0; e < 8; ++e) ss += x1[e] * x1[e] + x2[e] * x2[e];
    ss += __shfl_xor(ss, 1); ss += __shfl_xor(ss, 2);
    if (gain) { const float r = rsqrtf(ss * (1.f / 64.f) + EPS);
        const f32x4 g0 = *(const f32x4*)(gain + 8 * p), g1 = *(const f32x4*)(gain + 8 * p + 4), g2 = *(const f32x4*)(gain + 32 + 8 * p), g3 = *(const f32x4*)(gain + 36 + 8 * p);
#pragma unroll
        for (int e = 0; e < 4; ++e) { x1[e] *= r * g0[e]; x1[e + 4] *= r * g1[e]; x2[e] *= r * g2[e]; x2[e + 4] *= r * g3[e]; } }
    if (rope) { const f32x4 c0 = *(const f32x4*)(cs + 8 * p), c1 = *(const f32x4*)(cs + 8 * p + 4), s0 = *(const f32x4*)(sn + 8 * p), s1 = *(const f32x4*)(sn + 8 * p + 4);
#pragma unroll
        for (int e = 0; e < 8; ++e) { const float c = e < 4 ? c0[e & 3] : c1[e & 3], sv = e < 4 ? s0[e & 3] : s1[e & 3]; const float y1 = x1[e] * c - x2[e] * sv, y2 = x1[e] * sv + x2[e] * c; x1[e] = y1; x2[e] = y2; } }
#pragma unroll
    for (int e = 0; e < 8; ++e) { x1[e] *= scale; x2[e] *= scale; }
    if (act) { *(u32x4*)(zr + col) = pack8(x1); *(u32x4*)(zr + col + 32) = pack8(x2); }
}
__device__ __forceinline__ void phase_prep(const KArgs& a, int l) {
    const int tid = OTID(), lane = tid & 63, wave = tid >> 6;
    const int gw = OBLK() * NWAVES + wave, NGW = OGRID() * NWAVES;
    bf16_t* Z = (bf16_t*)(a.ws + WS_Z); bf16_t* P = (bf16_t*)(a.ws + WS_P);
    const float* cs0 = (const float*)(a.ws + WS_ROPE); const float* sn0 = cs0 + 4096 * 32;
    float* GBa = (float*)(a.ws + WS_GB); float* GBb = GBa + (size_t)MA * 8;
    const float* wqn = a.in[I_WQN] + l * 64; const float* wkn = a.in[I_WKN] + l * 64; const float* nqn = a.in[I_NQN] + l * 64; const float* nkn = a.in[I_NKN] + l * 64;
    const float* cw = a.in[I_GCONV] + (size_t)l * 3 * 1536;
    for (int row = gw; row < MA; row += NGW) {
        const bool lat = row < ML; const int t = lat ? (row & 4095) : ((row - ML) & 255); const int slen = lat ? 4096 : 256;
        bf16_t* zr = Z + (size_t)row * ZP;
        const float* cs = cs0 + t * 32; const float* sn = sn0 + t * 32;
        const u32x4 zero = (u32x4){0u, 0u, 0u, 0u};
        u32x4 guc[3], gup[3], gun[3];
#pragma unroll
        for (int ps = 0; ps < 3; ++ps) { const int c = (ps * 4 + (lane >> 4)) * 128 + (lane & 15) * 8; const bf16_t* zc = zr + C_GQ + c;
            guc[ps] = *(const u32x4*)zc; gup[ps] = (t > 0) ? *(const u32x4*)(zc - ZP) : zero; gun[ps] = (t < slen - 1) ? *(const u32x4*)(zc + ZP) : zero; }
        float gav = 0.f, gbv = 0.f; if (lane < 8) { gav = bf2f(zr[C_GA + lane]); gbv = bf2f(zr[C_GB + lane]); }
#pragma unroll
        for (int ps = 0; ps < 3; ++ps) {
            const int c = (ps * 4 + (lane >> 4)) * 128 + (lane & 15) * 8;
            float xp[8], xc[8], xn[8], y[8]; unpack8(gup[ps], xp); unpack8(guc[ps], xc); unpack8(gun[ps], xn);
            const f32x4 w00 = *(const f32x4*)(cw + c), w01 = *(const f32x4*)(cw + c + 4), w10 = *(const f32x4*)(cw + 1536 + c), w11 = *(const f32x4*)(cw + 1536 + c + 4), w20 = *(const f32x4*)(cw + 3072 + c), w21 = *(const f32x4*)(cw + 3072 + c + 4);
            float ss = 0.f;
#pragma unroll
            for (int e = 0; e < 8; ++e) { const float w0 = e < 4 ? w00[e & 3] : w01[e & 3], w1 = e < 4 ? w10[e & 3] : w11[e & 3], w2 = e < 4 ? w20[e & 3] : w21[e & 3];
                y[e] = silu_fast(w0 * xp[e] + w1 * xc[e] + w2 * xn[e]); ss += y[e] * y[e]; }
            if (ps < 2) { ss += __shfl_xor(ss, 1); ss += __shfl_xor(ss, 2); ss += __shfl_xor(ss, 4); ss += __shfl_xor(ss, 8);
                const float r = rsqrtf(ss + EPS) * (ps == 0 ? 0.08838834764831845f : 1.0f);
#pragma unroll
                for (int e = 0; e < 8; ++e) y[e] *= r; }
            *(u32x4*)(P + (size_t)row * PP + c) = pack8(y);
        }
        if (lane < 8) {
            const float av = gav + a.in[I_GDT][l * 8 + lane], bv = gbv;
            const float sp = fmaxf(av, 0.f) + log1pf(__expf(-fabsf(av)));
            const float g = -__expf(a.in[I_GALOG][l * 8 + lane]) * sp;
            GBa[(size_t)row * 8 + lane] = g; GBb[(size_t)row * 8 + lane] = sigmoidf_(bv);
        }
    }
}

constexpr int GPO_RS = 272;
__device__ __forceinline__ void phase_post(const KArgs& a, LAS unsigned char* lds, int l, int nrows) {
    const int tid = OTID(), lane = tid & 63, wave = tid >> 6, g = lane >> 4, r16 = lane & 15;
    const int gw = OBLK() * NWAVES + wave, NGW = OGRID() * NWAVES;
    bf16_t* Z = (bf16_t*)(a.ws + WS_Z);
    const float* gnm = a.in[I_GNORM] + l * 128;
    LAS unsigned char* img = lds + wave * (64 * GPO_RS);
    const f32x4 gn0 = *(const f32x4*)(gnm + r16 * 8), gn1 = *(const f32x4*)(gnm + r16 * 8 + 4);
    const int nunits = (nrows >> 6) * 4;
    for (int u = gw; u < nunits; u += NGW) {
        const int chunk = u >> 2, h = u & 3;
        bf16_t* zblk = Z + (size_t)chunk * 64 * ZP;
        u32x4 rf[8][2], rb[8][2];
#pragma unroll
        for (int sb = 0; sb < 8; ++sb) { const bf16_t* p = zblk + (size_t)(sb * 8 + (lane >> 3)) * ZP + h * 128 + (lane & 7) * 16;
            rf[sb][0] = *(const u32x4*)(p + C_GQ); rf[sb][1] = *(const u32x4*)(p + C_GQ + 8); rb[sb][0] = *(const u32x4*)(p + C_GK); rb[sb][1] = *(const u32x4*)(p + C_GK + 8); }
#pragma unroll
        for (int rt = 0; rt < 4; ++rt) {
            float v[2][4][4]; float ss[4] = {0.f, 0.f, 0.f, 0.f};
#pragma unroll
            for (int ch = 0; ch < 2; ++ch) { const int sb = rt * 2 + ch;
#pragma unroll
                for (int hf = 0; hf < 2; ++hf) { const u32x4 f = rf[sb][hf], bq = rb[sb][hf];
                    v[ch][2 * hf][0] = bflo(f.x) + bflo(bq.x); v[ch][2 * hf][1] = bfhi(f.x) + bfhi(bq.x); v[ch][2 * hf][2] = bflo(f.y) + bflo(bq.y); v[ch][2 * hf][3] = bfhi(f.y) + bfhi(bq.y);
                    v[ch][2 * hf + 1][0] = bflo(f.z) + bflo(bq.z); v[ch][2 * hf + 1][1] = bfhi(f.z) + bfhi(bq.z); v[ch][2 * hf + 1][2] = bflo(f.w) + bflo(bq.w); v[ch][2 * hf + 1][3] = bfhi(f.w) + bfhi(bq.w); } }
#pragma unroll
            for (int j = 0; j < 4; ++j) {
#pragma unroll
                for (int ch = 0; ch < 2; ++ch)
#pragma unroll
                    for (int ct = 0; ct < 4; ++ct) ss[j] += v[ch][ct][j] * v[ch][ct][j];
                ss[j] += __shfl_xor(ss[j], 1); ss[j] += __shfl_xor(ss[j], 2); ss[j] += __shfl_xor(ss[j], 4); ss[j] += __shfl_xor(ss[j], 8);
                const float r = rsqrtf(ss[j] * (1.f / 128.f) + EPS);
                const int row = 32 * (rt >> 1) + 8 * g + 4 * (rt & 1) + j;
#pragma unroll
                for (int ch = 0; ch < 2; ++ch)
#pragma unroll
                    for (int ct = 0; ct < 4; ++ct) *(LAS bf16_t*)(img + row * GPO_RS + (ch * 64 + ct * 16 + r16) * 2) = (bf16_t)f2bf(v[ch][ct][j] * r);
            }
        }
        u32x4 gt[16];
#pragma unroll
        for (int i = 0; i < 16; ++i) gt[i] = *(const u32x4*)(zblk + (size_t)(i * 4 + g) * ZP + C_GG + h * 128 + r16 * 8);
#pragma unroll
        for (int i = 0; i < 16; ++i) { const int row = i * 4 + g;
            const u32x4 o = *(const LAS u32x4*)(img + row * GPO_RS + r16 * 16); const u32x4 q = gt[i];
            u32x4 w;
            w.x = pk2(bflo(o.x) * gn0[0] * silu_fast(bflo(q.x)), bfhi(o.x) * gn0[1] * silu_fast(bfhi(q.x))); w.y = pk2(bflo(o.y) * gn0[2] * silu_fast(bflo(q.y)), bfhi(o.y) * gn0[3] * silu_fast(bfhi(q.y)));
            w.z = pk2(bflo(o.z) * gn1[0] * silu_fast(bflo(q.z)), bfhi(o.z) * gn1[1] * silu_fast(bfhi(q.z))); w.w = pk2(bflo(o.w) * gn1[2] * silu_fast(bflo(q.w)), bfhi(o.w) * gn1[3] * silu_fast(bfhi(q.w)));
            *(u32x4*)(zblk + (size_t)row * ZP + Y_GDN + h * 128 + r16 * 8) = w; }
    }
}
constexpr int AT_TILE = 4096;
constexpr int AT_BUF = 2 * AT_TILE;
constexpr int AT_TABOFF = 2 * AT_BUF;
constexpr int AT_WAVE_BYTES = 2 * AT_BUF + 2048;
template <int NQ> struct AttnSt { f32x4 O[NQ][4]; f32x4 nm[NQ]; float l[NQ]; bf16x8 Q[NQ][2]; };
__device__ __forceinline__ void stage_issue(const char* zb, const unsigned (&rp)[4], int kcolb, int vcolb, LAS unsigned char* buf) {
    asm volatile("s_waitcnt lgkmcnt(0)" ::: "memory");
#pragma unroll
    for (int c = 0; c < 4; ++c) {
        __builtin_amdgcn_global_load_lds((const unsigned*)(zb + rp[c] + kcolb), (LAS unsigned*)(buf + c * 1024), 16, 0, 0);
        __builtin_amdgcn_global_load_lds((const unsigned*)(zb + rp[c] + vcolb), (LAS unsigned*)(buf + AT_TILE + c * 1024), 16, 0, 0);
    }
}
__device__ __forceinline__ int at_piece_off(int lane) { const int row = lane >> 3; return (((lane & 7) ^ (row & 7)) * 16); }
__device__ __forceinline__ s16x4 lds_tr16(const LAS unsigned char* p) { return __builtin_bit_cast(s16x4, __builtin_amdgcn_ds_read_tr16_b64_v4i16((LAS s16x4*)p)); }

struct AttnAddr { unsigned k0, k1, v[4]; };
__device__ __forceinline__ unsigned lds_u32(const LAS unsigned char* p) { return (unsigned)(unsigned long long)p; }
__device__ __forceinline__ AttnAddr attn_addr(int lane) {
    const int g = lane >> 4, r16 = lane & 15, qq = r16 >> 2, pp = r16 & 3, row = 4 * g + qq; AttnAddr A;
    A.k0 = r16 * 128 + ((g ^ (r16 & 7)) * 16); A.k1 = r16 * 128 + (((4 + g) ^ (r16 & 7)) * 16);
#pragma unroll
    for (int dt = 0; dt < 4; ++dt) A.v[dt] = row * 128 + (((dt * 2 + (pp >> 1)) ^ (row & 7)) * 16) + (pp & 1) * 8;
    return A;
}
struct AttnFrag { bf16x8 kf[2][2]; bf16x8 vf[4]; };
__device__ __forceinline__ void attn_read(AttnFrag& F, const LAS unsigned char* kl, int lane) {
    const AttnAddr AD = attn_addr(lane);
    const unsigned base = lds_u32(kl);
    u32x4 k00, k01, k10, k11; u32x2 vl0, vh0, vl1, vh1, vl2, vh2, vl3, vh3;
    asm volatile(
        "ds_read_b128 %0, %12\n\t" "ds_read_b128 %1, %13\n\t" "ds_read_b128 %2, %12 offset:2048\n\t" "ds_read_b128 %3, %13 offset:2048\n\t"
        "ds_read_b64_tr_b16 %4, %14 offset:4096\n\t" "ds_read_b64_tr_b16 %5, %14 offset:6144\n\t"
        "ds_read_b64_tr_b16 %6, %15 offset:4096\n\t" "ds_read_b64_tr_b16 %7, %15 offset:6144\n\t"
        "ds_read_b64_tr_b16 %8, %16 offset:4096\n\t" "ds_read_b64_tr_b16 %9, %16 offset:6144\n\t"
        "ds_read_b64_tr_b16 %10, %17 offset:4096\n\t" "ds_read_b64_tr_b16 %11, %17 offset:6144\n\t"
        "s_waitcnt lgkmcnt(0)"
        : "=&v"(k00), "=&v"(k01), "=&v"(k10), "=&v"(k11), "=&v"(vl0), "=&v"(vh0), "=&v"(vl1), "=&v"(vh1), "=&v"(vl2), "=&v"(vh2), "=&v"(vl3), "=&v"(vh3)
        : "v"(base + AD.k0), "v"(base + AD.k1), "v"(base + AD.v[0]), "v"(base + AD.v[1]), "v"(base + AD.v[2]), "v"(base + AD.v[3])
        : "memory");
    F.kf[0][0] = __builtin_bit_cast(bf16x8, k00); F.kf[0][1] = __builtin_bit_cast(bf16x8, k01); F.kf[1][0] = __builtin_bit_cast(bf16x8, k10); F.kf[1][1] = __builtin_bit_cast(bf16x8, k11);
    F.vf[0] = cat8(vl0, vh0); F.vf[1] = cat8(vl1, vh1); F.vf[2] = cat8(vl2, vh2); F.vf[3] = cat8(vl3, vh3);
}
template <int NQ, int MASK, class BiasF>
__device__ __forceinline__ void attn_compute_m(AttnSt<NQ>& st, const AttnFrag& F, const BiasF& bias, bool useb, int lane) {
    const int g = lane >> 4, r16 = lane & 15;
    f32x4 s0[NQ], s1[NQ];
#pragma unroll
    for (int qi = 0; qi < NQ; ++qi) if ((MASK >> qi) & 1) {
        const f32x4 nm = st.nm[qi];
        s0[qi] = __builtin_amdgcn_mfma_f32_16x16x32_bf16(F.kf[0][0], st.Q[qi][0], nm, 0, 0, 0);
        s0[qi] = __builtin_amdgcn_mfma_f32_16x16x32_bf16(F.kf[0][1], st.Q[qi][1], s0[qi], 0, 0, 0);
        s1[qi] = __builtin_amdgcn_mfma_f32_16x16x32_bf16(F.kf[1][0], st.Q[qi][0], nm, 0, 0, 0);
        s1[qi] = __builtin_amdgcn_mfma_f32_16x16x32_bf16(F.kf[1][1], st.Q[qi][1], s1[qi], 0, 0, 0); }
    if (BiasF::HAS_BIAS && useb) {
#pragma unroll
        for (int qi = 0; qi < NQ; ++qi) if ((MASK >> qi) & 1) { f32x4 b0, b1; bias.get(qi, r16, g, b0, b1); s0[qi] = s0[qi] + b0; s1[qi] = s1[qi] + b1; } }
    bool grow = false;
#pragma unroll
    for (int qi = 0; qi < NQ; ++qi) if ((MASK >> qi) & 1) {
#pragma unroll
        for (int j = 0; j < 4; ++j) grow = grow || (s0[qi][j] > 8.0f) || (s1[qi][j] > 8.0f); }
    if (__builtin_amdgcn_ballot_w64(grow) != 0ull) {
#pragma unroll
        for (int qi = 0; qi < NQ; ++qi) if ((MASK >> qi) & 1) {
            float m_ = fmaxf(fmaxf(s0[qi][0], s0[qi][1]), s0[qi][2]); m_ = fmaxf(fmaxf(m_, s0[qi][3]), s1[qi][0]); m_ = fmaxf(fmaxf(m_, s1[qi][1]), s1[qi][2]); m_ = fmaxf(m_, s1[qi][3]);
            m_ = fmaxf(m_, __shfl_xor(m_, 16)); m_ = fmaxf(m_, __shfl_xor(m_, 32));
            const float dm = fmaxf(m_, 0.f), alpha = __builtin_amdgcn_exp2f(-dm);
            st.l[qi] *= alpha; st.nm[qi] = st.nm[qi] - dm;
#pragma unroll
            for (int dt = 0; dt < 4; ++dt) st.O[qi][dt] = st.O[qi][dt] * alpha;
            s0[qi] = s0[qi] - dm; s1[qi] = s1[qi] - dm; } }
    bf16x8 pf[NQ];
#pragma unroll
    for (int qi = 0; qi < NQ; ++qi) if ((MASK >> qi) & 1) {
        float p0[4], p1[4], ps = 0.f;
#pragma unroll
        for (int j = 0; j < 4; ++j) { p0[j] = __builtin_amdgcn_exp2f(s0[qi][j]); p1[j] = __builtin_amdgcn_exp2f(s1[qi][j]); ps += p0[j] + p1[j]; }
        st.l[qi] += ps;
        u32x4 pw; pw.x = pk2(p0[0], p0[1]); pw.y = pk2(p0[2], p0[3]); pw.z = pk2(p1[0], p1[1]); pw.w = pk2(p1[2], p1[3]);
        pf[qi] = __builtin_bit_cast(bf16x8, pw); }
#pragma unroll
    for (int qi = 0; qi < NQ; ++qi) if ((MASK >> qi) & 1) {
#pragma unroll
        for (int dt = 0; dt < 4; ++dt) st.O[qi][dt] = __builtin_amdgcn_mfma_f32_16x16x32_bf16(F.vf[dt], pf[qi], st.O[qi][dt], 0, 0, 0); }
}
template <int NQ, class BiasF>
__device__ __forceinline__ void attn_compute(AttnSt<NQ>& st, const AttnFrag& F, const BiasF& bias, int lane) {
    const bool useb = BiasF::HAS_BIAS && !bias.nobias();
    if constexpr (BiasF::HAS_SKIP && NQ == 4) {
        if (!bias.skip(0)) attn_compute_m<NQ, 0x1, BiasF>(st, F, bias, useb, lane);
        attn_compute_m<NQ, 0x2, BiasF>(st, F, bias, useb, lane); attn_compute_m<NQ, 0x4, BiasF>(st, F, bias, useb, lane);
        if (!bias.skip(3)) attn_compute_m<NQ, 0x8, BiasF>(st, F, bias, useb, lane);
    } else {
        if constexpr (NQ == 4) { attn_compute_m<NQ, 0x3, BiasF>(st, F, bias, useb, lane); attn_compute_m<NQ, 0xC, BiasF>(st, F, bias, useb, lane); }
        else attn_compute_m<NQ, (1 << NQ) - 1, BiasF>(st, F, bias, useb, lane);
    }
}
template <int NQ> __device__ __forceinline__ void attn_init(AttnSt<NQ>& st) {
#pragma unroll
    for (int qi = 0; qi < NQ; ++qi) { st.nm[qi] = (f32x4){64.0f, 64.0f, 64.0f, 64.0f};      st.l[qi] = 0.f;
#pragma unroll
        for (int dt = 0; dt < 4; ++dt) st.O[qi][dt] = (f32x4){0.f, 0.f, 0.f, 0.f}; }
}
template <int NQ> __device__ __forceinline__ void attn_store(AttnSt<NQ>& st, int qi, bf16_t* orow, int lane) {
    const int g = lane >> 4;
    float lt = st.l[qi]; lt += __shfl_xor(lt, 16); lt += __shfl_xor(lt, 32);
    const float inv = 1.0f / lt;
#pragma unroll
    for (int dt = 0; dt < 4; ++dt) { const f32x4 o = st.O[qi][dt] * inv; u32x2 w; w.x = pk2(o[0], o[1]); w.y = pk2(o[2], o[3]); *(u32x2*)(orow + dt * 16 + 4 * g) = w; }
}
constexpr float LOG2E = 1.4426950408889634f;
struct BiasZero { static constexpr bool HAS_BIAS = false, HAS_SKIP = false; __device__ __forceinline__ bool skip(int) const { return false; } __device__ __forceinline__ bool nobias() const { return true; }
    __device__ __forceinline__ void get(int, int, int, f32x4& b0, f32x4& b1) const { b0 = (f32x4){0.f, 0.f, 0.f, 0.f}; b1 = b0; } };
struct BiasWin { static constexpr bool HAS_BIAS = true, HAS_SKIP = false; int d0; int kstart; bool interior;
    __device__ __forceinline__ bool skip(int) const { return false; } __device__ __forceinline__ bool nobias() const { return interior; }
    __device__ __forceinline__ float one(int q, int kk) const { const int kp = kstart + kk, dd = d0 + kk - q; return (kp >= 0 && kp < SEQ && dd <= 128 && dd >= -128) ? 0.f : -1e30f; }
    __device__ __forceinline__ void get(int, int q, int g, f32x4& b0, f32x4& b1) const {
#pragma unroll
        for (int j = 0; j < 4; ++j) { b0[j] = one(q, 4 * g + j); b1[j] = one(q, 16 + 4 * g + j); } } };
struct BiasNA { static constexpr bool HAS_BIAS = true, HAS_SKIP = true; unsigned tabaddr; int rowoff31; int c0;
    __device__ __forceinline__ bool skip(int qi) const { return (qi == 0 && c0 != 0) || (qi == 3 && c0 == 0); } __device__ __forceinline__ bool nobias() const { return false; }
    __device__ __forceinline__ void get(int qi, int q, int g, f32x4& b0, f32x4& b1) const {
        const int qc = qi * 16 + q; int cst = qc - 8; cst = cst < 0 ? 0 : (cst > 48 ? 48 : cst);
        const int kc0 = c0 + 4 * g;
        const unsigned ad = tabaddr + (unsigned)((rowoff31 + kc0 - qc + 15) * 4);
        u32x2 t0, t1, t2, t3;
        asm volatile("ds_read2_b32 %0, %4 offset1:1\n\t" "ds_read2_b32 %1, %4 offset0:2 offset1:3\n\t" "ds_read2_b32 %2, %4 offset0:16 offset1:17\n\t" "ds_read2_b32 %3, %4 offset0:18 offset1:19\n\t" "s_waitcnt lgkmcnt(0)"
                     : "=&v"(t0), "=&v"(t1), "=&v"(t2), "=&v"(t3) : "v"(ad) : "memory");
        const float v0[4] = {__builtin_bit_cast(float, t0.x), __builtin_bit_cast(float, t0.y), __builtin_bit_cast(float, t1.x), __builtin_bit_cast(float, t1.y)};
        const float v1[4] = {__builtin_bit_cast(float, t2.x), __builtin_bit_cast(float, t2.y), __builtin_bit_cast(float, t3.x), __builtin_bit_cast(float, t3.y)};
#pragma unroll
        for (int j = 0; j < 4; ++j) { const int ka = kc0 + j, kb = kc0 + 16 + j;
            b0[j] = (ka >= cst && ka < cst + 16) ? v0[j] : -1e30f; b1[j] = (kb >= cst && kb < cst + 16) ? v1[j] : -1e30f; } } };

template <int NQ>
__device__ __forceinline__ void attn_ctx_steps(AttnSt<NQ>& st, const bf16_t* Z, int row0, int kcol, int vcol, int nsteps, LAS unsigned char* kl, int lane) {
    const char* zb = (const char*)Z;
    unsigned rp[4];
#pragma unroll
    for (int c = 0; c < 4; ++c) rp[c] = (unsigned)(row0 + (lane >> 3) + c * 8) * (unsigned)(ZP * 2) + (unsigned)at_piece_off(lane);
    stage_issue(zb, rp, kcol * 2, vcol * 2, kl);
    for (int s = 0; s < nsteps; ++s) {
        if (s + 1 < nsteps) {
#pragma unroll
            for (int c = 0; c < 4; ++c) rp[c] += 32u * (unsigned)(ZP * 2);
            stage_issue(zb, rp, kcol * 2, vcol * 2, kl + ((s + 1) & 1) * AT_BUF);
            asm volatile("s_waitcnt vmcnt(8)" ::: "memory");
        } else asm volatile("s_waitcnt vmcnt(0)" ::: "memory");
        AttnFrag F; attn_read(F, kl + (s & 1) * AT_BUF, lane);
        attn_compute<NQ>(st, F, BiasZero(), lane);
    }
}

__device__ __forceinline__ void win_item(const KArgs& a, int l, int item, bool ctxq, LAS unsigned char* kl, int lane) {
    asm volatile("" : "+v"(lane));
    bf16_t* Z = (bf16_t*)(a.ws + WS_Z);
    int b, gi, qt;
    if (!ctxq) { b = item >> 9; gi = (item >> 8) & 1; qt = item & 255; } else { b = item >> 5; gi = (item >> 4) & 1; qt = item & 15; }
    const int t0 = qt * 16, r16 = lane & 15;
    const int qrow0 = (ctxq ? ML + b * CTXL : b * SEQ) + t0, qrow = qrow0 + r16;
    const char* zb = (const char*)Z; const int g = lane >> 4;
    AttnSt<4> st; attn_init<4>(st);
#pragma unroll
    for (int qi = 0; qi < 4; ++qi) { const bf16_t* qp = Z + (size_t)qrow * ZP + C_WQ + (gi * 4 + qi) * 64 + g * 8;
        st.Q[qi][0] = *(const bf16x8*)qp; st.Q[qi][1] = *(const bf16x8*)(qp + 32); { const float sk = -a.in[I_WSINK][l * 8 + gi * 4 + qi] * LOG2E; st.nm[qi] = (f32x4){sk, sk, sk, sk}; } st.l[qi] = (g == 0) ? 1.0f : 0.f; }
    const int kcol = C_WK + gi * 64, vcol = C_WV + gi * 64;
    int s0 = 0, s1 = 0;
    if (!ctxq) { s1 = 9; const int ks = t0 - 128; while (s0 < s1 && ks + 32 * s0 + 31 < 0) ++s0; while (s1 > s0 && ks + 32 * (s1 - 1) >= SEQ) --s1; }
    const int nl = s1 - s0, n = nl + 8;
    unsigned rp[4];
#define AT_ISSUE(i_) do { const int ii_ = (i_); \
        if (ii_ < nl) { _Pragma("unroll") for (int c = 0; c < 4; ++c) { int kp = t0 - 128 + 32 * (s0 + ii_) + c * 8 + (lane >> 3); kp = kp < 0 ? 0 : (kp > SEQ - 1 ? SEQ - 1 : kp); \
                rp[c] = (unsigned)(b * SEQ + kp) * (unsigned)(ZP * 2) + (unsigned)at_piece_off(lane); } } \
        else if (ii_ == nl) { _Pragma("unroll") for (int c = 0; c < 4; ++c) rp[c] = (unsigned)(ML + b * CTXL + c * 8 + (lane >> 3)) * (unsigned)(ZP * 2) + (unsigned)at_piece_off(lane); } \
        else { _Pragma("unroll") for (int c = 0; c < 4; ++c) rp[c] += 32u * (unsigned)(ZP * 2); }            \
        stage_issue(zb, rp, kcol * 2, vcol * 2, kl + (ii_ & 1) * AT_BUF); } while (0)
    AT_ISSUE(0); AT_ISSUE(1);
    for (int i = 0; i < nl; ++i) {
        asm volatile("s_waitcnt vmcnt(8)" ::: "memory");
        AttnFrag F; attn_read(F, kl + (i & 1) * AT_BUF, lane);
        AT_ISSUE(i + 2);
        const int kstart = t0 - 128 + 32 * (s0 + i);
        BiasWin bw; bw.kstart = kstart; bw.d0 = kstart - t0; bw.interior = (kstart >= 0 && kstart + 31 < SEQ && kstart >= t0 + 15 - 128 && kstart + 31 <= t0 + 128);
        attn_compute<4>(st, F, bw, lane);
    }
    for (int i = nl; i < n; ++i) {
        if (i + 1 < n) asm volatile("s_waitcnt vmcnt(8)" ::: "memory"); else asm volatile("s_waitcnt vmcnt(0)" ::: "memory");
        AttnFrag F; attn_read(F, kl + (i & 1) * AT_BUF, lane);
        if (i + 2 < n) AT_ISSUE(i + 2);
        attn_compute<4>(st, F, BiasZero(), lane);
    }
#undef AT_ISSUE
#pragma unroll
    for (int qi = 0; qi < 4; ++qi) attn_store<4>(st, qi, Z + (size_t)qrow * ZP + Y_WIN + (gi * 4 + qi) * 64, lane);
}

__device__ __forceinline__ void na_item(const KArgs& a, int l, int item, bool ctxq, LAS unsigned char* kl, int lane) {
    asm volatile("" : "+v"(lane));
    bf16_t* Z = (bf16_t*)(a.ws + WS_Z);
    int b, h, r;
    if (!ctxq) { b = item >> 9; h = (item >> 6) & 7; r = item & 63; } else { b = item >> 5; h = (item >> 2) & 7; r = item & 3; }
    const int r16 = lane & 15;
    const int qbase = (ctxq ? ML + b * CTXL : b * SEQ) + r * 64, qrow0 = qbase + r16;
    const char* zb = (const char*)Z; const int g = lane >> 4;
    AttnSt<4> st; attn_init<4>(st);
#pragma unroll
    for (int qi = 0; qi < 4; ++qi) { const bf16_t* qp = Z + (size_t)(qrow0 + qi * 16) * ZP + C_NQ + h * 64 + g * 8; st.Q[qi][0] = *(const bf16x8*)qp; st.Q[qi][1] = *(const bf16x8*)(qp + 32); }
    const int kcol = C_NK + h * 64, vcol = C_NV + h * 64;
    LAS float* tab = (LAS float*)(kl + AT_TABOFF);
    int rs = r - 4; rs = rs < 0 ? 0 : (rs > 56 ? 56 : rs);
    if (!ctxq) { const float* rpbp = a.in[I_RPB] + (size_t)(l * 8 + h) * 465; for (int i = lane; i < 465; i += 64) tab[i] = rpbp[i] * LOG2E; }
    const int nl = ctxq ? 0 : 16, n = nl + 8;
    unsigned rp[4];
#define AT_ISSUE(i_) do { const int ii_ = (i_); \
        if (ii_ == 0 || ii_ == nl) { _Pragma("unroll") for (int c = 0; c < 4; ++c) { const int row_ = (ii_ < nl) ? b * SEQ + rs * 64 + c * 8 + (lane >> 3) : ML + b * CTXL + c * 8 + (lane >> 3); \
                rp[c] = (unsigned)row_ * (unsigned)(ZP * 2) + (unsigned)at_piece_off(lane); } } \
        else { _Pragma("unroll") for (int c = 0; c < 4; ++c) rp[c] += 32u * (unsigned)(ZP * 2); }            \
        stage_issue(zb, rp, kcol * 2, vcol * 2, kl + (ii_ & 1) * AT_BUF); } while (0)
    AT_ISSUE(0); AT_ISSUE(1);
    for (int i = 0; i < nl; ++i) {
        asm volatile("s_waitcnt vmcnt(8)" ::: "memory");
        AttnFrag F; attn_read(F, kl + (i & 1) * AT_BUF, lane);
        AT_ISSUE(i + 2);
        BiasNA bn; bn.tabaddr = lds_u32((const LAS unsigned char*)tab); bn.rowoff31 = (rs + (i >> 1) - r + 7) * 31; bn.c0 = (i & 1) * 32;
        attn_compute<4>(st, F, bn, lane);
    }
    for (int i = nl; i < n; ++i) {
        if (i + 1 < n) asm volatile("s_waitcnt vmcnt(8)" ::: "memory"); else asm volatile("s_waitcnt vmcnt(0)" ::: "memory");
        AttnFrag F; attn_read(F, kl + (i & 1) * AT_BUF, lane);
        if (i + 2 < n) AT_ISSUE(i + 2);
        attn_compute<4>(st, F, BiasZero(), lane);
    }
#undef AT_ISSUE
#pragma unroll
    for (int qi = 0; qi < 4; ++qi) attn_store<4>(st, qi, Z + (size_t)(qrow0 + qi * 16) * ZP + Y_NA + h * 64, lane);
}
constexpr int RT_VS = 288, RT_KS = 160, RT_SS = 144;
__device__ __forceinline__ size_t kvt_off(int bh, int dir, int ch) { return (((size_t)bh * 2 + dir) * 34 + ch) * 8192; }
__device__ __forceinline__ float log_sigmoidf_(float x) { return -(fmaxf(-x, 0.f) + log1pf(__expf(-fabsf(x)))); }
__device__ __forceinline__ int ret_row0(int b, int ch) { return ch < 2 ? ML + b * CTXL + ch * 128 : b * SEQ + (ch - 2) * 128; }

struct RkPre { u32x4 v[4], k[2]; };
__device__ __forceinline__ void ret_kv_load(const KArgs& a, int unit, RkPre& R) {
    const int tid = OTID(); const int bh = unit / 34, ch = unit % 34, b = bh >> 2, h = bh & 3; const bf16_t* Z = (const bf16_t*)(a.ws + WS_Z); const int row0 = ret_row0(b, ch);
#pragma unroll
    for (int i = 0; i < 4; ++i) { const int p = tid + i * 512, r = p >> 4, c = p & 15; R.v[i] = *(const u32x4*)(Z + (size_t)(row0 + r) * ZP + C_RV + h * 128 + c * 8); }
#pragma unroll
    for (int i = 0; i < 2; ++i) { const int p = tid + i * 512, r = p >> 3, c = p & 7; R.k[i] = *(const u32x4*)(Z + (size_t)(row0 + r) * ZP + C_RK + h * 64 + c * 8); }
}
__device__ __forceinline__ void ret_kv_unit(const KArgs& a, LAS unsigned char* lds, int l, int unit, const RkPre& PRE) {
    const int tid = OTID(), lane = tid & 63, wave = tid >> 6, g = lane >> 4, r16 = lane & 15;
    const int bh = unit / 34, ch = unit % 34, b = bh >> 2, h = bh & 3;
    const bf16_t* Z = (const bf16_t*)(a.ws + WS_Z);
    const int row0 = ret_row0(b, ch);
    const float lgf = log_sigmoidf_(a.in[I_RDECAY][l * 8 + h]), lgb = log_sigmoidf_(a.in[I_RDECAY][l * 8 + 4 + h]);
    LAS unsigned char* Vl = lds; LAS unsigned char* Kf = lds + 128 * RT_VS; LAS unsigned char* Kb = Kf + 128 * RT_KS;
#pragma unroll
    for (int i = 0; i < 4; ++i) { const int p = tid + i * 512, r = p >> 4, c = p & 15; *(LAS u32x4*)(Vl + r * RT_VS + c * 16) = PRE.v[i]; }
#pragma unroll
    for (int i = 0; i < 2; ++i) { const int p = tid + i * 512, r = p >> 3, c = p & 7;
        const u32x4 kv = PRE.k[i];
        const float df = __expf(lgf * (float)(127 - r)), db = __expf(lgb * (float)r);
        u32x4 of, ob;
        of.x = pk2(bflo(kv.x) * df, bfhi(kv.x) * df); of.y = pk2(bflo(kv.y) * df, bfhi(kv.y) * df); of.z = pk2(bflo(kv.z) * df, bfhi(kv.z) * df); of.w = pk2(bflo(kv.w) * df, bfhi(kv.w) * df);
        ob.x = pk2(bflo(kv.x) * db, bfhi(kv.x) * db); ob.y = pk2(bflo(kv.y) * db, bfhi(kv.y) * db); ob.z = pk2(bflo(kv.z) * db, bfhi(kv.z) * db); ob.w = pk2(bflo(kv.w) * db, bfhi(kv.w) * db);
        *(LAS u32x4*)(Kf + r * RT_KS + c * 16) = of; *(LAS u32x4*)(Kb + r * RT_KS + c * 16) = ob; }
    __syncthreads();
    f32x4 acc[2][4];
#pragma unroll
    for (int d = 0; d < 2; ++d)
#pragma unroll
        for (int t = 0; t < 4; ++t) acc[d][t] = (f32x4){0.f, 0.f, 0.f, 0.f};
    const int qq = r16 >> 2, pp = r16 & 3;
#pragma unroll
    for (int ks = 0; ks < 4; ++ks) {
        const int tr0 = ks * 32 + 4 * g + qq;
        const s16x4 alo = lds_tr16(Vl + tr0 * RT_VS + (wave * 16 + 4 * pp) * 2), ahi = lds_tr16(Vl + (tr0 + 16) * RT_VS + (wave * 16 + 4 * pp) * 2);
        const bf16x8 A = (bf16x8){alo[0], alo[1], alo[2], alo[3], ahi[0], ahi[1], ahi[2], ahi[3]};
#pragma unroll
        for (int t = 0; t < 4; ++t) {
            const s16x4 flo = lds_tr16(Kf + tr0 * RT_KS + (t * 16 + 4 * pp) * 2), fhi = lds_tr16(Kf + (tr0 + 16) * RT_KS + (t * 16 + 4 * pp) * 2);
            const s16x4 blo = lds_tr16(Kb + tr0 * RT_KS + (t * 16 + 4 * pp) * 2), bhi = lds_tr16(Kb + (tr0 + 16) * RT_KS + (t * 16 + 4 * pp) * 2);
            acc[0][t] = __builtin_amdgcn_mfma_f32_16x16x32_bf16(A, (bf16x8){flo[0], flo[1], flo[2], flo[3], fhi[0], fhi[1], fhi[2], fhi[3]}, acc[0][t], 0, 0, 0);
            acc[1][t] = __builtin_amdgcn_mfma_f32_16x16x32_bf16(A, (bf16x8){blo[0], blo[1], blo[2], blo[3], bhi[0], bhi[1], bhi[2], bhi[3]}, acc[1][t], 0, 0, 0);
        }
    }
    bf16_t* kvt = (bf16_t*)(a.ws + WS_KVT);
    LAS unsigned char* tw = lds + 81920 + wave * 4608;
#pragma unroll
    for (int d = 0; d < 2; ++d)
#pragma unroll
        for (int t = 0; t < 4; ++t)
#pragma unroll
            for (int j = 0; j < 4; ++j) *(LAS bf16_t*)(tw + d * 2304 + (4 * g + j) * 144 + (t * 16 + r16) * 2) = (bf16_t)f2bf(acc[d][t][j]);
#pragma unroll
    for (int d = 0; d < 2; ++d) { bf16_t* o = kvt + kvt_off(bh, d, ch) + (size_t)(wave * 16) * 64;
#pragma unroll
        for (int i = 0; i < 2; ++i) { const int idx = lane + 64 * i, r = idx >> 3, c8 = idx & 7; *(u32x4*)(o + r * 64 + c8 * 8) = *(const LAS u32x4*)(tw + d * 2304 + r * 144 + c8 * 16); } }
    __syncthreads();
}

__device__ __forceinline__ void ret_prefix(const KArgs& a, int l, int blk0) {
    const int tid = OTID(), blk = OBLK(), G = OGRID();
    if (G <= blk0) blk0 = 0;
    if (blk < blk0) return;
    bf16_t* kvt = (bf16_t*)(a.ws + WS_KVT);
    for (int gt = (blk - blk0) * NTHR + tid; gt < 64 * 1024; gt += (G - blk0) * NTHR) {
        const int pair = gt >> 10, e8 = gt & 1023, d = pair & 1, h = (pair >> 1) & 3;
        const float gC = __expf(log_sigmoidf_(a.in[I_RDECAY][l * 8 + d * 4 + h]) * 128.0f);
        bf16_t* base = kvt + (size_t)pair * 34 * 8192 + e8 * 8;
        float s[8];
#pragma unroll
        for (int e = 0; e < 8; ++e) s[e] = 0.f;
#pragma unroll
        for (int half = 0; half < 2; ++half) {
            u32x4 x[17];
#pragma unroll
            for (int k = 0; k < 17; ++k) { const int oo = half * 17 + k; const int ci = (d == 0) ? oo : (oo < 2 ? 1 - oo : 35 - oo); x[k] = *(const u32x4*)(base + (size_t)ci * 8192); }
#pragma unroll
            for (int k = 0; k < 17; ++k) { const int oo = half * 17 + k; const int ci = (d == 0) ? oo : (oo < 2 ? 1 - oo : 35 - oo);
                u32x4 w; w.x = pk2(s[0], s[1]); w.y = pk2(s[2], s[3]); w.z = pk2(s[4], s[5]); w.w = pk2(s[6], s[7]);
                *(u32x4*)(base + (size_t)ci * 8192) = w;
                s[0] = s[0] * gC + bflo(x[k].x); s[1] = s[1] * gC + bfhi(x[k].x); s[2] = s[2] * gC + bflo(x[k].y); s[3] = s[3] * gC + bfhi(x[k].y);
                s[4] = s[4] * gC + bflo(x[k].z); s[5] = s[5] * gC + bfhi(x[k].z); s[6] = s[6] * gC + bflo(x[k].w); s[7] = s[7] * gC + bfhi(x[k].w); }
        }
    }
}

__device__ __forceinline__ void ret_out_unit(const KArgs& a, LAS unsigned char* lds, int l, int unit) {
    const int tid = OTID(), lane = tid & 63, wave = tid >> 6, g = lane >> 4, r16 = lane & 15;
    const int bh = unit / 34, ch = unit % 34, b = bh >> 2, h = bh & 3;
    bf16_t* Z = (bf16_t*)(a.ws + WS_Z);
    const bf16_t* kvt = (const bf16_t*)(a.ws + WS_KVT);
    const int row0 = ret_row0(b, ch);
    const float lgf = log_sigmoidf_(a.in[I_RDECAY][l * 8 + h]), lgb = log_sigmoidf_(a.in[I_RDECAY][l * 8 + 4 + h]);
    LAS unsigned char* Vl = lds; LAS unsigned char* Sf = lds + 128 * RT_VS; LAS unsigned char* Sb = Sf + 128 * RT_SS;
    u32x4 vst[4];
#pragma unroll
    for (int i = 0; i < 4; ++i) { const int p = tid + i * 512, r = p >> 4, c = p & 15; vst[i] = *(const u32x4*)(Z + (size_t)(row0 + r) * ZP + C_RV + h * 128 + c * 8); }
    u32x4 sst[4];
    { const int dv = tid >> 2, dk0 = (tid & 3) * 16;
      const u32x4* sf = (const u32x4*)(kvt + kvt_off(bh, 0, ch) + dv * 64 + dk0); const u32x4* sb = (const u32x4*)(kvt + kvt_off(bh, 1, ch) + dv * 64 + dk0);
      sst[0] = sf[0]; sst[1] = sf[1]; sst[2] = sb[0]; sst[3] = sb[1]; }
    const int qi = wave * 16 + r16;
    const bf16_t* qp = Z + (size_t)(row0 + qi) * ZP + C_RQ + h * 64 + g * 8;
    const bf16x8 Q0 = *(const bf16x8*)qp, Q1 = *(const bf16x8*)(qp + 32);
    bf16x8 Kf[8][2];
#pragma unroll
    for (int kt = 0; kt < 8; ++kt) { const bf16_t* kp = Z + (size_t)(row0 + kt * 16 + r16) * ZP + C_RK + h * 64 + g * 8; Kf[kt][0] = *(const bf16x8*)kp; Kf[kt][1] = *(const bf16x8*)(kp + 32); }
    const float* gn = a.in[I_RGN] + l * 512 + h * 128;
    bf16_t* yrow = Z + (size_t)(row0 + qi) * ZP + Y_RET + h * 128;
#pragma unroll
    for (int i = 0; i < 4; ++i) { const int p = tid + i * 512, r = p >> 4, c = p & 15; *(LAS u32x4*)(Vl + r * RT_VS + c * 16) = vst[i]; }
    { const int dv = tid >> 2, dk0 = (tid & 3) * 16;
      *(LAS u32x4*)(Sf + dv * RT_SS + dk0 * 2) = sst[0]; *(LAS u32x4*)(Sf + dv * RT_SS + dk0 * 2 + 16) = sst[1];
      *(LAS u32x4*)(Sb + dv * RT_SS + dk0 * 2) = sst[2]; *(LAS u32x4*)(Sb + dv * RT_SS + dk0 * 2 + 16) = sst[3]; }
    __syncthreads();
    float dcf[4], dcb[4], dcd[4];
#pragma unroll
    for (int j = 0; j < 4; ++j) { const int dl = r16 - 4 * g - j; dcf[j] = __expf(lgf * (float)dl); dcb[j] = __expf(-lgb * (float)dl); dcd[j] = (dl >= 0 ? dcf[j] : 0.f) + (dl <= 0 ? dcb[j] : 0.f); }
    f32x4 O[8];
#pragma unroll
    for (int dt = 0; dt < 8; ++dt) O[dt] = (f32x4){0.f, 0.f, 0.f, 0.f};
    const int qq = r16 >> 2, pp = r16 & 3;
#pragma unroll
    for (int ks = 0; ks < 4; ++ks) {
        u32x4 pw;
#pragma unroll
        for (int half = 0; half < 2; ++half) {
            const int kt = 2 * ks + half;
            f32x4 s = (f32x4){0.f, 0.f, 0.f, 0.f};
            s = __builtin_amdgcn_mfma_f32_16x16x32_bf16(Kf[kt][0], Q0, s, 0, 0, 0);
            s = __builtin_amdgcn_mfma_f32_16x16x32_bf16(Kf[kt][1], Q1, s, 0, 0, 0);
            float p[4];
            {
                const int dk = __builtin_amdgcn_readfirstlane(wave) - kt;
                if (dk > 0) { const float E = __expf(lgf * (float)(16 * dk));
#pragma unroll
                    for (int j = 0; j < 4; ++j) p[j] = s[j] * (E * dcf[j]); }
                else if (dk < 0) { const float E = __expf(lgb * (float)(-16 * dk));
#pragma unroll
                    for (int j = 0; j < 4; ++j) p[j] = s[j] * (E * dcb[j]); }
                else {
#pragma unroll
                    for (int j = 0; j < 4; ++j) p[j] = s[j] * dcd[j]; } }
            if (half == 0) { pw.x = pk2(p[0], p[1]); pw.y = pk2(p[2], p[3]); } else { pw.z = pk2(p[0], p[1]); pw.w = pk2(p[2], p[3]); }
        }
        const bf16x8 pf = __builtin_bit_cast(bf16x8, pw);
        const int tr0 = ks * 32 + 4 * g + qq;
#pragma unroll
        for (int dt = 0; dt < 8; ++dt) {
            const s16x4 lo = lds_tr16(Vl + tr0 * RT_VS + (dt * 16 + 4 * pp) * 2), hi = lds_tr16(Vl + (tr0 + 16) * RT_VS + (dt * 16 + 4 * pp) * 2);
            O[dt] = __builtin_amdgcn_mfma_f32_16x16x32_bf16((bf16x8){lo[0], lo[1], lo[2], lo[3], hi[0], hi[1], hi[2], hi[3]}, pf, O[dt], 0, 0, 0);
        }
    }
    { const float dqf = __expf(lgf * (float)(qi + 1)), dqb = __expf(lgb * (float)(128 - qi));
#pragma unroll
      for (int dt = 0; dt < 8; ++dt) {
          f32x4 tf = (f32x4){0.f, 0.f, 0.f, 0.f}, tb = (f32x4){0.f, 0.f, 0.f, 0.f};
          const LAS unsigned char* sf = Sf + (dt * 16 + r16) * RT_SS + g * 16; const LAS unsigned char* sb = Sb + (dt * 16 + r16) * RT_SS + g * 16;
          tf = __builtin_amdgcn_mfma_f32_16x16x32_bf16(*(const LAS bf16x8*)sf, Q0, tf, 0, 0, 0); tf = __builtin_amdgcn_mfma_f32_16x16x32_bf16(*(const LAS bf16x8*)(sf + 64), Q1, tf, 0, 0, 0);
          tb = __builtin_amdgcn_mfma_f32_16x16x32_bf16(*(const LAS bf16x8*)sb, Q0, tb, 0, 0, 0); tb = __builtin_amdgcn_mfma_f32_16x16x32_bf16(*(const LAS bf16x8*)(sb + 64), Q1, tb, 0, 0, 0);
          O[dt] = O[dt] + tf * dqf + tb * dqb;
      } }
    float sm = 0.f;
#pragma unroll
    for (int dt = 0; dt < 8; ++dt) sm += (O[dt][0] + O[dt][1]) + (O[dt][2] + O[dt][3]);
    sm += __shfl_xor(sm, 16); sm += __shfl_xor(sm, 32);
    const float mean = sm * (1.f / 128.f);
    float sq = 0.f;
#pragma unroll
    for (int dt = 0; dt < 8; ++dt) { const f32x4 dd = O[dt] - mean; sq += (dd[0] * dd[0] + dd[1] * dd[1]) + (dd[2] * dd[2] + dd[3] * dd[3]); }
    sq += __shfl_xor(sq, 16); sq += __shfl_xor(sq, 32);
    const float rstd = rsqrtf(sq * (1.f / 128.f) + EPS);
    u32x2 gtv[8]; f32x4 gvv[8];
#pragma unroll
    for (int dt = 0; dt < 8; ++dt) { gtv[dt] = *(const u32x2*)(yrow + dt * 16 + 4 * g); gvv[dt] = *(const f32x4*)(gn + dt * 16 + 4 * g); }
#pragma unroll
    for (int dt = 0; dt < 8; ++dt) { const int c = dt * 16 + 4 * g;
        const u32x2 gt = gtv[dt]; const f32x4 gv = gvv[dt];
        u32x2 w; w.x = pk2((O[dt][0] - mean) * rstd * gv[0] * silu_fast(bflo(gt.x)), (O[dt][1] - mean) * rstd * gv[1] * silu_fast(bfhi(gt.x)));
        w.y = pk2((O[dt][2] - mean) * rstd * gv[2] * silu_fast(bflo(gt.y)), (O[dt][3] - mean) * rstd * gv[3] * silu_fast(bfhi(gt.y)));
        *(u32x2*)(yrow + c) = w; }
    __syncthreads();
}
constexpr int C_UF = C_GQ, C_UB = C_GK, C_WF = C_GV, C_AQ = 5888;
__device__ __forceinline__ int gdn_row0(int b, int c) { return c < 4 ? ML + b * CTXL + c * 64 : b * SEQ + (c - 4) * 64; }

constexpr int GP_SQ = 90112, GP_RS = 288, GP_SK = GP_SQ + 64 * GP_RS, GP_SV = GP_SK + 64 * GP_RS, GP_WS = 144;
struct GpPre { u32x4 st[3][2]; float gc, be; };
__device__ __forceinline__ void gdn_prep_load(const KArgs& a, int unit, GpPre& R) {
    const int tid = OTID(); const int bh = unit / 68, c = unit % 68, b = bh >> 2, h = bh & 3; const int row0 = gdn_row0(b, c);
    const bf16_t* P = (const bf16_t*)(a.ws + WS_P); const float* GBa = (const float*)(a.ws + WS_GB); const float* GBb = GBa + (size_t)MA * 8;
#pragma unroll
    for (int m = 0; m < 3; ++m)
#pragma unroll
        for (int i = 0; i < 2; ++i) { const int p = tid + i * 512, r = p >> 4, c16 = p & 15; R.st[m][i] = *(const u32x4*)(P + (size_t)(row0 + r) * PP + m * 512 + h * 128 + c16 * 8); }
    R.gc = 0.f; R.be = 0.f;
    if (tid < 128) { const int d = tid >> 6, i = tid & 63; const size_t o = (size_t)(row0 + i) * 8 + d * 4 + h; R.gc = GBa[o]; R.be = GBb[o]; }
}
__device__ __forceinline__ void gdn_prep_unit(const KArgs& a, LAS unsigned char* lds, int unit, const GpPre& PRE) {
    const int tid = OTID(), lane = tid & 63, wave = tid >> 6, g = lane >> 4, r16 = lane & 15;
    const int bh = unit / 68, c = unit % 68, b = bh >> 2, h = bh & 3;
    const int row0 = gdn_row0(b, c);
    bf16_t* Z = (bf16_t*)(a.ws + WS_Z); bf16_t* P = (bf16_t*)(a.ws + WS_P);
    float* GBa = (float*)(a.ws + WS_GB); const float* GBb = GBa + (size_t)MA * 8;
    LAS float* KK = (LAS float*)lds; LAS float* QK = KK + 4096; LAS float* AF = QK + 4096; LAS float* AB = AF + 4096;
    LAS float* gcs = AB + 4096;
    LAS float* bes = gcs + 128;
    { if (tid < 128) { gcs[tid] = PRE.gc; bes[tid] = PRE.be; }
#pragma unroll
      for (int m = 0; m < 3; ++m)
#pragma unroll
          for (int i = 0; i < 2; ++i) { const int p = tid + i * 512, r = p >> 4, c16 = p & 15; *(LAS u32x4*)(lds + GP_SQ + m * 64 * GP_RS + r * GP_RS + c16 * 16) = PRE.st[m][i]; } }
    __syncthreads();
    if (wave < 2) { float v = gcs[tid];
#pragma unroll
        for (int off = 1; off < 64; off <<= 1) { const float t = (wave == 0) ? __shfl_up(v, off) : __shfl_down(v, off); if ((wave == 0) ? (lane >= off) : (lane + off < 64)) v += t; }
        gcs[tid] = v; }
    { const int rt = wave & 3; const LAS unsigned char* ap = lds + (wave < 4 ? GP_SK : GP_SQ) + (rt * 16 + r16) * GP_RS + g * 16;
      bf16x8 A[4];
#pragma unroll
      for (int ks = 0; ks < 4; ++ks) A[ks] = *(const LAS bf16x8*)(ap + ks * 64);
      LAS float* M = (wave < 4) ? KK : QK;
#pragma unroll
      for (int ct = 0; ct < 4; ++ct) { const LAS unsigned char* bp = lds + GP_SK + (ct * 16 + r16) * GP_RS + g * 16;
          f32x4 acc = (f32x4){0.f, 0.f, 0.f, 0.f};
#pragma unroll
          for (int ks = 0; ks < 4; ++ks) acc = __builtin_amdgcn_mfma_f32_16x16x32_bf16(A[ks], *(const LAS bf16x8*)(bp + ks * 64), acc, 0, 0, 0);
#pragma unroll
          for (int j = 0; j < 4; ++j) M[(rt * 16 + 4 * g + j) * 64 + ct * 16 + r16] = acc[j]; } }
    __syncthreads();
    if (tid < 128) { const int d = tid >> 6, i = tid & 63; ((float*)(a.ws + WS_GC2))[(size_t)(d * 4 + h) * MA + row0 + i] = gcs[tid]; }
    { const int i = tid >> 3, j0 = (tid & 7) * 8;
      const f32x4 kk0 = *(const LAS f32x4*)(KK + i * 64 + j0), kk1 = *(const LAS f32x4*)(KK + i * 64 + j0 + 4), qk0 = *(const LAS f32x4*)(QK + i * 64 + j0), qk1 = *(const LAS f32x4*)(QK + i * 64 + j0 + 4);
      const f32x4 gf0 = *(const LAS f32x4*)(gcs + j0), gf1 = *(const LAS f32x4*)(gcs + j0 + 4), gb0 = *(const LAS f32x4*)(gcs + 64 + j0), gb1 = *(const LAS f32x4*)(gcs + 64 + j0 + 4);
      const float gfi = gcs[i], gbi = gcs[64 + i], bfi = bes[i], bbi = bes[64 + i];
      float af[8], ab[8], aq[8];
#pragma unroll
      for (int e = 0; e < 8; ++e) { const int j = j0 + e; const float kk = e < 4 ? kk0[e & 3] : kk1[e & 3], qk = e < 4 ? qk0[e & 3] : qk1[e & 3], gfj = e < 4 ? gf0[e & 3] : gf1[e & 3], gbj = e < 4 ? gb0[e & 3] : gb1[e & 3];
          const float ef = __expf(fminf(gfi - gfj, 0.f)), eb = __expf(fminf(gbi - gbj, 0.f));
          af[e] = (j < i) ? bfi * kk * ef : 0.f; ab[e] = (j > i) ? bbi * kk * eb : 0.f;
          aq[e] = qk * (j < i ? ef : (j > i ? eb : 1.0f)); }
      *(LAS f32x4*)(AF + i * 64 + j0) = (f32x4){af[0], af[1], af[2], af[3]}; *(LAS f32x4*)(AF + i * 64 + j0 + 4) = (f32x4){af[4], af[5], af[6], af[7]};
      *(LAS f32x4*)(AB + (63 - i) * 64 + 56 - j0) = (f32x4){ab[7], ab[6], ab[5], ab[4]}; *(LAS f32x4*)(AB + (63 - i) * 64 + 60 - j0) = (f32x4){ab[3], ab[2], ab[1], ab[0]};
      u32x4 w; w.x = pk2(-af[0], -af[1]); w.y = pk2(-af[2], -af[3]); w.z = pk2(-af[4], -af[5]); w.w = pk2(-af[6], -af[7]);
      *(LAS u32x4*)(lds + 66560 + (i * 64 + j0) * 2) = w;
      w.x = pk2(-ab[7], -ab[6]); w.y = pk2(-ab[5], -ab[4]); w.z = pk2(-ab[3], -ab[2]); w.w = pk2(-ab[1], -ab[0]);
      *(LAS u32x4*)(lds + 66560 + (4096 + (63 - i) * 64 + 56 - j0) * 2) = w;
      w.x = pk2(aq[0], aq[1]); w.y = pk2(aq[2], aq[3]); w.z = pk2(aq[4], aq[5]); w.w = pk2(aq[6], aq[7]);
      *(u32x4*)(Z + (size_t)(row0 + i) * ZP + C_AQ + h * 64 + j0) = w; }
    LAS bf16_t* NAm = (LAS bf16_t*)(lds + 66560);
    LAS bf16_t* TL = (LAS bf16_t*)(lds + 82944);
    __syncthreads();
    { const int dd = wave >> 2, bb = wave & 3; const LAS float* Am = (dd ? AB : AF) + (bb * 16) * 64 + bb * 16;
      if (lane < 16) { float t[16];
#pragma unroll
          for (int i = 0; i < 16; ++i) { float acc = (i == lane) ? 1.f : 0.f;
#pragma unroll
              for (int j = 0; j < i; ++j) acc -= Am[i * 64 + j] * t[j];
              t[i] = acc; }
#pragma unroll
          for (int i = 0; i < 16; ++i) TL[((dd * 4 + bb) * 16 + i) * 16 + lane] = (bf16_t)f2bf(t[i]); } }
    const int d = wave >> 2, part = wave & 3; const bool isw = part >= 2;
    f32x4 R[4][4];
    { const int qq = r16 >> 2, pp = r16 & 3; const LAS unsigned char* sx = lds + (isw ? GP_SK : GP_SV) + ((part & 1) * 64 + 4 * pp) * 2;
#pragma unroll
      for (int bk = 0; bk < 4; ++bk) { const int rb = d ? 60 - 16 * bk - 4 * g : 16 * bk + 4 * g;
          float f[4];
#pragma unroll
          for (int j = 0; j < 4; ++j) { const int tok = d ? rb + 3 - j : rb + j; f[j] = isw ? bes[d * 64 + tok] * __expf(gcs[d * 64 + tok]) : bes[d * 64 + tok]; }
#pragma unroll
          for (int ct = 0; ct < 4; ++ct) { const s16x4 v4 = lds_tr16(sx + (rb + qq) * GP_RS + ct * 32);
#pragma unroll
              for (int j = 0; j < 4; ++j) R[bk][ct][j] = f[j] * bf2f((bf16_t)(d ? v4[3 - j] : v4[j])); } } }
    __syncthreads();
    { const LAS bf16_t* Nd = NAm + d * 4096; const LAS bf16_t* Td = TL + d * 1024;
      const u32x2 zero2 = (u32x2){0u, 0u};
#pragma unroll
      for (int bk = 0; bk < 4; ++bk) {
#pragma unroll
          for (int c0 = 0; c0 < 4; c0 += 2) if (c0 < bk) {
              const u32x2 alo = *(const LAS u32x2*)(Nd + (bk * 16 + r16) * 64 + c0 * 16 + 4 * g);
              const u32x2 ahi = (c0 + 1 < bk) ? *(const LAS u32x2*)(Nd + (bk * 16 + r16) * 64 + (c0 + 1) * 16 + 4 * g) : zero2;
              const bf16x8 Af = cat8(alo, ahi);
#pragma unroll
              for (int ct = 0; ct < 4; ++ct) { u32x2 blo, bhi = zero2; blo.x = pk2(R[c0][ct][0], R[c0][ct][1]); blo.y = pk2(R[c0][ct][2], R[c0][ct][3]);
                  if (c0 + 1 < bk) { bhi.x = pk2(R[c0 + 1][ct][0], R[c0 + 1][ct][1]); bhi.y = pk2(R[c0 + 1][ct][2], R[c0 + 1][ct][3]); }
                  R[bk][ct] = __builtin_amdgcn_mfma_f32_16x16x32_bf16(Af, cat8(blo, bhi), R[bk][ct], 0, 0, 0); } }
          const bf16x8 Tf = cat8(*(const LAS u32x2*)(Td + (bk * 16 + r16) * 16 + 4 * g), zero2);
#pragma unroll
          for (int ct = 0; ct < 4; ++ct) { u32x2 blo; blo.x = pk2(R[bk][ct][0], R[bk][ct][1]); blo.y = pk2(R[bk][ct][2], R[bk][ct][3]);
              R[bk][ct] = __builtin_amdgcn_mfma_f32_16x16x32_bf16(Tf, cat8(blo, zero2), (f32x4){0.f, 0.f, 0.f, 0.f}, 0, 0, 0); }
      } }
    if (isw) {
        LAS unsigned char* wt = lds + GP_SQ + (d * 2 + (part & 1)) * 64 * GP_WS;
#pragma unroll
        for (int bk = 0; bk < 4; ++bk)
#pragma unroll
            for (int j = 0; j < 4; ++j) { const int ip = bk * 16 + 4 * g + j, tok = d ? 63 - ip : ip;
#pragma unroll
                for (int ct = 0; ct < 4; ++ct) *(LAS bf16_t*)(wt + tok * GP_WS + (ct * 16 + r16) * 2) = (bf16_t)f2bf(R[bk][ct][j]); }
        bf16_t* dst0 = (d == 0 ? Z + (size_t)row0 * ZP + C_WF : P + (size_t)row0 * PP + 1024) + h * 128 + (part & 1) * 64; const int dp = d == 0 ? ZP : PP;
#pragma unroll
        for (int i = 0; i < 8; ++i) { const int idx = lane + 64 * i, r = idx >> 3, c8 = idx & 7; *(u32x4*)(dst0 + (size_t)r * dp + c8 * 8) = *(const LAS u32x4*)(wt + r * GP_WS + c8 * 16); }
    } else {
#pragma unroll
        for (int bk = 0; bk < 4; ++bk) { const int i0 = d ? 60 - 16 * bk - 4 * g : 16 * bk + 4 * g; const int e0 = utile_off(i0, (part & 1) * 64 + r16);
            u32x4 lo, hi;
            if (d == 0) { lo.x = pk2(R[bk][0][0], R[bk][0][1]); lo.y = pk2(R[bk][0][2], R[bk][0][3]); lo.z = pk2(R[bk][1][0], R[bk][1][1]); lo.w = pk2(R[bk][1][2], R[bk][1][3]);
                          hi.x = pk2(R[bk][2][0], R[bk][2][1]); hi.y = pk2(R[bk][2][2], R[bk][2][3]); hi.z = pk2(R[bk][3][0], R[bk][3][1]); hi.w = pk2(R[bk][3][2], R[bk][3][3]); }
            else        { lo.x = pk2(R[bk][0][3], R[bk][0][2]); lo.y = pk2(R[bk][0][1], R[bk][0][0]); lo.z = pk2(R[bk][1][3], R[bk][1][2]); lo.w = pk2(R[bk][1][1], R[bk][1][0]);
                          hi.x = pk2(R[bk][2][3], R[bk][2][2]); hi.y = pk2(R[bk][2][1], R[bk][2][0]); hi.z = pk2(R[bk][3][3], R[bk][3][2]); hi.w = pk2(R[bk][3][1], R[bk][3][0]); }
            bf16_t* up = Z + (size_t)(row0 + (e0 >> 7)) * ZP + (d == 0 ? C_UF : C_UB) + h * 128 + (e0 & 127);
            *(u32x4*)up = lo; *(u32x4*)(up + 8) = hi; }
    }
    __syncthreads();
}

constexpr int GS_SF = 0, GS_VF = 32768, GS_VE = 49152, GS_KB = 65536;
struct GsRegs { bf16x8 W[4], Q[4], AQ[2]; u32x4 K[2]; float u[4][4], gc[4], gl; };
__device__ __forceinline__ void gdn_scan_unit(const KArgs& a, LAS unsigned char* lds, int unit, bool ctx_out) {
    const int tid = OTID(), lane = tid & 63, wave = tid >> 6, g = lane >> 4, r16 = lane & 15, rt = wave & 3, ch = wave >> 2;
    const int bh = unit >> 1, d = unit & 1, b = bh >> 2, h = bh & 3;
    bf16_t* Z = (bf16_t*)(a.ws + WS_Z); const bf16_t* P = (const bf16_t*)(a.ws + WS_P);
    const float* GBa = (const float*)(a.ws + WS_GB);
    const bf16_t* Wb = d == 0 ? (const bf16_t*)Z + C_WF : P + 1024; const int Wp = d == 0 ? ZP : PP;
    const int ubase = (d == 0 ? C_UF : C_UB) + h * 128, ue0 = ((rt * 2 + ch) * 64 + lane) * 16;
    const float* GC2 = (const float*)(a.ws + WS_GC2) + (size_t)(d * 4 + h) * MA;
    const int rhoA = 32 * (rt >> 1) + 8 * (r16 >> 2) + 4 * (rt & 1) + (r16 & 3);
    const int rhoC = 32 * (rt >> 1) + 8 * g + 4 * (rt & 1);
    f32x4 Sa[4], Sb[4];
#pragma unroll
    for (int c = 0; c < 4; ++c) { Sa[c] = (f32x4){0.f, 0.f, 0.f, 0.f}; Sb[c] = Sa[c]; }
#define GS_ROW0(s_) gdn_row0(b, d == 0 ? (s_) : ((s_) < 4 ? 3 - (s_) : 71 - (s_)))
#define GS_LOAD_WQ(R, s_) do { const int r0_ = GS_ROW0(s_); const size_t ra_ = (size_t)(r0_ + rhoA); \
        _Pragma("unroll") for (int ks = 0; ks < 4; ++ks) { R.W[ks] = *(const bf16x8*)(Wb + ra_ * Wp + h * 128 + ks * 32 + 8 * g); R.Q[ks] = *(const bf16x8*)(P + ra_ * PP + h * 128 + ks * 32 + 8 * g); } \
        { const f32x4 gv_ = *(const f32x4*)(GC2 + r0_ + rhoC); R.gc[0] = gv_[0]; R.gc[1] = gv_[1]; R.gc[2] = gv_[2]; R.gc[3] = gv_[3]; } \
        { const bf16_t* up_ = Z + (size_t)(r0_ + (ue0 >> 7)) * ZP + ubase + (ue0 & 127); const u32x4 ua_ = *(const u32x4*)up_, ub_ = *(const u32x4*)(up_ + 8); \
          R.u[0][0] = bflo(ua_.x); R.u[0][1] = bfhi(ua_.x); R.u[0][2] = bflo(ua_.y); R.u[0][3] = bfhi(ua_.y); R.u[1][0] = bflo(ua_.z); R.u[1][1] = bfhi(ua_.z); R.u[1][2] = bflo(ua_.w); R.u[1][3] = bfhi(ua_.w); \
          R.u[2][0] = bflo(ub_.x); R.u[2][1] = bfhi(ub_.x); R.u[2][2] = bflo(ub_.y); R.u[2][3] = bfhi(ub_.y); R.u[3][0] = bflo(ub_.z); R.u[3][1] = bfhi(ub_.z); R.u[3][2] = bflo(ub_.w); R.u[3][3] = bfhi(ub_.w); } \
        R.gl = GC2[r0_ + (d == 0 ? 63 : 0)]; } while (0)
#define GS_LOAD_AQ(R, s_) do { const int r0_ = GS_ROW0(s_); const size_t ra_ = (size_t)(r0_ + rhoA); \
        _Pragma("unroll") for (int k2 = 0; k2 < 2; ++k2) { u32x4 w_ = *(const u32x4*)(Z + ra_ * ZP + C_AQ + h * 64 + k2 * 32 + 8 * g); const int j0_ = k2 * 32 + 8 * g; \
              \
            w_.x &= ((d == 0 ? (j0_ + 0 <= rhoA) : (j0_ + 0 >= rhoA)) ? 0x0000ffffu : 0u) | ((d == 0 ? (j0_ + 1 <= rhoA) : (j0_ + 1 >= rhoA)) ? 0xffff0000u : 0u); \
            w_.y &= ((d == 0 ? (j0_ + 2 <= rhoA) : (j0_ + 2 >= rhoA)) ? 0x0000ffffu : 0u) | ((d == 0 ? (j0_ + 3 <= rhoA) : (j0_ + 3 >= rhoA)) ? 0xffff0000u : 0u); \
            w_.z &= ((d == 0 ? (j0_ + 4 <= rhoA) : (j0_ + 4 >= rhoA)) ? 0x0000ffffu : 0u) | ((d == 0 ? (j0_ + 5 <= rhoA) : (j0_ + 5 >= rhoA)) ? 0xffff0000u : 0u); \
            w_.w &= ((d == 0 ? (j0_ + 6 <= rhoA) : (j0_ + 6 >= rhoA)) ? 0x0000ffffu : 0u) | ((d == 0 ? (j0_ + 7 <= rhoA) : (j0_ + 7 >= rhoA)) ? 0xffff0000u : 0u); \
            R.AQ[k2] = __builtin_bit_cast(bf16x8, w_); } } while (0)
#define GS_LOAD_K(R, s_) do { const int r0_ = GS_ROW0(s_); \
        _Pragma("unroll") for (int cc = 0; cc < 2; ++cc) { const int row_ = wave * 8 + cc * 4 + (lane >> 4); \
            R.K[cc] = *(const u32x4*)(P + (size_t)(r0_ + row_) * PP + 512 + h * 128 + (lane & 15) * 8); } } while (0)
#define GS_LOAD(R, s_) do { GS_LOAD_WQ(R, s_); GS_LOAD_AQ(R, s_); GS_LOAD_K(R, s_); } while (0)
#define GS_BAR() do { asm volatile("s_waitcnt lgkmcnt(0)" ::: "memory"); __builtin_amdgcn_s_barrier(); asm volatile("" ::: "memory"); } while (0)
    const int qq = r16 >> 2, pp = r16 & 3;
#define GS_STEP(s_, PRE) do { const int s = (s_); \
        _Pragma("unroll") for (int c = 0; c < 4; ++c) { u32x4 w; w.x = pk2(Sa[c][0], Sa[c][1]); w.y = pk2(Sa[c][2], Sa[c][3]); w.z = pk2(Sb[c][0], Sb[c][1]); w.w = pk2(Sb[c][2], Sb[c][3]); \
            *(LAS u32x4*)(lds + GS_SF + ((rt * 8 + ch * 4 + c) * 64 + lane) * 16) = w; } \
        _Pragma("unroll") for (int cc = 0; cc < 2; ++cc) { const int row_ = wave * 8 + cc * 4 + (lane >> 4); \
            *(LAS u32x4*)(lds + GS_KB + (s & 1) * 16384 + row_ * 256 + (((lane & 15) ^ ((row_ & 3) << 2)) * 16)) = PRE.K[cc]; } \
        if (s + 1 < 68) GS_LOAD_K(PRE, s + 1); \
        GS_BAR(); \
        const int r0 = GS_ROW0(s); \
        f32x4 vacc[4], oacc[4]; \
        _Pragma("unroll") for (int c = 0; c < 4; ++c) { vacc[c] = (f32x4){0.f, 0.f, 0.f, 0.f}; oacc[c] = vacc[c]; } \
        { bf16x8 Bs[2][4]; \
          _Pragma("unroll") for (int c = 0; c < 4; ++c) Bs[0][c] = *(const LAS bf16x8*)(lds + GS_SF + ((0 * 8 + ch * 4 + c) * 64 + lane) * 16); \
          _Pragma("unroll") for (int ks = 0; ks < 4; ++ks) { \
              if (ks < 3) { _Pragma("unroll") for (int c = 0; c < 4; ++c) Bs[(ks + 1) & 1][c] = *(const LAS bf16x8*)(lds + GS_SF + (((ks + 1) * 8 + ch * 4 + c) * 64 + lane) * 16); } \
              __builtin_amdgcn_sched_barrier(0); \
              _Pragma("unroll") for (int c = 0; c < 4; ++c) { vacc[c] = __builtin_amdgcn_mfma_f32_16x16x32_bf16(PRE.W[ks], Bs[ks & 1][c], vacc[c], 0, 0, 0); oacc[c] = __builtin_amdgcn_mfma_f32_16x16x32_bf16(PRE.Q[ks], Bs[ks & 1][c], oacc[c], 0, 0, 0); } \
              __builtin_amdgcn_sched_barrier(0); } } \
        const float cd = __expf(PRE.gl); \
        float eg[4], ee[4]; \
        _Pragma("unroll") for (int j = 0; j < 4; ++j) { eg[j] = __expf(PRE.gc[j]); ee[j] = __expf(fminf(PRE.gl - PRE.gc[j], 0.f)); } \
        _Pragma("unroll") for (int c = 0; c < 4; ++c) { float vn[4], ve[4]; \
            _Pragma("unroll") for (int j = 0; j < 4; ++j) { vn[j] = PRE.u[c][j] - vacc[c][j]; oacc[c][j] *= eg[j]; ve[j] = vn[j] * ee[j]; } \
            u32x2 w; w.x = pk2(vn[0], vn[1]); w.y = pk2(vn[2], vn[3]); u32x2 e; e.x = pk2(ve[0], ve[1]); e.y = pk2(ve[2], ve[3]); \
            *(LAS u32x2*)(lds + GS_VF + (((rt >> 1) * 8 + ch * 4 + c) * 64 + lane) * 16 + (rt & 1) * 8) = w; \
            *(LAS u32x2*)(lds + GS_VE + (((rt >> 1) * 8 + ch * 4 + c) * 64 + lane) * 16 + (rt & 1) * 8) = e; } \
        if (s + 1 < 68) GS_LOAD_WQ(PRE, s + 1); \
        GS_BAR(); \
        const LAS unsigned char* kb = lds + GS_KB + (s & 1) * 16384; \
        _Pragma("unroll") for (int c = 0; c < 4; ++c) { Sa[c] = Sa[c] * cd; Sb[c] = Sb[c] * cd; } \
        _Pragma("unroll") for (int k2 = 0; k2 < 2; ++k2) { \
            const int rr = k2 * 32 + 8 * g + qq; const int pc = 4 * rt + pp; \
            bf16x8 Bv[4], Be[4]; \
            _Pragma("unroll") for (int c = 0; c < 4; ++c) { Bv[c] = *(const LAS bf16x8*)(lds + GS_VF + ((k2 * 8 + ch * 4 + c) * 64 + lane) * 16); Be[c] = *(const LAS bf16x8*)(lds + GS_VE + ((k2 * 8 + ch * 4 + c) * 64 + lane) * 16); } \
            const s16x4 alo = lds_tr16(kb + rr * 256 + ((pc ^ ((rr & 3) << 2)) * 16)), ahi = lds_tr16(kb + (rr + 4) * 256 + ((pc ^ (((rr + 4) & 3) << 2)) * 16)); \
            const s16x4 blo = lds_tr16(kb + rr * 256 + ((pc ^ ((rr & 3) << 2)) * 16) + 8), bhi = lds_tr16(kb + (rr + 4) * 256 + ((pc ^ (((rr + 4) & 3) << 2)) * 16) + 8); \
            const bf16x8 KTa = (bf16x8){alo[0], alo[1], alo[2], alo[3], ahi[0], ahi[1], ahi[2], ahi[3]}, KTb = (bf16x8){blo[0], blo[1], blo[2], blo[3], bhi[0], bhi[1], bhi[2], bhi[3]}; \
            __builtin_amdgcn_sched_barrier(0); \
            _Pragma("unroll") for (int c = 0; c < 4; ++c) { \
                oacc[c] = __builtin_amdgcn_mfma_f32_16x16x32_bf16(PRE.AQ[k2], Bv[c], oacc[c], 0, 0, 0); \
                Sa[c] = __builtin_amdgcn_mfma_f32_16x16x32_bf16(KTa, Be[c], Sa[c], 0, 0, 0); Sb[c] = __builtin_amdgcn_mfma_f32_16x16x32_bf16(KTb, Be[c], Sb[c], 0, 0, 0); } \
            __builtin_amdgcn_sched_barrier(0); \
        } \
        if (s + 1 < 68) GS_LOAD_AQ(PRE, s + 1); \
        if (s >= 4 || ctx_out) { \
            u32x4 oa_, ob_; oa_.x = pk2(oacc[0][0], oacc[0][1]); oa_.y = pk2(oacc[0][2], oacc[0][3]); oa_.z = pk2(oacc[1][0], oacc[1][1]); oa_.w = pk2(oacc[1][2], oacc[1][3]); \
            ob_.x = pk2(oacc[2][0], oacc[2][1]); ob_.y = pk2(oacc[2][2], oacc[2][3]); ob_.z = pk2(oacc[3][0], oacc[3][1]); ob_.w = pk2(oacc[3][2], oacc[3][3]); \
            bf16_t* op_ = Z + (size_t)(r0 + (ue0 >> 7)) * ZP + ubase + (ue0 & 127); *(u32x4*)op_ = oa_; *(u32x4*)(op_ + 8) = ob_; \
        } \
    } while (0)
    GsRegs RA;
    GS_LOAD(RA, 0);
    for (int s2 = 0; s2 < 68; s2 += 2) { GS_STEP(s2, RA); GS_STEP(s2 + 1, RA); }
#undef GS_STEP
#undef GS_BAR
#undef GS_ROW0
#undef GS_LOAD
#undef GS_LOAD_WQ
#undef GS_LOAD_AQ
#undef GS_LOAD_K
    __syncthreads();
}
typedef const __attribute__((address_space(4))) KArgs* KAP;
#define NOINL __forceinline__
__device__ __forceinline__ KArgs load_kargs(KAP kp) { unsigned long long kv = (unsigned long long)kp; asm volatile("" : "+s"(kv)); KAP ka = (KAP)kv; KArgs a;
#pragma unroll
    for (int i = 0; i < 29; ++i) a.in[i] = ka->in[i];
    a.out = ka->out; a.ws = ka->ws; a.ph_lo = ka->ph_lo; a.ph_hi = ka->ph_hi; return a; }
__device__ NOINL void loop_gdnprep(KAP ka, LAS unsigned char* lds, int u0, int n, int step) { const KArgs a = load_kargs(ka);
    if (u0 >= n) return;
    GpPre cur; gdn_prep_load(a, u0, cur);
    for (int u = u0; u < n; u += step) { GpPre nx; gdn_prep_load(a, (u + step < n) ? u + step : u, nx); gdn_prep_unit(a, lds, u, cur); cur = nx; } }
__device__ NOINL void loop_retkv(KAP ka, LAS unsigned char* lds, int l, int u0, int n, int step) { const KArgs a = load_kargs(ka);
    if (u0 >= n) return;
    RkPre cur; ret_kv_load(a, u0, cur);
    for (int u = u0; u < n; u += step) { RkPre nx; ret_kv_load(a, (u + step < n) ? u + step : u, nx); ret_kv_unit(a, lds, l, u, cur); cur = nx; } }
__device__ NOINL void call_gdnscan(KAP ka, LAS unsigned char* lds, int unit, bool ctx_out) { const KArgs a = load_kargs(ka); gdn_scan_unit(a, lds, unit, ctx_out); }
__device__ NOINL void call_retprefix(KAP ka, int l) { const KArgs a = load_kargs(ka); ret_prefix(a, l, 64); }
__device__ NOINL void call_retout(KAP ka, LAS unsigned char* lds, int l, int unit) { const KArgs a = load_kargs(ka); ret_out_unit(a, lds, l, unit); }
__device__ NOINL void call_na(KAP ka, int l, int item, bool ctxq, LAS unsigned char* kl, int lane) { const KArgs a = load_kargs(ka); na_item(a, l, item, ctxq, kl, lane); }
__device__ NOINL void call_win(KAP ka, int l, int item, bool ctxq, LAS unsigned char* kl, int lane) { const KArgs a = load_kargs(ka); win_item(a, l, item, ctxq, kl, lane); }
#ifndef SCAN_ONLY_M2
#define SCAN_ONLY_M2 0
#endif
constexpr int CW_WQ = 8192;
__device__ __forceinline__ void phase_mixers(KAP ka, LAS unsigned char* lds, int l, bool ctx_out) {
    const int blk = OBLK(), G = OGRID();
    loop_gdnprep(ka, lds, blk, 32 * 68, G);
    loop_retkv(ka, lds, l, G - 1 - blk, 32 * 34, G);
#if SCAN_ONLY_M2
    { const int tid = OTID(), lane = tid & 63, wave = tid >> 6; LAS unsigned char* kl = lds + __builtin_amdgcn_readfirstlane(wave) * AT_WAVE_BYTES;
      const int nitems = ctx_out ? 4096 + 4096 + 256 + 256 : 8192;
      for (int it = gw; it < nitems; it += NGW) { const bool cq = it >= 8192; const int j = cq ? it - 8192 : it; const bool isna = cq ? (j < 256) : (j < 4096); const int item = cq ? (j & 255) : (j & 4095);
          if (isna) call_na(ka, l, item, cq, kl, lane); else call_win(ka, l, item, cq, kl, lane); } }
#endif
}
__device__ __forceinline__ void phase_scan_attn(KAP ka, LAS unsigned char* lds, int l, bool ctx_out, int qslot) {
    const int tid = OTID(), lane = tid & 63, wave = tid >> 6, blk = OBLK(), G = OGRID();
    for (int u = blk; u < 64; u += G) call_gdnscan(ka, lds, (((u & 7) * 4 + ((u >> 3) >> 1)) << 1) | ((u >> 3) & 1), ctx_out);
    call_retprefix(ka, l);
#if SCAN_ONLY_M2
    return;
#endif
    LAS unsigned char* kl = lds + __builtin_amdgcn_readfirstlane(wave) * AT_WAVE_BYTES;
    unsigned* ctr; { const KArgs a = load_kargs(ka); ctr = (unsigned*)(a.ws + WS_CTL) + CW_WQ + qslot * 1024 + (blk & 7) * 64; }
    const int xb = blk & 7;
    const int nper = ctx_out ? 512 + 512 + 32 + 32 : 1024;
    for (;;) {
        int k = 0; if (lane == 0) k = (int)__hip_atomic_fetch_add(ctr, 1u, __ATOMIC_RELAXED, __HIP_MEMORY_SCOPE_AGENT);
        k = __builtin_amdgcn_readfirstlane(k);
        if (k >= nper) break;
        const bool cq = k >= 1024; const int j = cq ? k - 1024 : k;
        const bool isna = cq ? (j < 32) : (j < 512);
        const int item = cq ? xb * 32 + (j & 31) : xb * 512 + (j & 511);
        if (isna) call_na(ka, l, item, cq, kl, lane);
        else call_win(ka, l, item, cq, kl, lane);
    }
}
using pg8::Unit;
struct SchedPlain {
    const char* A0; const char* B0; size_t tA, tB;
    int nM, nN, nwg, G, c;
    __device__ __forceinline__ void init(const void* A, int lda, const void* Bt, int ldb, int M, int N, int G_, int c_) {
        A0 = (const char*)A; B0 = (const char*)Bt; tA = (size_t)256 * lda * 2; tB = (size_t)256 * ldb * 2; nM = M / 256; nN = N / 256; nwg = nM * nN; G = G_; c = c_; }
    __device__ __forceinline__ bool next(int i, Unit& u) const {
        const long L = (long)i * G + c; if (L >= nwg) return false;
        int wgid = (int)L; { const int q = nwg / 8, r = nwg % 8, xcd = wgid % 8, off = wgid / 8; wgid = (xcd < r ? xcd * (q + 1) : r * (q + 1) + (xcd - r) * q) + off; }
        const int nig = 8 * nN, gid = wgid / nig, fm = gid * 8, gsz = (nM - fm) < 8 ? (nM - fm) : 8;
        u.pm = fm + ((wgid % nig) % gsz); u.pn = (wgid % nig) / gsz; u.aux = 0; return true; }
    __device__ __forceinline__ const char* A(const Unit& u) const { return A0 + (size_t)u.pm * tA; }
    __device__ __forceinline__ const char* B(const Unit& u) const { return B0 + (size_t)u.pn * tB; }
};
struct SchedBranch {
    const char* Z0; const char* W0; int ntiles, G, c;
    __device__ __forceinline__ bool next(int i, Unit& u) const { const int tile = (i >> 2) * G + c; if (tile >= ntiles) return false; u.pm = tile >> 2; u.pn = tile & 3; u.aux = i & 3; return true; }
    __device__ __forceinline__ const char* A(const Unit& u) const { const int yc = u.aux == 0 ? Y_RET : (u.aux == 1 ? Y_WIN : (u.aux == 2 ? Y_NA : Y_GDN)); return Z0 + ((size_t)u.pm * 256 * ZP + yc) * 2; }
    __device__ __forceinline__ const char* B(const Unit& u) const { return W0 + ((size_t)u.aux * 1024 * 512 + (size_t)u.pn * 256 * 512) * 2; }
};
struct SchedMoe {
    const char* A0; const char* W0; const int* tile_start; size_t tA, eB, tB; int G, c;
    int e_[4], t0_[4], cum_[5], rank_, nrank_;
    __device__ __forceinline__ void init() {
        const int x = c & 7; rank_ = c >> 3; nrank_ = G >> 3; cum_[0] = 0;
#pragma unroll
        for (int k = 0; k < 4; ++k) { e_[k] = x + 8 * k; t0_[k] = tile_start[e_[k]]; cum_[k + 1] = cum_[k] + (tile_start[e_[k] + 1] - t0_[k]); }
    }
    __device__ __forceinline__ bool next(int i, Unit& u) const {
        const int L = i * nrank_ + rank_; const int tt = L >> 2; if (tt >= cum_[4]) return false;
        const int k = (tt >= cum_[1]) + (tt >= cum_[2]) + (tt >= cum_[3]);
        int e = e_[0], t0 = t0_[0], cm = cum_[0];
        if (k == 1) { e = e_[1]; t0 = t0_[1]; cm = cum_[1]; } else if (k == 2) { e = e_[2]; t0 = t0_[2]; cm = cum_[2]; } else if (k == 3) { e = e_[3]; t0 = t0_[3]; cm = cum_[3]; }
        u.pm = t0 + (tt - cm); u.pn = L & 3; u.aux = e; return true; }
    __device__ __forceinline__ const char* A(const Unit& u) const { return A0 + (size_t)u.pm * tA; }
    __device__ __forceinline__ const char* B(const Unit& u) const { return W0 + (size_t)u.aux * eB + (size_t)u.pn * tB; }
};

template <int MODE  > struct EpiStore {
    static constexpr bool INPLACE = false;
    bf16_t* O; int ldc;
    __device__ __forceinline__ void operator()(const f32x4 (&acc)[2][2][4][2], const Unit& u, int wr, int wc, int fr, int fq) const {
        const int row0 = u.pm * 256 + wr * 64 + fr; const int colt = (MODE == 1 ? dead_tile(u.pn) : u.pn) * 256; const int col0 = colt + wc * 32 + 8 * fq;
#pragma unroll
        for (int ai = 0; ai < 2; ++ai)
#pragma unroll
            for (int m = 0; m < 4; ++m) { bf16_t* rowp = O + (size_t)(row0 + ai * 128 + m * 16) * ldc + col0;
#pragma unroll
                for (int bj = 0; bj < 2; ++bj) { f32x4 v0 = acc[ai][bj][m][0], v1 = acc[ai][bj][m][1];
                    if (MODE == 1) {
#pragma unroll
                        for (int e = 0; e < 4; ++e) { v0[e] = sigmoidf_(v0[e]); v1[e] = sigmoidf_(v1[e]); } }
                    u32x4 w; w.x = pk2(v0[0], v0[1]); w.y = pk2(v0[2], v0[3]); w.z = pk2(v1[0], v1[1]); w.w = pk2(v1[2], v1[3]);
                    *(u32x4*)(rowp + bj * 128) = w; } }
    }
};
struct EpiIn {
    static constexpr bool INPLACE = false;
    bf16_t* Z; const float* wqn; const float* wkn; const float* nqn; const float* nkn; const float* cs0;
    __device__ __forceinline__ void operator()(const f32x4 (&acc)[2][2][4][2], const Unit& u, int wr, int wc, int fr, int fq) const {
        const int row0 = u.pm * 256 + wr * 64 + fr; const int T = u.pn;
        if (!win_head_tile(T)) {
            const int col0 = T * 256 + wc * 32 + 8 * fq;
#pragma unroll
            for (int ai = 0; ai < 2; ++ai)
#pragma unroll
                for (int m = 0; m < 4; ++m) { bf16_t* rowp = Z + (size_t)(row0 + ai * 128 + m * 16) * ZP + col0;
#pragma unroll
                    for (int bj = 0; bj < 2; ++bj) { const f32x4 v0 = acc[ai][bj][m][0], v1 = acc[ai][bj][m][1];
                        u32x4 w; w.x = pk2(v0[0], v0[1]); w.y = pk2(v0[2], v0[3]); w.z = pk2(v1[0], v1[1]); w.w = pk2(v1[2], v1[3]);
                        *(u32x4*)(rowp + bj * 128) = w; } }
            return;
        }
        const int hidx = (T < 2 ? T * 4 : (T < 9 ? 8 + (T - 6) * 4 : 18 + (T - 9) * 4)) + wc;
        const bool isv = (T == 8 && wc >= 2);
        const float* gain = (hidx < 8 || isv) ? nullptr : (hidx < 16 ? wqn : (hidx < 18 ? wkn : (hidx < 26 ? nqn : nkn)));
        const bool rope = (u.pm < ML / 256) && hidx < 18 && !isv;
        const float scale = isv ? 1.0f : ((hidx >= 4 && hidx < 8) ? 0.125f : (((hidx >= 8 && hidx < 16) || (hidx >= 18 && hidx < 26)) ? 0.125f * 1.4426950408889634f : 1.0f));
        const int col = T * 256 + wc * 64 + 8 * fq;
        f32x4 g0 = (f32x4){1.f, 1.f, 1.f, 1.f}, g1 = g0, g2 = g0, g3 = g0;
        if (gain) { g0 = *(const f32x4*)(gain + 8 * fq); g1 = *(const f32x4*)(gain + 8 * fq + 4); g2 = *(const f32x4*)(gain + 32 + 8 * fq); g3 = *(const f32x4*)(gain + 36 + 8 * fq); }
#pragma unroll
        for (int am = 0; am < 8; am += 2) {
            f32x4 c0[2], c1[2], s0[2], s1[2];
            if (rope) {
#pragma unroll
                for (int k = 0; k < 2; ++k) { const int ai = (am + k) >> 2, m = (am + k) & 3; const int t = (row0 + ai * 128 + m * 16) & 4095; const float* cs = cs0 + t * 32 + 8 * fq; const float* sn = cs + 4096 * 32;
                    c0[k] = *(const f32x4*)cs; c1[k] = *(const f32x4*)(cs + 4); s0[k] = *(const f32x4*)sn; s1[k] = *(const f32x4*)(sn + 4); } }
#pragma unroll
            for (int k = 0; k < 2; ++k) { const int ai = (am + k) >> 2, m = (am + k) & 3;
                f32x4 a0 = acc[ai][0][m][0], a1 = acc[ai][0][m][1], b0 = acc[ai][1][m][0], b1 = acc[ai][1][m][1];
                if (gain) {
                    const f32x4 q = a0 * a0 + a1 * a1 + b0 * b0 + b1 * b1; float ss = (q[0] + q[1]) + (q[2] + q[3]);
                    ss += __shfl_xor(ss, 16); ss += __shfl_xor(ss, 32);
                    const float r = rsqrtf(ss * (1.f / 64.f) + EPS);
                    a0 = a0 * (g0 * r); a1 = a1 * (g1 * r); b0 = b0 * (g2 * r); b1 = b1 * (g3 * r); }
                if (rope) { const f32x4 y0 = a0 * c0[k] - b0 * s0[k], y1 = a1 * c1[k] - b1 * s1[k], z0 = a0 * s0[k] + b0 * c0[k], z1 = a1 * s1[k] + b1 * c1[k]; a0 = y0; a1 = y1; b0 = z0; b1 = z1; }
                a0 = a0 * scale; a1 = a1 * scale; b0 = b0 * scale; b1 = b1 * scale;
                bf16_t* rowp = Z + (size_t)(row0 + ai * 128 + m * 16) * ZP + col;
                u32x4 w; w.x = pk2(a0[0], a0[1]); w.y = pk2(a0[2], a0[3]); w.z = pk2(a1[0], a1[1]); w.w = pk2(a1[2], a1[3]); *(u32x4*)rowp = w;
                w.x = pk2(b0[0], b0[1]); w.y = pk2(b0[2], b0[3]); w.z = pk2(b1[0], b1[1]); w.w = pk2(b1[2], b1[3]); *(u32x4*)(rowp + 32) = w;
            }
        }
    }
};
struct EpiGateF {
    static constexpr bool INPLACE = false;
    bf16_t* Z;
    __device__ __forceinline__ void operator()(const f32x4 (&acc)[2][2][4][2], const Unit& u, int wr, int wc, int fr, int fq) const {
        const int row0 = u.pm * 256 + wr * 64 + fr; const int cw = (u.pn & 3) * 64 + wc * 16 + fq * 4; const int ct = u.pn >> 2;
        const int c0 = dead_tile(ct) * 256 + cw, c1 = dead_tile(4 + ct) * 256 + cw, c2 = dead_tile(8 + ct) * 256 + cw, c3 = dead_tile(12 + ct) * 256 + cw;
#pragma unroll
        for (int ai = 0; ai < 2; ++ai)
#pragma unroll
            for (int m = 0; m < 4; ++m) { bf16_t* rowp = Z + (size_t)(row0 + ai * 128 + m * 16) * ZP;
                float f0[4], f1[4], f2[4], f3[4];
#pragma unroll
                for (int e = 0; e < 4; ++e) {
                    const float d0 = 1.0f + __expf(-acc[ai][0][m][0][e]), d1 = fminf(1.0f + __expf(-acc[ai][0][m][1][e]), 1e30f), d2 = fminf(1.0f + __expf(-acc[ai][1][m][0][e]), 1e30f), d3 = fminf(1.0f + __expf(-acc[ai][1][m][1][e]), 1e30f);
                    f0[e] = d1 * __builtin_amdgcn_rcpf(d0); f1[e] = d2 * __builtin_amdgcn_rcpf(d1); f2[e] = d3 * __builtin_amdgcn_rcpf(d2); f3[e] = __builtin_amdgcn_rcpf(d3); }
                u32x2 w;
                w.x = pk2(f0[0], f0[1]); w.y = pk2(f0[2], f0[3]); *(u32x2*)(rowp + c0) = w;
                w.x = pk2(f1[0], f1[1]); w.y = pk2(f1[2], f1[3]); *(u32x2*)(rowp + c1) = w;
                w.x = pk2(f2[0], f2[1]); w.y = pk2(f2[2], f2[3]); *(u32x2*)(rowp + c2) = w;
                w.x = pk2(f3[0], f3[1]); w.y = pk2(f3[2], f3[3]); *(u32x2*)(rowp + c3) = w; }
    }
};
struct EpiBranch {
    static constexpr bool INPLACE = true;
    bf16_t* ACC; const bf16_t* Z;
    __device__ __forceinline__ void operator()(f32x4 (&acc)[2][2][4][2], const Unit& u, int wr, int wc, int fr, int fq) const {
        const int row0 = u.pm * 256 + wr * 64 + fr; const int gcol0 = dead_tile(u.aux * 4 + u.pn) * 256 + wc * 32 + 8 * fq, col0 = u.pn * 256 + wc * 32 + 8 * fq;
        const bool lastb = (u.aux == 3);
#pragma unroll
        for (int ai = 0; ai < 2; ++ai) {
            u32x4 gw[4][2];
#pragma unroll
            for (int m = 0; m < 4; ++m)
#pragma unroll
                for (int bj = 0; bj < 2; ++bj) gw[m][bj] = *(const u32x4*)(Z + (size_t)(row0 + ai * 128 + m * 16) * ZP + gcol0 + bj * 128);
#pragma unroll
            for (int m = 0; m < 4; ++m)
#pragma unroll
                for (int bj = 0; bj < 2; ++bj) { const u32x4 g = gw[m][bj];
                    f32x4 v0 = acc[ai][bj][m][0], v1 = acc[ai][bj][m][1];
                    v0[0] *= bflo(g.x); v0[1] *= bfhi(g.x); v0[2] *= bflo(g.y); v0[3] *= bfhi(g.y); v1[0] *= bflo(g.z); v1[1] *= bfhi(g.z); v1[2] *= bflo(g.w); v1[3] *= bfhi(g.w);
                    if (lastb) { u32x4 w; w.x = pk2(v0[0], v0[1]); w.y = pk2(v0[2], v0[3]); w.z = pk2(v1[0], v1[1]); w.w = pk2(v1[2], v1[3]);
                        *(u32x4*)(ACC + (size_t)(row0 + ai * 128 + m * 16) * D + col0 + bj * 128) = w; v0 = (f32x4){0.f, 0.f, 0.f, 0.f}; v1 = v0; }
                    acc[ai][bj][m][0] = v0; acc[ai][bj][m][1] = v1; }
        }
    }
};
struct EpiResid {
    static constexpr bool INPLACE = false;
    const float* xl_src; const float* xc_src; float* xl_dst; float* xc_dst; const float* mod_g;
    __device__ __forceinline__ void operator()(const f32x4 (&acc)[2][2][4][2], const Unit& u, int wr, int wc, int fr, int fq) const {
        const int row0 = u.pm * 256 + wr * 64 + fr; const int col0 = u.pn * 256 + wc * 32 + 8 * fq;
        const bool lat = u.pm < ML / 256; const float* src = lat ? xl_src : xc_src - (size_t)ML * D; float* dst = lat ? xl_dst : xc_dst - (size_t)ML * D;
        const float* gv = mod_g + (size_t)(lat ? (u.pm >> 4) : 8) * 6144;
        f32x4 gg[2][2];
#pragma unroll
        for (int bj = 0; bj < 2; ++bj) { gg[bj][0] = *(const f32x4*)(gv + col0 + bj * 128); gg[bj][1] = *(const f32x4*)(gv + col0 + bj * 128 + 4); }
#pragma unroll
        for (int ai = 0; ai < 2; ++ai) {
            f32x4 xv[4][2][2];
#pragma unroll
            for (int m = 0; m < 4; ++m)
#pragma unroll
                for (int bj = 0; bj < 2; ++bj) { const size_t o = (size_t)(row0 + ai * 128 + m * 16) * D + col0 + bj * 128; xv[m][bj][0] = *(const f32x4*)(src + o); xv[m][bj][1] = *(const f32x4*)(src + o + 4); }
#pragma unroll
            for (int m = 0; m < 4; ++m)
#pragma unroll
                for (int bj = 0; bj < 2; ++bj) { const size_t o = (size_t)(row0 + ai * 128 + m * 16) * D + col0 + bj * 128;
                    *(f32x4*)(dst + o) = xv[m][bj][0] + gg[bj][0] * acc[ai][bj][m][0]; *(f32x4*)(dst + o + 4) = xv[m][bj][1] + gg[bj][1] * acc[ai][bj][m][1]; }
        }
    }
};
struct EpiAct {
    static constexpr bool INPLACE = false;
    bf16_t* ACT;
    __device__ __forceinline__ void operator()(const f32x4 (&acc)[2][2][4][2], const Unit& u, int wr, int wc, int fr, int fq) const {
        const int row0 = u.pm * 256 + wr * 64 + fr; const int col0 = u.pn * 128 + wc * 32 + 8 * fq;
#pragma unroll
        for (int ai = 0; ai < 2; ++ai)
#pragma unroll
            for (int m = 0; m < 4; ++m) { const f32x4 g0 = acc[ai][0][m][0], g1 = acc[ai][0][m][1], u0 = acc[ai][1][m][0], u1 = acc[ai][1][m][1];
                u32x4 w; w.x = pk2(silu_fast(g0[0]) * u0[0], silu_fast(g0[1]) * u0[1]); w.y = pk2(silu_fast(g0[2]) * u0[2], silu_fast(g0[3]) * u0[3]);
                w.z = pk2(silu_fast(g1[0]) * u1[0], silu_fast(g1[1]) * u1[1]); w.w = pk2(silu_fast(g1[2]) * u1[2], silu_fast(g1[3]) * u1[3]);
                *(u32x4*)(ACT + (size_t)(row0 + ai * 128 + m * 16) * DEXP + col0) = w; }
    }
};
constexpr int RT_WS = (1024 + 8) * 2;
constexpr int RT_LO = 32 * RT_WS, RT_BIAS = 2 * RT_LO, RT_SCR = RT_BIAS + 256, RT_SCR_W = 16 * 33 * 4 + 64;
__device__ __forceinline__ void phase_route(const KArgs& a, LAS unsigned char* lds, int l, int nrows) {
    const int tid = OTID(), lane = tid & 63, wave = tid >> 6, blk = OBLK(), G = OGRID(), g = lane >> 4, r16 = lane & 15;
    LAS unsigned* lcnt = (LAS unsigned*)(lds + RT_SCR + 8 * RT_SCR_W);
    LAS float* biasl = (LAS float*)(lds + RT_BIAS);
    LAS float* lg = (LAS float*)(lds + RT_SCR + wave * RT_SCR_W); LAS float* rsl = lg + 16 * 33;
    if (tid < 32) lcnt[tid] = 0u;
    const int ntile = nrows >> 4, per = (ntile + G - 1) / G, t0 = blk * per, t1 = (t0 + per < ntile) ? t0 + per : ntile;
    const float* xl = a.out; const float* xc = (const float*)(a.ws + WS_XC);
    unsigned* tokE = (unsigned*)(a.ws + WS_TOK + TOK_E); unsigned* tokS = (unsigned*)(a.ws + WS_TOK + TOK_SLOT); f32x2* tokW = (f32x2*)(a.ws + WS_TOK + TOK_W);
    float* tokR = (float*)(a.ws + WS_TOK + TOK_RSTD);
    int curb = -1;
    for (int tb = t0; tb < t1; tb += NWAVES) {
        const int tile = tb + wave; const bool act = tile < t1;
        const int bidx = row_modidx((tb << 4));
        const int blast = row_modidx(((tb + NWAVES - 1 < t1 ? tb + NWAVES - 1 : t1 - 1) << 4) + 15);
        for (int bsel = bidx; bsel <= blast; ++bsel) {
            if (bsel != curb) {
                __syncthreads();
                const float* mod = (const float*)(a.ws + WS_MOD) + (size_t)(l * 9 + bsel) * 6144; const float* gain = a.in[I_NORM2] + l * D;
                for (int idx = tid; idx < 32 * 1024; idx += NTHR) { const int e = idx >> 10, k = idx & 1023; const float w = a.in[I_WROUTER][k * 32 + e] * gain[k] * (1.0f + mod[4 * 1024 + k]);
                    const unsigned hi = pk2(w, w) & 0xffffu; const float lo = w - bf2f((bf16_t)hi);
                    *(LAS bf16_t*)(lds + e * RT_WS + k * 2) = (bf16_t)hi; *(LAS bf16_t*)(lds + RT_LO + e * RT_WS + k * 2) = (bf16_t)(pk2(lo, lo) & 0xffffu); }
                { const int e = tid & 31, part = tid >> 5; float s = 0.f;
                  for (int k = part * 64; k < part * 64 + 64; ++k) s += mod[3 * 1024 + k] * a.in[I_WROUTER][k * 32 + e];
                  LAS float* part_s = (LAS float*)(lds + RT_SCR); part_s[part * 32 + e] = s; }
                __syncthreads();
                if (tid < 32) { float s = 0.f; for (int p = 0; p < 16; ++p) s += ((LAS float*)(lds + RT_SCR))[p * 32 + tid]; biasl[tid] = s; }
                __syncthreads();
                curb = bsel;
            }
            if (act && row_modidx(tile << 4) == bsel) {
                const int row = (tile << 4) + r16;
                const float* xr = row < ML ? xl + (size_t)row * D : xc + (size_t)(row - ML) * D;
                f32x4 acc0 = (f32x4){0.f, 0.f, 0.f, 0.f}, acc1 = acc0; float ss = 0.f;
#pragma unroll 8
                for (int ks = 0; ks < 32; ++ks) {
                    const f32x4 xa = *(const f32x4*)(xr + ks * 32 + 8 * g), xb = *(const f32x4*)(xr + ks * 32 + 8 * g + 4);
                    ss += (xa.x * xa.x + xa.y * xa.y) + (xa.z * xa.z + xa.w * xa.w) + (xb.x * xb.x + xb.y * xb.y) + (xb.z * xb.z + xb.w * xb.w);
                    u32x4 hw; hw.x = pk2(xa.x, xa.y); hw.y = pk2(xa.z, xa.w); hw.z = pk2(xb.x, xb.y); hw.w = pk2(xb.z, xb.w);
                    u32x4 lw; lw.x = pk2(xa.x - bflo(hw.x), xa.y - bfhi(hw.x)); lw.y = pk2(xa.z - bflo(hw.y), xa.w - bfhi(hw.y)); lw.z = pk2(xb.x - bflo(hw.z), xb.y - bfhi(hw.z)); lw.w = pk2(xb.z - bflo(hw.w), xb.w - bfhi(hw.w));
                    const bf16x8 Ah = __builtin_bit_cast(bf16x8, hw), Al = __builtin_bit_cast(bf16x8, lw);
                    const LAS unsigned char* wp = lds + r16 * RT_WS + (ks * 32 + 8 * g) * 2;
                    const bf16x8 B0h = *(const LAS bf16x8*)wp, B1h = *(const LAS bf16x8*)(wp + 16 * RT_WS), B0l = *(const LAS bf16x8*)(wp + RT_LO), B1l = *(const LAS bf16x8*)(wp + RT_LO + 16 * RT_WS);
                    acc0 = __builtin_amdgcn_mfma_f32_16x16x32_bf16(Ah, B0h, acc0, 0, 0, 0); acc0 = __builtin_amdgcn_mfma_f32_16x16x32_bf16(Al, B0h, acc0, 0, 0, 0); acc0 = __builtin_amdgcn_mfma_f32_16x16x32_bf16(Ah, B0l, acc0, 0, 0, 0);
                    acc1 = __builtin_amdgcn_mfma_f32_16x16x32_bf16(Ah, B1h, acc1, 0, 0, 0); acc1 = __builtin_amdgcn_mfma_f32_16x16x32_bf16(Al, B1h, acc1, 0, 0, 0); acc1 = __builtin_amdgcn_mfma_f32_16x16x32_bf16(Ah, B1l, acc1, 0, 0, 0);
                }
                ss += __shfl_xor(ss, 16); ss += __shfl_xor(ss, 32);
                const float rstd = rsqrtf(ss * (1.f / 1024.f) + EPS);
                if (g == 0) { rsl[r16] = rstd; tokR[row] = rstd; }
                LDS_WAIT(); asm volatile("" ::: "memory");
#pragma unroll
                for (int j = 0; j < 4; ++j) { const float rs = rsl[4 * g + j]; lg[(4 * g + j) * 33 + r16] = acc0[j] * rs + biasl[r16]; lg[(4 * g + j) * 33 + 16 + r16] = acc1[j] * rs + biasl[16 + r16]; }
                LDS_WAIT(); asm volatile("" ::: "memory");
                if (lane < 16) {
                    const int rrow = (tile << 4) + lane;
                    float sc[32], bestg = -1e30f; int gi = 0;
#pragma unroll
                    for (int e = 0; e < 32; ++e) sc[e] = sigmoidf_(lg[lane * 33 + e]);
#pragma unroll
                    for (int gg = 0; gg < 8; ++gg) {
                        float s4[4];
#pragma unroll
                        for (int j = 0; j < 4; ++j) s4[j] = sc[gg * 4 + j] + a.in[I_RBIAS][gg * 4 + j];
                        const float m01 = fmaxf(s4[0], s4[1]), n01 = fminf(s4[0], s4[1]), m23 = fmaxf(s4[2], s4[3]), n23 = fminf(s4[2], s4[3]);
                        const float top = fmaxf(m01, m23), second = fmaxf(fminf(m01, m23), (m01 >= m23) ? n01 : n23);
                        const float gs = top + second;
                        if (gs > bestg) { bestg = gs; gi = gg; }
                    }
                    float s4[4], w4[4];
#pragma unroll
                    for (int j = 0; j < 4; ++j) { float sv = 0.f, wv = 0.f;
#pragma unroll
                        for (int gg = 0; gg < 8; ++gg) { if (gg == gi) { sv = sc[gg * 4 + j] + a.in[I_RBIAS][gg * 4 + j]; wv = sc[gg * 4 + j]; } }
                        s4[j] = sv; w4[j] = wv; }
                    int i0 = 0; float v0 = s4[0];
#pragma unroll
                    for (int j = 1; j < 4; ++j) if (s4[j] > v0) { v0 = s4[j]; i0 = j; }
                    int i1 = -1; float v1 = -1e30f;
#pragma unroll
                    for (int j = 0; j < 4; ++j) if (j != i0 && s4[j] > v1) { v1 = s4[j]; i1 = j; }
                    float w0 = 0.f, w1 = 0.f;
#pragma unroll
                    for (int j = 0; j < 4; ++j) { if (j == i0) w0 = w4[j]; if (j == i1) w1 = w4[j]; }
                    const float inv = 1.0f / (w0 + w1);
                    const int e0 = gi * 4 + i0, e1 = gi * 4 + i1;
                    const unsigned s0 = __hip_atomic_fetch_add(&lcnt[e0], 1u, __ATOMIC_RELAXED, __HIP_MEMORY_SCOPE_WORKGROUP), s1 = __hip_atomic_fetch_add(&lcnt[e1], 1u, __ATOMIC_RELAXED, __HIP_MEMORY_SCOPE_WORKGROUP);
                    tokE[rrow] = (unsigned)e0 | ((unsigned)e1 << 8); tokS[rrow] = s0 | (s1 << 16); tokW[rrow] = (f32x2){w0 * inv, w1 * inv};
                }
            }
        }
    }
    __syncthreads();
    if (tid < 32) ((unsigned*)(a.ws + WS_TOK + TOK_BCNT))[blk * 32 + tid] = lcnt[tid];
}

__device__ __forceinline__ void phase_gather(const KArgs& a, LAS unsigned char* lds, int l, int nrows) {
    const int tid = OTID(), lane = tid & 63, wave = tid >> 6, blk = OBLK(), G = OGRID();
    LAS unsigned* tot = (LAS unsigned*)lds;
    LAS unsigned* bef = tot + 32;
    LAS unsigned* base = tot + 64;
    const unsigned* bc = (const unsigned*)(a.ws + WS_TOK + TOK_BCNT);
    { LAS unsigned* ptot = tot + 96; LAS unsigned* pbef = ptot + 512;
      const int e = tid & 31, part = tid >> 5; unsigned t = 0u, bf = 0u;
#pragma unroll
      for (int k = 0; k < 16; ++k) { const int g = part * 16 + k; const unsigned c = (g < G) ? bc[g * 32 + e] : 0u; t += c; bf += (g < blk) ? c : 0u; }
      ptot[tid] = t; pbef[tid] = bf;
      __syncthreads();
      if (tid < 32) { unsigned tt = 0u, bb = 0u;
#pragma unroll
          for (int p = 0; p < 16; ++p) { tt += ptot[p * 32 + tid]; bb += pbef[p * 32 + tid]; }
          tot[tid] = tt; bef[tid] = bb; } }
    __syncthreads();
    if (tid == 0) {
        unsigned pos = 0u; int* tile_e = (int*)(a.ws + WS_TOK + TOK_TILE);
#pragma unroll 1
        for (int e = 0; e < 32; ++e) { base[e] = pos + bef[e]; const unsigned nt = (tot[e] + 255u) >> 8;
            if (blk == 0) tile_e[e] = (int)(pos >> 8);
            pos += nt << 8; }
        if (blk == 0) tile_e[32] = (int)(pos >> 8);
    }
    __syncthreads();
    const unsigned* tokE = (const unsigned*)(a.ws + WS_TOK + TOK_E); const unsigned* tokS = (const unsigned*)(a.ws + WS_TOK + TOK_SLOT); u32x2* tokP = (u32x2*)(a.ws + WS_TOK + TOK_POS);
    const float* tokR = (const float*)(a.ws + WS_TOK + TOK_RSTD);
    bf16_t* xb = (bf16_t*)(a.ws + WS_XB);
    const float* xl = a.out; const float* xc = (const float*)(a.ws + WS_XC);
    const int ntile = nrows >> 4, per = (ntile + G - 1) / G, r0 = blk * per * 16, r1 = ((blk + 1) * per * 16 < nrows) ? (blk + 1) * per * 16 : nrows;
    unsigned en = 0u, sn = 0u; float rn = 0.f;
    if (r0 + wave < r1) { en = tokE[r0 + wave]; sn = tokS[r0 + wave]; rn = tokR[r0 + wave]; }
    for (int row = r0 + wave; row < r1; row += NWAVES) {
        const unsigned e = en, s = sn; const float rstd_pre = rn;
        if (row + NWAVES < r1) { en = tokE[row + NWAVES]; sn = tokS[row + NWAVES]; rn = tokR[row + NWAVES]; }
        const unsigned p0 = base[e & 255u] + (s & 0xffffu), p1 = base[(e >> 8) & 255u] + (s >> 16);
        const float* xr = row < ML ? xl + (size_t)row * D : xc + (size_t)(row - ML) * D;
        const float rstd = rstd_pre;
        const float* mod = (const float*)(a.ws + WS_MOD) + (size_t)(l * 9 + row_modidx(row)) * 6144; const float* gain = a.in[I_NORM2] + l * D;
        f32x4 xv[4], gvv[4], s1v[4], s0v[4];
#pragma unroll
        for (int j = 0; j < 4; ++j) { xv[j] = ((const f32x4*)xr)[lane + 64 * j]; gvv[j] = ((const f32x4*)gain)[lane + 64 * j]; s1v[j] = ((const f32x4*)(mod + 4 * 1024))[lane + 64 * j]; s0v[j] = ((const f32x4*)(mod + 3 * 1024))[lane + 64 * j]; }
#pragma unroll
        for (int j = 0; j < 4; ++j) {
            const f32x4 x = xv[j], gv = gvv[j], s1 = s1v[j], s0 = s0v[j];
            const f32x4 y = (x * rstd * gv) * (s1 + 1.0f) + s0;
            u32x2 o; o.x = pk2(y.x, y.y); o.y = pk2(y.z, y.w);
            ((u32x2*)(xb + (size_t)p0 * D))[lane + 64 * j] = o; ((u32x2*)(xb + (size_t)p1 * D))[lane + 64 * j] = o;
        }
        if (lane == 0) tokP[row] = (u32x2){p0, p1};
    }
}

__device__ __forceinline__ void phase_combine(const KArgs& a, int l, int nrows) {
    const int tid = OTID(), lane = tid & 63, wave = tid >> 6;
    const int gw = OBLK() * NWAVES + wave, NGW = OGRID() * NWAVES;
    const u32x2* tokP = (const u32x2*)(a.ws + WS_TOK + TOK_POS); const f32x2* tokW = (const f32x2*)(a.ws + WS_TOK + TOK_W);
    const bf16_t* yb = (const bf16_t*)(a.ws + WS_YB); bf16_t* hl = (bf16_t*)(a.ws + WS_HL);
    u32x2 pn = (u32x2){0u, 0u}; f32x2 wn = (f32x2){0.f, 0.f};
    if (gw < nrows) { pn = tokP[gw]; wn = tokW[gw]; }
    for (int row = gw; row < nrows; row += NGW) {
        float* xr = row < ML ? a.out + (size_t)row * D : (float*)(a.ws + WS_XC) + (size_t)(row - ML) * D;
        const u32x2 p = pn; const f32x2 w = wn;
        if (row + NGW < nrows) { pn = tokP[row + NGW]; wn = tokW[row + NGW]; }
        const float* mod = (const float*)(a.ws + WS_MOD) + (size_t)(l * 9 + row_modidx(row)) * 6144;
        f32x4 v[4];
        f32x4 xv[4], g2v[4]; u32x2 y0v[4], y1v[4];
#pragma unroll
        for (int j = 0; j < 4; ++j) { xv[j] = ((const f32x4*)xr)[lane + 64 * j]; g2v[j] = ((const f32x4*)(mod + 5 * 1024))[lane + 64 * j];
            y0v[j] = ((const u32x2*)(yb + (size_t)p.x * D))[lane + 64 * j]; y1v[j] = ((const u32x2*)(yb + (size_t)p.y * D))[lane + 64 * j]; }
#pragma unroll
        for (int j = 0; j < 4; ++j) {
            const f32x4 x = xv[j], g2 = g2v[j];
            const u32x2 y0 = y0v[j], y1 = y1v[j];
            f32x4 m; m.x = w.x * bflo(y0.x) + w.y * bflo(y1.x); m.y = w.x * bfhi(y0.x) + w.y * bfhi(y1.x); m.z = w.x * bflo(y0.y) + w.y * bflo(y1.y); m.w = w.x * bfhi(y0.y) + w.y * bfhi(y1.y);
            v[j] = x + g2 * m; ((f32x4*)xr)[lane + 64 * j] = v[j];
        }
        if (l == 0) { const float* mod1 = (const float*)(a.ws + WS_MOD) + (size_t)(9 + row_modidx(row)) * 6144;
            modulate_store(v, a.in[I_NORM1] + D, mod1, mod1 + 1024, hl + (size_t)row * D, lane); }
    }
}
#ifndef MK_PER_PHASE
#define MK_PER_PHASE 0
#endif
#ifndef PROBE_DUP
#define PROBE_DUP 0
#endif
#define DUPON(k) ((PROBE_DUP >> (k)) & 1)
#define DUPBAR() do { if (use_bar) xcd_barrier(bar); } while (0)
#ifndef RERUN_K
#define RERUN_K 0
#endif
#define RERUN(k, l, ctx_out, mrows) do { if (RERUN_K == (k)) { DUPBAR(); ph_modulate1(ka, (l), MA); DUPBAR(); ph_gemm_in(ka, lds, (l)); DUPBAR(); ph_prep(ka, (l)); \
        if ((k) >= 3) { DUPBAR(); ph_mixers(ka, lds, (l), ctx_out); } if ((k) >= 4) { DUPBAR(); ph_gdnscan(ka, lds, (l), ctx_out, (l) + 2); } \
        if ((k) >= 5) { DUPBAR(); ph_post(ka, lds, (l), mrows); } } } while (0)
constexpr int NPH_LAYER = 14, NPHASES = 1 + 2 * NPH_LAYER;

#ifndef STAG_TICKS
#define STAG_TICKS 0
#endif
__device__ __forceinline__ void stagger(int mult) { const int g = (OBLK() >> 3) & 3; if (g == 0 || STAG_TICKS == 0) return; const unsigned long long lim = (unsigned long long)(g * mult);
    const unsigned long long t0 = __builtin_amdgcn_s_memrealtime(); while (__builtin_amdgcn_s_memrealtime() - t0 < lim) __builtin_amdgcn_s_sleep(4); }
__device__ NOINL void ph_prologue(KAP ka, LAS unsigned char* lds) { const KArgs a = load_kargs(ka); phase_prologue(a, lds); }
__device__ NOINL void ph_modulate1(KAP ka, int l, int nrows) { const KArgs a = load_kargs(ka); phase_modulate1(a, l, nrows); }
__device__ NOINL void ph_prep(KAP ka, int l) { const KArgs a = load_kargs(ka); phase_prep(a, l); }
__device__ NOINL void ph_mixers(KAP ka, LAS unsigned char* lds, int l, bool ctx_out) { phase_mixers(ka, lds, l, ctx_out); }
__device__ NOINL void ph_gdnscan(KAP ka, LAS unsigned char* lds, int l, bool ctx_out, int qslot) { phase_scan_attn(ka, lds, l, ctx_out, qslot); }
__device__ NOINL void ph_post(KAP ka, LAS unsigned char* lds, int l, int mrows) { { const int blk = OBLK(), G = OGRID(); const int nu = (mrows == ML) ? 32 * 32 : 32 * 34;
      for (int v = G - 1 - blk; v < nu; v += G) { const int u = (mrows == ML) ? (v >> 5) * 34 + 2 + (v & 31) : v; call_retout(ka, lds, l, u); } }
    __syncthreads(); const KArgs a = load_kargs(ka); phase_post(a, lds, l, mrows); }
__device__ NOINL void ph_gemm_in(KAP ka, LAS unsigned char* lds, int l) { const KArgs a = load_kargs(ka);
    const bf16_t* wsm = (const bf16_t*)(a.ws + WS_WSM);
    SchedPlain S; S.init(a.ws + WS_HL, 1024, wsm + WSM_IN / 2, 1024, MA, ZP, OGRID(), OBLK());
    EpiIn E{(bf16_t*)(a.ws + WS_Z), a.in[I_WQN] + l * 64, a.in[I_WKN] + l * 64, a.in[I_NQN] + l * 64, a.in[I_NKN] + l * 64, (const float*)(a.ws + WS_ROPE)};
    pg8::gemm_phase<EpiIn, SchedPlain, true>(lds, 1024, 1024, 1024, S, E); }
#ifndef PROBE_GK
#define PROBE_GK 0
#endif
__device__ NOINL void ph_gemm_in_probe(KAP ka, LAS unsigned char* lds, int l) { const KArgs a = load_kargs(ka);
    const bf16_t* wsm = (const bf16_t*)(a.ws + WS_WSM);
    SchedPlain S; S.init(a.ws + WS_HL, 1024, wsm + WSM_IN / 2, 1024, MA, ZP, OGRID(), OBLK());
    EpiStore<0> E{(bf16_t*)(a.ws + WS_Z), ZP};
    pg8::gemm_phase<EpiStore<0>, SchedPlain, true>(lds, PROBE_GK, 1024, 1024, S, E); }
__device__ NOINL void ph_gemm_gate(KAP ka, LAS unsigned char* lds, int l, int mrows) { const KArgs a = load_kargs(ka);
    const bf16_t* wsm = (const bf16_t*)(a.ws + WS_WSM);
    SchedPlain S; S.init(a.ws + WS_HL, 1024, wsm + WSM_MERGE / 2, 1024, mrows, 4096, OGRID(), OBLK());
    EpiGateF E{(bf16_t*)(a.ws + WS_Z)};
    pg8::gemm_phase<EpiGateF, SchedPlain, true>(lds, 1024, 1024, 1024, S, E); }
__device__ NOINL void ph_gemm_branch(KAP ka, LAS unsigned char* lds, int l, int mrows) { const KArgs a = load_kargs(ka);
    const bf16_t* wsm = (const bf16_t*)(a.ws + WS_WSM);
    SchedBranch S{(const char*)(a.ws + WS_Z), (const char*)(wsm + WSM_BR / 2), (mrows / 256) * 4, OGRID(), OBLK()};
    EpiBranch E{(bf16_t*)(a.ws + WS_HL), (const bf16_t*)(a.ws + WS_Z)};
    pg8::gemm_phase<EpiBranch, SchedBranch, true>(lds, 512, ZP, 512, S, E); }
__device__ NOINL void ph_gemm_out(KAP ka, LAS unsigned char* lds, int l, int mrows) { const KArgs a = load_kargs(ka);
    const bf16_t* wsm = (const bf16_t*)(a.ws + WS_WSM);
    SchedPlain S; S.init(a.ws + WS_HL, 1024, wsm + WSM_OUT / 2, 1024, mrows, 1024, OGRID(), OBLK());
    EpiResid E{l == 0 ? a.in[I_X] : a.out, l == 0 ? a.in[I_CTX] : (const float*)(a.ws + WS_XC), a.out, (float*)(a.ws + WS_XC), (const float*)(a.ws + WS_MOD) + (size_t)l * 9 * 6144 + 2 * 1024};
    pg8::gemm_phase<EpiResid, SchedPlain, true>(lds, 1024, 1024, 1024, S, E); }
#ifndef EXPC_SPLIT
#define EXPC_SPLIT 14000
#endif
__device__ NOINL void ph_expconv(KAP ka, LAS unsigned char* lds, int l, int lo, int hi, int blk0) { const KArgs a = load_kargs(ka); expert_convert_range(a, lds, l, lo, hi, blk0); }
__device__ NOINL void ph_route(KAP ka, LAS unsigned char* lds, int l, int mrows) { const KArgs a = load_kargs(ka); phase_route(a, lds, l, mrows); if (l == 0) { __syncthreads(); small_weight_convert(a, lds, 1); } }
__device__ NOINL void ph_gather(KAP ka, LAS unsigned char* lds, int l, int mrows) { const KArgs a = load_kargs(ka); phase_gather(a, lds, l, mrows); }
__device__ NOINL void ph_gemm_gu(KAP ka, LAS unsigned char* lds) { const KArgs a = load_kargs(ka);
    const int* tile_e = (const int*)(a.ws + WS_TOK + TOK_TILE);
    SchedMoe S; S.A0 = (const char*)(a.ws + WS_XB); S.W0 = (const char*)(a.ws + WS_WGU); S.tile_start = tile_e; S.tA = (size_t)256 * 1024 * 2; S.eB = (size_t)1024 * 1024 * 2; S.tB = (size_t)256 * 1024 * 2; S.G = OGRID(); S.c = OBLK(); S.init();
    EpiAct E{(bf16_t*)(a.ws + WS_ACT)};
    pg8::gemm_phase<EpiAct, SchedMoe, true>(lds, 1024, 1024, 1024, S, E); }
__device__ NOINL void ph_gemm_dn(KAP ka, LAS unsigned char* lds) { const KArgs a = load_kargs(ka);
    const int* tile_e = (const int*)(a.ws + WS_TOK + TOK_TILE);
    SchedMoe S; S.A0 = (const char*)(a.ws + WS_ACT); S.W0 = (const char*)(a.ws + WS_WDN); S.tile_start = tile_e; S.tA = (size_t)256 * 512 * 2; S.eB = (size_t)1024 * 512 * 2; S.tB = (size_t)256 * 512 * 2; S.G = OGRID(); S.c = OBLK(); S.init();
    EpiStore<0> E{(bf16_t*)(a.ws + WS_YB), 1024};
    pg8::gemm_phase<EpiStore<0>, SchedMoe, true>(lds, 512, 512, 512, S, E); }
__device__ NOINL void ph_combine(KAP ka, int l, int mrows) { const KArgs a = load_kargs(ka); phase_combine(a, l, mrows); }

__global__ void __launch_bounds__(NTHR, 2) fwd_kernel(KArgs a) {
    extern __shared__ __attribute__((aligned(16))) unsigned char lds_raw[];
    LAS unsigned char* lds = (LAS unsigned char*)lds_raw;
    KAP ka = (KAP)__builtin_amdgcn_kernarg_segment_ptr();
    const int tid = OTID();
    volatile LAS unsigned* ctlw = (volatile LAS unsigned*)(lds + LDS_CTL);
    if (tid < 64) ctlw[tid] = 0u;
    __syncthreads();
    const int lo = a.ph_lo, hi = a.ph_hi;
    const bool use_bar = (hi - lo) > 1;
    XcdBarrier bar; bar.bar = (unsigned*)(a.ws + WS_CTL) + CW_BAR; bar.x = 0u; bar.st = ctlw + 8;
    if (use_bar) bar = xcd_barrier_post((unsigned*)(a.ws + WS_CTL) + CW_BAR, ctlw + 8);
#define IN(k) (lo <= (k) && (k) < hi)
#define SEAM(k) do { if (use_bar && (k) + 1 < hi) xcd_barrier(bar); } while (0)
    if (IN(0)) { ph_prologue(ka, lds); SEAM(0); }
#define LAYER_BODY(l) do { \
        constexpr int pb = 1 + (l) * NPH_LAYER; constexpr bool ctx_out = ((l) == 0); constexpr int mrows = ctx_out ? MA : ML; \
        if ((l) == 0 && IN(pb + 0)) { ph_modulate1(ka, (l), MA); SEAM(pb + 0); }     \
        if (IN(pb + 1)) { if (PROBE_GK) { ph_gemm_in_probe(ka, lds, (l)); DUPBAR(); } ph_gemm_in(ka, lds, (l)); if (RERUN_K == 1) { DUPBAR(); ph_modulate1(ka, (l), MA); DUPBAR(); ph_gemm_in(ka, lds, (l)); } SEAM(pb + 1); } \
        if (IN(pb + 2)) { ph_prep(ka, (l)); RERUN(2, l, ctx_out, mrows); SEAM(pb + 2); } \
        if (IN(pb + 3)) { ph_mixers(ka, lds, (l), ctx_out); RERUN(3, l, ctx_out, mrows); SEAM(pb + 3); } \
        if (IN(pb + 4)) { ph_gdnscan(ka, lds, (l), ctx_out, (l)); RERUN(4, l, ctx_out, mrows); SEAM(pb + 4); } \
        if (IN(pb + 5)) { ph_post(ka, lds, (l), mrows); RERUN(5, l, ctx_out, mrows); SEAM(pb + 5); } \
        if (IN(pb + 6)) { ph_gemm_gate(ka, lds, (l), mrows); if ((l) == 0) ph_expconv(ka, lds, (l), 0, 4400, 128); SEAM(pb + 6); } \
        if (IN(pb + 7)) { ph_gemm_branch(ka, lds, (l), mrows); if ((l) == 0) ph_expconv(ka, lds, (l), 4400, 4400 + EXPC_SPLIT, 32); SEAM(pb + 7); } \
        if (IN(pb + 8)) { ph_gemm_out(ka, lds, (l), mrows); ph_expconv(ka, lds, (l), (l) == 0 ? 4400 + EXPC_SPLIT : 0, EXPC_ITEMS, (l) == 0 ? 32 : 0);     SEAM(pb + 8); } \
        if (IN(pb + 9)) { ph_route(ka, lds, (l), mrows); if (DUPON(9)) { DUPBAR(); ph_route(ka, lds, (l), mrows); } SEAM(pb + 9); } \
        if (IN(pb + 10)) { ph_gather(ka, lds, (l), mrows); if (DUPON(10)) { DUPBAR(); ph_gather(ka, lds, (l), mrows); } SEAM(pb + 10); } \
        if (IN(pb + 11)) { ph_gemm_gu(ka, lds); if (DUPON(11)) { DUPBAR(); ph_gemm_gu(ka, lds); } SEAM(pb + 11); } \
        if (IN(pb + 12)) { ph_gemm_dn(ka, lds); if (DUPON(12)) { DUPBAR(); ph_gemm_dn(ka, lds); } if (RERUN_K == 12) { DUPBAR(); ph_route(ka, lds, (l), mrows); DUPBAR(); ph_gather(ka, lds, (l), mrows); DUPBAR(); ph_gemm_gu(ka, lds); DUPBAR(); ph_gemm_dn(ka, lds); } SEAM(pb + 12); } \
        if (IN(pb + 13)) { ph_combine(ka, (l), mrows); SEAM(pb + 13); } \
    } while (0)
    LAYER_BODY(0);
    LAYER_BODY(1);
#undef LAYER_BODY
#undef IN
#undef SEAM
}

extern "C" void kernel_launch(void* const* d_in, const int* in_sizes, int n_in, void* d_out, int out_size, void* d_ws, size_t ws_size, hipStream_t stream) {
    static int grid = 0;
    if (grid == 0) {
        if (n_in != 29 || in_sizes[0] != ML * D || out_size != ML * D || ws_size < WS_END) {
            fprintf(stderr, "kernel_launch: unexpected problem (n_in %d, in0 %d, out %d, ws %zu < %zu); nothing launched\n", n_in, n_in > 0 ? in_sizes[0] : -1, out_size, ws_size, (size_t)WS_END); grid = -1; return; }
        int dev = 0, cus = 0, per_cu = 0;
        if (hipGetDevice(&dev) != hipSuccess || hipDeviceGetAttribute(&cus, hipDeviceAttributeMultiprocessorCount, dev) != hipSuccess) { grid = -1; return; }
        if (hipFuncSetAttribute((const void*)fwd_kernel, hipFuncAttributeMaxDynamicSharedMemorySize, LDS_BYTES) != hipSuccess) { fprintf(stderr, "kernel_launch: hipFuncSetAttribute failed\n"); grid = -1; return; }
        if (hipOccupancyMaxActiveBlocksPerMultiprocessor(&per_cu, (const void*)fwd_kernel, NTHR, LDS_BYTES) != hipSuccess || per_cu < 1) {
            fprintf(stderr, "kernel_launch: occupancy query says %d workgroups per CU\n", per_cu); }
        (void)hipGetLastError();
        grid = cus;
        if (grid > 256) grid = 256;
    }
    if (grid < 0) return;
    if (hipMemsetAsync((char*)d_ws + WS_CTL, 0, CTL_ZERO_BYTES, stream) != hipSuccess) return;
    KArgs a{};
    for (int i = 0; i < 29; ++i) a.in[i] = (const float*)d_in[i];
    a.out = (float*)d_out; a.ws = (unsigned char*)d_ws;
#if MK_PER_PHASE
    for (int k = 0; k < NPHASES; ++k) { if (k == 1 + NPH_LAYER) continue; a.ph_lo = k; a.ph_hi = k + 1; hipLaunchKernelGGL(fwd_kernel, dim3(grid), dim3(NTHR), LDS_BYTES, stream, a); }
#else
    a.ph_lo = 0; a.ph_hi = NPHASES;
    hipLaunchKernelGGL(fwd_kernel, dim3(grid), dim3(NTHR), LDS_BYTES, stream, a);
#endif
}
```

```cpp
#include <hip/hip_runtime.h>
#include <cstdio>
#include <cstdint>

#define LAS __attribute__((address_space(3)))
#define GAS __attribute__((address_space(1)))
typedef unsigned short bf16_t;
typedef short bf16x8 __attribute__((ext_vector_type(8)));
typedef short s16x4 __attribute__((ext_vector_type(4)));
typedef float f32x4 __attribute__((ext_vector_type(4)));
typedef float f32x2 __attribute__((ext_vector_type(2)));
typedef unsigned u32x4 __attribute__((ext_vector_type(4)));
typedef unsigned u32x2 __attribute__((ext_vector_type(2)));

typedef __bf16 bf16x2_t __attribute__((ext_vector_type(2)));
__device__ __forceinline__ unsigned pk2(float lo, float hi) { const f32x2 v = {lo, hi}; const bf16x2_t b = __builtin_convertvector(v, bf16x2_t); return __builtin_bit_cast(unsigned, b); }
__device__ __forceinline__ unsigned f2bf(float f) { return pk2(f, f) & 0xffffu; }
__device__ __forceinline__ float bflo(unsigned u) { return __builtin_bit_cast(float, u << 16); }
__device__ __forceinline__ float bfhi(unsigned u) { return __builtin_bit_cast(float, u & 0xffff0000u); }
__device__ __forceinline__ float bf2f(bf16_t h) { return __builtin_bit_cast(float, (unsigned)h << 16); }
__device__ __forceinline__ float sigmoidf_(float x) { return 1.0f / (1.0f + __expf(-x)); }
__device__ __forceinline__ float siluf_(float x) { return x / (1.0f + __expf(-x)); }
__device__ __forceinline__ float sigmoid_fast(float x) { return __builtin_amdgcn_rcpf(1.0f + __expf(-x)); }
__device__ __forceinline__ float silu_fast(float x) { return x * __builtin_amdgcn_rcpf(1.0f + __expf(-x)); }

__device__ __forceinline__ bf16x8 cat8(u32x2 lo, u32x2 hi) { u32x4 w; w.x = lo.x; w.y = lo.y; w.z = hi.x; w.w = hi.y; return __builtin_bit_cast(bf16x8, w); }
__device__ __forceinline__ int OTID() { int t = threadIdx.x; asm volatile("" : "+v"(t)); return t; }
__device__ __forceinline__ int OBLK() { int t = blockIdx.x; asm volatile("" : "+s"(t)); return t; }
__device__ __forceinline__ int OGRID() { int t = gridDim.x; asm volatile("" : "+s"(t)); return t; }

namespace pg8 {
constexpr int BM = 256, BK = 64, HALF = 128, HTB = HALF * BK * 2, STAGE_BYTES = 8 * HTB, NXCD = 8, WGM = 8;
__host__ __device__ __forceinline__ int lds_byte(int r, int c) { const int st = (r >> 4) * 2 + (c >> 5), rr = r & 15, cc = c & 31, ob = rr * 64 + cc * 2; return st * 1024 + (ob ^ (((ob >> 9) & 1) << 5)); }
__host__ __device__ __forceinline__ void stage_rc(int b, int& R, int& C) { const int st = b / 1024, sb = b % 1024, swz = sb ^ (((sb >> 9) & 1) << 5); R = (st >> 1) * 16 + swz / 64; C = (st & 1) * 32 + (swz % 64) / 2; }
__host__ __device__ __forceinline__ int perm32(int rho) { const int n = rho >> 4, i = rho & 15; return 8 * (i >> 2) + 4 * n + (i & 3); }

struct Unit { int pm, pn, aux; };

template <class Epi, class Sched, bool ALIGN_EPI>
__device__ __forceinline__ void gemm_phase(LAS unsigned char* lds, const int K, const int lda, const int ldb, const Sched& S, const Epi& E) {
    const int tid = OTID(), wid = __builtin_amdgcn_readfirstlane(tid >> 6), lane = tid & 63, wr = wid >> 2, wc = wid & 3, fr = lane & 15, fq = lane >> 4;
    const int nt = K / BK;
    unsigned voffA[2], voffB[2];
#pragma unroll
    for (int i = 0; i < 2; ++i) { int R, C; stage_rc(tid * 16 + i * 8192, R, C); const int Rb = (R & ~31) + perm32(R & 31);
        voffA[i] = (unsigned)(R * lda + C) * 2u; voffB[i] = (unsigned)(Rb * ldb + C) * 2u; }
    const size_t kstep = (size_t)(BK * 2);
    const size_t hstepA = (size_t)HALF * lda * 2, hstepB = (size_t)HALF * ldb * 2;
    const unsigned ldsw = (unsigned)wid * 1024u;
    const int aoff = lds_byte(wr * 64 + fr, fq * 8), boff = lds_byte(wc * 32 + fr, fq * 8);
#define PG8_SA(b, h) (((b) * 2 + (h)) * HTB)
#define PG8_SB(b, h) ((4 + (b) * 2 + (h)) * HTB)
#define PG8_STAGE(bufoff, gbase, voff) do { _Pragma("unroll") for (int _i = 0; _i < 2; ++_i) \
        __builtin_amdgcn_global_load_lds((const unsigned*)((const char*)(gbase) + (voff)[_i]), (LAS unsigned*)(lds + (bufoff) + ldsw + _i * 8192), 16, 0, 0); } while (0)
#define PG8_LDA(dst, b, h) do { _Pragma("unroll") for (int m = 0; m < 4; ++m) _Pragma("unroll") for (int k = 0; k < 2; ++k) dst[m][k] = *(const LAS bf16x8*)(lds + PG8_SA(b, h) + aoff + m * 2048 + k * 1024); } while (0)
#define PG8_LDB(dst, b, h) do { _Pragma("unroll") for (int n = 0; n < 2; ++n) _Pragma("unroll") for (int k = 0; k < 2; ++k) dst[n][k] = *(const LAS bf16x8*)(lds + PG8_SB(b, h) + boff + n * 2048 + k * 1024); } while (0)
#define PG8_MMA(ai, bj, At, Bt) do { __builtin_amdgcn_s_setprio(1); _Pragma("unroll") for (int m = 0; m < 4; ++m) _Pragma("unroll") for (int n = 0; n < 2; ++n) _Pragma("unroll") for (int k = 0; k < 2; ++k) \
        acc[ai][bj][m][n] = __builtin_amdgcn_mfma_f32_16x16x32_bf16(Bt[n][k], At[m][k], acc[ai][bj][m][n], 0, 0, 0); __builtin_amdgcn_s_setprio(0); } while (0)
#define PG8_WAIT_V(n) asm volatile("s_waitcnt vmcnt(" #n ")" ::: "memory")
#define PG8_WAIT_L(n) asm volatile("s_waitcnt lgkmcnt(" #n ")" ::: "memory")
#define PG8_BAR __builtin_amdgcn_s_barrier()
#define PG8_SCHED __builtin_amdgcn_sched_barrier(0)
    Unit cur, nxt; int ui = 0;
    if (!S.next(0, cur)) return;
    f32x4 acc[2][2][4][2];
#pragma unroll
    for (int a = 0; a < 2; ++a)
#pragma unroll
        for (int b = 0; b < 2; ++b)
#pragma unroll
            for (int m = 0; m < 4; ++m)
#pragma unroll
                for (int n = 0; n < 2; ++n) acc[a][b][m][n] = (f32x4){0.f, 0.f, 0.f, 0.f};
    bf16x8 At[4][2], B0[2][2], B1[2][2];
    const char* cA = S.A(cur); const char* cB = S.B(cur);
    PG8_STAGE(PG8_SB(0, 0), cB, voffB); PG8_STAGE(PG8_SB(0, 1), cB + hstepB, voffB); PG8_STAGE(PG8_SA(0, 0), cA, voffA); PG8_STAGE(PG8_SA(0, 1), cA + hstepA, voffA);
    if (wr == 1) PG8_BAR;
    PG8_WAIT_V(2); PG8_BAR;
    PG8_STAGE(PG8_SB(1, 0), cB + kstep, voffB); PG8_STAGE(PG8_SA(1, 0), cA + kstep, voffA); PG8_STAGE(PG8_SB(1, 1), cB + hstepB + kstep, voffB);
    PG8_WAIT_V(6); PG8_BAR;
    for (;;) {
        const bool has_next = S.next(ui + 1, nxt);
        const char* nA = has_next ? S.A(nxt) : cA; const char* nB = has_next ? S.B(nxt) : cB;
        for (int t = 0; t < nt; t += 2) {
            const bool last = (t == nt - 2);
            const char* a1 = cA + (size_t)(t + 1) * kstep;
            const char* a2 = last ? nA : cA + (size_t)(t + 2) * kstep; const char* b2 = last ? nB : cB + (size_t)(t + 2) * kstep;
            const char* a3 = a2 + kstep; const char* b3 = b2 + kstep;
            PG8_LDB(B0, 0, 0); PG8_LDB(B1, 0, 1); PG8_SCHED; PG8_LDA(At, 0, 0); PG8_STAGE(PG8_SA(1, 1), a1 + hstepA, voffA);
            PG8_WAIT_V(8); PG8_WAIT_L(0); PG8_BAR; PG8_MMA(0, 0, At, B0); PG8_MMA(0, 1, At, B1); PG8_BAR; PG8_SCHED;
            PG8_LDA(At, 0, 1); PG8_STAGE(PG8_SB(0, 0), b2, voffB); PG8_STAGE(PG8_SB(0, 1), b2 + hstepB, voffB); PG8_STAGE(PG8_SA(0, 0), a2, voffA);
            PG8_WAIT_V(8); PG8_WAIT_L(0); PG8_BAR; PG8_MMA(1, 0, At, B0); PG8_MMA(1, 1, At, B1); PG8_BAR; PG8_SCHED;
            PG8_LDB(B0, 1, 0); PG8_LDB(B1, 1, 1); PG8_SCHED; PG8_LDA(At, 1, 0); PG8_STAGE(PG8_SA(0, 1), a2 + hstepA, voffA);
            PG8_WAIT_V(8); PG8_WAIT_L(0); PG8_BAR; PG8_MMA(0, 0, At, B0); PG8_MMA(0, 1, At, B1); PG8_BAR; PG8_SCHED;
            PG8_LDA(At, 1, 1); PG8_STAGE(PG8_SB(1, 0), b3, voffB); PG8_STAGE(PG8_SB(1, 1), b3 + hstepB, voffB); PG8_STAGE(PG8_SA(1, 0), a3, voffA);
            PG8_WAIT_V(8); PG8_WAIT_L(0); PG8_BAR; PG8_MMA(1, 0, At, B0); PG8_MMA(1, 1, At, B1); PG8_BAR; PG8_SCHED;
        }
        if constexpr (ALIGN_EPI) { if (wr == 0) PG8_BAR; }
        E(acc, cur, wr, wc, fr, fq);
        if (!has_next) break;
        if constexpr (!Epi::INPLACE) {
#pragma unroll
        for (int a = 0; a < 2; ++a)
#pragma unroll
            for (int b = 0; b < 2; ++b)
#pragma unroll
                for (int m = 0; m < 4; ++m)
#pragma unroll
                    for (int n = 0; n < 2; ++n) acc[a][b][m][n] = (f32x4){0.f, 0.f, 0.f, 0.f};
        }
        cur = nxt; cA = nA; cB = nB; ++ui;
        if constexpr (ALIGN_EPI) { if (wr == 1) PG8_BAR; }
    }
    PG8_WAIT_V(0);
    if constexpr (!ALIGN_EPI) { if (wr == 0) PG8_BAR; }
    PG8_BAR;
#undef PG8_SA
#undef PG8_SB
#undef PG8_STAGE
#undef PG8_LDA
#undef PG8_LDB
#undef PG8_MMA
#undef PG8_WAIT_V
#undef PG8_WAIT_L
#undef PG8_BAR
#undef PG8_SCHED
}
}
#define XB_TMO      128
#define XB_XCNT(j)  (256  + 64 * (j))
#define XB_XSUB(j)  (1280 + 64 * (j))
#define XB_XGEN(j)  (2304 + 64 * (j))
#define XB_TOP      3328
#define XB_TOPGEN   3392
#define XCD_BAR_WORDS 3456
#define XB_SPIN_CAP (1u << 22)
__device__ __forceinline__ unsigned xb_ld(unsigned* p)              { return __hip_atomic_load(p, __ATOMIC_RELAXED, __HIP_MEMORY_SCOPE_AGENT); }
__device__ __forceinline__ unsigned xb_add(unsigned* p, unsigned v) { return __hip_atomic_fetch_add(p, v, __ATOMIC_RELAXED, __HIP_MEMORY_SCOPE_AGENT); }
__device__ __forceinline__ unsigned xb_xcc_id() { return (unsigned)__builtin_amdgcn_s_getreg((3 << 11) | 20) & 0xFu; }
#define XB_SPIN(cond, bar) do { unsigned _sp = 0; while (cond) { __builtin_amdgcn_s_sleep(1); \
    if ((++_sp & 255u) == 0u) { if (xb_ld(&(bar)[XB_TMO])) break; if (_sp > XB_SPIN_CAP) { atomicAdd(&(bar)[XB_TMO], 1u); break; } } } } while (0)
struct XcdBarrier { unsigned* bar; unsigned x; volatile LAS unsigned* st; };
__device__ __forceinline__ XcdBarrier xcd_barrier_post(unsigned* bar, volatile LAS unsigned* st) {
    XcdBarrier b; b.bar = bar; b.x = xb_xcc_id(); b.st = st;
    if (threadIdx.x == 0) (void)xb_add(&bar[XB_XCNT(b.x)], 1u);
    return b;
}
__device__ __forceinline__ void xcd_barrier_complete(unsigned* bar, unsigned x, unsigned& nloc, unsigned& nx) {
    const unsigned G = gridDim.x * gridDim.y * gridDim.z;
    unsigned sum, cnt, mine, sp = 0u;
    for (;;) {
        sum = 0u; cnt = 0u; mine = 0u;
#pragma unroll 1
        for (unsigned j = 0; j < 16; ++j) { const unsigned c = xb_ld(&bar[XB_XCNT(j)]); sum += c; cnt += (c > 0u) ? 1u : 0u; mine = (j == x) ? c : mine; }
        if (sum == G) break;
        __builtin_amdgcn_s_sleep(1);
        if ((++sp & 255u) == 0u) { if (xb_ld(&bar[XB_TMO])) break; if (sp > XB_SPIN_CAP) { atomicAdd(&bar[XB_TMO], 1u); break; } }
    }
    nloc = mine > 0u ? mine : 1u; nx = cnt > 0u ? cnt : 1u;
}
__device__ __forceinline__ void xcd_barrier_impl(unsigned* bbar, unsigned bx, volatile LAS unsigned* bst) {
    XcdBarrier b; b.bar = bbar; b.x = bx; b.st = bst;
    asm volatile("s_waitcnt vmcnt(0)" ::: "memory");
    __syncthreads();
    if (threadIdx.x == 0) {
        unsigned* bar = b.bar;
        __builtin_amdgcn_s_waitcnt(0);
        unsigned nloc = b.st[0], nx = b.st[1];
        if (nloc == 0u) { xcd_barrier_complete(bar, b.x, nloc, nx); b.st[0] = nloc; b.st[1] = nx; }
        const unsigned old = xb_add(&bar[XB_XSUB(b.x)], 1u);
        const unsigned gen = old / nloc;
        if (old + 1u == (gen + 1u) * nloc) {
            __builtin_amdgcn_fence(__ATOMIC_RELEASE, "agent");
            asm volatile("s_waitcnt vmcnt(0)" ::: "memory");
            const unsigned og = xb_add(&bar[XB_TOP], 1u);
            const unsigned tg = og / nx;
            if (og + 1u == (tg + 1u) * nx) xb_add(&bar[XB_TOPGEN], 1u);
            else XB_SPIN(xb_ld(&bar[XB_TOPGEN]) == tg, bar);
            __builtin_amdgcn_fence(__ATOMIC_ACQUIRE, "agent");
            xb_add(&bar[XB_XGEN(b.x)], 1u);
            asm volatile("s_waitcnt vmcnt(0)" ::: "memory");
        } else {
            XB_SPIN(xb_ld(&bar[XB_XGEN(b.x)]) == gen, bar);
            __builtin_amdgcn_fence(__ATOMIC_ACQUIRE, "agent");
            asm volatile("s_waitcnt vmcnt(0)" ::: "memory");
        }
    }
    __syncthreads();
}
__device__ __forceinline__ void xcd_barrier(const XcdBarrier& b) { xcd_barrier_impl(b.bar, b.x, b.st); }

constexpr int D = 1024, NBATCH = 8, SEQ = 4096, CTXL = 256, ML = NBATCH * SEQ, MC = NBATCH * CTXL, MA = ML + MC;
constexpr int ZP = 6144, PP = 1536;
constexpr int C_RQ = 0, C_RK = 256, C_RV = 512, C_RG = 1024, C_WQ = 1536, C_WK = 2048, C_WV = 2176, C_NQ = 2304, C_NK = 2816, C_NV = 3328,
              C_GQ = 3840, C_GK = 4352, C_GV = 4864, C_GG = 5376, C_GA = 5888, C_GB = 5896;
constexpr int C_GSUM = 3840;
constexpr int Y_RET = C_RG, Y_WIN = C_WQ, Y_NA = C_NQ, Y_GDN = C_GG;
__host__ __device__ __forceinline__ int dead_tile(int gt) { return gt < 4 ? gt : (gt == 4 ? 8 : (gt < 15 ? gt + 6 : 23)); }
__device__ __forceinline__ int utile_off(int i, int col) { const int a_ = i >> 5, g_ = (i >> 3) & 3, p_ = (i >> 2) & 1, j_ = i & 3; const int rt_ = 2 * a_ + p_, lane_ = 16 * g_ + (col & 15), ch_ = col >> 6, c_ = (col >> 4) & 3;
    return ((((rt_ * 2 + ch_) * 64 + lane_) * 4 + c_) * 4 + j_); }
constexpr float EPS = 1e-6f;
constexpr int NEXP = 32, DEXP = 512, MAXT = 304;
constexpr int NWAVES = 8, NTHR = 512;

constexpr size_t MiB = 1u << 20;
constexpr size_t WS_CTL = 0, CTL_ZERO_BYTES = 1 * MiB;
constexpr size_t WS_ROPE = 1 * MiB;
constexpr size_t WS_MOD = 2 * MiB;
constexpr size_t WS_XC = 3 * MiB;
constexpr size_t WS_GB = 11 * MiB;
constexpr size_t WS_TOK = 14 * MiB;
constexpr size_t WS_WSM = 16 * MiB;
constexpr size_t WSM_IN = 0, WSM_MERGE = 12 * MiB, WSM_BR = 20 * MiB, WSM_OUT = 24 * MiB;
constexpr size_t WS_KVT = 42 * MiB;
constexpr size_t WS_HL = 76 * MiB;
constexpr size_t WS_Z = 144 * MiB;
constexpr size_t WS_P = 552 * MiB;
constexpr size_t WS_GC2 = 654 * MiB;
constexpr size_t WS_END = 656 * MiB;
constexpr size_t WS_WGU = WS_P, WS_WDN = WS_P + 64 * MiB;
constexpr size_t WS_XB = WS_Z, WS_ACT = WS_Z + 152 * MiB, WS_YB = WS_Z + 228 * MiB;
static_assert(WS_YB + (size_t)MAXT * 256 * 1024 * 2 <= WS_P && WS_WDN + (size_t)32 * 1024 * 512 * 2 <= WS_P + (size_t)MA * PP * 2, "moe overlay");
static_assert(WS_HL + (size_t)MA * 1024 * 2 <= WS_Z && WS_Z + (size_t)MA * ZP * 2 <= WS_P && WS_P + (size_t)MA * PP * 2 <= WS_END, "ws map");
constexpr size_t TOK_E = 0, TOK_SLOT = 256 * 1024, TOK_W = 512 * 1024, TOK_POS = 1024 * 1024, TOK_BCNT = 1536 * 1024, TOK_TILE = 1600 * 1024, TOK_RSTD = 1664 * 1024;
constexpr int CW_BAR = 1024;

constexpr int LDS_BYTES = 163840 - 1024;
constexpr int LDS_CTL = LDS_BYTES - 256;
struct KArgs { const float* in[29]; float* out; unsigned char* ws; int ph_lo, ph_hi; };
enum { I_X = 0, I_C, I_CTX, I_CCTX, I_WMOD, I_BMOD, I_NORM1, I_NORM2, I_WIN, I_RDECAY, I_RGN, I_WQN, I_WKN, I_WSINK, I_NQN, I_NKN, I_RPB, I_GCONV, I_GALOG, I_GDT, I_GNORM,
       I_WBR, I_WMERGE, I_WOUT, I_WROUTER, I_RBIAS, I_WEG, I_WEU, I_WED };

__device__ __forceinline__ float wave_sum(float v) {
#pragma unroll
    for (int o = 1; o < 64; o <<= 1) v += __shfl_xor(v, o);
    return v;
}
__device__ __forceinline__ float sum16(float v) { v += __shfl_xor(v, 1); v += __shfl_xor(v, 2); v += __shfl_xor(v, 4); v += __shfl_xor(v, 8); return v; }
#define LDS_WAIT() asm volatile("s_waitcnt lgkmcnt(0)" ::: "memory")

__device__ __forceinline__ int merge_row(int sc) { const int br = sc >> 10, oc = sc & 1023; return (oc >> 6) * 256 + (br >> 1) * 128 + ((oc >> 4) & 3) * 32 + ((oc >> 2) & 3) * 8 + (br & 1) * 4 + (oc & 3); }
__host__ __device__ __forceinline__ bool win_head_tile(int t) { return t < 2 || (t >= 6 && t <= 12); }
__device__ __forceinline__ int win_row(int sc) { const int t = sc >> 8, w = sc & 255; return win_head_tile(t) ? (sc & ~255) + ((w >> 5) & 1) * 128 + (w >> 6) * 32 + (w & 31) : sc; }
template <int MERGE = 0>
__device__ __forceinline__ void transpose_item(const float* W, int ldw, int ncols, int k0, int n0, bf16_t* WT, int ldt, int dst_row0, LAS float* scr, int lane) {
    const int nn = n0 + (lane & 31);
    { float v[32]; const float* wp = W + (size_t)(k0 + (lane >> 5)) * ldw + (nn < ncols ? nn : 0);
#pragma unroll
      for (int i = 0; i < 32; ++i) v[i] = wp[(size_t)(2 * i) * ldw];
#pragma unroll
      for (int i = 0; i < 32; ++i) { const int kk = 2 * i + (lane >> 5); scr[kk * 33 + (lane & 31)] = (nn < ncols) ? v[i] : 0.f; } }
    LDS_WAIT(); asm volatile("" ::: "memory");
    const int c = lane & 7;
#pragma unroll
    for (int j = 0; j < 4; ++j) { const int n = (lane >> 3) + 8 * j; const LAS float* s = scr + (8 * c) * 33 + n;
        u32x4 o; o.x = pk2(s[0 * 33], s[1 * 33]); o.y = pk2(s[2 * 33], s[3 * 33]); o.z = pk2(s[4 * 33], s[5 * 33]); o.w = pk2(s[6 * 33], s[7 * 33]);
        *(u32x4*)(WT + (size_t)(MERGE == 1 ? merge_row(dst_row0 + n) : (MERGE == 2 ? win_row(dst_row0 + n) : dst_row0 + n)) * ldt + k0 + 8 * c) = o; }
    LDS_WAIT(); asm volatile("" ::: "memory");
}

__device__ __forceinline__ void small_weight_convert(const KArgs& a, LAS unsigned char* lds, int l) {
    const int tid = OTID(), lane = tid & 63, wave = tid >> 6, G = OGRID(), blk = OBLK();
    unsigned char* ws = a.ws;
    LAS float* scr = (LAS float*)(lds + 65536 + wave * 8448);
    const int gw = blk * NWAVES + wave, NGW = G * NWAVES;
    constexpr int I_IN = 16 * 192, I_MG = 16 * 128, I_BR = 4 * 8 * 32, I_OUT = 16 * 32, I_LAYER = I_IN + I_MG + I_BR + I_OUT;
    bf16_t* wsm = (bf16_t*)(ws + WS_WSM);
    for (int it = gw; it < I_LAYER; it += NGW) {
        int r = it;
        if (r < I_IN) { const int kb = r / 192, nb = r % 192; transpose_item<2>(a.in[I_WIN] + (size_t)l * 1024 * 5904, 5904, 5904, kb * 64, nb * 32, wsm + WSM_IN / 2, 1024, nb * 32, scr, lane); continue; } r -= I_IN;
        if (r < I_MG) { const int kb = r / 128, nb = r % 128; transpose_item<1>(a.in[I_WMERGE] + (size_t)l * 1024 * 4096, 4096, 4096, kb * 64, nb * 32, wsm + WSM_MERGE / 2, 1024, nb * 32, scr, lane); continue; } r -= I_MG;
        if (r < I_BR) { const int br = r / 256, q = r % 256, kb = q / 32, nb = q % 32;
            transpose_item(a.in[I_WBR] + (size_t)(l * 4 + br) * 512 * 1024, 1024, 1024, kb * 64, nb * 32, wsm + WSM_BR / 2 + (size_t)br * 1024 * 512, 512, nb * 32, scr, lane); continue; } r -= I_BR;
        { const int kb = r / 32, nb = r % 32; transpose_item(a.in[I_WOUT] + (size_t)l * 1024 * 1024, 1024, 1024, kb * 64, nb * 32, wsm + WSM_OUT / 2, 1024, nb * 32, scr, lane); }
    }
}

__device__ __forceinline__ void phase_prologue(const KArgs& a, LAS unsigned char* lds) {
    const int tid = OTID(), lane = tid & 63, wave = tid >> 6, G = OGRID(), blk = OBLK();
    unsigned char* ws = a.ws;
    { float* cs = (float*)(ws + WS_ROPE); float* sn = cs + 4096 * 32;
      for (int idx = blk * NTHR + tid; idx < 4096 * 32; idx += G * NTHR) { const int t = idx >> 5, i = idx & 31; const float pos = (float)((i < 16) ? (t >> 6) : (t & 63));
          const float inv = exp2f(-(float)(i & 15) * (13.287712379549449f / 16.0f)); const float ang = pos * inv; cs[idx] = cosf(ang); sn[idx] = sinf(ang); } }
    if (blk < 192) {
        const int l = blk / 96, cg = blk % 96;
        LAS float* sc = (LAS float*)lds; LAS float* red = (LAS float*)(lds + 40960);
        for (int idx = tid; idx < 9 * 1024; idx += NTHR) { const int v = idx >> 10, k = idx & 1023; const float cv = (v < 8) ? a.in[I_C][v * 1024 + k] : a.in[I_CCTX][k]; sc[idx] = siluf_(cv); }
        __syncthreads();
        const float* wm = a.in[I_WMOD] + (size_t)l * 1024 * 6144 + cg * 64 + lane;
        float acc[9];
#pragma unroll
        for (int v = 0; v < 9; ++v) acc[v] = 0.f;
#pragma unroll 32
        for (int kk = 0; kk < 128; ++kk) { const int k = wave * 128 + kk; const float w = wm[(size_t)k * 6144];
#pragma unroll
            for (int v = 0; v < 9; ++v) acc[v] += sc[v * 1024 + k] * w; }
#pragma unroll
        for (int v = 0; v < 9; ++v) red[(wave * 9 + v) * 64 + lane] = acc[v];
        __syncthreads();
        for (int idx = tid; idx < 576; idx += NTHR) { const int v = idx >> 6, ln = idx & 63; float s = a.in[I_BMOD][l * 6144 + cg * 64 + ln];
#pragma unroll
            for (int w = 0; w < 8; ++w) s += red[(w * 9 + v) * 64 + ln];
            ((float*)(ws + WS_MOD))[(size_t)(l * 9 + v) * 6144 + cg * 64 + ln] = s; }
        __syncthreads();
    }
    small_weight_convert(a, lds, 0);
}

constexpr int EXPC_ITEMS = 3 * 8192;
__device__ __forceinline__ void expert_convert_range(const KArgs& a, LAS unsigned char* lds, int l, int lo, int hi, int blk0) {
    const int tid = OTID(), lane = tid & 63, wave = tid >> 6, blk = OBLK(), G = OGRID();
    if (G <= blk0) blk0 = 0;
    if (blk < blk0) return;
    LAS float* scr = (LAS float*)(lds + 65536 + wave * 8448);
    bf16_t* wgu = (bf16_t*)(a.ws + WS_WGU); bf16_t* wdn = (bf16_t*)(a.ws + WS_WDN);
    const int gw = (blk - blk0) * NWAVES + wave, NGW = (G - blk0) * NWAVES;
    for (int it = lo + gw; it < hi; it += NGW) {
        const int which = it / 8192, r = it % 8192, e = r / 256, q = r % 256;
        if (which < 2) { const int kb = q / 16, nb = q % 16, n0 = nb * 32;
            transpose_item(a.in[which == 0 ? I_WEG : I_WEU] + (size_t)(l * 32 + e) * 1024 * 512, 512, 512, kb * 64, n0, wgu + (size_t)e * 1024 * 1024, 1024, 256 * (n0 >> 7) + (n0 & 127) + which * 128, scr, lane); }
        else { const int kb = q / 32, nb = q % 32; transpose_item(a.in[I_WED] + (size_t)(l * 32 + e) * 512 * 1024, 1024, 1024, kb * 64, nb * 32, wdn + (size_t)e * 1024 * 512, 512, nb * 32, scr, lane); }
    }
}

__device__ __forceinline__ void modulate_store(const f32x4 (&v)[4], const float* gain, const float* sh, const float* sc, bf16_t* orow, int lane) {
    float ss = 0.f;
#pragma unroll
    for (int j = 0; j < 4; ++j) ss += (v[j].x * v[j].x + v[j].y * v[j].y) + (v[j].z * v[j].z + v[j].w * v[j].w);
    const float rstd = rsqrtf(wave_sum(ss) * (1.f / 1024.f) + EPS);
    f32x4 gq[4], s1q[4], s0q[4];
#pragma unroll
    for (int j = 0; j < 4; ++j) { gq[j] = ((const f32x4*)gain)[lane + 64 * j]; s1q[j] = ((const f32x4*)sc)[lane + 64 * j]; s0q[j] = ((const f32x4*)sh)[lane + 64 * j]; }
#pragma unroll
    for (int j = 0; j < 4; ++j) {
        const f32x4 g = gq[j], s1 = s1q[j], s0 = s0q[j];
        const f32x4 y = (v[j] * rstd * g) * (s1 + 1.0f) + s0;
        u32x2 o; o.x = pk2(y.x, y.y); o.y = pk2(y.z, y.w);
        ((u32x2*)orow)[lane + 64 * j] = o;
    }
}
__device__ __forceinline__ int row_modidx(int row) { return row < ML ? (row >> 12) : 8; }

__device__ __forceinline__ void phase_modulate1(const KArgs& a, int l, int nrows) {
    const int tid = OTID(), lane = tid & 63, wave = tid >> 6;
    const int gw = OBLK() * NWAVES + wave, NGW = OGRID() * NWAVES;
    const float* xl = (l == 0) ? a.in[I_X] : a.out; const float* xc = (l == 0) ? a.in[I_CTX] : (const float*)(a.ws + WS_XC);
    bf16_t* hl = (bf16_t*)(a.ws + WS_HL);
    for (int row = gw; row < nrows; row += NGW) {
        const float* xr = row < ML ? xl + (size_t)row * D : xc + (size_t)(row - ML) * D;
        f32x4 v[4];
#pragma unroll
        for (int j = 0; j < 4; ++j) v[j] = ((const f32x4*)xr)[lane + 64 * j];
        const float* mod = (const float*)(a.ws + WS_MOD) + (size_t)(l * 9 + row_modidx(row)) * 6144;
        modulate_store(v, a.in[I_NORM1] + l * D, mod, mod + 1024, hl + (size_t)row * D, lane);
    }
}
__device__ __forceinline__ void unpack8(const u32x4 u, float (&x)[8]) { x[0] = bflo(u.x); x[1] = bfhi(u.x); x[2] = bflo(u.y); x[3] = bfhi(u.y); x[4] = bflo(u.z); x[5] = bfhi(u.z); x[6] = bflo(u.w); x[7] = bfhi(u.w); }
__device__ __forceinline__ u32x4 pack8(const float (&x)[8]) { u32x4 u; u.x = pk2(x[0], x[1]); u.y = pk2(x[2], x[3]); u.z = pk2(x[4], x[5]); u.w = pk2(x[6], x[7]); return u; }
__device__ __forceinline__ int head64_col(int hbase, int lane) { const int hidx = hbase + (lane >> 2), p = lane & 3; return (hidx < 8 ? hidx * 64 : (hidx < 18 ? C_WQ + (hidx - 8) * 64 : C_NQ + (hidx - 18) * 64)) + 8 * p; }
__device__ __forceinline__ void head64_load(const bf16_t* zr, int hbase, int lane, u32x4& u1, u32x4& u2) { const bool act = hbase + (lane >> 2) < 34; const int col = head64_col(hbase, lane);
    u1 = (u32x4){0u, 0u, 0u, 0u}; u2 = u1; if (act) { u1 = *(const u32x4*)(zr + col); u2 = *(const u32x4*)(zr + col + 32); } }
__device__ __forceinline__ void head64_pass16(bf16_t* zr, int hbase, const float* wqn, const float* wkn, const float* nqn, const float* nkn, bool lat, const float* cs, const float* sn, int lane, const u32x4 u1, const u32x4 u2) {
    const int hidx = hbase + (lane >> 2), p = lane & 3; const bool act = hidx < 34;
    const int col = (hidx < 8 ? hidx * 64 : (hidx < 18 ? C_WQ + (hidx - 8) * 64 : C_NQ + (hidx - 18) * 64)) + 8 * p;
    const float* gain = hidx < 8 ? nullptr : (hidx < 16 ? wqn : (hidx < 18 ? wkn : (hidx < 26 ? nqn : nkn)));
    const bool rope = lat && hidx < 18;
    const float scale = (hidx >= 4 && hidx < 8) ? 0.125f : (((hidx >= 8 && hidx < 16) || (hidx >= 18 && hidx < 26)) ? 0.125f * 1.4426950408889634f : 1.0f);
    float x1[8], x2[8];
    unpack8(u1, x1); unpack8(u2, x2);
    float ss = 0.f;
#pragma unroll
    for (int e = 0; e < 8; ++e) ss += x1[e] * x1[e] + x2[e] * x2[e];
    ss += __shfl_xor(ss, 1); ss += __shfl_xor(ss, 2);
    if (gain) { const float r = rsqrtf(ss * (1.f / 64.f) + EPS);
        const f32x4 g0 = *(const f32x4*)(gain + 8 * p), g1 = *(const f32x4*)(gain + 8 * p + 4), g2 = *(const f32x4*)(gain + 32 + 8 * p), g3 = *(const f32x4*)(gain + 36 + 8 * p);
#pragma unroll
        for (int e = 0; e < 4; ++e) { x1[e] *= r * g0[e]; x1[e + 4] *= r * g1[e]; x2[e] *= r * g2[e]; x2[e + 4] *= r * g3[e]; } }
    if (rope) { const f32x4 c0 = *(const f32x4*)(cs + 8 * p), c1 = *(const f32x4*)(cs + 8 * p + 4), s0 = *(const f32x4*)(sn + 8 * p), s1 = *(const f32x4*)(sn + 8 * p + 4);
#pragma unroll
        for (int e = 0; e < 8; ++e) { const float c = e < 4 ? c0[e & 3] : c1[e & 3], sv = e < 4 ? s0[e & 3] : s1[e & 3]; const float y1 = x1[e] * c - x2[e] * sv, y2 = x1[e] * sv + x2[e] * c; x1[e] = y1; x2[e] = y2; } }
#pragma unroll
    for (int e = 0; e < 8; ++e) { x1[e] *= scale; x2[e] *= scale; }
    if (act) { *(u32x4*)(zr + col) = pack8(x1); *(u32x4*)(zr + col + 32) = pack8(x2); }
}
__device__ __forceinline__ void phase_prep(const KArgs& a, int l) {
    const int tid = OTID(), lane = tid & 63, wave = tid >> 6;
    const int gw = OBLK() * NWAVES + wave, NGW = OGRID() * NWAVES;
    bf16_t* Z = (bf16_t*)(a.ws + WS_Z); bf16_t* P = (bf16_t*)(a.ws + WS_P);
    const float* cs0 = (const float*)(a.ws + WS_ROPE); const float* sn0 = cs0 + 4096 * 32;
    float* GBa = (float*)(a.ws + WS_GB); float* GBb = GBa + (size_t)MA * 8;
    const float* wqn = a.in[I_WQN] + l * 64; const float* wkn = a.in[I_WKN] + l * 64; const float* nqn = a.in[I_NQN] + l * 64; const float* nkn = a.in[I_NKN] + l * 64;
    const float* cw = a.in[I_GCONV] + (size_t)l * 3 * 1536;
    for (int row = gw; row < MA; row += NGW) {
        const bool lat = row < ML; const int t = lat ? (row & 4095) : ((row - ML) & 255); const int slen = lat ? 4096 : 256;
        bf16_t* zr = Z + (size_t)row * ZP;
        const float* cs = cs0 + t * 32; const float* sn = sn0 + t * 32;
        const u32x4 zero = (u32x4){0u, 0u, 0u, 0u};
        u32x4 guc[3], gup[3], gun[3];
#pragma unroll
        for (int ps = 0; ps < 3; ++ps) { const int c = (ps * 4 + (lane >> 4)) * 128 + (lane & 15) * 8; const bf16_t* zc = zr + C_GQ + c;
            guc[ps] = *(const u32x4*)zc; gup[ps] = (t > 0) ? *(const u32x4*)(zc - ZP) : zero; gun[ps] = (t < slen - 1) ? *(const u32x4*)(zc + ZP) : zero; }
        float gav = 0.f, gbv = 0.f; if (lane < 8) { gav = bf2f(zr[C_GA + lane]); gbv = bf2f(zr[C_GB + lane]); }
#pragma unroll
        for (int ps = 0; ps < 3; ++ps) {
            const int c = (ps * 4 + (lane >> 4)) * 128 + (lane & 15) * 8;
            float xp[8], xc[8], xn[8], y[8]; unpack8(gup[ps], xp); unpack8(guc[ps], xc); unpack8(gun[ps], xn);
            const f32x4 w00 = *(const f32x4*)(cw + c), w01 = *(const f32x4*)(cw + c + 4), w10 = *(const f32x4*)(cw + 1536 + c), w11 = *(const f32x4*)(cw + 1536 + c + 4), w20 = *(const f32x4*)(cw + 3072 + c), w21 = *(const f32x4*)(cw + 3072 + c + 4);
            float ss = 0.f;
#pragma unroll
            for (int e = 0; e < 8; ++e) { const float w0 = e < 4 ? w00[e & 3] : w01[e & 3], w1 = e < 4 ? w10[e & 3] : w11[e & 3], w2 = e < 4 ? w20[e & 3] : w21[e & 3];
                y[e] = silu_fast(w0 * xp[e] + w1 * xc[e] + w2 * xn[e]); ss += y[e] * y[e]; }
            if (ps < 2) { ss += __shfl_xor(ss, 1); ss += __shfl_xor(ss, 2); ss += __shfl_xor(ss, 4); ss += __shfl_xor(ss, 8);
                const float r = rsqrtf(ss + EPS) * (ps == 0 ? 0.08838834764831845f : 1.0f);
#pragma unroll
                for (int e = 0; e < 8; ++e) y[e] *= r; }
            *(u32x4*)(P + (size_t)row * PP + c) = pack8(y);
        }
        if (lane < 8) {
            const float av = gav + a.in[I_GDT][l * 8 + lane], bv = gbv;
            const float sp = fmaxf(av, 0.f) + log1pf(__expf(-fabsf(av)));
            const float g = -__expf(a.in[I_GALOG][l * 8 + lane]) * sp;
            GBa[(size_t)row * 8 + lane] = g; GBb[(size_t)row * 8 + lane] = sigmoidf_(bv);
        }
    }
}

constexpr int GPO_RS = 272;
__device__ __forceinline__ void phase_post(const KArgs& a, LAS unsigned char* lds, int l, int nrows) {
    const int tid = OTID(), lane = tid & 63, wave = tid >> 6, g = lane >> 4, r16 = lane & 15;
    const int gw = OBLK() * NWAVES + wave, NGW = OGRID() * NWAVES;
    bf16_t* Z = (bf16_t*)(a.ws + WS_Z);
    const float* gnm = a.in[I_GNORM] + l * 128;
    LAS unsigned char* img = lds + wave * (64 * GPO_RS);
    const f32x4 gn0 = *(const f32x4*)(gnm + r16 * 8), gn1 = *(const f32x4*)(gnm + r16 * 8 + 4);
    const int nunits = (nrows >> 6) * 4;
    for (int u = gw; u < nunits; u += NGW) {
        const int chunk = u >> 2, h = u & 3;
        bf16_t* zblk = Z + (size_t)chunk * 64 * ZP;
        u32x4 rf[8][2], rb[8][2];
#pragma unroll
        for (int sb = 0; sb < 8; ++sb) { const bf16_t* p = zblk + (size_t)(sb * 8 + (lane >> 3)) * ZP + h * 128 + (lane & 7) * 16;
            rf[sb][0] = *(const u32x4*)(p + C_GQ); rf[sb][1] = *(const u32x4*)(p + C_GQ + 8); rb[sb][0] = *(const u32x4*)(p + C_GK); rb[sb][1] = *(const u32x4*)(p + C_GK + 8); }
#pragma unroll
        for (int rt = 0; rt < 4; ++rt) {
            float v[2][4][4]; float ss[4] = {0.f, 0.f, 0.f, 0.f};
#pragma unroll
            for (int ch = 0; ch < 2; ++ch) { const int sb = rt * 2 + ch;
#pragma unroll
                for (int hf = 0; hf < 2; ++hf) { const u32x4 f = rf[sb][hf], bq = rb[sb][hf];
                    v[ch][2 * hf][0] = bflo(f.x) + bflo(bq.x); v[ch][2 * hf][1] = bfhi(f.x) + bfhi(bq.x); v[ch][2 * hf][2] = bflo(f.y) + bflo(bq.y); v[ch][2 * hf][3] = bfhi(f.y) + bfhi(bq.y);
                    v[ch][2 * hf + 1][0] = bflo(f.z) + bflo(bq.z); v[ch][2 * hf + 1][1] = bfhi(f.z) + bfhi(bq.z); v[ch][2 * hf + 1][2] = bflo(f.w) + bflo(bq.w); v[ch][2 * hf + 1][3] = bfhi(f.w) + bfhi(bq.w); } }
#pragma unroll
            for (int j = 0; j < 4; ++j) {
#pragma unroll
                for (int ch = 0; ch < 2; ++ch)
#pragma unroll
                    for (int ct = 0; ct < 4; ++ct) ss[j] += v[ch][ct][j] * v[ch][ct][j];
                ss[j] += __shfl_xor(ss[j], 1); ss[j] += __shfl_xor(ss[j], 2); ss[j] += __shfl_xor(ss[j], 4); ss[j] += __shfl_xor(ss[j], 8);
                const float r = rsqrtf(ss[j] * (1.f / 128.f) + EPS);
                const int row = 32 * (rt >> 1) + 8 * g + 4 * (rt & 1) + j;
#pragma unroll
                for (int ch = 0; ch < 2; ++ch)
#pragma unroll
                    for (int ct = 0; ct < 4; ++ct) *(LAS bf16_t*)(img + row * GPO_RS + (ch * 64 + ct * 16 + r16) * 2) = (bf16_t)f2bf(v[ch][ct][j] * r);
            }
        }
        u32x4 gt[16];
#pragma unroll
        for (int i = 0; i < 16; ++i) gt[i] = *(const u32x4*)(zblk + (size_t)(i * 4 + g) * ZP + C_GG + h * 128 + r16 * 8);
#pragma unroll
        for (int i = 0; i < 16; ++i) { const int row = i * 4 + g;
            const u32x4 o = *(const LAS u32x4*)(img + row * GPO_RS + r16 * 16); const u32x4 q = gt[i];
            u32x4 w;
            w.x = pk2(bflo(o.x) * gn0[0] * silu_fast(bflo(q.x)), bfhi(o.x) * gn0[1] * silu_fast(bfhi(q.x))); w.y = pk2(bflo(o.y) * gn0[2] * silu_fast(bflo(q.y)), bfhi(o.y) * gn0[3] * silu_fast(bfhi(q.y)));
            w.z = pk2(bflo(o.z) * gn1[0] * silu_fast(bflo(q.z)), bfhi(o.z) * gn1[1] * silu_fast(bfhi(q.z))); w.w = pk2(bflo(o.w) * gn1[2] * silu_fast(bflo(q.w)), bfhi(o.w) * gn1[3] * silu_fast(bfhi(q.w)));
            *(u32x4*)(zblk + (size_t)row * ZP + Y_GDN + h * 128 + r16 * 8) = w; }
    }
}
constexpr int AT_TILE = 4096;
constexpr int AT_BUF = 2 * AT_TILE;
constexpr int AT_TABOFF = 2 * AT_BUF;
constexpr int AT_WAVE_BYTES = 2 * AT_BUF + 2048;
template <int NQ> struct AttnSt { f32x4 O[NQ][4]; f32x4 nm[NQ]; float l[NQ]; bf16x8 Q[NQ][2]; };
__device__ __forceinline__ void stage_issue(const char* zb, const unsigned (&rp)[4], int kcolb, int vcolb, LAS unsigned char* buf) {
    asm volatile("s_waitcnt lgkmcnt(0)" ::: "memory");
#pragma unroll
    for (int c = 0; c < 4; ++c) {
        __builtin_amdgcn_global_load_lds((const unsigned*)(zb + rp[c] + kcolb), (LAS unsigned*)(buf + c * 1024), 16, 0, 0);
        __builtin_amdgcn_global_load_lds((const unsigned*)(zb + rp[c] + vcolb), (LAS unsigned*)(buf + AT_TILE + c * 1024), 16, 0, 0);
    }
}
__device__ __forceinline__ int at_piece_off(int lane) { const int row = lane >> 3; return (((lane & 7) ^ (row & 7)) * 16); }
__device__ __forceinline__ s16x4 lds_tr16(const LAS unsigned char* p) { return __builtin_bit_cast(s16x4, __builtin_amdgcn_ds_read_tr16_b64_v4i16((LAS s16x4*)p)); }

struct AttnAddr { unsigned k0, k1, v[4]; };
__device__ __forceinline__ unsigned lds_u32(const LAS unsigned char* p) { return (unsigned)(unsigned long long)p; }
__device__ __forceinline__ AttnAddr attn_addr(int lane) {
    const int g = lane >> 4, r16 = lane & 15, qq = r16 >> 2, pp = r16 & 3, row = 4 * g + qq; AttnAddr A;
    A.k0 = r16 * 128 + ((g ^ (r16 & 7)) * 16); A.k1 = r16 * 128 + (((4 + g) ^ (r16 & 7)) * 16);
#pragma unroll
    for (int dt = 0; dt < 4; ++dt) A.v[dt] = row * 128 + (((dt * 2 + (pp >> 1)) ^ (row & 7)) * 16) + (pp & 1) * 8;
    return A;
}
struct AttnFrag { bf16x8 kf[2][2]; bf16x8 vf[4]; };
__device__ __forceinline__ void attn_read(AttnFrag& F, const LAS unsigned char* kl, int lane) {
    const AttnAddr AD = attn_addr(lane);
    const unsigned base = lds_u32(kl);
    u32x4 k00, k01, k10, k11; u32x2 vl0, vh0, vl1, vh1, vl2, vh2, vl3, vh3;
    asm volatile(
        "ds_read_b128 %0, %12\n\t" "ds_read_b128 %1, %13\n\t" "ds_read_b128 %2, %12 offset:2048\n\t" "ds_read_b128 %3, %13 offset:2048\n\t"
        "ds_read_b64_tr_b16 %4, %14 offset:4096\n\t" "ds_read_b64_tr_b16 %5, %14 offset:6144\n\t"
        "ds_read_b64_tr_b16 %6, %15 offset:4096\n\t" "ds_read_b64_tr_b16 %7, %15 offset:6144\n\t"
        "ds_read_b64_tr_b16 %8, %16 offset:4096\n\t" "ds_read_b64_tr_b16 %9, %16 offset:6144\n\t"
        "ds_read_b64_tr_b16 %10, %17 offset:4096\n\t" "ds_read_b64_tr_b16 %11, %17 offset:6144\n\t"
        "s_waitcnt lgkmcnt(0)"
        : "=&v"(k00), "=&v"(k01), "=&v"(k10), "=&v"(k11), "=&v"(vl0), "=&v"(vh0), "=&v"(vl1), "=&v"(vh1), "=&v"(vl2), "=&v"(vh2), "=&v"(vl3), "=&v"(vh3)
        : "v"(base + AD.k0), "v"(base + AD.k1), "v"(base + AD.v[0]), "v"(base + AD.v[1]), "v"(base + AD.v[2]), "v"(base + AD.v[3])
        : "memory");
    F.kf[0][0] = __builtin_bit_cast(bf16x8, k00); F.kf[0][1] = __builtin_bit_cast(bf16x8, k01); F.kf[1][0] = __builtin_bit_cast(bf16x8, k10); F.kf[1][1] = __builtin_bit_cast(bf16x8, k11);
    F.vf[0] = cat8(vl0, vh0); F.vf[1] = cat8(vl1, vh1); F.vf[2] = cat8(vl2, vh2); F.vf[3] = cat8(vl3, vh3);
}
template <int NQ, int MASK, class BiasF>
__device__ __forceinline__ void attn_compute_m(AttnSt<NQ>& st, const AttnFrag& F, const BiasF& bias, bool useb, int lane) {
    const int g = lane >> 4, r16 = lane & 15;
    f32x4 s0[NQ], s1[NQ];
#pragma unroll
    for (int qi = 0; qi < NQ; ++qi) if ((MASK >> qi) & 1) {
        const f32x4 nm = st.nm[qi];
        s0[qi] = __builtin_amdgcn_mfma_f32_16x16x32_bf16(F.kf[0][0], st.Q[qi][0], nm, 0, 0, 0);
        s0[qi] = __builtin_amdgcn_mfma_f32_16x16x32_bf16(F.kf[0][1], st.Q[qi][1], s0[qi], 0, 0, 0);
        s1[qi] = __builtin_amdgcn_mfma_f32_16x16x32_bf16(F.kf[1][0], st.Q[qi][0], nm, 0, 0, 0);
        s1[qi] = __builtin_amdgcn_mfma_f32_16x16x32_bf16(F.kf[1][1], st.Q[qi][1], s1[qi], 0, 0, 0); }
    if (BiasF::HAS_BIAS && useb) {
#pragma unroll
        for (int qi = 0; qi < NQ; ++qi) if ((MASK >> qi) & 1) { f32x4 b0, b1; bias.get(qi, r16, g, b0, b1); s0[qi] = s0[qi] + b0; s1[qi] = s1[qi] + b1; } }
    bool grow = false;
#pragma unroll
    for (int qi = 0; qi < NQ; ++qi) if ((MASK >> qi) & 1) {
#pragma unroll
        for (int j = 0; j < 4; ++j) grow = grow || (s0[qi][j] > 8.0f) || (s1[qi][j] > 8.0f); }
    if (__builtin_amdgcn_ballot_w64(grow) != 0ull) {
#pragma unroll
        for (int qi = 0; qi < NQ; ++qi) if ((MASK >> qi) & 1) {
            float m_ = fmaxf(fmaxf(s0[qi][0], s0[qi][1]), s0[qi][2]); m_ = fmaxf(fmaxf(m_, s0[qi][3]), s1[qi][0]); m_ = fmaxf(fmaxf(m_, s1[qi][1]), s1[qi][2]); m_ = fmaxf(m_, s1[qi][3]);
            m_ = fmaxf(m_, __shfl_xor(m_, 16)); m_ = fmaxf(m_, __shfl_xor(m_, 32));
            const float dm = fmaxf(m_, 0.f), alpha = __builtin_amdgcn_exp2f(-dm);
            st.l[qi] *= alpha; st.nm[qi] = st.nm[qi] - dm;
#pragma unroll
            for (int dt = 0; dt < 4; ++dt) st.O[qi][dt] = st.O[qi][dt] * alpha;
            s0[qi] = s0[qi] - dm; s1[qi] = s1[qi] - dm; } }
    bf16x8 pf[NQ];
#pragma unroll
    for (int qi = 0; qi < NQ; ++qi) if ((MASK >> qi) & 1) {
        float p0[4], p1[4], ps = 0.f;
#pragma unroll
        for (int j = 0; j < 4; ++j) { p0[j] = __builtin_amdgcn_exp2f(s0[qi][j]); p1[j] = __builtin_amdgcn_exp2f(s1[qi][j]); ps += p0[j] + p1[j]; }
        st.l[qi] += ps;
        u32x4 pw; pw.x = pk2(p0[0], p0[1]); pw.y = pk2(p0[2], p0[3]); pw.z = pk2(p1[0], p1[1]); pw.w = pk2(p1[2], p1[3]);
        pf[qi] = __builtin_bit_cast(bf16x8, pw); }
#pragma unroll
    for (int qi = 0; qi < NQ; ++qi) if ((MASK >> qi) & 1) {
#pragma unroll
        for (int dt = 0; dt < 4; ++dt) st.O[qi][dt] = __builtin_amdgcn_mfma_f32_16x16x32_bf16(F.vf[dt], pf[qi], st.O[qi][dt], 0, 0, 0); }
}
template <int NQ, class BiasF>
__device__ __forceinline__ void attn_compute(AttnSt<NQ>& st, const AttnFrag& F, const BiasF& bias, int lane) {
    const bool useb = BiasF::HAS_BIAS && !bias.nobias();
    if constexpr (BiasF::HAS_SKIP && NQ == 4) {
        if (!bias.skip(0)) attn_compute_m<NQ, 0x1, BiasF>(st, F, bias, useb, lane);
        attn_compute_m<NQ, 0x2, BiasF>(st, F, bias, useb, lane); attn_compute_m<NQ, 0x4, BiasF>(st, F, bias, useb, lane);
        if (!bias.skip(3)) attn_compute_m<NQ, 0x8, BiasF>(st, F, bias, useb, lane);
    } else {
        if constexpr (NQ == 4) { attn_compute_m<NQ, 0x3, BiasF>(st, F, bias, useb, lane); attn_compute_m<NQ, 0xC, BiasF>(st, F, bias, useb, lane); }
        else attn_compute_m<NQ, (1 << NQ) - 1, BiasF>(st, F, bias, useb, lane);
    }
}
template <int NQ> __device__ __forceinline__ void attn_init(AttnSt<NQ>& st) {
#pragma unroll
    for (int qi = 0; qi < NQ; ++qi) { st.nm[qi] = (f32x4){64.0f, 64.0f, 64.0f, 64.0f};      st.l[qi] = 0.f;
#pragma unroll
        for (int dt = 0; dt < 4; ++dt) st.O[qi][dt] = (f32x4){0.f, 0.f, 0.f, 0.f}; }
}
template <int NQ> __device__ __forceinline__ void attn_store(AttnSt<NQ>& st, int qi, bf16_t* orow, int lane) {
    const int g = lane >> 4;
    float lt = st.l[qi]; lt += __shfl_xor(lt, 16); lt += __shfl_xor(lt, 32);
    const float inv = 1.0f / lt;
#pragma unroll
    for (int dt = 0; dt < 4; ++dt) { const f32x4 o = st.O[qi][dt] * inv; u32x2 w; w.x = pk2(o[0], o[1]); w.y = pk2(o[2], o[3]); *(u32x2*)(orow + dt * 16 + 4 * g) = w; }
}
constexpr float LOG2E = 1.4426950408889634f;
struct BiasZero { static constexpr bool HAS_BIAS = false, HAS_SKIP = false; __device__ __forceinline__ bool skip(int) const { return false; } __device__ __forceinline__ bool nobias() const { return true; }
    __device__ __forceinline__ void get(int, int, int, f32x4& b0, f32x4& b1) const { b0 = (f32x4){0.f, 0.f, 0.f, 0.f}; b1 = b0; } };
struct BiasWin { static constexpr bool HAS_BIAS = true, HAS_SKIP = false; int d0; int kstart; bool interior;
    __device__ __forceinline__ bool skip(int) const { return false; } __device__ __forceinline__ bool nobias() const { return interior; }
    __device__ __forceinline__ float one(int q, int kk) const { const int kp = kstart + kk, dd = d0 + kk - q; return (kp >= 0 && kp < SEQ && dd <= 128 && dd >= -128) ? 0.f : -1e30f; }
    __device__ __forceinline__ void get(int, int q, int g, f32x4& b0, f32x4& b1) const {
#pragma unroll
        for (int j = 0; j < 4; ++j) { b0[j] = one(q, 4 * g + j); b1[j] = one(q, 16 + 4 * g + j); } } };
struct BiasNA { static constexpr bool HAS_BIAS = true, HAS_SKIP = true; unsigned tabaddr; int rowoff31; int c0;
    __device__ __forceinline__ bool skip(int qi) const { return (qi == 0 && c0 != 0) || (qi == 3 && c0 == 0); } __device__ __forceinline__ bool nobias() const { return false; }
    __device__ __forceinline__ void get(int qi, int q, int g, f32x4& b0, f32x4& b1) const {
        const int qc = qi * 16 + q; int cst = qc - 8; cst = cst < 0 ? 0 : (cst > 48 ? 48 : cst);
        const int kc0 = c0 + 4 * g;
        const unsigned ad = tabaddr + (unsigned)((rowoff31 + kc0 - qc + 15) * 4);
        u32x2 t0, t1, t2, t3;
        asm volatile("ds_read2_b32 %0, %4 offset1:1\n\t" "ds_read2_b32 %1, %4 offset0:2 offset1:3\n\t" "ds_read2_b32 %2, %4 offset0:16 offset1:17\n\t" "ds_read2_b32 %3, %4 offset0:18 offset1:19\n\t" "s_waitcnt lgkmcnt(0)"
                     : "=&v"(t0), "=&v"(t1), "=&v"(t2), "=&v"(t3) : "v"(ad) : "memory");
        const float v0[4] = {__builtin_bit_cast(float, t0.x), __builtin_bit_cast(float, t0.y), __builtin_bit_cast(float, t1.x), __builtin_bit_cast(float, t1.y)};
        const float v1[4] = {__builtin_bit_cast(float, t2.x), __builtin_bit_cast(float, t2.y), __builtin_bit_cast(float, t3.x), __builtin_bit_cast(float, t3.y)};
#pragma unroll
        for (int j = 0; j < 4; ++j) { const int ka = kc0 + j, kb = kc0 + 16 + j;
            b0[j] = (ka >= cst && ka < cst + 16) ? v0[j] : -1e30f; b1[j] = (kb >= cst && kb < cst + 16) ? v1[j] : -1e30f; } } };

template <int NQ>
__device__ __forceinline__ void attn_ctx_steps(AttnSt<NQ>& st, const bf16_t* Z, int row0, int kcol, int vcol, int nsteps, LAS unsigned char* kl, int lane) {
    const char* zb = (const char*)Z;
    unsigned rp[4];
#pragma unroll
    for (int c = 0; c < 4; ++c) rp[c] = (unsigned)(row0 + (lane >> 3) + c * 8) * (unsigned)(ZP * 2) + (unsigned)at_piece_off(lane);
    stage_issue(zb, rp, kcol * 2, vcol * 2, kl);
    for (int s = 0; s < nsteps; ++s) {
        if (s + 1 < nsteps) {
#pragma unroll
            for (int c = 0; c < 4; ++c) rp[c] += 32u * (unsigned)(ZP * 2);
            stage_issue(zb, rp, kcol * 2, vcol * 2, kl + ((s + 1) & 1) * AT_BUF);
            asm volatile("s_waitcnt vmcnt(8)" ::: "memory");
        } else asm volatile("s_waitcnt vmcnt(0)" ::: "memory");
        AttnFrag F; attn_read(F, kl + (s & 1) * AT_BUF, lane);
        attn_compute<NQ>(st, F, BiasZero(), lane);
    }
}

__device__ __forceinline__ void win_item(const KArgs& a, int l, int item, bool ctxq, LAS unsigned char* kl, int lane) {
    asm volatile("" : "+v"(lane));
    bf16_t* Z = (bf16_t*)(a.ws + WS_Z);
    int b, gi, qt;
    if (!ctxq) { b = item >> 9; gi = (item >> 8) & 1; qt = item & 255; } else { b = item >> 5; gi = (item >> 4) & 1; qt = item & 15; }
    const int t0 = qt * 16, r16 = lane & 15;
    const int qrow0 = (ctxq ? ML + b * CTXL : b * SEQ) + t0, qrow = qrow0 + r16;
    const char* zb = (const char*)Z; const int g = lane >> 4;
    AttnSt<4> st; attn_init<4>(st);
#pragma unroll
    for (int qi = 0; qi < 4; ++qi) { const bf16_t* qp = Z + (size_t)qrow * ZP + C_WQ + (gi * 4 + qi) * 64 + g * 8;
        st.Q[qi][0] = *(const bf16x8*)qp; st.Q[qi][1] = *(const bf16x8*)(qp + 32); { const float sk = -a.in[I_WSINK][l * 8 + gi * 4 + qi] * LOG2E; st.nm[qi] = (f32x4){sk, sk, sk, sk}; } st.l[qi] = (g == 0) ? 1.0f : 0.f; }
    const int kcol = C_WK + gi * 64, vcol = C_WV + gi * 64;
    int s0 = 0, s1 = 0;
    if (!ctxq) { s1 = 9; const int ks = t0 - 128; while (s0 < s1 && ks + 32 * s0 + 31 < 0) ++s0; while (s1 > s0 && ks + 32 * (s1 - 1) >= SEQ) --s1; }
    const int nl = s1 - s0, n = nl + 8;
    unsigned rp[4];
#define AT_ISSUE(i_) do { const int ii_ = (i_); \
        if (ii_ < nl) { _Pragma("unroll") for (int c = 0; c < 4; ++c) { int kp = t0 - 128 + 32 * (s0 + ii_) + c * 8 + (lane >> 3); kp = kp < 0 ? 0 : (kp > SEQ - 1 ? SEQ - 1 : kp); \
                rp[c] = (unsigned)(b * SEQ + kp) * (unsigned)(ZP * 2) + (unsigned)at_piece_off(lane); } } \
        else if (ii_ == nl) { _Pragma("unroll") for (int c = 0; c < 4; ++c) rp[c] = (unsigned)(ML + b * CTXL + c * 8 + (lane >> 3)) * (unsigned)(ZP * 2) + (unsigned)at_piece_off(lane); } \
        else { _Pragma("unroll") for (int c = 0; c < 4; ++c) rp[c] += 32u * (unsigned)(ZP * 2); }            \
        stage_issue(zb, rp, kcol * 2, vcol * 2, kl + (ii_ & 1) * AT_BUF); } while (0)
    AT_ISSUE(0); AT_ISSUE(1);
    for (int i = 0; i < nl; ++i) {
        asm volatile("s_waitcnt vmcnt(8)" ::: "memory");
        AttnFrag F; attn_read(F, kl + (i & 1) * AT_BUF, lane);
        AT_ISSUE(i + 2);
        const int kstart = t0 - 128 + 32 * (s0 + i);
        BiasWin bw; bw.kstart = kstart; bw.d0 = kstart - t0; bw.interior = (kstart >= 0 && kstart + 31 < SEQ && kstart >= t0 + 15 - 128 && kstart + 31 <= t0 + 128);
        attn_compute<4>(st, F, bw, lane);
    }
    for (int i = nl; i < n; ++i) {
        if (i + 1 < n) asm volatile("s_waitcnt vmcnt(8)" ::: "memory"); else asm volatile("s_waitcnt vmcnt(0)" ::: "memory");
        AttnFrag F; attn_read(F, kl + (i & 1) * AT_BUF, lane);
        if (i + 2 < n) AT_ISSUE(i + 2);
        attn_compute<4>(st, F, BiasZero(), lane);
    }
#undef AT_ISSUE
#pragma unroll
    for (int qi = 0; qi < 4; ++qi) attn_store<4>(st, qi, Z + (size_t)qrow * ZP + Y_WIN + (gi * 4 + qi) * 64, lane);
}

__device__ __forceinline__ void na_item(const KArgs& a, int l, int item, bool ctxq, LAS unsigned char* kl, int lane) {
    asm volatile("" : "+v"(lane));
    bf16_t* Z = (bf16_t*)(a.ws + WS_Z);
    int b, h, r;
    if (!ctxq) { b = item >> 9; h = (item >> 6) & 7; r = item & 63; } else { b = item >> 5; h = (item >> 2) & 7; r = item & 3; }
    const int r16 = lane & 15;
    const int qbase = (ctxq ? ML + b * CTXL : b * SEQ) + r * 64, qrow0 = qbase + r16;
    const char* zb = (const char*)Z; const int g = lane >> 4;
    AttnSt<4> st; attn_init<4>(st);
#pragma unroll
    for (int qi = 0; qi < 4; ++qi) { const bf16_t* qp = Z + (size_t)(qrow0 + qi * 16) * ZP + C_NQ + h * 64 + g * 8; st.Q[qi][0] = *(const bf16x8*)qp; st.Q[qi][1] = *(const bf16x8*)(qp + 32); }
    const int kcol = C_NK + h * 64, vcol = C_NV + h * 64;
    LAS float* tab = (LAS float*)(kl + AT_TABOFF);
    int rs = r - 4; rs = rs < 0 ? 0 : (rs > 56 ? 56 : rs);
    if (!ctxq) { const float* rpbp = a.in[I_RPB] + (size_t)(l * 8 + h) * 465; for (int i = lane; i < 465; i += 64) tab[i] = rpbp[i] * LOG2E; }
    const int nl = ctxq ? 0 : 16, n = nl + 8;
    unsigned rp[4];
#define AT_ISSUE(i_) do { const int ii_ = (i_); \
        if (ii_ == 0 || ii_ == nl) { _Pragma("unroll") for (int c = 0; c < 4; ++c) { const int row_ = (ii_ < nl) ? b * SEQ + rs * 64 + c * 8 + (lane >> 3) : ML + b * CTXL + c * 8 + (lane >> 3); \
                rp[c] = (unsigned)row_ * (unsigned)(ZP * 2) + (unsigned)at_piece_off(lane); } } \
        else { _Pragma("unroll") for (int c = 0; c < 4; ++c) rp[c] += 32u * (unsigned)(ZP * 2); }            \
        stage_issue(zb, rp, kcol * 2, vcol * 2, kl + (ii_ & 1) * AT_BUF); } while (0)
    AT_ISSUE(0); AT_ISSUE(1);
    for (int i = 0; i < nl; ++i) {
        asm volatile("s_waitcnt vmcnt(8)" ::: "memory");
        AttnFrag F; attn_read(F, kl + (i & 1) * AT_BUF, lane);
        AT_ISSUE(i + 2);
        BiasNA bn; bn.tabaddr = lds_u32((const LAS unsigned char*)tab); bn.rowoff31 = (rs + (i >> 1) - r + 7) * 31; bn.c0 = (i & 1) * 32;
        attn_compute<4>(st, F, bn, lane);
    }
    for (int i = nl; i < n; ++i) {
        if (i + 1 < n) asm volatile("s_waitcnt vmcnt(8)" ::: "memory"); else asm volatile("s_waitcnt vmcnt(0)" ::: "memory");
        AttnFrag F; attn_read(F, kl + (i & 1) * AT_BUF, lane);
        if (i + 2 < n) AT_ISSUE(i + 2);
        attn_compute<4>(st, F, BiasZero(), lane);
    }
#undef AT_ISSUE
#pragma unroll
    for (int qi = 0; qi < 4; ++qi) attn_store<4>(st, qi, Z + (size_t)(qrow0 + qi * 16) * ZP + Y_NA + h * 64, lane);
}
constexpr int RT_VS = 288, RT_KS = 160, RT_SS = 144;
__device__ __forceinline__ size_t kvt_off(int bh, int dir, int ch) { return (((size_t)bh * 2 + dir) * 34 + ch) * 8192; }
__device__ __forceinline__ float log_sigmoidf_(float x) { return -(fmaxf(-x, 0.f) + log1pf(__expf(-fabsf(x)))); }
__device__ __forceinline__ int ret_row0(int b, int ch) { return ch < 2 ? ML + b * CTXL + ch * 128 : b * SEQ + (ch - 2) * 128; }

struct RkPre { u32x4 v[4], k[2]; };
__device__ __forceinline__ void ret_kv_load(const KArgs& a, int unit, RkPre& R) {
    const int tid = OTID(); const int bh = unit / 34, ch = unit % 34, b = bh >> 2, h = bh & 3; const bf16_t* Z = (const bf16_t*)(a.ws + WS_Z); const int row0 = ret_row0(b, ch);
#pragma unroll
    for (int i = 0; i < 4; ++i) { const int p = tid + i * 512, r = p >> 4, c = p & 15; R.v[i] = *(const u32x4*)(Z + (size_t)(row0 + r) * ZP + C_RV + h * 128 + c * 8); }
#pragma unroll
    for (int i = 0; i < 2; ++i) { const int p = tid + i * 512, r = p >> 3, c = p & 7; R.k[i] = *(const u32x4*)(Z + (size_t)(row0 + r) * ZP + C_RK + h * 64 + c * 8); }
}
__device__ __forceinline__ void ret_kv_unit(const KArgs& a, LAS unsigned char* lds, int l, int unit, const RkPre& PRE) {
    const int tid = OTID(), lane = tid & 63, wave = tid >> 6, g = lane >> 4, r16 = lane & 15;
    const int bh = unit / 34, ch = unit % 34, b = bh >> 2, h = bh & 3;
    const bf16_t* Z = (const bf16_t*)(a.ws + WS_Z);
    const int row0 = ret_row0(b, ch);
    const float lgf = log_sigmoidf_(a.in[I_RDECAY][l * 8 + h]), lgb = log_sigmoidf_(a.in[I_RDECAY][l * 8 + 4 + h]);
    LAS unsigned char* Vl = lds; LAS unsigned char* Kf = lds + 128 * RT_VS; LAS unsigned char* Kb = Kf + 128 * RT_KS;
#pragma unroll
    for (int i = 0; i < 4; ++i) { const int p = tid + i * 512, r = p >> 4, c = p & 15; *(LAS u32x4*)(Vl + r * RT_VS + c * 16) = PRE.v[i]; }
#pragma unroll
    for (int i = 0; i < 2; ++i) { const int p = tid + i * 512, r = p >> 3, c = p & 7;
        const u32x4 kv = PRE.k[i];
        const float df = __expf(lgf * (float)(127 - r)), db = __expf(lgb * (float)r);
        u32x4 of, ob;
        of.x = pk2(bflo(kv.x) * df, bfhi(kv.x) * df); of.y = pk2(bflo(kv.y) * df, bfhi(kv.y) * df); of.z = pk2(bflo(kv.z) * df, bfhi(kv.z) * df); of.w = pk2(bflo(kv.w) * df, bfhi(kv.w) * df);
        ob.x = pk2(bflo(kv.x) * db, bfhi(kv.x) * db); ob.y = pk2(bflo(kv.y) * db, bfhi(kv.y) * db); ob.z = pk2(bflo(kv.z) * db, bfhi(kv.z) * db); ob.w = pk2(bflo(kv.w) * db, bfhi(kv.w) * db);
        *(LAS u32x4*)(Kf + r * RT_KS + c * 16) = of; *(LAS u32x4*)(Kb + r * RT_KS + c * 16) = ob; }
    __syncthreads();
    f32x4 acc[2][4];
#pragma unroll
    for (int d = 0; d < 2; ++d)
#pragma unroll
        for (int t = 0; t < 4; ++t) acc[d][t] = (f32x4){0.f, 0.f, 0.f, 0.f};
    const int qq = r16 >> 2, pp = r16 & 3;
#pragma unroll
    for (int ks = 0; ks < 4; ++ks) {
        const int tr0 = ks * 32 + 4 * g + qq;
        const s16x4 alo = lds_tr16(Vl + tr0 * RT_VS + (wave * 16 + 4 * pp) * 2), ahi = lds_tr16(Vl + (tr0 + 16) * RT_VS + (wave * 16 + 4 * pp) * 2);
        const bf16x8 A = (bf16x8){alo[0], alo[1], alo[2], alo[3], ahi[0], ahi[1], ahi[2], ahi[3]};
#pragma unroll
        for (int t = 0; t < 4; ++t) {
            const s16x4 flo = lds_tr16(Kf + tr0 * RT_KS + (t * 16 + 4 * pp) * 2), fhi = lds_tr16(Kf + (tr0 + 16) * RT_KS + (t * 16 + 4 * pp) * 2);
            const s16x4 blo = lds_tr16(Kb + tr0 * RT_KS + (t * 16 + 4 * pp) * 2), bhi = lds_tr16(Kb + (tr0 + 16) * RT_KS + (t * 16 + 4 * pp) * 2);
            acc[0][t] = __builtin_amdgcn_mfma_f32_16x16x32_bf16(A, (bf16x8){flo[0], flo[1], flo[2], flo[3], fhi[0], fhi[1], fhi[2], fhi[3]}, acc[0][t], 0, 0, 0);
            acc[1][t] = __builtin_amdgcn_mfma_f32_16x16x32_bf16(A, (bf16x8){blo[0], blo[1], blo[2], blo[3], bhi[0], bhi[1], bhi[2], bhi[3]}, acc[1][t], 0, 0, 0);
        }
    }
    bf16_t* kvt = (bf16_t*)(a.ws + WS_KVT);
    LAS unsigned char* tw = lds + 81920 + wave * 4608;
#pragma unroll
    for (int d = 0; d < 2; ++d)
#pragma unroll
        for (int t = 0; t < 4; ++t)
#pragma unroll
            for (int j = 0; j < 4; ++j) *(LAS bf16_t*)(tw + d * 2304 + (4 * g + j) * 144 + (t * 16 + r16) * 2) = (bf16_t)f2bf(acc[d][t][j]);
#pragma unroll
    for (int d = 0; d < 2; ++d) { bf16_t* o = kvt + kvt_off(bh, d, ch) + (size_t)(wave * 16) * 64;
#pragma unroll
        for (int i = 0; i < 2; ++i) { const int idx = lane + 64 * i, r = idx >> 3, c8 = idx & 7; *(u32x4*)(o + r * 64 + c8 * 8) = *(const LAS u32x4*)(tw + d * 2304 + r * 144 + c8 * 16); } }
    __syncthreads();
}

__device__ __forceinline__ void ret_prefix(const KArgs& a, int l, int blk0) {
    const int tid = OTID(), blk = OBLK(), G = OGRID();
    if (G <= blk0) blk0 = 0;
    if (blk < blk0) return;
    bf16_t* kvt = (bf16_t*)(a.ws + WS_KVT);
    for (int gt = (blk - blk0) * NTHR + tid; gt < 64 * 1024; gt += (G - blk0) * NTHR) {
        const int pair = gt >> 10, e8 = gt & 1023, d = pair & 1, h = (pair >> 1) & 3;
        const float gC = __expf(log_sigmoidf_(a.in[I_RDECAY][l * 8 + d * 4 + h]) * 128.0f);
        bf16_t* base = kvt + (size_t)pair * 34 * 8192 + e8 * 8;
        float s[8];
#pragma unroll
        for (int e = 0; e < 8; ++e) s[e] = 0.f;
#pragma unroll
        for (int half = 0; half < 2; ++half) {
            u32x4 x[17];
#pragma unroll
            for (int k = 0; k < 17; ++k) { const int oo = half * 17 + k; const int ci = (d == 0) ? oo : (oo < 2 ? 1 - oo : 35 - oo); x[k] = *(const u32x4*)(base + (size_t)ci * 8192); }
#pragma unroll
            for (int k = 0; k < 17; ++k) { const int oo = half * 17 + k; const int ci = (d == 0) ? oo : (oo < 2 ? 1 - oo : 35 - oo);
                u32x4 w; w.x = pk2(s[0], s[1]); w.y = pk2(s[2], s[3]); w.z = pk2(s[4], s[5]); w.w = pk2(s[6], s[7]);
                *(u32x4*)(base + (size_t)ci * 8192) = w;
                s[0] = s[0] * gC + bflo(x[k].x); s[1] = s[1] * gC + bfhi(x[k].x); s[2] = s[2] * gC + bflo(x[k].y); s[3] = s[3] * gC + bfhi(x[k].y);
                s[4] = s[4] * gC + bflo(x[k].z); s[5] = s[5] * gC + bfhi(x[k].z); s[6] = s[6] * gC + bflo(x[k].w); s[7] = s[7] * gC + bfhi(x[k].w); }
        }
    }
}

__device__ __forceinline__ void ret_out_unit(const KArgs& a, LAS unsigned char* lds, int l, int unit) {
    const int tid = OTID(), lane = tid & 63, wave = tid >> 6, g = lane >> 4, r16 = lane & 15;
    const int bh = unit / 34, ch = unit % 34, b = bh >> 2, h = bh & 3;
    bf16_t* Z = (bf16_t*)(a.ws + WS_Z);
    const bf16_t* kvt = (const bf16_t*)(a.ws + WS_KVT);
    const int row0 = ret_row0(b, ch);
    const float lgf = log_sigmoidf_(a.in[I_RDECAY][l * 8 + h]), lgb = log_sigmoidf_(a.in[I_RDECAY][l * 8 + 4 + h]);
    LAS unsigned char* Vl = lds; LAS unsigned char* Sf = lds + 128 * RT_VS; LAS unsigned char* Sb = Sf + 128 * RT_SS;
    u32x4 vst[4];
#pragma unroll
    for (int i = 0; i < 4; ++i) { const int p = tid + i * 512, r = p >> 4, c = p & 15; vst[i] = *(const u32x4*)(Z + (size_t)(row0 + r) * ZP + C_RV + h * 128 + c * 8); }
    u32x4 sst[4];
    { const int dv = tid >> 2, dk0 = (tid & 3) * 16;
      const u32x4* sf = (const u32x4*)(kvt + kvt_off(bh, 0, ch) + dv * 64 + dk0); const u32x4* sb = (const u32x4*)(kvt + kvt_off(bh, 1, ch) + dv * 64 + dk0);
      sst[0] = sf[0]; sst[1] = sf[1]; sst[2] = sb[0]; sst[3] = sb[1]; }
    const int qi = wave * 16 + r16;
    const bf16_t* qp = Z + (size_t)(row0 + qi) * ZP + C_RQ + h * 64 + g * 8;
    const bf16x8 Q0 = *(const bf16x8*)qp, Q1 = *(const bf16x8*)(qp + 32);
    bf16x8 Kf[8][2];
#pragma unroll
    for (int kt = 0; kt < 8; ++kt) { const bf16_t* kp = Z + (size_t)(row0 + kt * 16 + r16) * ZP + C_RK + h * 64 + g * 8; Kf[kt][0] = *(const bf16x8*)kp; Kf[kt][1] = *(const bf16x8*)(kp + 32); }
    const float* gn = a.in[I_RGN] + l * 512 + h * 128;
    bf16_t* yrow = Z + (size_t)(row0 + qi) * ZP + Y_RET + h * 128;
#pragma unroll
    for (int i = 0; i < 4; ++i) { const int p = tid + i * 512, r = p >> 4, c = p & 15; *(LAS u32x4*)(Vl + r * RT_VS + c * 16) = vst[i]; }
    { const int dv = tid >> 2, dk0 = (tid & 3) * 16;
      *(LAS u32x4*)(Sf + dv * RT_SS + dk0 * 2) = sst[0]; *(LAS u32x4*)(Sf + dv * RT_SS + dk0 * 2 + 16) = sst[1];
      *(LAS u32x4*)(Sb + dv * RT_SS + dk0 * 2) = sst[2]; *(LAS u32x4*)(Sb + dv * RT_SS + dk0 * 2 + 16) = sst[3]; }
    __syncthreads();
    float dcf[4], dcb[4], dcd[4];
#pragma unroll
    for (int j = 0; j < 4; ++j) { const int dl = r16 - 4 * g - j; dcf[j] = __expf(lgf * (float)dl); dcb[j] = __expf(-lgb * (float)dl); dcd[j] = (dl >= 0 ? dcf[j] : 0.f) + (dl <= 0 ? dcb[j] : 0.f); }
    f32x4 O[8];
#pragma unroll
    for (int dt = 0; dt < 8; ++dt) O[dt] = (f32x4){0.f, 0.f, 0.f, 0.f};
    const int qq = r16 >> 2, pp = r16 & 3;
#pragma unroll
    for (int ks = 0; ks < 4; ++ks) {
        u32x4 pw;
#pragma unroll
        for (int half = 0; half < 2; ++half) {
            const int kt = 2 * ks + half;
            f32x4 s = (f32x4){0.f, 0.f, 0.f, 0.f};
            s = __builtin_amdgcn_mfma_f32_16x16x32_bf16(Kf[kt][0], Q0, s, 0, 0, 0);
            s = __builtin_amdgcn_mfma_f32_16x16x32_bf16(Kf[kt][1], Q1, s, 0, 0, 0);
            float p[4];
            {
                const int dk = __builtin_amdgcn_readfirstlane(wave) - kt;
                if (dk > 0) { const float E = __expf(lgf * (float)(16 * dk));
#pragma unroll
                    for (int j = 0; j < 4; ++j) p[j] = s[j] * (E * dcf[j]); }
                else if (dk < 0) { const float E = __expf(lgb * (float)(-16 * dk));
#pragma unroll
                    for (int j = 0; j < 4; ++j) p[j] = s[j] * (E * dcb[j]); }
                else {
#pragma unroll
                    for (int j = 0; j < 4; ++j) p[j] = s[j] * dcd[j]; } }
            if (half == 0) { pw.x = pk2(p[0], p[1]); pw.y = pk2(p[2], p[3]); } else { pw.z = pk2(p[0], p[1]); pw.w = pk2(p[2], p[3]); }
        }
        const bf16x8 pf = __builtin_bit_cast(bf16x8, pw);
        const int tr0 = ks * 32 + 4 * g + qq;
#pragma unroll
        for (int dt = 0; dt < 8; ++dt) {
            const s16x4 lo = lds_tr16(Vl + tr0 * RT_VS + (dt * 16 + 4 * pp) * 2), hi = lds_tr16(Vl + (tr0 + 16) * RT_VS + (dt * 16 + 4 * pp) * 2);
            O[dt] = __builtin_amdgcn_mfma_f32_16x16x32_bf16((bf16x8){lo[0], lo[1], lo[2], lo[3], hi[0], hi[1], hi[2], hi[3]}, pf, O[dt], 0, 0, 0);
        }
    }
    { const float dqf = __expf(lgf * (float)(qi + 1)), dqb = __expf(lgb * (float)(128 - qi));
#pragma unroll
      for (int dt = 0; dt < 8; ++dt) {
          f32x4 tf = (f32x4){0.f, 0.f, 0.f, 0.f}, tb = (f32x4){0.f, 0.f, 0.f, 0.f};
          const LAS unsigned char* sf = Sf + (dt * 16 + r16) * RT_SS + g * 16; const LAS unsigned char* sb = Sb + (dt * 16 + r16) * RT_SS + g * 16;
          tf = __builtin_amdgcn_mfma_f32_16x16x32_bf16(*(const LAS bf16x8*)sf, Q0, tf, 0, 0, 0); tf = __builtin_amdgcn_mfma_f32_16x16x32_bf16(*(const LAS bf16x8*)(sf + 64), Q1, tf, 0, 0, 0);
          tb = __builtin_amdgcn_mfma_f32_16x16x32_bf16(*(const LAS bf16x8*)sb, Q0, tb, 0, 0, 0); tb = __builtin_amdgcn_mfma_f32_16x16x32_bf16(*(const LAS bf16x8*)(sb + 64), Q1, tb, 0, 0, 0);
          O[dt] = O[dt] + tf * dqf + tb * dqb;
      } }
    float sm = 0.f;
#pragma unroll
    for (int dt = 0; dt < 8; ++dt) sm += (O[dt][0] + O[dt][1]) + (O[dt][2] + O[dt][3]);
    sm += __shfl_xor(sm, 16); sm += __shfl_xor(sm, 32);
    const float mean = sm * (1.f / 128.f);
    float sq = 0.f;
#pragma unroll
    for (int dt = 0; dt < 8; ++dt) { const f32x4 dd = O[dt] - mean; sq += (dd[0] * dd[0] + dd[1] * dd[1]) + (dd[2] * dd[2] + dd[3] * dd[3]); }
    sq += __shfl_xor(sq, 16); sq += __shfl_xor(sq, 32);
    const float rstd = rsqrtf(sq * (1.f / 128.f) + EPS);
    u32x2 gtv[8]; f32x4 gvv[8];
#pragma unroll
    for (int dt = 0; dt < 8; ++dt) { gtv[dt] = *(const u32x2*)(yrow + dt * 16 + 4 * g); gvv[dt] = *(const f32x4*)(gn + dt * 16 + 4 * g); }
#pragma unroll
    for (int dt = 0; dt < 8; ++dt) { const int c = dt * 16 + 4 * g;
        const u32x2 gt = gtv[dt]; const f32x4 gv = gvv[dt];
        u32x2 w; w.x = pk2((O[dt][0] - mean) * rstd * gv[0] * silu_fast(bflo(gt.x)), (O[dt][1] - mean) * rstd * gv[1] * silu_fast(bfhi(gt.x)));
        w.y = pk2((O[dt][2] - mean) * rstd * gv[2] * silu_fast(bflo(gt.y)), (O[dt][3] - mean) * rstd * gv[3] * silu_fast(bfhi(gt.y)));
        *(u32x2*)(yrow + c) = w; }
    __syncthreads();
}
constexpr int C_UF = C_GQ, C_UB = C_GK, C_WF = C_GV, C_AQ = 5888;
__device__ __forceinline__ int gdn_row0(int b, int c) { return c < 4 ? ML + b * CTXL + c * 64 : b * SEQ + (c - 4) * 64; }

constexpr int GP_SQ = 90112, GP_RS = 288, GP_SK = GP_SQ + 64 * GP_RS, GP_SV = GP_SK + 64 * GP_RS, GP_WS = 144;
struct GpPre { u32x4 st[3][2]; float gc, be; };
__device__ __forceinline__ void gdn_prep_load(const KArgs& a, int unit, GpPre& R) {
    const int tid = OTID(); const int bh = unit / 68, c = unit % 68, b = bh >> 2, h = bh & 3; const int row0 = gdn_row0(b, c);
    const bf16_t* P = (const bf16_t*)(a.ws + WS_P); const float* GBa = (const float*)(a.ws + WS_GB); const float* GBb = GBa + (size_t)MA * 8;
#pragma unroll
    for (int m = 0; m < 3; ++m)
#pragma unroll
        for (int i = 0; i < 2; ++i) { const int p = tid + i * 512, r = p >> 4, c16 = p & 15; R.st[m][i] = *(const u32x4*)(P + (size_t)(row0 + r) * PP + m * 512 + h * 128 + c16 * 8); }
    R.gc = 0.f; R.be = 0.f;
    if (tid < 128) { const int d = tid >> 6, i = tid & 63; const size_t o = (size_t)(row0 + i) * 8 + d * 4 + h; R.gc = GBa[o]; R.be = GBb[o]; }
}
__device__ __forceinline__ void gdn_prep_unit(const KArgs& a, LAS unsigned char* lds, int unit, const GpPre& PRE) {
    const int tid = OTID(), lane = tid & 63, wave = tid >> 6, g = lane >> 4, r16 = lane & 15;
    const int bh = unit / 68, c = unit % 68, b = bh >> 2, h = bh & 3;
    const int row0 = gdn_row0(b, c);
    bf16_t* Z = (bf16_t*)(a.ws + WS_Z); bf16_t* P = (bf16_t*)(a.ws + WS_P);
    float* GBa = (float*)(a.ws + WS_GB); const float* GBb = GBa + (size_t)MA * 8;
    LAS float* KK = (LAS float*)lds; LAS float* QK = KK + 4096; LAS float* AF = QK + 4096; LAS float* AB = AF + 4096;
    LAS float* gcs = AB + 4096;
    LAS float* bes = gcs + 128;
    { if (tid < 128) { gcs[tid] = PRE.gc; bes[tid] = PRE.be; }
#pragma unroll
      for (int m = 0; m < 3; ++m)
#pragma unroll
          for (int i = 0; i < 2; ++i) { const int p = tid + i * 512, r = p >> 4, c16 = p & 15; *(LAS u32x4*)(lds + GP_SQ + m * 64 * GP_RS + r * GP_RS + c16 * 16) = PRE.st[m][i]; } }
    __syncthreads();
    if (wave < 2) { float v = gcs[tid];
#pragma unroll
        for (int off = 1; off < 64; off <<= 1) { const float t = (wave == 0) ? __shfl_up(v, off) : __shfl_down(v, off); if ((wave == 0) ? (lane >= off) : (lane + off < 64)) v += t; }
        gcs[tid] = v; }
    { const int rt = wave & 3; const LAS unsigned char* ap = lds + (wave < 4 ? GP_SK : GP_SQ) + (rt * 16 + r16) * GP_RS + g * 16;
      bf16x8 A[4];
#pragma unroll
      for (int ks = 0; ks < 4; ++ks) A[ks] = *(const LAS bf16x8*)(ap + ks * 64);
      LAS float* M = (wave < 4) ? KK : QK;
#pragma unroll
      for (int ct = 0; ct < 4; ++ct) { const LAS unsigned char* bp = lds + GP_SK + (ct * 16 + r16) * GP_RS + g * 16;
          f32x4 acc = (f32x4){0.f, 0.f, 0.f, 0.f};
#pragma unroll
          for (int ks = 0; ks < 4; ++ks) acc = __builtin_amdgcn_mfma_f32_16x16x32_bf16(A[ks], *(const LAS bf16x8*)(bp + ks * 64), acc, 0, 0, 0);
#pragma unroll
          for (int j = 0; j < 4; ++j) M[(rt * 16 + 4 * g + j) * 64 + ct * 16 + r16] = acc[j]; } }
    __syncthreads();
    if (tid < 128) { const int d = tid >> 6, i = tid & 63; ((float*)(a.ws + WS_GC2))[(size_t)(d * 4 + h) * MA + row0 + i] = gcs[tid]; }
    { const int i = tid >> 3, j0 = (tid & 7) * 8;
      const f32x4 kk0 = *(const LAS f32x4*)(KK + i * 64 + j0), kk1 = *(const LAS f32x4*)(KK + i * 64 + j0 + 4), qk0 = *(const LAS f32x4*)(QK + i * 64 + j0), qk1 = *(const LAS f32x4*)(QK + i * 64 + j0 + 4);
      const f32x4 gf0 = *(const LAS f32x4*)(gcs + j0), gf1 = *(const LAS f32x4*)(gcs + j0 + 4), gb0 = *(const LAS f32x4*)(gcs + 64 + j0), gb1 = *(const LAS f32x4*)(gcs + 64 + j0 + 4);
      const float gfi = gcs[i], gbi = gcs[64 + i], bfi = bes[i], bbi = bes[64 + i];
      float af[8], ab[8], aq[8];
#pragma unroll
      for (int e = 0; e < 8; ++e) { const int j = j0 + e; const float kk = e < 4 ? kk0[e & 3] : kk1[e & 3], qk = e < 4 ? qk0[e & 3] : qk1[e & 3], gfj = e < 4 ? gf0[e & 3] : gf1[e & 3], gbj = e < 4 ? gb0[e & 3] : gb1[e & 3];
          const float ef = __expf(fminf(gfi - gfj, 0.f)), eb = __expf(fminf(gbi - gbj, 0.f));
          af[e] = (j < i) ? bfi * kk * ef : 0.f; ab[e] = (j > i) ? bbi * kk * eb : 0.f;
          aq[e] = qk * (j < i ? ef : (j > i ? eb : 1.0f)); }
      *(LAS f32x4*)(AF + i * 64 + j0) = (f32x4){af[0], af[1], af[2], af[3]}; *(LAS f32x4*)(AF + i * 64 + j0 + 4) = (f32x4){af[4], af[5], af[6], af[7]};
      *(LAS f32x4*)(AB + (63 - i) * 64 + 56 - j0) = (f32x4){ab[7], ab[6], ab[5], ab[4]}; *(LAS f32x4*)(AB + (63 - i) * 64 + 60 - j0) = (f32x4){ab[3], ab[2], ab[1], ab[0]};
      u32x4 w; w.x = pk2(-af[0], -af[1]); w.y = pk2(-af[2], -af[3]); w.z = pk2(-af[4], -af[5]); w.w = pk2(-af[6], -af[7]);
      *(LAS u32x4*)(lds + 66560 + (i * 64 + j0) * 2) = w;
      w.x = pk2(-ab[7], -ab[6]); w.y = pk2(-ab[5], -ab[4]); w.z = pk2(-ab[3], -ab[2]); w.w = pk2(-ab[1], -ab[0]);
      *(LAS u32x4*)(lds + 66560 + (4096 + (63 - i) * 64 + 56 - j0) * 2) = w;
      w.x = pk2(aq[0], aq[1]); w.y = pk2(aq[2], aq[3]); w.z = pk2(aq[4], aq[5]); w.w = pk2(aq[6], aq[7]);
      *(u32x4*)(Z + (size_t)(row0 + i) * ZP + C_AQ + h * 64 + j0) = w; }
    LAS bf16_t* NAm = (LAS bf16_t*)(lds + 66560);
    LAS bf16_t* TL = (LAS bf16_t*)(lds + 82944);
    __syncthreads();
    { const int dd = wave >> 2, bb = wave & 3; const LAS float* Am = (dd ? AB : AF) + (bb * 16) * 64 + bb * 16;
      if (lane < 16) { float t[16];
#pragma unroll
          for (int i = 0; i < 16; ++i) { float acc = (i == lane) ? 1.f : 0.f;
#pragma unroll
              for (int j = 0; j < i; ++j) acc -= Am[i * 64 + j] * t[j];
              t[i] = acc; }
#pragma unroll
          for (int i = 0; i < 16; ++i) TL[((dd * 4 + bb) * 16 + i) * 16 + lane] = (bf16_t)f2bf(t[i]); } }
    const int d = wave >> 2, part = wave & 3; const bool isw = part >= 2;
    f32x4 R[4][4];
    { const int qq = r16 >> 2, pp = r16 & 3; const LAS unsigned char* sx = lds + (isw ? GP_SK : GP_SV) + ((part & 1) * 64 + 4 * pp) * 2;
#pragma unroll
      for (int bk = 0; bk < 4; ++bk) { const int rb = d ? 60 - 16 * bk - 4 * g : 16 * bk + 4 * g;
          float f[4];
#pragma unroll
          for (int j = 0; j < 4; ++j) { const int tok = d ? rb + 3 - j : rb + j; f[j] = isw ? bes[d * 64 + tok] * __expf(gcs[d * 64 + tok]) : bes[d * 64 + tok]; }
#pragma unroll
          for (int ct = 0; ct < 4; ++ct) { const s16x4 v4 = lds_tr16(sx + (rb + qq) * GP_RS + ct * 32);
#pragma unroll
              for (int j = 0; j < 4; ++j) R[bk][ct][j] = f[j] * bf2f((bf16_t)(d ? v4[3 - j] : v4[j])); } } }
    __syncthreads();
    { const LAS bf16_t* Nd = NAm + d * 4096; const LAS bf16_t* Td = TL + d * 1024;
      const u32x2 zero2 = (u32x2){0u, 0u};
#pragma unroll
      for (int bk = 0; bk < 4; ++bk) {
#pragma unroll
          for (int c0 = 0; c0 < 4; c0 += 2) if (c0 < bk) {
              const u32x2 alo = *(const LAS u32x2*)(Nd + (bk * 16 + r16) * 64 + c0 * 16 + 4 * g);
              const u32x2 ahi = (c0 + 1 < bk) ? *(const LAS u32x2*)(Nd + (bk * 16 + r16) * 64 + (c0 + 1) * 16 + 4 * g) : zero2;
              const bf16x8 Af = cat8(alo, ahi);
#pragma unroll
              for (int ct = 0; ct < 4; ++ct) { u32x2 blo, bhi = zero2; blo.x = pk2(R[c0][ct][0], R[c0][ct][1]); blo.y = pk2(R[c0][ct][2], R[c0][ct][3]);
                  if (c0 + 1 < bk) { bhi.x = pk2(R[c0 + 1][ct][0], R[c0 + 1][ct][1]); bhi.y = pk2(R[c0 + 1][ct][2], R[c0 + 1][ct][3]); }
                  R[bk][ct] = __builtin_amdgcn_mfma_f32_16x16x32_bf16(Af, cat8(blo, bhi), R[bk][ct], 0, 0, 0); } }
          const bf16x8 Tf = cat8(*(const LAS u32x2*)(Td + (bk * 16 + r16) * 16 + 4 * g), zero2);
#pragma unroll
          for (int ct = 0; ct < 4; ++ct) { u32x2 blo; blo.x = pk2(R[bk][ct][0], R[bk][ct][1]); blo.y = pk2(R[bk][ct][2], R[bk][ct][3]);
              R[bk][ct] = __builtin_amdgcn_mfma_f32_16x16x32_bf16(Tf, cat8(blo, zero2), (f32x4){0.f, 0.f, 0.f, 0.f}, 0, 0, 0); }
      } }
    if (isw) {
        LAS unsigned char* wt = lds + GP_SQ + (d * 2 + (part & 1)) * 64 * GP_WS;
#pragma unroll
        for (int bk = 0; bk < 4; ++bk)
#pragma unroll
            for (int j = 0; j < 4; ++j) { const int ip = bk * 16 + 4 * g + j, tok = d ? 63 - ip : ip;
#pragma unroll
                for (int ct = 0; ct < 4; ++ct) *(LAS bf16_t*)(wt + tok * GP_WS + (ct * 16 + r16) * 2) = (bf16_t)f2bf(R[bk][ct][j]); }
        bf16_t* dst0 = (d == 0 ? Z + (size_t)row0 * ZP + C_WF : P + (size_t)row0 * PP + 1024) + h * 128 + (part & 1) * 64; const int dp = d == 0 ? ZP : PP;
#pragma unroll
        for (int i = 0; i < 8; ++i) { const int idx = lane + 64 * i, r = idx >> 3, c8 = idx & 7; *(u32x4*)(dst0 + (size_t)r * dp + c8 * 8) = *(const LAS u32x4*)(wt + r * GP_WS + c8 * 16); }
    } else {
#pragma unroll
        for (int bk = 0; bk < 4; ++bk) { const int i0 = d ? 60 - 16 * bk - 4 * g : 16 * bk + 4 * g; const int e0 = utile_off(i0, (part & 1) * 64 + r16);
            u32x4 lo, hi;
            if (d == 0) { lo.x = pk2(R[bk][0][0], R[bk][0][1]); lo.y = pk2(R[bk][0][2], R[bk][0][3]); lo.z = pk2(R[bk][1][0], R[bk][1][1]); lo.w = pk2(R[bk][1][2], R[bk][1][3]);
                          hi.x = pk2(R[bk][2][0], R[bk][2][1]); hi.y = pk2(R[bk][2][2], R[bk][2][3]); hi.z = pk2(R[bk][3][0], R[bk][3][1]); hi.w = pk2(R[bk][3][2], R[bk][3][3]); }
            else        { lo.x = pk2(R[bk][0][3], R[bk][0][2]); lo.y = pk2(R[bk][0][1], R[bk][0][0]); lo.z = pk2(R[bk][1][3], R[bk][1][2]); lo.w = pk2(R[bk][1][1], R[bk][1][0]);
                          hi.x = pk2(R[bk][2][3], R[bk][2][2]); hi.y = pk2(R[bk][2][1], R[bk][2][0]); hi.z = pk2(R[bk][3][3], R[bk][3][2]); hi.w = pk2(R[bk][3][1], R[bk][3][0]); }
            bf16_t* up = Z + (size_t)(row0 + (e0 >> 7)) * ZP + (d == 0 ? C_UF : C_UB) + h * 128 + (e0 & 127);
            *(u32x4*)up = lo; *(u32x4*)(up + 8) = hi; }
    }
    __syncthreads();
}

constexpr int GS_SF = 0, GS_VF = 32768, GS_VE = 49152, GS_KB = 65536;
struct GsRegs { bf16x8 W[4], Q[4], AQ[2]; u32x4 K[2]; float u[4][4], gc[4], gl; };
__device__ __forceinline__ void gdn_scan_unit(const KArgs& a, LAS unsigned char* lds, int unit, bool ctx_out) {
    const int tid = OTID(), lane = tid & 63, wave = tid >> 6, g = lane >> 4, r16 = lane & 15, rt = wave & 3, ch = wave >> 2;
    const int bh = unit >> 1, d = unit & 1, b = bh >> 2, h = bh & 3;
    bf16_t* Z = (bf16_t*)(a.ws + WS_Z); const bf16_t* P = (const bf16_t*)(a.ws + WS_P);
    const float* GBa = (const float*)(a.ws + WS_GB);
    const bf16_t* Wb = d == 0 ? (const bf16_t*)Z + C_WF : P + 1024; const int Wp = d == 0 ? ZP : PP;
    const int ubase = (d == 0 ? C_UF : C_UB) + h * 128, ue0 = ((rt * 2 + ch) * 64 + lane) * 16;
    const float* GC2 = (const float*)(a.ws + WS_GC2) + (size_t)(d * 4 + h) * MA;
    const int rhoA = 32 * (rt >> 1) + 8 * (r16 >> 2) + 4 * (rt & 1) + (r16 & 3);
    const int rhoC = 32 * (rt >> 1) + 8 * g + 4 * (rt & 1);
    f32x4 Sa[4], Sb[4];
#pragma unroll
    for (int c = 0; c < 4; ++c) { Sa[c] = (f32x4){0.f, 0.f, 0.f, 0.f}; Sb[c] = Sa[c]; }
#define GS_ROW0(s_) gdn_row0(b, d == 0 ? (s_) : ((s_) < 4 ? 3 - (s_) : 71 - (s_)))
#define GS_LOAD_WQ(R, s_) do { const int r0_ = GS_ROW0(s_); const size_t ra_ = (size_t)(r0_ + rhoA); \
        _Pragma("unroll") for (int ks = 0; ks < 4; ++ks) { R.W[ks] = *(const bf16x8*)(Wb + ra_ * Wp + h * 128 + ks * 32 + 8 * g); R.Q[ks] = *(const bf16x8*)(P + ra_ * PP + h * 128 + ks * 32 + 8 * g); } \
        { const f32x4 gv_ = *(const f32x4*)(GC2 + r0_ + rhoC); R.gc[0] = gv_[0]; R.gc[1] = gv_[1]; R.gc[2] = gv_[2]; R.gc[3] = gv_[3]; } \
        { const bf16_t* up_ = Z + (size_t)(r0_ + (ue0 >> 7)) * ZP + ubase + (ue0 & 127); const u32x4 ua_ = *(const u32x4*)up_, ub_ = *(const u32x4*)(up_ + 8); \
          R.u[0][0] = bflo(ua_.x); R.u[0][1] = bfhi(ua_.x); R.u[0][2] = bflo(ua_.y); R.u[0][3] = bfhi(ua_.y); R.u[1][0] = bflo(ua_.z); R.u[1][1] = bfhi(ua_.z); R.u[1][2] = bflo(ua_.w); R.u[1][3] = bfhi(ua_.w); \
          R.u[2][0] = bflo(ub_.x); R.u[2][1] = bfhi(ub_.x); R.u[2][2] = bflo(ub_.y); R.u[2][3] = bfhi(ub_.y); R.u[3][0] = bflo(ub_.z); R.u[3][1] = bfhi(ub_.z); R.u[3][2] = bflo(ub_.w); R.u[3][3] = bfhi(ub_.w); } \
        R.gl = GC2[r0_ + (d == 0 ? 63 : 0)]; } while (0)
#define GS_LOAD_AQ(R, s_) do { const int r0_ = GS_ROW0(s_); const size_t ra_ = (size_t)(r0_ + rhoA); \
        _Pragma("unroll") for (int k2 = 0; k2 < 2; ++k2) { u32x4 w_ = *(const u32x4*)(Z + ra_ * ZP + C_AQ + h * 64 + k2 * 32 + 8 * g); const int j0_ = k2 * 32 + 8 * g; \
              \
            w_.x &= ((d == 0 ? (j0_ + 0 <= rhoA) : (j0_ + 0 >= rhoA)) ? 0x0000ffffu : 0u) | ((d == 0 ? (j0_ + 1 <= rhoA) : (j0_ + 1 >= rhoA)) ? 0xffff0000u : 0u); \
            w_.y &= ((d == 0 ? (j0_ + 2 <= rhoA) : (j0_ + 2 >= rhoA)) ? 0x0000ffffu : 0u) | ((d == 0 ? (j0_ + 3 <= rhoA) : (j0_ + 3 >= rhoA)) ? 0xffff0000u : 0u); \
            w_.z &= ((d == 0 ? (j0_ + 4 <= rhoA) : (j0_ + 4 >= rhoA)) ? 0x0000ffffu : 0u) | ((d == 0 ? (j0_ + 5 <= rhoA) : (j0_ + 5 >= rhoA)) ? 0xffff0000u : 0u); \
            w_.w &= ((d == 0 ? (j0_ + 6 <= rhoA) : (j0_ + 6 >= rhoA)) ? 0x0000ffffu : 0u) | ((d == 0 ? (j0_ + 7 <= rhoA) : (j0_ + 7 >= rhoA)) ? 0xffff0000u : 0u); \
            R.AQ[k2] = __builtin_bit_cast(bf16x8, w_); } } while (0)
#define GS_LOAD_K(R, s_) do { const int r0_ = GS_ROW0(s_); \
        _Pragma("unroll") for (int cc = 0; cc < 2; ++cc) { const int row_ = wave * 8 + cc * 4 + (lane >> 4); \
            R.K[cc] = *(const u32x4*)(P + (size_t)(r0_ + row_) * PP + 512 + h * 128 + (lane & 15) * 8); } } while (0)
#define GS_LOAD(R, s_) do { GS_LOAD_WQ(R, s_); GS_LOAD_AQ(R, s_); GS_LOAD_K(R, s_); } while (0)
#define GS_BAR() do { asm volatile("s_waitcnt lgkmcnt(0)" ::: "memory"); __builtin_amdgcn_s_barrier(); asm volatile("" ::: "memory"); } while (0)
    const int qq = r16 >> 2, pp = r16 & 3;
#define GS_STEP(s_, PRE) do { const int s = (s_); \
        _Pragma("unroll") for (int c = 0; c < 4; ++c) { u32x4 w; w.x = pk2(Sa[c][0], Sa[c][1]); w.y = pk2(Sa[c][2], Sa[c][3]); w.z = pk2(Sb[c][0], Sb[c][1]); w.w = pk2(Sb[c][2], Sb[c][3]); \
            *(LAS u32x4*)(lds + GS_SF + ((rt * 8 + ch * 4 + c) * 64 + lane) * 16) = w; } \
        _Pragma("unroll") for (int cc = 0; cc < 2; ++cc) { const int row_ = wave * 8 + cc * 4 + (lane >> 4); \
            *(LAS u32x4*)(lds + GS_KB + (s & 1) * 16384 + row_ * 256 + (((lane & 15) ^ ((row_ & 3) << 2)) * 16)) = PRE.K[cc]; } \
        if (s + 1 < 68) GS_LOAD_K(PRE, s + 1); \
        GS_BAR(); \
        const int r0 = GS_ROW0(s); \
        f32x4 vacc[4], oacc[4]; \
        _Pragma("unroll") for (int c = 0; c < 4; ++c) { vacc[c] = (f32x4){0.f, 0.f, 0.f, 0.f}; oacc[c] = vacc[c]; } \
        { bf16x8 Bs[2][4]; \
          _Pragma("unroll") for (int c = 0; c < 4; ++c) Bs[0][c] = *(const LAS bf16x8*)(lds + GS_SF + ((0 * 8 + ch * 4 + c) * 64 + lane) * 16); \
          _Pragma("unroll") for (int ks = 0; ks < 4; ++ks) { \
              if (ks < 3) { _Pragma("unroll") for (int c = 0; c < 4; ++c) Bs[(ks + 1) & 1][c] = *(const LAS bf16x8*)(lds + GS_SF + (((ks + 1) * 8 + ch * 4 + c) * 64 + lane) * 16); } \
              __builtin_amdgcn_sched_barrier(0); \
              _Pragma("unroll") for (int c = 0; c < 4; ++c) { vacc[c] = __builtin_amdgcn_mfma_f32_16x16x32_bf16(PRE.W[ks], Bs[ks & 1][c], vacc[c], 0, 0, 0); oacc[c] = __builtin_amdgcn_mfma_f32_16x16x32_bf16(PRE.Q[ks], Bs[ks & 1][c], oacc[c], 0, 0, 0); } \
              __builtin_amdgcn_sched_barrier(0); } } \
        const float cd = __expf(PRE.gl); \
        float eg[4], ee[4]; \
        _Pragma("unroll") for (int j = 0; j < 4; ++j) { eg[j] = __expf(PRE.gc[j]); ee[j] = __expf(fminf(PRE.gl - PRE.gc[j], 0.f)); } \
        _Pragma("unroll") for (int c = 0; c < 4; ++c) { float vn[4], ve[4]; \
            _Pragma("unroll") for (int j = 0; j < 4; ++j) { vn[j] = PRE.u[c][j] - vacc[c][j]; oacc[c][j] *= eg[j]; ve[j] = vn[j] * ee[j]; } \
            u32x2 w; w.x = pk2(vn[0], vn[1]); w.y = pk2(vn[2], vn[3]); u32x2 e; e.x = pk2(ve[0], ve[1]); e.y = pk2(ve[2], ve[3]); \
            *(LAS u32x2*)(lds + GS_VF + (((rt >> 1) * 8 + ch * 4 + c) * 64 + lane) * 16 + (rt & 1) * 8) = w; \
            *(LAS u32x2*)(lds + GS_VE + (((rt >> 1) * 8 + ch * 4 + c) * 64 + lane) * 16 + (rt & 1) * 8) = e; } \
        if (s + 1 < 68) GS_LOAD_WQ(PRE, s + 1); \
        GS_BAR(); \
        const LAS unsigned char* kb = lds + GS_KB + (s & 1) * 16384; \
        _Pragma("unroll") for (int c = 0; c < 4; ++c) { Sa[c] = Sa[c] * cd; Sb[c] = Sb[c] * cd; } \
        _Pragma("unroll") for (int k2 = 0; k2 < 2; ++k2) { \
            const int rr = k2 * 32 + 8 * g + qq; const int pc = 4 * rt + pp; \
            bf16x8 Bv[4], Be[4]; \
            _Pragma("unroll") for (int c = 0; c < 4; ++c) { Bv[c] = *(const LAS bf16x8*)(lds + GS_VF + ((k2 * 8 + ch * 4 + c) * 64 + lane) * 16); Be[c] = *(const LAS bf16x8*)(lds + GS_VE + ((k2 * 8 + ch * 4 + c) * 64 + lane) * 16); } \
            const s16x4 alo = lds_tr16(kb + rr * 256 + ((pc ^ ((rr & 3) << 2)) * 16)), ahi = lds_tr16(kb + (rr + 4) * 256 + ((pc ^ (((rr + 4) & 3) << 2)) * 16)); \
            const s16x4 blo = lds_tr16(kb + rr * 256 + ((pc ^ ((rr & 3) << 2)) * 16) + 8), bhi = lds_tr16(kb + (rr + 4) * 256 + ((pc ^ (((rr + 4) & 3) << 2)) * 16) + 8); \
            const bf16x8 KTa = (bf16x8){alo[0], alo[1], alo[2], alo[3], ahi[0], ahi[1], ahi[2], ahi[3]}, KTb = (bf16x8){blo[0], blo[1], blo[2], blo[3], bhi[0], bhi[1], bhi[2], bhi[3]}; \
            __builtin_amdgcn_sched_barrier(0); \
            _Pragma("unroll") for (int c = 0; c < 4; ++c) { \
                oacc[c] = __builtin_amdgcn_mfma_f32_16x16x32_bf16(PRE.AQ[k2], Bv[c], oacc[c], 0, 0, 0); \
                Sa[c] = __builtin_amdgcn_mfma_f32_16x16x32_bf16(KTa, Be[c], Sa[c], 0, 0, 0); Sb[c] = __builtin_amdgcn_mfma_f32_16x16x32_bf16(KTb, Be[c], Sb[c], 0, 0, 0); } \
            __builtin_amdgcn_sched_barrier(0); \
        } \
        if (s + 1 < 68) GS_LOAD_AQ(PRE, s + 1); \
        if (s >= 4 || ctx_out) { \
            u32x4 oa_, ob_; oa_.x = pk2(oacc[0][0], oacc[0][1]); oa_.y = pk2(oacc[0][2], oacc[0][3]); oa_.z = pk2(oacc[1][0], oacc[1][1]); oa_.w = pk2(oacc[1][2], oacc[1][3]); \
            ob_.x = pk2(oacc[2][0], oacc[2][1]); ob_.y = pk2(oacc[2][2], oacc[2][3]); ob_.z = pk2(oacc[3][0], oacc[3][1]); ob_.w = pk2(oacc[3][2], oacc[3][3]); \
            bf16_t* op_ = Z + (size_t)(r0 + (ue0 >> 7)) * ZP + ubase + (ue0 & 127); *(u32x4*)op_ = oa_; *(u32x4*)(op_ + 8) = ob_; \
        } \
    } while (0)
    GsRegs RA;
    GS_LOAD(RA, 0);
    for (int s2 = 0; s2 < 68; s2 += 2) { GS_STEP(s2, RA); GS_STEP(s2 + 1, RA); }
#undef GS_STEP
#undef GS_BAR
#undef GS_ROW0
#undef GS_LOAD
#undef GS_LOAD_WQ
#undef GS_LOAD_AQ
#undef GS_LOAD_K
    __syncthreads();
}
typedef const __attribute__((address_space(4))) KArgs* KAP;
#define NOINL __forceinline__
__device__ __forceinline__ KArgs load_kargs(KAP kp) { unsigned long long kv = (unsigned long long)kp; asm volatile("" : "+s"(kv)); KAP ka = (KAP)kv; KArgs a;
#pragma unroll
    for (int i = 0; i < 29; ++i) a.in[i] = ka->in[i];
    a.out = ka->out; a.ws = ka->ws; a.ph_lo = ka->ph_lo; a.ph_hi = ka->ph_hi; return a; }
__device__ NOINL void loop_gdnprep(KAP ka, LAS unsigned char* lds, int u0, int n, int step) { const KArgs a = load_kargs(ka);
    if (u0 >= n) return;
    GpPre cur; gdn_prep_load(a, u0, cur);
    for (int u = u0; u < n; u += step) { GpPre nx; gdn_prep_load(a, (u + step < n) ? u + step : u, nx); gdn_prep_unit(a, lds, u, cur); cur = nx; } }
__device__ NOINL void loop_retkv(KAP ka, LAS unsigned char* lds, int l, int u0, int n, int step) { const KArgs a = load_kargs(ka);
    if (u0 >= n) return;
    RkPre cur; ret_kv_load(a, u0, cur);
    for (int u = u0; u < n; u += step) { RkPre nx; ret_kv_load(a, (u + step < n) ? u + step : u, nx); ret_kv_unit(a, lds, l, u, cur); cur = nx; } }
__device__ NOINL void call_gdnscan(KAP ka, LAS unsigned char* lds, int unit, bool ctx_out) { const KArgs a = load_kargs(ka); gdn_scan_unit(a, lds, unit, ctx_out); }
__device__ NOINL void call_retprefix(KAP ka, int l) { const KArgs a = load_kargs(ka); ret_prefix(a, l, 64); }
__device__ NOINL void call_retout(KAP ka, LAS unsigned char* lds, int l, int unit) { const KArgs a = load_kargs(ka); ret_out_unit(a, lds, l, unit); }
__device__ NOINL void call_na(KAP ka, int l, int item, bool ctxq, LAS unsigned char* kl, int lane) { const KArgs a = load_kargs(ka); na_item(a, l, item, ctxq, kl, lane); }
__device__ NOINL void call_win(KAP ka, int l, int item, bool ctxq, LAS unsigned char* kl, int lane) { const KArgs a = load_kargs(ka); win_item(a, l, item, ctxq, kl, lane); }
#ifndef R3_IN_M2
#define R3_IN_M2 1
#endif
#ifndef PROBE_NOSCAN
#define PROBE_NOSCAN 0
#endif
#ifndef PROBE_SCANBLK_SKIP
#define PROBE_SCANBLK_SKIP 0
#endif
#ifndef SCAN_ONLY_M2
#define SCAN_ONLY_M2 0
#endif
constexpr int CW_WQ = 8192;
__device__ __forceinline__ void phase_mixers(KAP ka, LAS unsigned char* lds, int l, bool ctx_out) {
    const int blk = OBLK(), G = OGRID();
    loop_gdnprep(ka, lds, blk, 32 * 68, G);
    loop_retkv(ka, lds, l, G - 1 - blk, 32 * 34, G);
#if SCAN_ONLY_M2
    { const int tid = OTID(), lane = tid & 63, wave = tid >> 6; LAS unsigned char* kl = lds + __builtin_amdgcn_readfirstlane(wave) * AT_WAVE_BYTES;
      const int nitems = ctx_out ? 4096 + 4096 + 256 + 256 : 8192;
      for (int it = gw; it < nitems; it += NGW) { const bool cq = it >= 8192; const int j = cq ? it - 8192 : it; const bool isna = cq ? (j < 256) : (j < 4096); const int item = cq ? (j & 255) : (j & 4095);
          if (isna) call_na(ka, l, item, cq, kl, lane); else call_win(ka, l, item, cq, kl, lane); } }
#endif
}
__device__ __forceinline__ void phase_scan_attn(KAP ka, LAS unsigned char* lds, int l, bool ctx_out, int qslot) {
    const int tid = OTID(), lane = tid & 63, wave = tid >> 6, blk = OBLK(), G = OGRID();
#if PROBE_NOSCAN
    if (qslot >= 2)
#endif
    for (int u = blk; u < 64; u += G) call_gdnscan(ka, lds, (((u & 7) * 4 + ((u >> 3) >> 1)) << 1) | ((u >> 3) & 1), ctx_out);
    call_retprefix(ka, l);
#if SCAN_ONLY_M2
    return;
#endif
#if PROBE_SCANBLK_SKIP
    if (blk < 64 && G > 64) return;
#endif
    LAS unsigned char* kl = lds + __builtin_amdgcn_readfirstlane(wave) * AT_WAVE_BYTES;
    unsigned* ctr; { const KArgs a = load_kargs(ka); ctr = (unsigned*)(a.ws + WS_CTL) + CW_WQ + qslot * 1024 + (blk & 7) * 64; }
    const int xb = blk & 7;
    const int nper = ctx_out ? 512 + 512 + 32 + 32 : 1024;
    for (;;) {
        int k = 0; if (lane == 0) k = (int)__hip_atomic_fetch_add(ctr, 1u, __ATOMIC_RELAXED, __HIP_MEMORY_SCOPE_AGENT);
        k = __builtin_amdgcn_readfirstlane(k);
        if (k >= nper) break;
        const bool cq = k >= 1024; const int j = cq ? k - 1024 : k;
        const bool isna = cq ? (j < 32) : (j < 512);
        const int item = cq ? xb * 32 + (j & 31) : xb * 512 + (j & 511);
        if (isna) call_na(ka, l, item, cq, kl, lane);
        else call_win(ka, l, item, cq, kl, lane);
    }
#if R3_IN_M2
    if (G > 64 && blk >= 64) {
        unsigned* sb; { const KArgs a = load_kargs(ka); sb = (unsigned*)(a.ws + WS_CTL) + CW_WQ + 4096 + qslot * 64; }
        asm volatile("s_waitcnt vmcnt(0)" ::: "memory");
        __syncthreads();
        if (tid == 0) {
            __builtin_amdgcn_fence(__ATOMIC_RELEASE, "agent");
            asm volatile("s_waitcnt vmcnt(0)" ::: "memory");
            (void)__hip_atomic_fetch_add(sb, 1u, __ATOMIC_RELAXED, __HIP_MEMORY_SCOPE_AGENT);
            const unsigned need = (unsigned)(G - 64); unsigned sp = 0u;
            while (__hip_atomic_load(sb, __ATOMIC_RELAXED, __HIP_MEMORY_SCOPE_AGENT) < need) { __builtin_amdgcn_s_sleep(2); if (++sp > (1u << 22)) break; }
            __builtin_amdgcn_fence(__ATOMIC_ACQUIRE, "agent");
            asm volatile("s_waitcnt vmcnt(0)" ::: "memory");
        }
        __syncthreads();
        const int nu = ctx_out ? 32 * 34 : 32 * 32;
        for (int v = blk - 64; v < nu; v += G - 64) { const int u = ctx_out ? v : (v >> 5) * 34 + 2 + (v & 31); call_retout(ka, lds, l, u); }
    }
#endif
}
using pg8::Unit;
struct SchedPlain {
    const char* A0; const char* B0; size_t tA, tB;
    int nM, nN, nwg, G, c;
    __device__ __forceinline__ void init(const void* A, int lda, const void* Bt, int ldb, int M, int N, int G_, int c_) {
        A0 = (const char*)A; B0 = (const char*)Bt; tA = (size_t)256 * lda * 2; tB = (size_t)256 * ldb * 2; nM = M / 256; nN = N / 256; nwg = nM * nN; G = G_; c = c_; }
    __device__ __forceinline__ bool next(int i, Unit& u) const {
        const long L = (long)i * G + c; if (L >= nwg) return false;
        int wgid = (int)L; { const int q = nwg / 8, r = nwg % 8, xcd = wgid % 8, off = wgid / 8; wgid = (xcd < r ? xcd * (q + 1) : r * (q + 1) + (xcd - r) * q) + off; }
        const int nig = 8 * nN, gid = wgid / nig, fm = gid * 8, gsz = (nM - fm) < 8 ? (nM - fm) : 8;
        u.pm = fm + ((wgid % nig) % gsz); u.pn = (wgid % nig) / gsz; u.aux = 0; return true; }
    __device__ __forceinline__ const char* A(const Unit& u) const { return A0 + (size_t)u.pm * tA; }
    __device__ __forceinline__ const char* B(const Unit& u) const { return B0 + (size_t)u.pn * tB; }
};
struct SchedBranch {
    const char* Z0; const char* W0; int ntiles, G, c;
    __device__ __forceinline__ bool next(int i, Unit& u) const { const int tile = (i >> 2) * G + c; if (tile >= ntiles) return false; u.pm = tile >> 2; u.pn = tile & 3; u.aux = i & 3; return true; }
    __device__ __forceinline__ const char* A(const Unit& u) const { const int yc = u.aux == 0 ? Y_RET : (u.aux == 1 ? Y_WIN : (u.aux == 2 ? Y_NA : Y_GDN)); return Z0 + ((size_t)u.pm * 256 * ZP + yc) * 2; }
    __device__ __forceinline__ const char* B(const Unit& u) const { return W0 + ((size_t)u.aux * 1024 * 512 + (size_t)u.pn * 256 * 512) * 2; }
};
struct SchedMoe {
    const char* A0; const char* W0; const int* tile_start; size_t tA, eB, tB; int G, c;
    int e_[4], t0_[4], cum_[5], rank_, nrank_;
    __device__ __forceinline__ void init() {
        const int x = c & 7; rank_ = c >> 3; nrank_ = G >> 3; cum_[0] = 0;
#pragma unroll
        for (int k = 0; k < 4; ++k) { e_[k] = x + 8 * k; t0_[k] = tile_start[e_[k]]; cum_[k + 1] = cum_[k] + (tile_start[e_[k] + 1] - t0_[k]); }
    }
    __device__ __forceinline__ bool next(int i, Unit& u) const {
        const int L = i * nrank_ + rank_; const int tt = L >> 2; if (tt >= cum_[4]) return false;
        const int k = (tt >= cum_[1]) + (tt >= cum_[2]) + (tt >= cum_[3]);
        int e = e_[0], t0 = t0_[0], cm = cum_[0];
        if (k == 1) { e = e_[1]; t0 = t0_[1]; cm = cum_[1]; } else if (k == 2) { e = e_[2]; t0 = t0_[2]; cm = cum_[2]; } else if (k == 3) { e = e_[3]; t0 = t0_[3]; cm = cum_[3]; }
        u.pm = t0 + (tt - cm); u.pn = L & 3; u.aux = e; return true; }
    __device__ __forceinline__ const char* A(const Unit& u) const { return A0 + (size_t)u.pm * tA; }
    __device__ __forceinline__ const char* B(const Unit& u) const { return W0 + (size_t)u.aux * eB + (size_t)u.pn * tB; }
};

template <int MODE  > struct EpiStore {
    static constexpr bool INPLACE = false;
    bf16_t* O; int ldc;
    __device__ __forceinline__ void operator()(const f32x4 (&acc)[2][2][4][2], const Unit& u, int wr, int wc, int fr, int fq) const {
        const int row0 = u.pm * 256 + wr * 64 + fr; const int colt = (MODE == 1 ? dead_tile(u.pn) : u.pn) * 256; const int col0 = colt + wc * 32 + 8 * fq;
#pragma unroll
        for (int ai = 0; ai < 2; ++ai)
#pragma unroll
            for (int m = 0; m < 4; ++m) { bf16_t* rowp = O + (size_t)(row0 + ai * 128 + m * 16) * ldc + col0;
#pragma unroll
                for (int bj = 0; bj < 2; ++bj) { f32x4 v0 = acc[ai][bj][m][0], v1 = acc[ai][bj][m][1];
                    if (MODE == 1) {
#pragma unroll
                        for (int e = 0; e < 4; ++e) { v0[e] = sigmoidf_(v0[e]); v1[e] = sigmoidf_(v1[e]); } }
                    u32x4 w; w.x = pk2(v0[0], v0[1]); w.y = pk2(v0[2], v0[3]); w.z = pk2(v1[0], v1[1]); w.w = pk2(v1[2], v1[3]);
                    *(u32x4*)(rowp + bj * 128) = w; } }
    }
};
struct EpiIn {
    static constexpr bool INPLACE = false;
    bf16_t* Z; const float* wqn; const float* wkn; const float* nqn; const float* nkn; const float* cs0;
    __device__ __forceinline__ void operator()(const f32x4 (&acc)[2][2][4][2], const Unit& u, int wr, int wc, int fr, int fq) const {
        const int row0 = u.pm * 256 + wr * 64 + fr; const int T = u.pn;
        if (!win_head_tile(T)) {
            const int col0 = T * 256 + wc * 32 + 8 * fq;
#pragma unroll
            for (int ai = 0; ai < 2; ++ai)
#pragma unroll
                for (int m = 0; m < 4; ++m) { bf16_t* rowp = Z + (size_t)(row0 + ai * 128 + m * 16) * ZP + col0;
#pragma unroll
                    for (int bj = 0; bj < 2; ++bj) { const f32x4 v0 = acc[ai][bj][m][0], v1 = acc[ai][bj][m][1];
                        u32x4 w; w.x = pk2(v0[0], v0[1]); w.y = pk2(v0[2], v0[3]); w.z = pk2(v1[0], v1[1]); w.w = pk2(v1[2], v1[3]);
                        *(u32x4*)(rowp + bj * 128) = w; } }
            return;
        }
        const int hidx = (T < 2 ? T * 4 : (T < 9 ? 8 + (T - 6) * 4 : 18 + (T - 9) * 4)) + wc;
        const bool isv = (T == 8 && wc >= 2);
        const float* gain = (hidx < 8 || isv) ? nullptr : (hidx < 16 ? wqn : (hidx < 18 ? wkn : (hidx < 26 ? nqn : nkn)));
        const bool rope = (u.pm < ML / 256) && hidx < 18 && !isv;
        const float scale = isv ? 1.0f : ((hidx >= 4 && hidx < 8) ? 0.125f : (((hidx >= 8 && hidx < 16) || (hidx >= 18 && hidx < 26)) ? 0.125f * 1.4426950408889634f : 1.0f));
        const int col = T * 256 + wc * 64 + 8 * fq;
        f32x4 g0 = (f32x4){1.f, 1.f, 1.f, 1.f}, g1 = g0, g2 = g0, g3 = g0;
        if (gain) { g0 = *(const f32x4*)(gain + 8 * fq); g1 = *(const f32x4*)(gain + 8 * fq + 4); g2 = *(const f32x4*)(gain + 32 + 8 * fq); g3 = *(const f32x4*)(gain + 36 + 8 * fq); }
#pragma unroll
        for (int am = 0; am < 8; am += 2) {
            f32x4 c0[2], c1[2], s0[2], s1[2];
            if (rope) {
#pragma unroll
                for (int k = 0; k < 2; ++k) { const int ai = (am + k) >> 2, m = (am + k) & 3; const int t = (row0 + ai * 128 + m * 16) & 4095; const float* cs = cs0 + t * 32 + 8 * fq; const float* sn = cs + 4096 * 32;
                    c0[k] = *(const f32x4*)cs; c1[k] = *(const f32x4*)(cs + 4); s0[k] = *(const f32x4*)sn; s1[k] = *(const f32x4*)(sn + 4); } }
#pragma unroll
            for (int k = 0; k < 2; ++k) { const int ai = (am + k) >> 2, m = (am + k) & 3;
                f32x4 a0 = acc[ai][0][m][0], a1 = acc[ai][0][m][1], b0 = acc[ai][1][m][0], b1 = acc[ai][1][m][1];
                if (gain) {
                    const f32x4 q = a0 * a0 + a1 * a1 + b0 * b0 + b1 * b1; float ss = (q[0] + q[1]) + (q[2] + q[3]);
                    ss += __shfl_xor(ss, 16); ss += __shfl_xor(ss, 32);
                    const float r = rsqrtf(ss * (1.f / 64.f) + EPS);
                    a0 = a0 * (g0 * r); a1 = a1 * (g1 * r); b0 = b0 * (g2 * r); b1 = b1 * (g3 * r); }
                if (rope) { const f32x4 y0 = a0 * c0[k] - b0 * s0[k], y1 = a1 * c1[k] - b1 * s1[k], z0 = a0 * s0[k] + b0 * c0[k], z1 = a1 * s1[k] + b1 * c1[k]; a0 = y0; a1 = y1; b0 = z0; b1 = z1; }
                a0 = a0 * scale; a1 = a1 * scale; b0 = b0 * scale; b1 = b1 * scale;
                bf16_t* rowp = Z + (size_t)(row0 + ai * 128 + m * 16) * ZP + col;
                u32x4 w; w.x = pk2(a0[0], a0[1]); w.y = pk2(a0[2], a0[3]); w.z = pk2(a1[0], a1[1]); w.w = pk2(a1[2], a1[3]); *(u32x4*)rowp = w;
                w.x = pk2(b0[0], b0[1]); w.y = pk2(b0[2], b0[3]); w.z = pk2(b1[0], b1[1]); w.w = pk2(b1[2], b1[3]); *(u32x4*)(rowp + 32) = w;
            }
        }
    }
};
struct EpiGateF {
    static constexpr bool INPLACE = false;
    bf16_t* Z;
    __device__ __forceinline__ void operator()(const f32x4 (&acc)[2][2][4][2], const Unit& u, int wr, int wc, int fr, int fq) const {
        const int row0 = u.pm * 256 + wr * 64 + fr; const int cw = (u.pn & 3) * 64 + wc * 16 + fq * 4; const int ct = u.pn >> 2;
        const int c0 = dead_tile(ct) * 256 + cw, c1 = dead_tile(4 + ct) * 256 + cw, c2 = dead_tile(8 + ct) * 256 + cw, c3 = dead_tile(12 + ct) * 256 + cw;
#pragma unroll
        for (int ai = 0; ai < 2; ++ai)
#pragma unroll
            for (int m = 0; m < 4; ++m) { bf16_t* rowp = Z + (size_t)(row0 + ai * 128 + m * 16) * ZP;
                float f0[4], f1[4], f2[4], f3[4];
#pragma unroll
                for (int e = 0; e < 4; ++e) {
                    const float d0 = 1.0f + __expf(-acc[ai][0][m][0][e]), d1 = fminf(1.0f + __expf(-acc[ai][0][m][1][e]), 1e30f), d2 = fminf(1.0f + __expf(-acc[ai][1][m][0][e]), 1e30f), d3 = fminf(1.0f + __expf(-acc[ai][1][m][1][e]), 1e30f);
                    f0[e] = d1 * __builtin_amdgcn_rcpf(d0); f1[e] = d2 * __builtin_amdgcn_rcpf(d1); f2[e] = d3 * __builtin_amdgcn_rcpf(d2); f3[e] = __builtin_amdgcn_rcpf(d3); }
                u32x2 w;
                w.x = pk2(f0[0], f0[1]); w.y = pk2(f0[2], f0[3]); *(u32x2*)(rowp + c0) = w;
                w.x = pk2(f1[0], f1[1]); w.y = pk2(f1[2], f1[3]); *(u32x2*)(rowp + c1) = w;
                w.x = pk2(f2[0], f2[1]); w.y = pk2(f2[2], f2[3]); *(u32x2*)(rowp + c2) = w;
                w.x = pk2(f3[0], f3[1]); w.y = pk2(f3[2], f3[3]); *(u32x2*)(rowp + c3) = w; }
    }
};
struct EpiBranch {
    static constexpr bool INPLACE = true;
    bf16_t* ACC; const bf16_t* Z;
    __device__ __forceinline__ void operator()(f32x4 (&acc)[2][2][4][2], const Unit& u, int wr, int wc, int fr, int fq) const {
        const int row0 = u.pm * 256 + wr * 64 + fr; const int gcol0 = dead_tile(u.aux * 4 + u.pn) * 256 + wc * 32 + 8 * fq, col0 = u.pn * 256 + wc * 32 + 8 * fq;
        const bool lastb = (u.aux == 3);
#pragma unroll
        for (int ai = 0; ai < 2; ++ai) {
            u32x4 gw[4][2];
#pragma unroll
            for (int m = 0; m < 4; ++m)
#pragma unroll
                for (int bj = 0; bj < 2; ++bj) gw[m][bj] = *(const u32x4*)(Z + (size_t)(row0 + ai * 128 + m * 16) * ZP + gcol0 + bj * 128);
#pragma unroll
            for (int m = 0; m < 4; ++m)
#pragma unroll
                for (int bj = 0; bj < 2; ++bj) { const u32x4 g = gw[m][bj];
                    f32x4 v0 = acc[ai][bj][m][0], v1 = acc[ai][bj][m][1];
                    v0[0] *= bflo(g.x); v0[1] *= bfhi(g.x); v0[2] *= bflo(g.y); v0[3] *= bfhi(g.y); v1[0] *= bflo(g.z); v1[1] *= bfhi(g.z); v1[2] *= bflo(g.w); v1[3] *= bfhi(g.w);
                    if (lastb) { u32x4 w; w.x = pk2(v0[0], v0[1]); w.y = pk2(v0[2], v0[3]); w.z = pk2(v1[0], v1[1]); w.w = pk2(v1[2], v1[3]);
                        *(u32x4*)(ACC + (size_t)(row0 + ai * 128 + m * 16) * D + col0 + bj * 128) = w; v0 = (f32x4){0.f, 0.f, 0.f, 0.f}; v1 = v0; }
                    acc[ai][bj][m][0] = v0; acc[ai][bj][m][1] = v1; }
        }
    }
};
struct EpiResid {
    static constexpr bool INPLACE = false;
    const float* xl_src; const float* xc_src; float* xl_dst; float* xc_dst; const float* mod_g;
    __device__ __forceinline__ void operator()(const f32x4 (&acc)[2][2][4][2], const Unit& u, int wr, int wc, int fr, int fq) const {
        const int row0 = u.pm * 256 + wr * 64 + fr; const int col0 = u.pn * 256 + wc * 32 + 8 * fq;
        const bool lat = u.pm < ML / 256; const float* src = lat ? xl_src : xc_src - (size_t)ML * D; float* dst = lat ? xl_dst : xc_dst - (size_t)ML * D;
        const float* gv = mod_g + (size_t)(lat ? (u.pm >> 4) : 8) * 6144;
        f32x4 gg[2][2];
#pragma unroll
        for (int bj = 0; bj < 2; ++bj) { gg[bj][0] = *(const f32x4*)(gv + col0 + bj * 128); gg[bj][1] = *(const f32x4*)(gv + col0 + bj * 128 + 4); }
#pragma unroll
        for (int ai = 0; ai < 2; ++ai) {
            f32x4 xv[4][2][2];
#pragma unroll
            for (int m = 0; m < 4; ++m)
#pragma unroll
                for (int bj = 0; bj < 2; ++bj) { const size_t o = (size_t)(row0 + ai * 128 + m * 16) * D + col0 + bj * 128; xv[m][bj][0] = *(const f32x4*)(src + o); xv[m][bj][1] = *(const f32x4*)(src + o + 4); }
#pragma unroll
            for (int m = 0; m < 4; ++m)
#pragma unroll
                for (int bj = 0; bj < 2; ++bj) { const size_t o = (size_t)(row0 + ai * 128 + m * 16) * D + col0 + bj * 128;
                    *(f32x4*)(dst + o) = xv[m][bj][0] + gg[bj][0] * acc[ai][bj][m][0]; *(f32x4*)(dst + o + 4) = xv[m][bj][1] + gg[bj][1] * acc[ai][bj][m][1]; }
        }
    }
};
struct EpiAct {
    static constexpr bool INPLACE = false;
    bf16_t* ACT;
    __device__ __forceinline__ void operator()(const f32x4 (&acc)[2][2][4][2], const Unit& u, int wr, int wc, int fr, int fq) const {
        const int row0 = u.pm * 256 + wr * 64 + fr; const int col0 = u.pn * 128 + wc * 32 + 8 * fq;
#pragma unroll
        for (int ai = 0; ai < 2; ++ai)
#pragma unroll
            for (int m = 0; m < 4; ++m) { const f32x4 g0 = acc[ai][0][m][0], g1 = acc[ai][0][m][1], u0 = acc[ai][1][m][0], u1 = acc[ai][1][m][1];
                u32x4 w; w.x = pk2(silu_fast(g0[0]) * u0[0], silu_fast(g0[1]) * u0[1]); w.y = pk2(silu_fast(g0[2]) * u0[2], silu_fast(g0[3]) * u0[3]);
                w.z = pk2(silu_fast(g1[0]) * u1[0], silu_fast(g1[1]) * u1[1]); w.w = pk2(silu_fast(g1[2]) * u1[2], silu_fast(g1[3]) * u1[3]);
                *(u32x4*)(ACT + (size_t)(row0 + ai * 128 + m * 16) * DEXP + col0) = w; }
    }
};
constexpr int RT_WS = (1024 + 8) * 2;
constexpr int RT_LO = 32 * RT_WS, RT_BIAS = 2 * RT_LO, RT_SCR = RT_BIAS + 256, RT_SCR_W = 16 * 33 * 4 + 64;
__device__ __forceinline__ void phase_route(const KArgs& a, LAS unsigned char* lds, int l, int nrows) {
    const int tid = OTID(), lane = tid & 63, wave = tid >> 6, blk = OBLK(), G = OGRID(), g = lane >> 4, r16 = lane & 15;
    LAS unsigned* lcnt = (LAS unsigned*)(lds + RT_SCR + 8 * RT_SCR_W);
    LAS float* biasl = (LAS float*)(lds + RT_BIAS);
    LAS float* lg = (LAS float*)(lds + RT_SCR + wave * RT_SCR_W); LAS float* rsl = lg + 16 * 33;
    if (tid < 32) lcnt[tid] = 0u;
    const int ntile = nrows >> 4, per = (ntile + G - 1) / G, t0 = blk * per, t1 = (t0 + per < ntile) ? t0 + per : ntile;
    const float* xl = a.out; const float* xc = (const float*)(a.ws + WS_XC);
    unsigned* tokE = (unsigned*)(a.ws + WS_TOK + TOK_E); unsigned* tokS = (unsigned*)(a.ws + WS_TOK + TOK_SLOT); f32x2* tokW = (f32x2*)(a.ws + WS_TOK + TOK_W);
    float* tokR = (float*)(a.ws + WS_TOK + TOK_RSTD);
    int curb = -1;
    for (int tb = t0; tb < t1; tb += NWAVES) {
        const int tile = tb + wave; const bool act = tile < t1;
        const int bidx = row_modidx((tb << 4));
        const int blast = row_modidx(((tb + NWAVES - 1 < t1 ? tb + NWAVES - 1 : t1 - 1) << 4) + 15);
        for (int bsel = bidx; bsel <= blast; ++bsel) {
            if (bsel != curb) {
                __syncthreads();
                const float* mod = (const float*)(a.ws + WS_MOD) + (size_t)(l * 9 + bsel) * 6144; const float* gain = a.in[I_NORM2] + l * D;
                for (int idx = tid; idx < 32 * 1024; idx += NTHR) { const int e = idx >> 10, k = idx & 1023; const float w = a.in[I_WROUTER][k * 32 + e] * gain[k] * (1.0f + mod[4 * 1024 + k]);
                    const unsigned hi = pk2(w, w) & 0xffffu; const float lo = w - bf2f((bf16_t)hi);
                    *(LAS bf16_t*)(lds + e * RT_WS + k * 2) = (bf16_t)hi; *(LAS bf16_t*)(lds + RT_LO + e * RT_WS + k * 2) = (bf16_t)(pk2(lo, lo) & 0xffffu); }
                { const int e = tid & 31, part = tid >> 5; float s = 0.f;
                  for (int k = part * 64; k < part * 64 + 64; ++k) s += mod[3 * 1024 + k] * a.in[I_WROUTER][k * 32 + e];
                  LAS float* part_s = (LAS float*)(lds + RT_SCR); part_s[part * 32 + e] = s; }
                __syncthreads();
                if (tid < 32) { float s = 0.f; for (int p = 0; p < 16; ++p) s += ((LAS float*)(lds + RT_SCR))[p * 32 + tid]; biasl[tid] = s; }
                __syncthreads();
                curb = bsel;
            }
            if (act && row_modidx(tile << 4) == bsel) {
                const int row = (tile << 4) + r16;
                const float* xr = row < ML ? xl + (size_t)row * D : xc + (size_t)(row - ML) * D;
                f32x4 acc0 = (f32x4){0.f, 0.f, 0.f, 0.f}, acc1 = acc0; float ss = 0.f;
#pragma unroll 8
                for (int ks = 0; ks < 32; ++ks) {
                    const f32x4 xa = *(const f32x4*)(xr + ks * 32 + 8 * g), xb = *(const f32x4*)(xr + ks * 32 + 8 * g + 4);
                    ss += (xa.x * xa.x + xa.y * xa.y) + (xa.z * xa.z + xa.w * xa.w) + (xb.x * xb.x + xb.y * xb.y) + (xb.z * xb.z + xb.w * xb.w);
                    u32x4 hw; hw.x = pk2(xa.x, xa.y); hw.y = pk2(xa.z, xa.w); hw.z = pk2(xb.x, xb.y); hw.w = pk2(xb.z, xb.w);
                    u32x4 lw; lw.x = pk2(xa.x - bflo(hw.x), xa.y - bfhi(hw.x)); lw.y = pk2(xa.z - bflo(hw.y), xa.w - bfhi(hw.y)); lw.z = pk2(xb.x - bflo(hw.z), xb.y - bfhi(hw.z)); lw.w = pk2(xb.z - bflo(hw.w), xb.w - bfhi(hw.w));
                    const bf16x8 Ah = __builtin_bit_cast(bf16x8, hw), Al = __builtin_bit_cast(bf16x8, lw);
                    const LAS unsigned char* wp = lds + r16 * RT_WS + (ks * 32 + 8 * g) * 2;
                    const bf16x8 B0h = *(const LAS bf16x8*)wp, B1h = *(const LAS bf16x8*)(wp + 16 * RT_WS), B0l = *(const LAS bf16x8*)(wp + RT_LO), B1l = *(const LAS bf16x8*)(wp + RT_LO + 16 * RT_WS);
                    acc0 = __builtin_amdgcn_mfma_f32_16x16x32_bf16(Ah, B0h, acc0, 0, 0, 0); acc0 = __builtin_amdgcn_mfma_f32_16x16x32_bf16(Al, B0h, acc0, 0, 0, 0); acc0 = __builtin_amdgcn_mfma_f32_16x16x32_bf16(Ah, B0l, acc0, 0, 0, 0);
                    acc1 = __builtin_amdgcn_mfma_f32_16x16x32_bf16(Ah, B1h, acc1, 0, 0, 0); acc1 = __builtin_amdgcn_mfma_f32_16x16x32_bf16(Al, B1h, acc1, 0, 0, 0); acc1 = __builtin_amdgcn_mfma_f32_16x16x32_bf16(Ah, B1l, acc1, 0, 0, 0);
                }
                ss += __shfl_xor(ss, 16); ss += __shfl_xor(ss, 32);
                const float rstd = rsqrtf(ss * (1.f / 1024.f) + EPS);
                if (g == 0) { rsl[r16] = rstd; tokR[row] = rstd; }
                LDS_WAIT(); asm volatile("" ::: "memory");
#pragma unroll
                for (int j = 0; j < 4; ++j) { const float rs = rsl[4 * g + j]; lg[(4 * g + j) * 33 + r16] = acc0[j] * rs + biasl[r16]; lg[(4 * g + j) * 33 + 16 + r16] = acc1[j] * rs + biasl[16 + r16]; }
                LDS_WAIT(); asm volatile("" ::: "memory");
                if (lane < 16) {
                    const int rrow = (tile << 4) + lane;
                    float sc[32], bestg = -1e30f; int gi = 0;
#pragma unroll
                    for (int e = 0; e < 32; ++e) sc[e] = sigmoidf_(lg[lane * 33 + e]);
#pragma unroll
                    for (int gg = 0; gg < 8; ++gg) {
                        float s4[4];
#pragma unroll
                        for (int j = 0; j < 4; ++j) s4[j] = sc[gg * 4 + j] + a.in[I_RBIAS][gg * 4 + j];
                        const float m01 = fmaxf(s4[0], s4[1]), n01 = fminf(s4[0], s4[1]), m23 = fmaxf(s4[2], s4[3]), n23 = fminf(s4[2], s4[3]);
                        const float top = fmaxf(m01, m23), second = fmaxf(fminf(m01, m23), (m01 >= m23) ? n01 : n23);
                        const float gs = top + second;
                        if (gs > bestg) { bestg = gs; gi = gg; }
                    }
                    float s4[4], w4[4];
#pragma unroll
                    for (int j = 0; j < 4; ++j) { float sv = 0.f, wv = 0.f;
#pragma unroll
                        for (int gg = 0; gg < 8; ++gg) { if (gg == gi) { sv = sc[gg * 4 + j] + a.in[I_RBIAS][gg * 4 + j]; wv = sc[gg * 4 + j]; } }
                        s4[j] = sv; w4[j] = wv; }
                    int i0 = 0; float v0 = s4[0];
#pragma unroll
                    for (int j = 1; j < 4; ++j) if (s4[j] > v0) { v0 = s4[j]; i0 = j; }
                    int i1 = -1; float v1 = -1e30f;
#pragma unroll
                    for (int j = 0; j < 4; ++j) if (j != i0 && s4[j] > v1) { v1 = s4[j]; i1 = j; }
                    float w0 = 0.f, w1 = 0.f;
#pragma unroll
                    for (int j = 0; j < 4; ++j) { if (j == i0) w0 = w4[j]; if (j == i1) w1 = w4[j]; }
                    const float inv = 1.0f / (w0 + w1);
                    const int e0 = gi * 4 + i0, e1 = gi * 4 + i1;
                    const unsigned s0 = __hip_atomic_fetch_add(&lcnt[e0], 1u, __ATOMIC_RELAXED, __HIP_MEMORY_SCOPE_WORKGROUP), s1 = __hip_atomic_fetch_add(&lcnt[e1], 1u, __ATOMIC_RELAXED, __HIP_MEMORY_SCOPE_WORKGROUP);
                    tokE[rrow] = (unsigned)e0 | ((unsigned)e1 << 8); tokS[rrow] = s0 | (s1 << 16); tokW[rrow] = (f32x2){w0 * inv, w1 * inv};
                }
            }
        }
    }
    __syncthreads();
    if (tid < 32) ((unsigned*)(a.ws + WS_TOK + TOK_BCNT))[blk * 32 + tid] = lcnt[tid];
}

__device__ __forceinline__ void phase_gather(const KArgs& a, LAS unsigned char* lds, int l, int nrows) {
    const int tid = OTID(), lane = tid & 63, wave = tid >> 6, blk = OBLK(), G = OGRID();
    LAS unsigned* tot = (LAS unsigned*)lds;
    LAS unsigned* bef = tot + 32;
    LAS unsigned* base = tot + 64;
    const unsigned* bc = (const unsigned*)(a.ws + WS_TOK + TOK_BCNT);
    { LAS unsigned* ptot = tot + 96; LAS unsigned* pbef = ptot + 512;
      const int e = tid & 31, part = tid >> 5; unsigned t = 0u, bf = 0u;
#pragma unroll
      for (int k = 0; k < 16; ++k) { const int g = part * 16 + k; const unsigned c = (g < G) ? bc[g * 32 + e] : 0u; t += c; bf += (g < blk) ? c : 0u; }
      ptot[tid] = t; pbef[tid] = bf;
      __syncthreads();
      if (tid < 32) { unsigned tt = 0u, bb = 0u;
#pragma unroll
          for (int p = 0; p < 16; ++p) { tt += ptot[p * 32 + tid]; bb += pbef[p * 32 + tid]; }
          tot[tid] = tt; bef[tid] = bb; } }
    __syncthreads();
    if (tid == 0) {
        unsigned pos = 0u; int* tile_e = (int*)(a.ws + WS_TOK + TOK_TILE);
#pragma unroll 1
        for (int e = 0; e < 32; ++e) { base[e] = pos + bef[e]; const unsigned nt = (tot[e] + 255u) >> 8;
            if (blk == 0) tile_e[e] = (int)(pos >> 8);
            pos += nt << 8; }
        if (blk == 0) tile_e[32] = (int)(pos >> 8);
    }
    __syncthreads();
    const unsigned* tokE = (const unsigned*)(a.ws + WS_TOK + TOK_E); const unsigned* tokS = (const unsigned*)(a.ws + WS_TOK + TOK_SLOT); u32x2* tokP = (u32x2*)(a.ws + WS_TOK + TOK_POS);
    const float* tokR = (const float*)(a.ws + WS_TOK + TOK_RSTD);
    bf16_t* xb = (bf16_t*)(a.ws + WS_XB);
    const float* xl = a.out; const float* xc = (const float*)(a.ws + WS_XC);
    const int ntile = nrows >> 4, per = (ntile + G - 1) / G, r0 = blk * per * 16, r1 = ((blk + 1) * per * 16 < nrows) ? (blk + 1) * per * 16 : nrows;
    unsigned en = 0u, sn = 0u; float rn = 0.f;
    if (r0 + wave < r1) { en = tokE[r0 + wave]; sn = tokS[r0 + wave]; rn = tokR[r0 + wave]; }
    for (int row = r0 + wave; row < r1; row += NWAVES) {
        const unsigned e = en, s = sn; const float rstd_pre = rn;
        if (row + NWAVES < r1) { en = tokE[row + NWAVES]; sn = tokS[row + NWAVES]; rn = tokR[row + NWAVES]; }
        const unsigned p0 = base[e & 255u] + (s & 0xffffu), p1 = base[(e >> 8) & 255u] + (s >> 16);
        const float* xr = row < ML ? xl + (size_t)row * D : xc + (size_t)(row - ML) * D;
        const float rstd = rstd_pre;
        const float* mod = (const float*)(a.ws + WS_MOD) + (size_t)(l * 9 + row_modidx(row)) * 6144; const float* gain = a.in[I_NORM2] + l * D;
        f32x4 xv[4], gvv[4], s1v[4], s0v[4];
#pragma unroll
        for (int j = 0; j < 4; ++j) { xv[j] = ((const f32x4*)xr)[lane + 64 * j]; gvv[j] = ((const f32x4*)gain)[lane + 64 * j]; s1v[j] = ((const f32x4*)(mod + 4 * 1024))[lane + 64 * j]; s0v[j] = ((const f32x4*)(mod + 3 * 1024))[lane + 64 * j]; }
#pragma unroll
        for (int j = 0; j < 4; ++j) {
            const f32x4 x = xv[j], gv = gvv[j], s1 = s1v[j], s0 = s0v[j];
            const f32x4 y = (x * rstd * gv) * (s1 + 1.0f) + s0;
            u32x2 o; o.x = pk2(y.x, y.y); o.y = pk2(y.z, y.w);
            ((u32x2*)(xb + (size_t)p0 * D))[lane + 64 * j] = o; ((u32x2*)(xb + (size_t)p1 * D))[lane + 64 * j] = o;
        }
        if (lane == 0) tokP[row] = (u32x2){p0, p1};
    }
}

__device__ __forceinline__ void phase_combine(const KArgs& a, int l, int nrows) {
    const int tid = OTID(), lane = tid & 63, wave = tid >> 6;
    const int gw = OBLK() * NWAVES + wave, NGW = OGRID() * NWAVES;
    const u32x2* tokP = (const u32x2*)(a.ws + WS_TOK + TOK_POS); const f32x2* tokW = (const f32x2*)(a.ws + WS_TOK + TOK_W);
    const bf16_t* yb = (const bf16_t*)(a.ws + WS_YB); bf16_t* hl = (bf16_t*)(a.ws + WS_HL);
    u32x2 pn = (u32x2){0u, 0u}; f32x2 wn = (f32x2){0.f, 0.f};
    if (gw < nrows) { pn = tokP[gw]; wn = tokW[gw]; }
    for (int row = gw; row < nrows; row += NGW) {
        float* xr = row < ML ? a.out + (size_t)row * D : (float*)(a.ws + WS_XC) + (size_t)(row - ML) * D;
        const u32x2 p = pn; const f32x2 w = wn;
        if (row + NGW < nrows) { pn = tokP[row + NGW]; wn = tokW[row + NGW]; }
        const float* mod = (const float*)(a.ws + WS_MOD) + (size_t)(l * 9 + row_modidx(row)) * 6144;
        f32x4 v[4];
        f32x4 xv[4], g2v[4]; u32x2 y0v[4], y1v[4];
#pragma unroll
        for (int j = 0; j < 4; ++j) { xv[j] = ((const f32x4*)xr)[lane + 64 * j]; g2v[j] = ((const f32x4*)(mod + 5 * 1024))[lane + 64 * j];
            y0v[j] = ((const u32x2*)(yb + (size_t)p.x * D))[lane + 64 * j]; y1v[j] = ((const u32x2*)(yb + (size_t)p.y * D))[lane + 64 * j]; }
#pragma unroll
        for (int j = 0; j < 4; ++j) {
            const f32x4 x = xv[j], g2 = g2v[j];
            const u32x2 y0 = y0v[j], y1 = y1v[j];
            f32x4 m; m.x = w.x * bflo(y0.x) + w.y * bflo(y1.x); m.y = w.x * bfhi(y0.x) + w.y * bfhi(y1.x); m.z = w.x * bflo(y0.y) + w.y * bflo(y1.y); m.w = w.x * bfhi(y0.y) + w.y * bfhi(y1.y);
            v[j] = x + g2 * m; ((f32x4*)xr)[lane + 64 * j] = v[j];
        }
        if (l == 0) { const float* mod1 = (const float*)(a.ws + WS_MOD) + (size_t)(9 + row_modidx(row)) * 6144;
            modulate_store(v, a.in[I_NORM1] + D, mod1, mod1 + 1024, hl + (size_t)row * D, lane); }
    }
}
#ifndef MK_PER_PHASE
#define MK_PER_PHASE 0
#endif
#ifndef PROBE_DUP
#define PROBE_DUP 0
#endif
#define DUPON(k) ((PROBE_DUP >> (k)) & 1)
#define DUPBAR() do { if (use_bar) xcd_barrier(bar); } while (0)
#ifndef RERUN_K
#define RERUN_K 0
#endif
#define RERUN(k, l, ctx_out, mrows) do { if (RERUN_K == (k)) { DUPBAR(); ph_modulate1(ka, (l), MA); DUPBAR(); ph_gemm_in(ka, lds, (l)); DUPBAR(); ph_prep(ka, (l)); \
        if ((k) >= 3) { DUPBAR(); ph_mixers(ka, lds, (l), ctx_out); } if ((k) >= 4) { DUPBAR(); ph_gdnscan(ka, lds, (l), ctx_out, (l) + 2); } \
        if ((k) >= 5) { DUPBAR(); ph_post(ka, lds, (l), mrows); } } } while (0)
constexpr int NPH_LAYER = 14, NPHASES = 1 + 2 * NPH_LAYER;

#ifndef STAG_TICKS
#define STAG_TICKS 0
#endif
__device__ __forceinline__ void stagger(int mult) { const int g = (OBLK() >> 3) & 3; if (g == 0 || STAG_TICKS == 0) return; const unsigned long long lim = (unsigned long long)(g * mult);
    const unsigned long long t0 = __builtin_amdgcn_s_memrealtime(); while (__builtin_amdgcn_s_memrealtime() - t0 < lim) __builtin_amdgcn_s_sleep(4); }
__device__ NOINL void ph_prologue(KAP ka, LAS unsigned char* lds) { const KArgs a = load_kargs(ka); phase_prologue(a, lds); }
__device__ NOINL void ph_modulate1(KAP ka, int l, int nrows) { const KArgs a = load_kargs(ka); phase_modulate1(a, l, nrows); }
__device__ NOINL void ph_prep(KAP ka, int l) { const KArgs a = load_kargs(ka); phase_prep(a, l); }
__device__ NOINL void ph_mixers(KAP ka, LAS unsigned char* lds, int l, bool ctx_out) { phase_mixers(ka, lds, l, ctx_out); }
__device__ NOINL void ph_gdnscan(KAP ka, LAS unsigned char* lds, int l, bool ctx_out, int qslot) { phase_scan_attn(ka, lds, l, ctx_out, qslot); }
__device__ NOINL void ph_post(KAP ka, LAS unsigned char* lds, int l, int mrows) { { const int blk = OBLK(), G = OGRID(); const int nu = (mrows == ML) ? 32 * 32 : 32 * 34;
      if (!(R3_IN_M2 && G > 64)) for (int v = G - 1 - blk; v < nu; v += G) { const int u = (mrows == ML) ? (v >> 5) * 34 + 2 + (v & 31) : v; call_retout(ka, lds, l, u); } }
    __syncthreads(); const KArgs a = load_kargs(ka); phase_post(a, lds, l, mrows); }
__device__ NOINL void ph_gemm_in(KAP ka, LAS unsigned char* lds, int l) { const KArgs a = load_kargs(ka);
    const bf16_t* wsm = (const bf16_t*)(a.ws + WS_WSM);
    SchedPlain S; S.init(a.ws + WS_HL, 1024, wsm + WSM_IN / 2, 1024, MA, ZP, OGRID(), OBLK());
    EpiIn E{(bf16_t*)(a.ws + WS_Z), a.in[I_WQN] + l * 64, a.in[I_WKN] + l * 64, a.in[I_NQN] + l * 64, a.in[I_NKN] + l * 64, (const float*)(a.ws + WS_ROPE)};
    pg8::gemm_phase<EpiIn, SchedPlain, true>(lds, 1024, 1024, 1024, S, E); }
#ifndef PROBE_GK
#define PROBE_GK 0
#endif
__device__ NOINL void ph_gemm_in_probe(KAP ka, LAS unsigned char* lds, int l) { const KArgs a = load_kargs(ka);
    const bf16_t* wsm = (const bf16_t*)(a.ws + WS_WSM);
    SchedPlain S; S.init(a.ws + WS_HL, 1024, wsm + WSM_IN / 2, 1024, MA, ZP, OGRID(), OBLK());
    EpiStore<0> E{(bf16_t*)(a.ws + WS_Z), ZP};
    pg8::gemm_phase<EpiStore<0>, SchedPlain, true>(lds, PROBE_GK, 1024, 1024, S, E); }
__device__ NOINL void ph_gemm_gate(KAP ka, LAS unsigned char* lds, int l, int mrows) { const KArgs a = load_kargs(ka);
    const bf16_t* wsm = (const bf16_t*)(a.ws + WS_WSM);
    SchedPlain S; S.init(a.ws + WS_HL, 1024, wsm + WSM_MERGE / 2, 1024, mrows, 4096, OGRID(), OBLK());
    EpiGateF E{(bf16_t*)(a.ws + WS_Z)};
    pg8::gemm_phase<EpiGateF, SchedPlain, true>(lds, 1024, 1024, 1024, S, E); }
__device__ NOINL void ph_gemm_branch(KAP ka, LAS unsigned char* lds, int l, int mrows) { const KArgs a = load_kargs(ka);
    const bf16_t* wsm = (const bf16_t*)(a.ws + WS_WSM);
    SchedBranch S{(const char*)(a.ws + WS_Z), (const char*)(wsm + WSM_BR / 2), (mrows / 256) * 4, OGRID(), OBLK()};
    EpiBranch E{(bf16_t*)(a.ws + WS_HL), (const bf16_t*)(a.ws + WS_Z)};
    pg8::gemm_phase<EpiBranch, SchedBranch, true>(lds, 512, ZP, 512, S, E); }
__device__ NOINL void ph_gemm_out(KAP ka, LAS unsigned char* lds, int l, int mrows) { const KArgs a = load_kargs(ka);
    const bf16_t* wsm = (const bf16_t*)(a.ws + WS_WSM);
    SchedPlain S; S.init(a.ws + WS_HL, 1024, wsm + WSM_OUT / 2, 1024, mrows, 1024, OGRID(), OBLK());
    EpiResid E{l == 0 ? a.in[I_X] : a.out, l == 0 ? a.in[I_CTX] : (const float*)(a.ws + WS_XC), a.out, (float*)(a.ws + WS_XC), (const float*)(a.ws + WS_MOD) + (size_t)l * 9 * 6144 + 2 * 1024};
    pg8::gemm_phase<EpiResid, SchedPlain, true>(lds, 1024, 1024, 1024, S, E); }
#ifndef EXPC_SPLIT
#define EXPC_SPLIT 14000
#endif
__device__ NOINL void ph_expconv(KAP ka, LAS unsigned char* lds, int l, int lo, int hi, int blk0) { const KArgs a = load_kargs(ka); expert_convert_range(a, lds, l, lo, hi, blk0); }
__device__ NOINL void ph_route(KAP ka, LAS unsigned char* lds, int l, int mrows) { const KArgs a = load_kargs(ka); phase_route(a, lds, l, mrows); if (l == 0) { __syncthreads(); small_weight_convert(a, lds, 1); } }
__device__ NOINL void ph_gather(KAP ka, LAS unsigned char* lds, int l, int mrows) { const KArgs a = load_kargs(ka); phase_gather(a, lds, l, mrows); }
__device__ NOINL void ph_gemm_gu(KAP ka, LAS unsigned char* lds) { const KArgs a = load_kargs(ka);
    const int* tile_e = (const int*)(a.ws + WS_TOK + TOK_TILE);
    SchedMoe S; S.A0 = (const char*)(a.ws + WS_XB); S.W0 = (const char*)(a.ws + WS_WGU); S.tile_start = tile_e; S.tA = (size_t)256 * 1024 * 2; S.eB = (size_t)1024 * 1024 * 2; S.tB = (size_t)256 * 1024 * 2; S.G = OGRID(); S.c = OBLK(); S.init();
    EpiAct E{(bf16_t*)(a.ws + WS_ACT)};
    pg8::gemm_phase<EpiAct, SchedMoe, true>(lds, 1024, 1024, 1024, S, E); }
__device__ NOINL void ph_gemm_dn(KAP ka, LAS unsigned char* lds) { const KArgs a = load_kargs(ka);
    const int* tile_e = (const int*)(a.ws + WS_TOK + TOK_TILE);
    SchedMoe S; S.A0 = (const char*)(a.ws + WS_ACT); S.W0 = (const char*)(a.ws + WS_WDN); S.tile_start = tile_e; S.tA = (size_t)256 * 512 * 2; S.eB = (size_t)1024 * 512 * 2; S.tB = (size_t)256 * 512 * 2; S.G = OGRID(); S.c = OBLK(); S.init();
    EpiStore<0> E{(bf16_t*)(a.ws + WS_YB), 1024};
    pg8::gemm_phase<EpiStore<0>, SchedMoe, true>(lds, 512, 512, 512, S, E); }
__device__ NOINL void ph_combine(KAP ka, int l, int mrows) { const KArgs a = load_kargs(ka); phase_combine(a, l, mrows); }

__global__ void __launch_bounds__(NTHR, 2) fwd_kernel(KArgs a) {
    extern __shared__ __attribute__((aligned(16))) unsigned char lds_raw[];
    LAS unsigned char* lds = (LAS unsigned char*)lds_raw;
    KAP ka = (KAP)__builtin_amdgcn_kernarg_segment_ptr();
    const int tid = OTID();
    volatile LAS unsigned* ctlw = (volatile LAS unsigned*)(lds + LDS_CTL);
    if (tid < 64) ctlw[tid] = 0u;
    __syncthreads();
    const int lo = a.ph_lo, hi = a.ph_hi;
    const bool use_bar = (hi - lo) > 1;
    XcdBarrier bar; bar.bar = (unsigned*)(a.ws + WS_CTL) + CW_BAR; bar.x = 0u; bar.st = ctlw + 8;
    if (use_bar) bar = xcd_barrier_post((unsigned*)(a.ws + WS_CTL) + CW_BAR, ctlw + 8);
#define IN(k) (lo <= (k) && (k) < hi)
#define SEAM(k) do { if (use_bar && (k) + 1 < hi) xcd_barrier(bar); } while (0)
    if (IN(0)) { ph_prologue(ka, lds); SEAM(0); }
#define LAYER_BODY(l) do { \
        constexpr int pb = 1 + (l) * NPH_LAYER; constexpr bool ctx_out = ((l) == 0); constexpr int mrows = ctx_out ? MA : ML; \
        if ((l) == 0 && IN(pb + 0)) { ph_modulate1(ka, (l), MA); SEAM(pb + 0); }     \
        if (IN(pb + 1)) { if (PROBE_GK) { ph_gemm_in_probe(ka, lds, (l)); DUPBAR(); } ph_gemm_in(ka, lds, (l)); if (RERUN_K == 1) { DUPBAR(); ph_modulate1(ka, (l), MA); DUPBAR(); ph_gemm_in(ka, lds, (l)); } SEAM(pb + 1); } \
        if (IN(pb + 2)) { ph_prep(ka, (l)); RERUN(2, l, ctx_out, mrows); SEAM(pb + 2); } \
        if (IN(pb + 3)) { ph_mixers(ka, lds, (l), ctx_out); RERUN(3, l, ctx_out, mrows); SEAM(pb + 3); } \
        if (IN(pb + 4)) { ph_gdnscan(ka, lds, (l), ctx_out, (l)); RERUN(4, l, ctx_out, mrows); SEAM(pb + 4); } \
        if (IN(pb + 5)) { ph_post(ka, lds, (l), mrows); RERUN(5, l, ctx_out, mrows); SEAM(pb + 5); } \
        if (IN(pb + 6)) { ph_gemm_gate(ka, lds, (l), mrows); if ((l) == 0) ph_expconv(ka, lds, (l), 0, 4400, 128); SEAM(pb + 6); } \
        if (IN(pb + 7)) { ph_gemm_branch(ka, lds, (l), mrows); if ((l) == 0) ph_expconv(ka, lds, (l), 4400, 4400 + EXPC_SPLIT, 32); SEAM(pb + 7); } \
        if (IN(pb + 8)) { ph_gemm_out(ka, lds, (l), mrows); ph_expconv(ka, lds, (l), (l) == 0 ? 4400 + EXPC_SPLIT : 0, EXPC_ITEMS, (l) == 0 ? 32 : 0);     SEAM(pb + 8); } \
        if (IN(pb + 9)) { ph_route(ka, lds, (l), mrows); if (DUPON(9)) { DUPBAR(); ph_route(ka, lds, (l), mrows); } SEAM(pb + 9); } \
        if (IN(pb + 10)) { ph_gather(ka, lds, (l), mrows); if (DUPON(10)) { DUPBAR(); ph_gather(ka, lds, (l), mrows); } SEAM(pb + 10); } \
        if (IN(pb + 11)) { ph_gemm_gu(ka, lds); if (DUPON(11)) { DUPBAR(); ph_gemm_gu(ka, lds); } SEAM(pb + 11); } \
        if (IN(pb + 12)) { ph_gemm_dn(ka, lds); if (DUPON(12)) { DUPBAR(); ph_gemm_dn(ka, lds); } if (RERUN_K == 12) { DUPBAR(); ph_route(ka, lds, (l), mrows); DUPBAR(); ph_gather(ka, lds, (l), mrows); DUPBAR(); ph_gemm_gu(ka, lds); DUPBAR(); ph_gemm_dn(ka, lds); } SEAM(pb + 12); } \
        if (IN(pb + 13)) { ph_combine(ka, (l), mrows); SEAM(pb + 13); } \
    } while (0)
    LAYER_BODY(0);
    LAYER_BODY(1);
#undef LAYER_BODY
#undef IN
#undef SEAM
}

extern "C" void kernel_launch(void* const* d_in, const int* in_sizes, int n_in, void* d_out, int out_size, void* d_ws, size_t ws_size, hipStream_t stream) {
    static int grid = 0;
    if (grid == 0) {
        if (n_in != 29 || in_sizes[0] != ML * D || out_size != ML * D || ws_size < WS_END) {
            fprintf(stderr, "kernel_launch: unexpected problem (n_in %d, in0 %d, out %d, ws %zu < %zu); nothing launched\n", n_in, n_in > 0 ? in_sizes[0] : -1, out_size, ws_size, (size_t)WS_END); grid = -1; return; }
        int dev = 0, cus = 0, per_cu = 0;
        if (hipGetDevice(&dev) != hipSuccess || hipDeviceGetAttribute(&cus, hipDeviceAttributeMultiprocessorCount, dev) != hipSuccess) { grid = -1; return; }
        if (hipFuncSetAttribute((const void*)fwd_kernel, hipFuncAttributeMaxDynamicSharedMemorySize, LDS_BYTES) != hipSuccess) { fprintf(stderr, "kernel_launch: hipFuncSetAttribute failed\n"); grid = -1; return; }
        if (hipOccupancyMaxActiveBlocksPerMultiprocessor(&per_cu, (const void*)fwd_kernel, NTHR, LDS_BYTES) != hipSuccess || per_cu < 1) {
            fprintf(stderr, "kernel_launch: occupancy query says %d workgroups per CU\n", per_cu); }
        (void)hipGetLastError();
        grid = cus;
        if (grid > 256) grid = 256;
    }
    if (grid < 0) return;
    if (hipMemsetAsync((char*)d_ws + WS_CTL, 0, CTL_ZERO_BYTES, stream) != hipSuccess) return;
    KArgs a{};
    for (int i = 0; i < 29; ++i) a.in[i] = (const float*)d_in[i];
    a.out = (float*)d_out; a.ws = (unsigned char*)d_ws;
#if MK_PER_PHASE
    for (int k = 0; k < NPHASES; ++k) { if (k == 1 + NPH_LAYER) continue; a.ph_lo = k; a.ph_hi = k + 1; hipLaunchKernelGGL(fwd_kernel, dim3(grid), dim3(NTHR), LDS_BYTES, stream, a); }
#else
    a.ph_lo = 0; a.ph_hi = NPHASES;
    hipLaunchKernelGGL(fwd_kernel, dim3(grid), dim3(NTHR), LDS_BYTES, stream, a);
#endif
}
```
